# Optimizing an MI355X kernel written in HIP

```python
import jax
import jax.numpy as jnp
from jax import lax
import numpy as np

D_MODEL = 1024
BATCH = 8
SEQ = 2048
DEPTH = 2

GRID_W = 64
CTX_LEN = 256
N_EVEN = (DEPTH + 1) // 2
N_ODD = DEPTH // 2
NORM_EPS = 1e-6

HEAD_DIM = 128
N_Q_HEADS = 8
N_KV_HEADS = 2
Q_PER_KV = N_Q_HEADS // N_KV_HEADS
ATTN_W = N_Q_HEADS * HEAD_DIM
KV_W = N_KV_HEADS * HEAD_DIM
ROPE_THETA = 10000.0
ROPE_PAIRS_PER_AXIS = HEAD_DIM // 4
Q_BLOCK = 128

CONV_W = D_MODEL
CONV_TAPS = 3

PROJ_SPLITS = (ATTN_W, ATTN_W + KV_W, ATTN_W + 2 * KV_W,
               ATTN_W + 2 * KV_W + CONV_W, ATTN_W + 2 * KV_W + 2 * CONV_W)
PROJ_W = ATTN_W + 2 * KV_W + 3 * CONV_W
MIX_OUT_W = ATTN_W + CONV_W

RW_N = 64
RW_H = D_MODEL // RW_N
DECAY_LORA = 64
ICLR_LORA = 64
GATE_LORA = 128
GN_EPS = 64e-5

N_EXPERTS = 16
D_EXPERT = 1024
EC_CAPACITY = 2

kernel_name = "hybrid_diffusion_attnconv_rwkv7_ecmoe"


def _rms(t, g):
    tf = t.astype(jnp.float32)
    y = tf * lax.rsqrt(jnp.mean(tf * tf, axis=-1, keepdims=True) + NORM_EPS)
    return (y * g.astype(jnp.float32)).astype(t.dtype)


def _ada(t, g, shift, scale):
    return _rms(t, g) * (1.0 + scale) + shift


def _conv3(u, w):
    up = jnp.pad(u, ((0, 0), (1, 1), (0, 0)))
    return up[:, :-2] * w[0] + up[:, 1:-1] * w[1] + up[:, 2:] * w[2]


def _neighbour_mean(h):
    hp = jnp.pad(h, ((0, 0), (1, 1), (0, 0)))
    return 0.5 * (hp[:, :-2] + hp[:, 2:])


def _axial_rope(n):
    rows = n // GRID_W
    row = jnp.broadcast_to(jnp.arange(rows)[:, None], (rows, GRID_W)).reshape(-1).astype(jnp.float32)
    col = jnp.broadcast_to(jnp.arange(GRID_W)[None, :], (rows, GRID_W)).reshape(-1).astype(jnp.float32)
    inv = ROPE_THETA ** (-jnp.arange(ROPE_PAIRS_PER_AXIS, dtype=jnp.float32) / ROPE_PAIRS_PER_AXIS)
    ang = jnp.concatenate([row[:, None] * inv, col[:, None] * inv], axis=-1)
    return jnp.cos(ang), jnp.sin(ang)


def _rope(t, cos, sin):
    tf = t.astype(jnp.float32)
    half = HEAD_DIM // 2
    t1, t2 = tf[..., :half], tf[..., half:]
    c = cos[None, :, None, :]
    s = sin[None, :, None, :]
    return jnp.concatenate([t1 * c - t2 * s, t2 * c + t1 * s], axis=-1).astype(t.dtype)


def _attend(q, k, v):
    b, tq = q.shape[:2]
    qg = q.reshape(b, tq, N_KV_HEADS, Q_PER_KV, HEAD_DIM)
    s = jnp.einsum('bqhgd,bkhd->bhgqk', qg, k).astype(jnp.float32) * (HEAD_DIM ** -0.5)
    p = jax.nn.softmax(s, axis=-1).astype(v.dtype)
    o = jnp.einsum('bhgqk,bkhd->bqhgd', p, v)
    return o.reshape(b, tq, ATTN_W)


def _block_attention(q, k, v):
    b, n = q.shape[:2]
    nb = n // Q_BLOCK
    qb = jnp.moveaxis(q.reshape(b, nb, Q_BLOCK, N_Q_HEADS, HEAD_DIM), 1, 0)
    ob = lax.map(lambda qi: _attend(qi, k, v), qb)
    return jnp.moveaxis(ob, 0, 1).reshape(b, n, ATTN_W)


def _attn_conv_mixer(h, hc, w_in, w_out, q_g, k_g, conv_w, cos, sin, need_ctx):
    b, n, _ = h.shape
    lc = hc.shape[1]
    q, k, v, gb, gc, xc = jnp.split(h @ w_in, PROJ_SPLITS, axis=-1)
    q = _rope(_rms(q.reshape(b, n, N_Q_HEADS, HEAD_DIM), q_g), cos, sin)
    k = _rope(_rms(k.reshape(b, n, N_KV_HEADS, HEAD_DIM), k_g), cos, sin)
    v = v.reshape(b, n, N_KV_HEADS, HEAD_DIM)
    if need_ctx:
        qc, kc, vc, gbc, gcc, xcc = jnp.split(hc @ w_in, PROJ_SPLITS, axis=-1)
    else:
        kc, vc = jnp.split(hc @ w_in[:, ATTN_W:ATTN_W + 2 * KV_W], 2, axis=-1)
    kc = _rms(kc.reshape(b, lc, N_KV_HEADS, HEAD_DIM), k_g)
    vc = vc.reshape(b, lc, N_KV_HEADS, HEAD_DIM)
    k_all = jnp.concatenate([kc, k], axis=1)
    v_all = jnp.concatenate([vc, v], axis=1)
    o_attn = _block_attention(q, k_all, v_all)
    o_conv = gb * _conv3(gc * xc, conv_w)
    y = jnp.concatenate([o_attn, o_conv], axis=-1) @ w_out
    if not need_ctx:
        return y, None
    qc = _rms(qc.reshape(b, lc, N_Q_HEADS, HEAD_DIM), q_g)
    oc_attn = _attend(qc, kc, vc)
    oc_conv = gbc * _conv3(gcc * xcc, conv_w)
    yc = jnp.concatenate([oc_attn, oc_conv], axis=-1) @ w_out
    return y, yc


def _heads(t):
    return t.reshape(t.shape[:-1] + (RW_H, RW_N))


def _rwkv_features(h, mu, w_k, w_v, w0, w1, w2, a0, a1, a2, k_k, k_a):
    xx = _neighbour_mean(h) - h
    k = ((h + xx * mu[2]) @ w_k).astype(jnp.float32)
    v = ((h + xx * mu[3]) @ w_v).astype(jnp.float32)
    xw = h + xx * mu[1]
    xa = h + xx * mu[4]
    kk = _heads(k * k_k.astype(jnp.float32))
    kk = kk * lax.rsqrt(jnp.maximum(jnp.sum(kk * kk, axis=-1, keepdims=True), 1e-24))
    dirs = []
    for d in range(2):
        w_log = -jax.nn.softplus(-(w0[d] + jnp.tanh(xw @ w1[d]) @ w2[d]).astype(jnp.float32)) - 0.5
        a = jax.nn.sigmoid((a0[d] + (xa @ a1[d]) @ a2[d]).astype(jnp.float32))
        kd = k * (1.0 + (a - 1.0) * k_a.astype(jnp.float32))
        dirs.append((_heads(jnp.exp(-jnp.exp(w_log))), _heads(kd), _heads(a)))
    return xx, _heads(v), kk, dirs


def _rwkv_scan(s0, decay, kd, v, kk, a, r, reverse):
    emit = r is not None
    seq = (decay, kd, v, kk, a) + ((r,) if emit else ())
    seq = tuple(jnp.moveaxis(t, 1, 0) for t in seq)

    def step(s, inp):
        w_t, k_t, v_t, kk_t, a_t = inp[:5]
        s_kk = jnp.einsum('bhvk,bhk->bhv', s, kk_t)
        s = (s * w_t[:, :, None, :] - s_kk[..., None] * (kk_t * a_t)[:, :, None, :]
             + v_t[..., None] * k_t[:, :, None, :])
        y_t = jnp.einsum('bhvk,bhk->bhv', s, inp[5]) if emit else None
        return s, y_t

    s_final, ys = lax.scan(step, s0, seq, reverse=reverse)
    return s_final, (jnp.moveaxis(ys, 0, 1) if emit else None)


def _rwkv_readout(h, xx, y_fwd, y_bwd, r, v, kd_fwd, kd_bwd, mu_g, g1, g2, r_k, ln_w, ln_b, w_o):
    y = y_fwd + y_bwd
    mean = jnp.mean(y, axis=-1, keepdims=True)
    var = jnp.mean(jnp.square(y - mean), axis=-1, keepdims=True)
    y = ((y - mean) * lax.rsqrt(var + GN_EPS)).reshape(h.shape) * ln_w + ln_b
    rk = r_k.astype(jnp.float32)
    bonus = (jnp.sum(r * kd_fwd * rk, axis=-1, keepdims=True)
             + jnp.sum(r * kd_bwd * rk, axis=-1, keepdims=True)) * v
    g = jax.nn.sigmoid((h + xx * mu_g) @ g1) @ g2
    return ((y + bonus.reshape(h.shape)).astype(h.dtype) * g) @ w_o


def _rwkv_mixer(h, hc, mu, w_r, w_k, w_v, w_o, w0, w1, w2, a0, a1, a2, g1, g2,
                k_k, k_a, r_k, ln_w, ln_b, need_ctx):
    xx, v, kk, dirs = _rwkv_features(h, mu, w_k, w_v, w0, w1, w2, a0, a1, a2, k_k, k_a)
    xxc, vc, kkc, dirsc = _rwkv_features(hc, mu, w_k, w_v, w0, w1, w2, a0, a1, a2, k_k, k_a)
    r = _heads(((h + xx * mu[0]) @ w_r).astype(jnp.float32))
    rc = _heads(((hc + xxc * mu[0]) @ w_r).astype(jnp.float32)) if need_ctx else None
    s0 = jnp.zeros((h.shape[0], RW_H, RW_N, RW_N), jnp.float32)
    ys, ycs = [], []
    for d, reverse in enumerate((False, True)):
        dec, kd, a = dirs[d]
        decc, kdc, ac = dirsc[d]
        s_ctx, yc = _rwkv_scan(s0, decc, kdc, vc, kkc, ac, rc, reverse)
        _, y = _rwkv_scan(s_ctx, dec, kd, v, kk, a, r, reverse)
        ys.append(y)
        ycs.append(yc)
    out = _rwkv_readout(h, xx, ys[0], ys[1], r, v, dirs[0][1], dirs[1][1],
                        mu[5], g1, g2, r_k, ln_w, ln_b, w_o)
    if not need_ctx:
        return out, None
    out_c = _rwkv_readout(hc, xxc, ycs[0], ycs[1], rc, vc, dirsc[0][1], dirsc[1][1],
                          mu[5], g1, g2, r_k, ln_w, ln_b, w_o)
    return out, out_c


def _ec_moe(h, router, w_gate, w_up, w_down):
    b, n, d = h.shape
    cap = EC_CAPACITY * n // N_EXPERTS
    aff = jax.nn.softmax((h @ router).astype(jnp.float32), axis=-1)
    top_aff, top_idx = lax.top_k(jnp.swapaxes(aff, 1, 2), cap)
    xs = jax.vmap(lambda hb, ib: hb[ib])(h, top_idx)
    gate = jnp.einsum('becd,edf->becf', xs, w_gate)
    up = jnp.einsum('becd,edf->becf', xs, w_up)
    out = jnp.einsum('becf,efd->becd', jax.nn.silu(gate) * up, w_down)
    out = out * top_aff[..., None].astype(out.dtype)
    flat = (jnp.arange(b)[:, None, None] * n + top_idx).reshape(-1)
    y = jnp.zeros((b * n, d), out.dtype).at[flat].add(out.reshape(-1, d))
    return y.reshape(b, n, d)


def setup_inputs(seed: int = 0) -> dict:
    key = jax.random.key(seed)
    ks = iter(jax.random.split(key, 40))
    D = D_MODEL

    def nrm(shape, scale):
        return scale * jax.random.normal(next(ks), shape, jnp.float32)

    return {
        "x": nrm((BATCH, SEQ, D), 1.0),
        "c": nrm((BATCH, D), 1.0),
        "ctx": nrm((BATCH, CTX_LEN, D), 1.0),
        "c_ctx": nrm((D,), 1.0),
        "ada_w": nrm((DEPTH, D, 6 * D), 0.5 * D ** -0.5),
        "ada_b": nrm((DEPTH, 6 * D), 0.02),
        "norm_g": 1.0 + nrm((DEPTH, 2, D), 0.05),
        "final_g": 1.0 + nrm((D,), 0.05),
        "mix_w_in": nrm((N_EVEN, D, PROJ_W), D ** -0.5),
        "mix_w_out": nrm((N_EVEN, MIX_OUT_W, D), MIX_OUT_W ** -0.5),
        "q_norm_g": 1.0 + nrm((N_EVEN, HEAD_DIM), 0.05),
        "k_norm_g": 1.0 + nrm((N_EVEN, HEAD_DIM), 0.05),
        "conv_w": nrm((N_EVEN, CONV_TAPS, CONV_W), CONV_TAPS ** -0.5),
        "rw_mu": jax.random.uniform(next(ks), (N_ODD, 6, D), jnp.float32),
        "rw_w_r": nrm((N_ODD, D, D), D ** -0.5),
        "rw_w_k": nrm((N_ODD, D, D), D ** -0.5),
        "rw_w_v": nrm((N_ODD, D, D), D ** -0.5),
        "rw_w_o": nrm((N_ODD, D, D), D ** -0.5),
        "rw_w0": -1.0 + nrm((N_ODD, 2, D), 0.5),
        "rw_w1": nrm((N_ODD, 2, D, DECAY_LORA), D ** -0.5),
        "rw_w2": nrm((N_ODD, 2, DECAY_LORA, D), 0.5 * DECAY_LORA ** -0.5),
        "rw_a0": nrm((N_ODD, 2, D), 0.1),
        "rw_a1": nrm((N_ODD, 2, D, ICLR_LORA), D ** -0.5),
        "rw_a2": nrm((N_ODD, 2, ICLR_LORA, D), 0.5 * ICLR_LORA ** -0.5),
        "rw_g1": nrm((N_ODD, D, GATE_LORA), D ** -0.5),
        "rw_g2": nrm((N_ODD, GATE_LORA, D), GATE_LORA ** -0.5),
        "rw_k_k": 0.85 + nrm((N_ODD, D), 0.05),
        "rw_k_a": 1.0 + nrm((N_ODD, D), 0.05),
        "rw_r_k": nrm((N_ODD, RW_H, RW_N), 0.1),
        "rw_ln_w": 1.0 + nrm((N_ODD, D), 0.05),
        "rw_ln_b": nrm((N_ODD, D), 0.02),
        "moe_router": nrm((DEPTH, D, N_EXPERTS), D ** -0.5),
        "moe_w_gate": nrm((DEPTH, N_EXPERTS, D, D_EXPERT), D ** -0.5),
        "moe_w_up": nrm((DEPTH, N_EXPERTS, D, D_EXPERT), D ** -0.5),
        "moe_w_down": nrm((DEPTH, N_EXPERTS, D_EXPERT, D), D_EXPERT ** -0.5),
    }


def reference(x, c, ctx, c_ctx, ada_w, ada_b, norm_g, final_g,
              mix_w_in, mix_w_out, q_norm_g, k_norm_g, conv_w,
              rw_mu, rw_w_r, rw_w_k, rw_w_v, rw_w_o, rw_w0, rw_w1, rw_w2,
              rw_a0, rw_a1, rw_a2, rw_g1, rw_g2, rw_k_k, rw_k_a, rw_r_k, rw_ln_w, rw_ln_b,
              moe_router, moe_w_gate, moe_w_up, moe_w_down):
    n = x.shape[1]
    cos, sin = _axial_rope(n)
    for i in range(DEPTH):
        need_ctx = i < DEPTH - 1
        mod = jax.nn.silu(c) @ ada_w[i] + ada_b[i]
        mod_c = jax.nn.silu(c_ctx) @ ada_w[i] + ada_b[i]
        sh1, sc1, gt1, sh2, sc2, gt2 = jnp.split(mod[:, None, :], 6, axis=-1)
        sh1c, sc1c, gt1c, sh2c, sc2c, gt2c = jnp.split(mod_c, 6, axis=-1)

        h = _ada(x, norm_g[i, 0], sh1, sc1)
        hc = _ada(ctx, norm_g[i, 0], sh1c, sc1c)
        j = i // 2
        if i % 2 == 0:
            y, yc = _attn_conv_mixer(h, hc, mix_w_in[j], mix_w_out[j], q_norm_g[j], k_norm_g[j],
                                     conv_w[j], cos, sin, need_ctx)
        else:
            y, yc = _rwkv_mixer(h, hc, rw_mu[j], rw_w_r[j], rw_w_k[j], rw_w_v[j], rw_w_o[j],
                                rw_w0[j], rw_w1[j], rw_w2[j], rw_a0[j], rw_a1[j], rw_a2[j],
                                rw_g1[j], rw_g2[j], rw_k_k[j], rw_k_a[j], rw_r_k[j],
                                rw_ln_w[j], rw_ln_b[j], need_ctx)
        x = x + gt1 * y
        x = x + gt2 * _ec_moe(_ada(x, norm_g[i, 1], sh2, sc2),
                              moe_router[i], moe_w_gate[i], moe_w_up[i], moe_w_down[i])
        if need_ctx:
            ctx = ctx + gt1c * yc
            ctx = ctx + gt2c * _ec_moe(_ada(ctx, norm_g[i, 1], sh2c, sc2c),
                                       moe_router[i], moe_w_gate[i], moe_w_up[i], moe_w_down[i])
    return _rms(x, final_g)
```

```cpp
#include <hip/hip_runtime.h>
#include <cstdio>
#include <cstdint>

#define GAS __attribute__((address_space(1)))
#define LAS __attribute__((address_space(3)))
typedef unsigned short bf16_t;
typedef short bf16x8 __attribute__((ext_vector_type(8)));
typedef short s16x4 __attribute__((ext_vector_type(4)));
typedef float f32x4 __attribute__((ext_vector_type(4)));
typedef float f32x2 __attribute__((ext_vector_type(2)));
typedef float f32x8 __attribute__((ext_vector_type(8)));
typedef float f32x16 __attribute__((ext_vector_type(16)));
typedef unsigned u32x4 __attribute__((ext_vector_type(4)));
typedef unsigned u32x2 __attribute__((ext_vector_type(2)));

constexpr int NB = 8, SEQ = 2048, CTXL = 256, DM = 1024;
constexpr int ML = NB * SEQ, MC = NB * CTXL, MT = ML + MC;
constexpr int PROJ = 4608, NE = 16;
constexpr int KVL = CTXL + SEQ;
constexpr int CAPL = 256, CAPC = 32, SL0 = NB * CAPL + NB * CAPC  , SL1 = NB * CAPL  ;

constexpr size_t MiB = 1u << 20;
constexpr size_t WS_CTL = 0;
constexpr size_t CTL_BAR_WORD = 4096;
constexpr size_t WS_MOD = 512 * 1024;
constexpr size_t WS_AFF = 2 * MiB;
constexpr size_t WS_TOKSLOT = 4 * MiB;
constexpr size_t WS_SELAFF = 6 * MiB;
constexpr size_t WS_WIN_T = 8 * MiB;
constexpr size_t WS_WOUT_T = 17 * MiB;
constexpr size_t WS_WR_T = 21 * MiB, WS_WK_T = 23 * MiB, WS_WV_T = 25 * MiB, WS_WO_T = 27 * MiB;
constexpr size_t WS_WL1_T = 29 * MiB;
constexpr size_t WS_W2T = 31 * MiB;
constexpr size_t WS_A2T = WS_W2T + 256 * 1024, WS_G2T = WS_W2T + 512 * 1024;
constexpr size_t WS_WMOE = 32 * MiB;
constexpr size_t WS_WGU_T = WS_WMOE, WS_WD_T = WS_WMOE + 64 * MiB;
constexpr size_t AB = 128 * MiB;
constexpr size_t WS_P = AB + 0 * MiB;
constexpr size_t WS_H = AB + 162 * MiB;
constexpr size_t WS_AO = AB + 198 * MiB;
constexpr size_t WS_Q = AB + 270 * MiB;
constexpr size_t WS_KA = AB + 306 * MiB, WS_VA = AB + 315 * MiB;
constexpr size_t WS_X1 = AB + 0 * MiB;
constexpr size_t WS_XS0 = AB + 72 * MiB, WS_YS0 = AB + 72 * MiB;
constexpr size_t WS_ACT0 = AB + 198 * MiB;
constexpr size_t WS_X2 = AB + 308 * MiB;
constexpr size_t WS_XR = AB + 0 * MiB, WS_XK = AB + 32 * MiB, WS_XV = AB + 68 * MiB, WS_XW = AB + 104 * MiB, WS_XA = AB + 198 * MiB, WS_XG = AB + 234 * MiB;
constexpr size_t WS_RB = WS_WMOE, WS_KB = WS_WMOE + 32 * MiB, WS_T1 = WS_WMOE + 68 * MiB;
constexpr size_t WS_VB = AB + 380 * MiB;
constexpr size_t WS_KK = AB + 0 * MiB, WS_LD = AB + 36 * MiB, WS_AA = AB + 108 * MiB;
constexpr size_t WS_Y = AB + 180 * MiB;
constexpr size_t WS_Z = AB + 0 * MiB;
constexpr size_t WS_X3 = AB + 36 * MiB;
constexpr size_t WS_H2 = AB + 108 * MiB;
constexpr size_t WS_XS1 = AB + 180 * MiB, WS_YS1 = AB + 180 * MiB, WS_ACT1 = AB + 244 * MiB;
constexpr size_t WS_END = AB + 416 * MiB;

constexpr int RING_BYTES = 131072, LDSCTL_OFF = RING_BYTES, MISC_OFF = LDSCTL_OFF + 320, LDS_BYTES = 147456;

#define LDS_WAIT() asm volatile("s_waitcnt lgkmcnt(0)" ::: "memory")
#define VM_WAIT() asm volatile("s_waitcnt vmcnt(0)" ::: "memory")
__device__ __forceinline__ float bf2f(unsigned b) { return __uint_as_float(b << 16); }
__device__ __forceinline__ unsigned f2bf(float f) { unsigned u = __float_as_uint(f); return (u + 0x7fffu + ((u >> 16) & 1u)) >> 16; }
__device__ __forceinline__ unsigned pk2(float lo, float hi) { return f2bf(lo) | (f2bf(hi) << 16); }
__device__ __forceinline__ float wave_sum(float v) {
#pragma unroll
    for (int o = 1; o < 64; o <<= 1) v += __shfl_xor(v, o);
    return v;
}
__device__ __forceinline__ int wave_sum_i(int v) {
#pragma unroll
    for (int o = 1; o < 64; o <<= 1) v += __shfl_xor(v, o);
    return v;
}
__device__ __forceinline__ float sigmoidf_(float x) { return 1.0f / (1.0f + __expf(-x)); }
__device__ __forceinline__ f32x4 unpk4(u32x2 w) { return (f32x4){bf2f(w.x & 0xffffu), bf2f(w.x >> 16), bf2f(w.y & 0xffffu), bf2f(w.y >> 16)}; }
__device__ __forceinline__ u32x2 pk4(f32x4 v) { u32x2 w; w.x = pk2(v.x, v.y); w.y = pk2(v.z, v.w); return w; }

#define XB_TMO      128
#define XB_XCNT(j)  (256  + 64 * (j))
#define XB_XSUB(j)  (1280 + 64 * (j))
#define XB_XGEN(j)  (2304 + 64 * (j))
#define XB_TOP      3328
#define XB_TOPGEN   3392
#define XCD_BAR_WORDS 3456
#define XB_SPIN_CAP (1u << 18)
__device__ __forceinline__ unsigned xb_ld(unsigned* p)              { return __hip_atomic_load(p, __ATOMIC_RELAXED, __HIP_MEMORY_SCOPE_AGENT); }
__device__ __forceinline__ unsigned xb_add(unsigned* p, unsigned v) { return __hip_atomic_fetch_add(p, v, __ATOMIC_RELAXED, __HIP_MEMORY_SCOPE_AGENT); }
__device__ __forceinline__ unsigned xb_xcc_id() { return (unsigned)__builtin_amdgcn_s_getreg((3 << 11) | 20) & 0xFu; }
#define XB_SPIN(cond, bar) do { unsigned _sp = 0; while (cond) { __builtin_amdgcn_s_sleep(1); \
    if ((++_sp & 255u) == 0u) { if (xb_ld(&(bar)[XB_TMO])) break; if (_sp > XB_SPIN_CAP) { atomicAdd(&(bar)[XB_TMO], 1u); break; } } } } while (0)
struct XcdBarrier { unsigned* bar; unsigned x; volatile LAS unsigned* st; };
__device__ __forceinline__ XcdBarrier xcd_barrier_post(unsigned* bar, volatile LAS unsigned* st) {
    XcdBarrier b; b.bar = bar; b.x = xb_xcc_id(); b.st = st;
    if (threadIdx.x == 0) (void)xb_add(&bar[XB_XCNT(b.x)], 1u);
    return b;
}
__device__ __forceinline__ void xcd_barrier_complete(unsigned* bar, unsigned x, unsigned& nloc, unsigned& nx) {
    const unsigned G = gridDim.x * gridDim.y * gridDim.z;
    unsigned sum, cnt, mine, sp = 0u;
    for (;;) {
        sum = 0u; cnt = 0u; mine = 0u;
#pragma unroll
        for (unsigned j = 0; j < 16; ++j) { const unsigned c = xb_ld(&bar[XB_XCNT(j)]); sum += c; cnt += (c > 0u) ? 1u : 0u; mine = (j == x) ? c : mine; }
        if (sum == G) break;
        __builtin_amdgcn_s_sleep(1);
        if ((++sp & 255u) == 0u) { if (xb_ld(&bar[XB_TMO])) break; if (sp > XB_SPIN_CAP) { atomicAdd(&bar[XB_TMO], 1u); break; } }
    }
    nloc = mine > 0u ? mine : 1u; nx = cnt > 0u ? cnt : 1u;
}
__device__ __forceinline__ void xcd_barrier(const XcdBarrier& b) {
    asm volatile("s_waitcnt vmcnt(0)" ::: "memory");
    __syncthreads();
    if (threadIdx.x == 0) {
        unsigned* bar = b.bar;
        __builtin_amdgcn_s_waitcnt(0);
        unsigned nloc = b.st[0], nx = b.st[1];
        if (nloc == 0u) { xcd_barrier_complete(bar, b.x, nloc, nx); b.st[0] = nloc; b.st[1] = nx; }
        const unsigned old = xb_add(&bar[XB_XSUB(b.x)], 1u);
        const unsigned gen = old / nloc;
        if (old + 1u == (gen + 1u) * nloc) {
            __builtin_amdgcn_fence(__ATOMIC_RELEASE, "agent");
            asm volatile("s_waitcnt vmcnt(0)" ::: "memory");
            const unsigned og = xb_add(&bar[XB_TOP], 1u);
            const unsigned tg = og / nx;
            if (og + 1u == (tg + 1u) * nx) xb_add(&bar[XB_TOPGEN], 1u);
            else XB_SPIN(xb_ld(&bar[XB_TOPGEN]) == tg, bar);
            __builtin_amdgcn_fence(__ATOMIC_ACQUIRE, "agent");
            xb_add(&bar[XB_XGEN(b.x)], 1u);
            asm volatile("s_waitcnt vmcnt(0)" ::: "memory");
        } else {
            XB_SPIN(xb_ld(&bar[XB_XGEN(b.x)]) == gen, bar);
            __builtin_amdgcn_fence(__ATOMIC_ACQUIRE, "agent");
            asm volatile("s_waitcnt vmcnt(0)" ::: "memory");
        }
    }
    __syncthreads();
}

namespace pg8 {
constexpr int BM = 256, BK = 64, HALF = 128, HTB = HALF * BK * 2, STAGE_BYTES = 8 * HTB;
__host__ __device__ __forceinline__ int lds_byte(int r, int c) { const int st = (r >> 4) * 2 + (c >> 5), rr = r & 15, cc = c & 31, ob = rr * 64 + cc * 2; return st * 1024 + (ob ^ (((ob >> 9) & 1) << 5)); }
__host__ __device__ __forceinline__ void stage_rc(int b, int& R, int& C) { const int st = b / 1024, sb = b % 1024, swz = sb ^ (((sb >> 9) & 1) << 5); R = (st >> 1) * 16 + swz / 64; C = (st & 1) * 32 + (swz % 64) / 2; }
__host__ __device__ __forceinline__ int perm32(int rho) { const int n = rho >> 4, i = rho & 15; return 8 * (i >> 2) + 4 * n + (i & 3); }
struct Unit { int pm, pn, gi; };
__device__ __forceinline__ unsigned cvt_pk_bf16(float lo, float hi) { unsigned r; asm volatile("v_cvt_pk_bf16_f32 %0, %1, %2" : "=v"(r) : "v"(lo), "v"(hi)); return r; }

template <class Epi, class Sched>
__device__ __forceinline__ void gemm_phase(LAS unsigned char* lds, const int K, const Sched& S, const Epi& E) {
    const int tid = threadIdx.x, wid = __builtin_amdgcn_readfirstlane(tid >> 6), lane = tid & 63, wr = wid >> 2, wc = wid & 3, fr = lane & 15, fq = lane >> 4;
    const int nt = K / BK;
    unsigned voffA[2], voffB[2];
#pragma unroll
    for (int i = 0; i < 2; ++i) { int R, C; stage_rc(tid * 16 + i * 8192, R, C); const int Rb = Epi::PERM ? ((R & ~31) + perm32(R & 31)) : R;
        voffA[i] = (unsigned)(R * K + C) * 2u; voffB[i] = (unsigned)(Rb * K + C) * 2u; }
    const size_t kstep = (size_t)(BK * 2);
    const size_t hstep = (size_t)HALF * K * 2;
    const unsigned ldsw = (unsigned)wid * 1024u;
    const int aoff = lds_byte(wr * 64 + fr, fq * 8), boff = lds_byte(wc * 32 + fr, fq * 8);
#define PG8_SA(b, h) (((b) * 2 + (h)) * HTB)
#define PG8_SB(b, h) ((4 + (b) * 2 + (h)) * HTB)
#define PG8_STAGE(bufoff, gbase, voff) do { _Pragma("unroll") for (int _i = 0; _i < 2; ++_i) \
        __builtin_amdgcn_global_load_lds((const unsigned*)((const char*)(gbase) + (voff)[_i]), (LAS unsigned*)(lds + (bufoff) + ldsw + _i * 8192), 16, 0, 0); } while (0)
#define PG8_LDA(dst, b, h) do { _Pragma("unroll") for (int m = 0; m < 4; ++m) _Pragma("unroll") for (int k = 0; k < 2; ++k) dst[m][k] = *(const LAS bf16x8*)(lds + PG8_SA(b, h) + aoff + m * 2048 + k * 1024); } while (0)
#define PG8_LDB(dst, b, h) do { _Pragma("unroll") for (int n = 0; n < 2; ++n) _Pragma("unroll") for (int k = 0; k < 2; ++k) dst[n][k] = *(const LAS bf16x8*)(lds + PG8_SB(b, h) + boff + n * 2048 + k * 1024); } while (0)
#define PG8_MMA(ai, bj, At, Bt) do { __builtin_amdgcn_s_setprio(1); _Pragma("unroll") for (int m = 0; m < 4; ++m) _Pragma("unroll") for (int n = 0; n < 2; ++n) _Pragma("unroll") for (int k = 0; k < 2; ++k) \
        acc[ai][bj][m][n] = __builtin_amdgcn_mfma_f32_16x16x32_bf16(Bt[n][k], At[m][k], acc[ai][bj][m][n], 0, 0, 0); __builtin_amdgcn_s_setprio(0); } while (0)
#define PG8_WAIT_V(n) asm volatile("s_waitcnt vmcnt(" #n ")" ::: "memory")
#define PG8_WAIT_L(n) asm volatile("s_waitcnt lgkmcnt(" #n ")" ::: "memory")
#define PG8_BAR __builtin_amdgcn_s_barrier()
#define PG8_SCHED __builtin_amdgcn_sched_barrier(0)
    Unit cur, nxt; int ui = 0;
    if (!S.next(0, cur)) return;
    f32x4 acc[2][2][4][2];
#pragma unroll
    for (int a = 0; a < 2; ++a)
#pragma unroll
        for (int b = 0; b < 2; ++b)
#pragma unroll
            for (int m = 0; m < 4; ++m)
#pragma unroll
                for (int n = 0; n < 2; ++n) acc[a][b][m][n] = (f32x4){0.f, 0.f, 0.f, 0.f};
    bf16x8 At[4][2], B0[2][2], B1[2][2];
    const char* cA = S.a_base(cur); const char* cB = S.b_base(cur);
    PG8_STAGE(PG8_SB(0, 0), cB, voffB); PG8_STAGE(PG8_SA(0, 0), cA, voffA); PG8_STAGE(PG8_SB(0, 1), cB + hstep, voffB); PG8_STAGE(PG8_SA(0, 1), cA + hstep, voffA);
    if (wr == 1) PG8_BAR;
    PG8_WAIT_V(4); PG8_BAR;
    PG8_STAGE(PG8_SB(1, 0), cB + kstep, voffB); PG8_STAGE(PG8_SA(1, 0), cA + kstep, voffA); PG8_STAGE(PG8_SB(1, 1), cB + hstep + kstep, voffB);
    PG8_WAIT_V(6); PG8_BAR;
    for (;;) {
        const bool has_next = S.next(ui + 1, nxt);
        const char* nA = has_next ? S.a_base(nxt) : cA; const char* nB = has_next ? S.b_base(nxt) : cB;
        for (int t = 0; t < nt; t += 2) {
            const bool last = (t == nt - 2);
            const char* a1 = cA + (size_t)(t + 1) * kstep;
            const char* a2 = last ? nA : cA + (size_t)(t + 2) * kstep; const char* b2 = last ? nB : cB + (size_t)(t + 2) * kstep;
            const char* a3 = a2 + kstep; const char* b3 = b2 + kstep;
            PG8_LDB(B0, 0, 0); PG8_SCHED; PG8_LDA(At, 0, 0); PG8_STAGE(PG8_SA(1, 1), a1 + hstep, voffA);
            PG8_WAIT_L(8); PG8_BAR; PG8_WAIT_L(0); PG8_MMA(0, 0, At, B0); PG8_BAR; PG8_SCHED;
            PG8_LDB(B1, 0, 1); PG8_STAGE(PG8_SB(0, 0), b2, voffB);
            PG8_BAR; PG8_WAIT_L(0); PG8_MMA(0, 1, At, B1); PG8_BAR;
            PG8_LDA(At, 0, 1); PG8_STAGE(PG8_SA(0, 0), a2, voffA);
            PG8_BAR; PG8_WAIT_L(0); PG8_MMA(1, 0, At, B0); PG8_BAR; PG8_SCHED;
            PG8_STAGE(PG8_SB(0, 1), b2 + hstep, voffB);
            PG8_WAIT_V(6); PG8_BAR; PG8_MMA(1, 1, At, B1); PG8_BAR;
            PG8_LDB(B0, 1, 0); PG8_SCHED; PG8_LDA(At, 1, 0); PG8_STAGE(PG8_SA(0, 1), a2 + hstep, voffA);
            PG8_WAIT_L(8); PG8_BAR; PG8_WAIT_L(0); PG8_MMA(0, 0, At, B0); PG8_BAR; PG8_SCHED;
            PG8_LDB(B1, 1, 1); PG8_STAGE(PG8_SB(1, 0), b3, voffB);
            PG8_BAR; PG8_WAIT_L(0); PG8_MMA(0, 1, At, B1); PG8_BAR;
            PG8_LDA(At, 1, 1); PG8_STAGE(PG8_SA(1, 0), a3, voffA);
            PG8_BAR; PG8_WAIT_L(0); PG8_MMA(1, 0, At, B0); PG8_BAR; PG8_SCHED;
            PG8_STAGE(PG8_SB(1, 1), b3 + hstep, voffB);
            PG8_WAIT_V(6); PG8_BAR; PG8_MMA(1, 1, At, B1); PG8_BAR;
        }
        E(acc, cur, wr, wc, fr, fq);
        if (!has_next) break;
#pragma unroll
        for (int a = 0; a < 2; ++a)
#pragma unroll
            for (int b = 0; b < 2; ++b)
#pragma unroll
                for (int m = 0; m < 4; ++m)
#pragma unroll
                    for (int n = 0; n < 2; ++n) acc[a][b][m][n] = (f32x4){0.f, 0.f, 0.f, 0.f};
        cur = nxt; cA = nA; cB = nB; ++ui;
    }
    PG8_WAIT_V(0);
    if (wr == 0) PG8_BAR;
    PG8_BAR;
#undef PG8_SA
#undef PG8_SB
#undef PG8_STAGE
#undef PG8_LDA
#undef PG8_LDB
#undef PG8_MMA
#undef PG8_WAIT_V
#undef PG8_WAIT_L
#undef PG8_BAR
#undef PG8_SCHED
}
}
struct Params { const float* in[35]; float* out; unsigned char* ws; int ph_lo, ph_hi; };
enum { I_X = 0, I_C, I_CTX, I_CCTX, I_ADAW, I_ADAB, I_NORMG, I_FINALG, I_WIN, I_WOUT, I_QG, I_KG, I_CONVW, I_MU, I_WR, I_WK, I_WV, I_WO, I_W0, I_W1, I_W2,
       I_A0, I_A1, I_A2, I_G1, I_G2, I_KK, I_KA, I_RK, I_LNW, I_LNB, I_ROUTER, I_WGATE, I_WUP, I_WDOWN };

struct OrderSingle {
    const char* A; const char* Bt; int nM, nN, nwg, G, c; size_t tstep;
    __device__ __forceinline__ void init(const void* A_, const void* Bt_, int M, int N, int K, int G_, int c_) { A = (const char*)A_; Bt = (const char*)Bt_; nM = M / 256; nN = N / 256; nwg = nM * nN; G = G_; c = c_; tstep = (size_t)256 * K * 2; }
    __device__ __forceinline__ bool next(int i, pg8::Unit& u) const {
        const long L = (long)i * G + c; if (L >= nwg) return false;
        int wgid = (int)L; { const int q = nwg / 8, r = nwg % 8, xcd = wgid % 8, off = wgid / 8; wgid = (xcd < r ? xcd * (q + 1) : r * (q + 1) + (xcd - r) * q) + off; }
        const int nig = 8 * nN, gid = wgid / nig, fm = gid * 8, gsz = (nM - fm) < 8 ? (nM - fm) : 8;
        u.pm = fm + ((wgid % nig) % gsz); u.pn = (wgid % nig) / gsz; u.gi = 0; return true;
    }
    __device__ __forceinline__ const char* a_base(const pg8::Unit& u) const { return A + (size_t)u.pm * tstep; }
    __device__ __forceinline__ const char* b_base(const pg8::Unit& u) const { return Bt + (size_t)u.pn * tstep; }
};
struct OrderMoe {
    const char* A; const char* Bt; int PM, PN, nwg, G, c; size_t tstep;
    __device__ __forceinline__ void init(const void* A_, const void* Bt_, int PM_, int PN_, int K, int G_, int c_) { A = (const char*)A_; Bt = (const char*)Bt_; PM = PM_; PN = PN_; nwg = NE * PM * PN; G = G_; c = c_; tstep = (size_t)256 * K * 2; }
    __device__ __forceinline__ bool next(int i, pg8::Unit& u) const {
        const int L = i * G + c; if (L >= nwg) return false;
        const int per = PM * PN, e = L / per, r = L % per; u.pm = e * PM + (r % PM); u.pn = e * PN + (r / PM); u.gi = e; return true;
    }
    __device__ __forceinline__ const char* a_base(const pg8::Unit& u) const { return A + (size_t)u.pm * tstep; }
    __device__ __forceinline__ const char* b_base(const pg8::Unit& u) const { return Bt + (size_t)u.pn * tstep; }
};
struct OrderRkv {
    const char *A0, *A1, *A2, *A3, *A4, *A5, *B0, *B1, *B2, *B3; int G, c;
    __device__ __forceinline__ bool next(int i, pg8::Unit& u) const {
        int L = i * G + c; if (L >= 1040) return false;
        int gi, nM;
        if (L < 256) { gi = 0; nM = 64; } else if (L < 544) { gi = 1; nM = 72; L -= 256; } else if (L < 832) { gi = 2; nM = 72; L -= 544; }
        else if (L < 904) { gi = 3; nM = 72; L -= 832; } else if (L < 976) { gi = 4; nM = 72; L -= 904; } else { gi = 5; nM = 64; L -= 976; }
        u.gi = gi; u.pm = L % nM; u.pn = L / nM; return true;
    }
    __device__ __forceinline__ const char* a_base(const pg8::Unit& u) const {
        const char* a = u.gi == 0 ? A0 : u.gi == 1 ? A1 : u.gi == 2 ? A2 : u.gi == 3 ? A3 : u.gi == 4 ? A4 : A5; return a + (size_t)u.pm * (256 * 1024 * 2); }
    __device__ __forceinline__ const char* b_base(const pg8::Unit& u) const {
        const char* b = u.gi == 0 ? B0 : u.gi == 1 ? B1 : u.gi == 2 ? B2 : B3 + (size_t)(u.gi - 3) * (256 * 1024 * 2); return b + (size_t)u.pn * (256 * 1024 * 2); }
};

typedef f32x4 Acc[2][2][4][2];
__device__ __forceinline__ u32x4 pack8(f32x4 v0, f32x4 v1) { u32x4 w; w.x = pg8::cvt_pk_bf16(v0[0], v0[1]); w.y = pg8::cvt_pk_bf16(v0[2], v0[3]); w.z = pg8::cvt_pk_bf16(v1[0], v1[1]); w.w = pg8::cvt_pk_bf16(v1[2], v1[3]); return w; }
struct EpiStore {
    static constexpr bool PERM = true;
    bf16_t* O; int ldc;
    __device__ __forceinline__ void operator()(const Acc& acc, const pg8::Unit& u, int wr, int wc, int fr, int fq) const {
        const int row0 = u.pm * 256 + wr * 64 + fr, col0 = u.pn * 256 + wc * 32 + 8 * fq;
#pragma unroll
        for (int ai = 0; ai < 2; ++ai)
#pragma unroll
            for (int m = 0; m < 4; ++m) { bf16_t* rowp = O + (size_t)(row0 + ai * 128 + m * 16) * ldc + col0;
#pragma unroll
                for (int bj = 0; bj < 2; ++bj) *(u32x4*)(rowp + bj * 128) = pack8(acc[ai][bj][m][0], acc[ai][bj][m][1]); }
    }
};
struct EpiResid {
    static constexpr bool PERM = false;
    const float* baseL; const float* baseC; float* O; const float* gate;
    __device__ __forceinline__ void operator()(const Acc& acc, const pg8::Unit& u, int wr, int wc, int fr, int fq) const {
        const int row0 = u.pm * 256 + wr * 64 + fr, col0 = u.pn * 256 + wc * 32 + 4 * fq;
        const int mr = u.pm < 64 ? (u.pm >> 3) : 8;
        const float* gt = gate + (size_t)mr * 6144;
        f32x4 g4[2][2];
#pragma unroll
        for (int bj = 0; bj < 2; ++bj)
#pragma unroll
            for (int n = 0; n < 2; ++n) g4[bj][n] = *(const f32x4*)(gt + col0 + bj * 128 + n * 16);
#pragma unroll
        for (int ai = 0; ai < 2; ++ai)
#pragma unroll
            for (int m = 0; m < 4; ++m) { const int row = row0 + ai * 128 + m * 16;
                const float* bp = (row < ML ? baseL + (size_t)row * DM : baseC + (size_t)(row - ML) * DM) + col0; float* op = O + (size_t)row * DM + col0;
#pragma unroll
                for (int bj = 0; bj < 2; ++bj)
#pragma unroll
                    for (int n = 0; n < 2; ++n) { const f32x4 b = *(const f32x4*)(bp + bj * 128 + n * 16); *(f32x4*)(op + bj * 128 + n * 16) = b + g4[bj][n] * acc[ai][bj][m][n]; }
                asm volatile("" ::: "memory"); }
    }
};
struct EpiAct {
    static constexpr bool PERM = true;
    bf16_t* O;
    __device__ __forceinline__ void operator()(const Acc& acc, const pg8::Unit& u, int wr, int wc, int fr, int fq) const {
        const int row0 = u.pm * 256 + wr * 64 + fr, f0 = (u.pn & 7) * 128 + wc * 32 + 8 * fq;
#pragma unroll
        for (int ai = 0; ai < 2; ++ai)
#pragma unroll
            for (int m = 0; m < 4; ++m) { bf16_t* rowp = O + (size_t)(row0 + ai * 128 + m * 16) * DM + f0;
                f32x4 o[2];
#pragma unroll
                for (int n = 0; n < 2; ++n) { const f32x4 g = acc[ai][0][m][n], up = acc[ai][1][m][n];
#pragma unroll
                    for (int j = 0; j < 4; ++j) o[n][j] = g[j] * sigmoidf_(g[j]) * up[j]; }
                *(u32x4*)rowp = pack8(o[0], o[1]); }
    }
};
struct EpiYs {
    static constexpr bool PERM = true;
    bf16_t* O; const float* selaff;
    __device__ __forceinline__ void operator()(const Acc& acc, const pg8::Unit& u, int wr, int wc, int fr, int fq) const {
        const int row0 = u.pm * 256 + wr * 64 + fr, col0 = (u.pn & 3) * 256 + wc * 32 + 8 * fq;
#pragma unroll
        for (int ai = 0; ai < 2; ++ai)
#pragma unroll
            for (int m = 0; m < 4; ++m) { const int row = row0 + ai * 128 + m * 16; const float s = selaff[row]; bf16_t* rowp = O + (size_t)row * DM + col0;
#pragma unroll
                for (int bj = 0; bj < 2; ++bj) *(u32x4*)(rowp + bj * 128) = pack8(acc[ai][bj][m][0] * s, acc[ai][bj][m][1] * s); }
    }
};
struct EpiRkv {
    static constexpr bool PERM = true;
    bf16_t *R, *K, *V, *T1;
    __device__ __forceinline__ void operator()(const Acc& acc, const pg8::Unit& u, int wr, int wc, int fr, int fq) const {
        const int row0 = u.pm * 256 + wr * 64 + fr;
        if (u.gi < 3) {
            bf16_t* O = u.gi == 0 ? R : u.gi == 1 ? K : V; const int col0 = u.pn * 256 + wc * 32 + 8 * fq;
#pragma unroll
            for (int ai = 0; ai < 2; ++ai)
#pragma unroll
                for (int m = 0; m < 4; ++m) { bf16_t* rowp = O + (size_t)(row0 + ai * 128 + m * 16) * DM + col0;
#pragma unroll
                    for (int bj = 0; bj < 2; ++bj) *(u32x4*)(rowp + bj * 128) = pack8(acc[ai][bj][m][0], acc[ai][bj][m][1]); }
        } else {
            bf16_t* O = T1 + (size_t)(u.gi - 3) * MT * 128; const int col0 = wc * 32 + 8 * fq;
#pragma unroll
            for (int ai = 0; ai < 2; ++ai)
#pragma unroll
                for (int m = 0; m < 4; ++m) *(u32x4*)(O + (size_t)(row0 + ai * 128 + m * 16) * 128 + col0) = pack8(acc[ai][0][m][0], acc[ai][0][m][1]);
        }
    }
};
__device__ __forceinline__ void ld_row_f32(const float* p, int lane, f32x4 (&v)[4]) {
#pragma unroll
    for (int j = 0; j < 4; ++j) v[j] = *(const f32x4*)(p + 256 * j + 4 * lane);
}
__device__ __forceinline__ void ld_row_bf16(const bf16_t* p, int lane, f32x4 (&v)[4]) {
#pragma unroll
    for (int j = 0; j < 4; ++j) v[j] = unpk4(*(const u32x2*)(p + 256 * j + 4 * lane));
}
__device__ __forceinline__ void st_row_f32(float* p, int lane, const f32x4 (&v)[4]) {
#pragma unroll
    for (int j = 0; j < 4; ++j) *(f32x4*)(p + 256 * j + 4 * lane) = v[j];
}
__device__ __forceinline__ void st_row_bf16(bf16_t* p, int lane, const f32x4 (&v)[4]) {
#pragma unroll
    for (int j = 0; j < 4; ++j) *(u32x2*)(p + 256 * j + 4 * lane) = pk4(v[j]);
}
__device__ __forceinline__ void ada_row(f32x4 (&v)[4], const float* g, const float* sh, const float* sc, int lane) {
    float ss = 0.f;
#pragma unroll
    for (int j = 0; j < 4; ++j) ss += (v[j].x * v[j].x + v[j].y * v[j].y) + (v[j].z * v[j].z + v[j].w * v[j].w);
    ss = wave_sum(ss);
    const float rinv = 1.0f / sqrtf(ss * (1.0f / DM) + 1e-6f);
#pragma unroll
    for (int j = 0; j < 4; ++j) { const f32x4 gg = *(const f32x4*)(g + 256 * j + 4 * lane), s = *(const f32x4*)(sc + 256 * j + 4 * lane), h = *(const f32x4*)(sh + 256 * j + 4 * lane);
        v[j] = (v[j] * rinv) * gg * (s + 1.0f) + h; }
}

__device__ __forceinline__ void transpose_item(const float* W, int N, bf16_t* WT, int ldk, LAS float* scr, int k0, int n0, int drow0, int lane) {
#pragma unroll 8
    for (int i = 0; i < 32; ++i) { const int kk = 2 * i + (lane >> 5); scr[kk * 33 + (lane & 31)] = W[(size_t)(k0 + kk) * N + n0 + (lane & 31)]; }
    LDS_WAIT(); asm volatile("" ::: "memory");
    const int c = lane & 7;
#pragma unroll
    for (int j = 0; j < 4; ++j) { const int n = (lane >> 3) + 8 * j; const LAS float* s = scr + (8 * c) * 33 + n;
        u32x4 o; o.x = pk2(s[0 * 33], s[1 * 33]); o.y = pk2(s[2 * 33], s[3 * 33]); o.z = pk2(s[4 * 33], s[5 * 33]); o.w = pk2(s[6 * 33], s[7 * 33]);
        *(u32x4*)(WT + (size_t)(drow0 + n) * ldk + k0 + 8 * c) = o; }
    LDS_WAIT(); asm volatile("" ::: "memory");
}
__device__ __forceinline__ void moe_convert_item(const Params& p, int layer, int it, LAS float* scr, int lane) {
    const int e = it / 1536, r = it % 1536, which = r / 512, li = r % 512, k0 = 64 * (li / 32), n0 = 32 * (li % 32);
    const size_t woff = (size_t)(layer * NE + e) * 1024 * 1024;
    if (which == 0)      transpose_item(p.in[I_WGATE] + woff, 1024, (bf16_t*)(p.ws + WS_WGU_T) + (size_t)e * 2048 * 1024, 1024, scr, k0, n0, (n0 >> 7) * 256 + (n0 & 127), lane);
    else if (which == 1) transpose_item(p.in[I_WUP] + woff, 1024, (bf16_t*)(p.ws + WS_WGU_T) + (size_t)e * 2048 * 1024, 1024, scr, k0, n0, (n0 >> 7) * 256 + 128 + (n0 & 127), lane);
    else                 transpose_item(p.in[I_WDOWN] + woff, 1024, (bf16_t*)(p.ws + WS_WD_T) + (size_t)e * 1024 * 1024, 1024, scr, k0, n0, n0, lane);
}
__device__ __forceinline__ void small_convert_item(const Params& p, int it, LAS float* scr, int lane) {
    const float* W; int K, N, ldk; bf16_t* WT; int base;
    unsigned char* ws = p.ws;
    if (it < 2304)      { base = 0;    W = p.in[I_WIN];  K = 1024; N = 4608; WT = (bf16_t*)(ws + WS_WIN_T);  ldk = 1024; }
    else if (it < 3328) { base = 2304; W = p.in[I_WOUT]; K = 2048; N = 1024; WT = (bf16_t*)(ws + WS_WOUT_T); ldk = 2048; }
    else if (it < 3840) { base = 3328; W = p.in[I_WR];   K = 1024; N = 1024; WT = (bf16_t*)(ws + WS_WR_T);   ldk = 1024; }
    else if (it < 4352) { base = 3840; W = p.in[I_WK];   K = 1024; N = 1024; WT = (bf16_t*)(ws + WS_WK_T);   ldk = 1024; }
    else if (it < 4864) { base = 4352; W = p.in[I_WV];   K = 1024; N = 1024; WT = (bf16_t*)(ws + WS_WV_T);   ldk = 1024; }
    else if (it < 5376) { base = 4864; W = p.in[I_WO];   K = 1024; N = 1024; WT = (bf16_t*)(ws + WS_WO_T);   ldk = 1024; }
    else if (it < 5408) { base = 5376; W = p.in[I_W1];             K = 1024; N = 64;  WT = (bf16_t*)(ws + WS_WL1_T);                      ldk = 1024; }
    else if (it < 5440) { base = 5408; W = p.in[I_W1] + 1024 * 64; K = 1024; N = 64;  WT = (bf16_t*)(ws + WS_WL1_T) + 64 * 1024;          ldk = 1024; }
    else if (it < 5472) { base = 5440; W = p.in[I_A1];             K = 1024; N = 64;  WT = (bf16_t*)(ws + WS_WL1_T) + 256 * 1024;         ldk = 1024; }
    else if (it < 5504) { base = 5472; W = p.in[I_A1] + 1024 * 64; K = 1024; N = 64;  WT = (bf16_t*)(ws + WS_WL1_T) + (256 + 64) * 1024;  ldk = 1024; }
    else if (it < 5568) { base = 5504; W = p.in[I_G1];             K = 1024; N = 128; WT = (bf16_t*)(ws + WS_WL1_T) + 512 * 1024;         ldk = 1024; }
    else if (it < 5600) { base = 5568; W = p.in[I_W2];             K = 64;   N = 1024; WT = (bf16_t*)(ws + WS_W2T);                       ldk = 64; }
    else if (it < 5632) { base = 5600; W = p.in[I_W2] + 64 * 1024; K = 64;   N = 1024; WT = (bf16_t*)(ws + WS_W2T) + 1024 * 64;           ldk = 64; }
    else if (it < 5664) { base = 5632; W = p.in[I_A2];             K = 64;   N = 1024; WT = (bf16_t*)(ws + WS_A2T);                       ldk = 64; }
    else if (it < 5696) { base = 5664; W = p.in[I_A2] + 64 * 1024; K = 64;   N = 1024; WT = (bf16_t*)(ws + WS_A2T) + 1024 * 64;           ldk = 64; }
    else                { base = 5696; W = p.in[I_G2];             K = 128;  N = 1024; WT = (bf16_t*)(ws + WS_G2T);                       ldk = 128; }
    const int li = it - base, nblk = N / 32, k0 = 64 * (li / nblk), n0 = 32 * (li % nblk);
    (void)K;
    transpose_item(W, N, WT, ldk, scr, k0, n0, n0, lane);
}
constexpr int P0_NMOD = 768, P0_NSMALL = 5760, P0_NZERO = 384, P0_NMOE = 16 * 1536;
__device__ __forceinline__ void phase_prep(const Params& p, LAS unsigned char* lds, int gw, int NGW, int wave, int lane) {
    LAS float* scr = (LAS float*)(lds + wave * 8448);
    LAS float* S = (LAS float*)(lds + 69632);
    for (int i = threadIdx.x; i < 9 * 1024; i += 512) { const float c = i < 8192 ? p.in[I_C][i] : p.in[I_CCTX][i - 8192]; S[i] = c / (1.0f + __expf(-c)); }
    __syncthreads();
    float* mod = (float*)(p.ws + WS_MOD);
    const int NIT = P0_NMOD + P0_NSMALL + P0_NZERO + P0_NMOE;
    for (int it = gw; it < NIT; it += NGW) {
        if (it < P0_NMOD) {
            const int l = it / 384, r = it % 384, nch = r >> 2, kq = r & 3, n = nch * 64 + lane, kb = kq * 256;
            const float* w = p.in[I_ADAW] + ((size_t)l * 1024 + kb) * 6144 + n;
            float acc[9];
#pragma unroll
            for (int r9 = 0; r9 < 9; ++r9) acc[r9] = 0.f;
            for (int k = 0; k < 256; k += 8) {
                float wv[8];
#pragma unroll
                for (int u = 0; u < 8; ++u) wv[u] = w[(size_t)(k + u) * 6144];
#pragma unroll
                for (int u = 0; u < 8; ++u)
#pragma unroll
                    for (int r9 = 0; r9 < 9; ++r9) acc[r9] += S[r9 * 1024 + kb + k + u] * wv[u];
            }
            const float bias = kq == 0 ? p.in[I_ADAB][l * 6144 + n] : 0.f;
#pragma unroll
            for (int r9 = 0; r9 < 9; ++r9) atomicAdd(&mod[(size_t)(l * 9 + r9) * 6144 + n], acc[r9] + bias);
        } else if (it < P0_NMOD + P0_NSMALL) {
            small_convert_item(p, it - P0_NMOD, scr, lane);
        } else if (it < P0_NMOD + P0_NSMALL + P0_NZERO) {
            const int r = it - P0_NMOD - P0_NSMALL, g = r >> 7, row = 128 + (r & 127);
            bf16_t* dst = (bf16_t*)(p.ws + WS_WL1_T) + (size_t)(g * 256 + row) * 1024;
            *(u32x4*)(dst + lane * 8) = (u32x4){0u, 0u, 0u, 0u}; *(u32x4*)(dst + 512 + lane * 8) = (u32x4){0u, 0u, 0u, 0u};
        } else {
            moe_convert_item(p, 0, it - P0_NMOD - P0_NSMALL - P0_NZERO, scr, lane);
        }
    }
}

__device__ __forceinline__ void phase_prenorm0(const Params& p, int gw, int NGW, int lane) {
    const float* mod = (const float*)(p.ws + WS_MOD);
    bf16_t* H = (bf16_t*)(p.ws + WS_H);
    for (int row = gw; row < MT; row += NGW) {
        const float* xr = row < ML ? p.in[I_X] + (size_t)row * DM : p.in[I_CTX] + (size_t)(row - ML) * DM;
        const int mr = row < ML ? (row >> 11) : 8;
        const float* m = mod + (size_t)mr * 6144;
        f32x4 v[4]; ld_row_f32(xr, lane, v);
        ada_row(v, p.in[I_NORMG], m, m + 1024, lane);
        st_row_bf16(H + (size_t)row * DM, lane, v);
    }
}

__device__ __forceinline__ void phase_qkconv(const Params& p, int gw, int NGW, int lane) {
    const bf16_t* P = (const bf16_t*)(p.ws + WS_P);
    bf16_t* Q = (bf16_t*)(p.ws + WS_Q); bf16_t* KA = (bf16_t*)(p.ws + WS_KA); bf16_t* VA = (bf16_t*)(p.ws + WS_VA); bf16_t* AO = (bf16_t*)(p.ws + WS_AO);
    const float qg1 = p.in[I_QG][lane], qg2 = p.in[I_QG][64 + lane], kg1 = p.in[I_KG][lane], kg2 = p.in[I_KG][64 + lane];
    const float inv = powf(10000.0f, -(float)(lane & 31) / 32.0f);
    const float* cw = p.in[I_CONVW];
    for (int row = gw; row < MT; row += NGW) {
        const bool lat = row < ML;
        const int b = lat ? (row >> 11) : ((row - ML) >> 8), t = lat ? (row & 2047) : ((row - ML) & 255), T = lat ? SEQ : CTXL;
        const bf16_t* pr = P + (size_t)row * PROJ;
        float cs = 1.f, sn = 0.f;
        if (lat) { const float pos = (float)(lane < 32 ? (t >> 6) : (t & 63)); const float ang = pos * inv; cs = cosf(ang); sn = sinf(ang); }
#pragma unroll
        for (int hd = 0; hd < 8; ++hd) {
            const float x1 = bf2f(pr[hd * 128 + lane]), x2 = bf2f(pr[hd * 128 + 64 + lane]);
            const float ss = wave_sum(x1 * x1 + x2 * x2);
            const float rinv = 1.0f / sqrtf(ss * (1.0f / 128.0f) + 1e-6f);
            const float y1 = x1 * rinv * qg1, y2 = x2 * rinv * qg2;
            Q[(size_t)row * DM + hd * 128 + lane] = (bf16_t)f2bf(y1 * cs - y2 * sn);
            Q[(size_t)row * DM + hd * 128 + 64 + lane] = (bf16_t)f2bf(y2 * cs + y1 * sn);
        }
        const size_t kvrow = ((size_t)b * KVL + (lat ? CTXL + t : t)) * 256;
#pragma unroll
        for (int kh = 0; kh < 2; ++kh) {
            const float x1 = bf2f(pr[1024 + kh * 128 + lane]), x2 = bf2f(pr[1024 + kh * 128 + 64 + lane]);
            const float ss = wave_sum(x1 * x1 + x2 * x2);
            const float rinv = 1.0f / sqrtf(ss * (1.0f / 128.0f) + 1e-6f);
            const float y1 = x1 * rinv * kg1, y2 = x2 * rinv * kg2;
            KA[kvrow + kh * 128 + lane] = (bf16_t)f2bf(y1 * cs - y2 * sn);
            KA[kvrow + kh * 128 + 64 + lane] = (bf16_t)f2bf(y2 * cs + y1 * sn);
        }
        *(u32x2*)(VA + kvrow + 4 * lane) = *(const u32x2*)(pr + 1280 + 4 * lane);
        const bf16_t* pp = (t > 0) ? pr - PROJ : pr; const bf16_t* pn = (t < T - 1) ? pr + PROJ : pr;
        const float mp = (t > 0) ? 1.f : 0.f, mn = (t < T - 1) ? 1.f : 0.f;
#pragma unroll
        for (int q4 = 0; q4 < 4; ++q4) {
            const int c = 16 * lane + 4 * q4;
            const f32x4 gb = unpk4(*(const u32x2*)(pr + 1536 + c)), gc = unpk4(*(const u32x2*)(pr + 2560 + c)), xc = unpk4(*(const u32x2*)(pr + 3584 + c));
            const f32x4 gcp = unpk4(*(const u32x2*)(pp + 2560 + c)), xcp = unpk4(*(const u32x2*)(pp + 3584 + c));
            const f32x4 gcn = unpk4(*(const u32x2*)(pn + 2560 + c)), xcn = unpk4(*(const u32x2*)(pn + 3584 + c));
            const f32x4 w0 = *(const f32x4*)(cw + c), w1 = *(const f32x4*)(cw + 1024 + c), w2 = *(const f32x4*)(cw + 2048 + c);
            const f32x4 o = gb * ((gcp * xcp) * mp * w0 + (gc * xc) * w1 + (gcn * xcn) * mn * w2);
            *(u32x2*)(AO + (size_t)row * 2048 + 1024 + c) = pk4(o);
        }
    }
}

namespace attn {
constexpr int D = 128, NW = 8, QBLK = 32, KVBLK = 64;
constexpr float SCALE = 0.088388347648318440f;
constexpr float THR = 8.f;
constexpr size_t SHM_V = KVBLK * D * 2, SHM_K = KVBLK * D * 2, SHM_ATTN = 2 * SHM_V + 2 * SHM_K + NW * 64 * 4;
#define KSWZ(row, colB) ((row) * 256 + ((colB) ^ (((row) & 7) << 4)))
#define SBAR() __builtin_amdgcn_sched_barrier(0)
__device__ __forceinline__ int crow(int r, int hi) { return (r & 3) + 8 * (r >> 2) + 4 * hi; }
__device__ __forceinline__ unsigned cvtpk(float lo, float hi) { unsigned r; asm volatile("v_cvt_pk_bf16_f32 %0, %1, %2" : "=v"(r) : "v"(lo), "v"(hi)); return r; }
__device__ __forceinline__ void partialSM(f32x16& p0, f32x16& p1, float& m_reg, float& mn, float& alpha) {
  constexpr float C = SCALE * 1.4426950408889634f;
  float pmax = p0[0]; for (int r = 1; r < 16; ++r) pmax = fmaxf(pmax, p0[r]); for (int r = 0; r < 16; ++r) pmax = fmaxf(pmax, p1[r]);
  { auto rr = __builtin_amdgcn_permlane32_swap(__float_as_uint(pmax), __float_as_uint(pmax), false, false);
    pmax = fmaxf(__uint_as_float(rr[0]), __uint_as_float(rr[1])); }
  if (__builtin_expect(__all(pmax - m_reg <= THR / SCALE), 1)) { mn = m_reg; alpha = 1.f; }
  else { mn = fmaxf(m_reg, pmax); alpha = __builtin_amdgcn_exp2f((m_reg - mn) * C); m_reg = mn; }
  float mnC = -mn * C;
  for (int r = 0; r < 16; ++r) p0[r] = fmaf(p0[r], C, mnC); for (int r = 0; r < 16; ++r) p1[r] = fmaf(p1[r], C, mnC);
  for (int r = 0; r < 16; ++r) p0[r] = __builtin_amdgcn_exp2f(p0[r]);
}
__device__ __forceinline__ void finishSM(f32x16& p0, f32x16& p1, float alpha, float& l_reg, bf16x8& pa0, bf16x8& pa1, bf16x8& pa2, bf16x8& pa3) {
  for (int r = 0; r < 16; ++r) p1[r] = __builtin_amdgcn_exp2f(p1[r]);
  float ps = 0; for (int r = 0; r < 16; ++r) ps += p0[r]; for (int r = 0; r < 16; ++r) ps += p1[r];
  { auto rr = __builtin_amdgcn_permlane32_swap(__float_as_uint(ps), __float_as_uint(ps), false, false);
    ps = __uint_as_float(rr[0]) + __uint_as_float(rr[1]); }
  l_reg = l_reg * alpha + ps;
#define PK4(P, BASE, OUT) do { unsigned a0 = cvtpk(P[BASE + 0], P[BASE + 1]), a1 = cvtpk(P[BASE + 2], P[BASE + 3]);   \
    unsigned b0 = cvtpk(P[BASE + 4], P[BASE + 5]), b1 = cvtpk(P[BASE + 6], P[BASE + 7]);                              \
    auto r0 = __builtin_amdgcn_permlane32_swap(a0, b0, false, false); auto r1 = __builtin_amdgcn_permlane32_swap(a1, b1, false, false); \
    u32x4 w = {r0[0], r1[0], r0[1], r1[1]}; OUT = *reinterpret_cast<bf16x8*>(&w); } while (0)
  PK4(p0, 0, pa0); PK4(p0, 8, pa1); PK4(p1, 0, pa2); PK4(p1, 8, pa3);
#undef PK4
}
__device__ __forceinline__ void qkt(f32x16& p0, f32x16& p1, const bf16_t* Ks, const bf16x8* qr, int r32, int hi) {
  p0 = f32x16{}; p1 = f32x16{};
  for (int d0 = 0; d0 < 8; ++d0) { int cb = (d0 * 16 + hi * 8) * 2;
    bf16x8 b0 = *reinterpret_cast<const bf16x8*>((const char*)Ks + KSWZ(r32, cb));
    bf16x8 b1 = *reinterpret_cast<const bf16x8*>((const char*)Ks + KSWZ(32 + r32, cb));
    p0 = __builtin_amdgcn_mfma_f32_32x32x16_bf16(b0, qr[d0], p0, 0, 0, 0);
    p1 = __builtin_amdgcn_mfma_f32_32x32x16_bf16(b1, qr[d0], p1, 0, 0, 0); }
}
__device__ __forceinline__ int v_st(int k, int c) { const int kk = (k & ~0xC) | ((k & 4) << 1) | ((k & 8) >> 1); return ((kk >> 3) * 4 + (c >> 5)) * 512 + ((kk & 7) * 32 + (c & 31)) * 2; }
__device__ __forceinline__ int v_rd_base(int lane) { return ((lane & 3) << 3) | (((lane >> 2) & 3) << 6) | (((lane >> 4) & 1) << 5) | (((lane >> 5) & 1) << 8); }
constexpr int v_rd_off(int d0, int ks, int half) { return d0 * 512 + ks * 4096 + half * 2048; }
template <int OFF> __device__ __forceinline__ s16x4 tr_read(int vb) {
  s16x4 r; asm volatile("ds_read_b64_tr_b16 %0, %1 offset:%2" : "=&v"(r) : "v"(vb), "i"(OFF) : "memory"); return r;
}
template <int D0> __device__ __forceinline__ void pv_one(f32x16& od, int vb, bf16x8 pa0, bf16x8 pa1, bf16x8 pa2, bf16x8 pa3) {
  const s16x4 l0 = tr_read<v_rd_off(D0, 0, 0)>(vb), h0 = tr_read<v_rd_off(D0, 0, 1)>(vb), l1 = tr_read<v_rd_off(D0, 1, 0)>(vb), h1 = tr_read<v_rd_off(D0, 1, 1)>(vb);
  const s16x4 l2 = tr_read<v_rd_off(D0, 2, 0)>(vb), h2 = tr_read<v_rd_off(D0, 2, 1)>(vb), l3 = tr_read<v_rd_off(D0, 3, 0)>(vb), h3 = tr_read<v_rd_off(D0, 3, 1)>(vb);
  asm volatile("s_waitcnt lgkmcnt(0)" ::: "memory"); SBAR();
#define PK(L, H) (bf16x8){L[0], L[1], L[2], L[3], H[0], H[1], H[2], H[3]}
  od = __builtin_amdgcn_mfma_f32_32x32x16_bf16(pa0, PK(l0, h0), od, 0, 0, 0);
  od = __builtin_amdgcn_mfma_f32_32x32x16_bf16(pa1, PK(l1, h1), od, 0, 0, 0);
  od = __builtin_amdgcn_mfma_f32_32x32x16_bf16(pa2, PK(l2, h2), od, 0, 0, 0);
  od = __builtin_amdgcn_mfma_f32_32x32x16_bf16(pa3, PK(l3, h3), od, 0, 0, 0);
#undef PK
}
__device__ __forceinline__ void pv_d0(f32x16* o, int vb, bf16x8 pa0, bf16x8 pa1, bf16x8 pa2, bf16x8 pa3) {
  pv_one<0>(o[0], vb, pa0, pa1, pa2, pa3); pv_one<1>(o[1], vb, pa0, pa1, pa2, pa3); pv_one<2>(o[2], vb, pa0, pa1, pa2, pa3); pv_one<3>(o[3], vb, pa0, pa1, pa2, pa3);
}
template <int LDQ, int LDK, int LDO>
__device__ __forceinline__ void attn_dense_body(const bf16_t* __restrict__ Qb, const bf16_t* __restrict__ Kh, const bf16_t* __restrict__ Vh,
                                                bf16_t* __restrict__ Ob, int seq, char* lds) {
  constexpr int SDEPTH = 2;
  const int tid = threadIdx.x, wid = tid >> 6, lane = tid & 63, r32 = lane & 31, hi = lane >> 5;
  bf16_t* V_lds = (bf16_t*)lds; bf16_t* K_lds = (bf16_t*)(lds + 2 * SHM_V);
  float* ws = (float*)(lds + 2 * SHM_V + 2 * SHM_K) + wid * 64; float* li_l = ws; float* al_l = ws + 32;
  float m_reg = -1e30f, l_reg = 0; f32x16 o[4] = {}; bf16x8 qr[8];
  const bf16_t* Qw = Qb + (long)(wid * QBLK + r32) * LDQ + hi * 8;
#pragma unroll
  for (int d0 = 0; d0 < 8; ++d0) qr[d0] = *reinterpret_cast<const bf16x8*>(Qw + d0 * 16);
  const int sr = tid >> 4, sc = (tid & 15) * 8, vst0 = v_st(sr, sc), vst1 = v_st(32 + sr, sc);
  const int vb0 = (int)(uintptr_t)V_lds + v_rd_base(lane);
  struct { bf16x8 vs0, vs1, ks0, ks1; } sr_[SDEPTH];
#define SLOAD(i, k0) do { sr_[i].vs0 = *reinterpret_cast<const bf16x8*>(&Vh[(long)((k0) + sr) * LDK + sc]); sr_[i].vs1 = *reinterpret_cast<const bf16x8*>(&Vh[(long)((k0) + 32 + sr) * LDK + sc]); \
    sr_[i].ks0 = *reinterpret_cast<const bf16x8*>(&Kh[(long)((k0) + sr) * LDK + sc]); sr_[i].ks1 = *reinterpret_cast<const bf16x8*>(&Kh[(long)((k0) + 32 + sr) * LDK + sc]); } while (0)
#define SWRITE(b, i) do { *(bf16x8*)((char*)V_lds + (b) * SHM_V + vst0) = sr_[i].vs0;          \
    *(bf16x8*)((char*)V_lds + (b) * SHM_V + vst1) = sr_[i].vs1; int kc = sc * 2;               \
    *(bf16x8*)((char*)K_lds + (b) * SHM_K + KSWZ(sr, kc)) = sr_[i].ks0;                       \
    *(bf16x8*)((char*)K_lds + (b) * SHM_K + KSWZ(32 + sr, kc)) = sr_[i].ks1; } while (0)
#define SWAIT() do { asm volatile("s_waitcnt vmcnt(4)" ::: "memory"); } while (0)
#define RESC(a) do { if (__any((a) < 1.f)) { if (hi == 0) al_l[r32] = (a); asm volatile("s_waitcnt lgkmcnt(0)" ::: "memory"); \
    for (int d = 0; d < 4; ++d) for (int r = 0; r < 16; ++r) o[d][r] *= al_l[crow(r, hi)]; } } while (0)
  f32x16 pA0, pA1, pB0, pB1; float mnA, mnB, alA, alB; bf16x8 pa0, pa1, pa2, pa3; const int NT = seq / KVBLK;
  constexpr int SE = 0, SO = SDEPTH - 1;
  SLOAD(SE, 0); asm volatile("s_waitcnt vmcnt(0)" ::: "memory"); SWRITE(0, SE); __syncthreads();
  qkt(pA0, pA1, K_lds, qr, r32, hi); partialSM(pA0, pA1, m_reg, mnA, alA);
  SLOAD(SO, KVBLK); if (2 < NT) SLOAD(SE, 2 * KVBLK);
  SWAIT(); SWRITE(1, SO); __syncthreads();
  for (int j = 1; j + 1 < NT; j += 2) {
    SBAR(); qkt(pB0, pB1, (bf16_t*)((char*)K_lds + SHM_K), qr, r32, hi);
    finishSM(pA0, pA1, alA, l_reg, pa0, pa1, pa2, pa3); SBAR();
    SLOAD(SO, (j + SDEPTH) * KVBLK); SBAR();
    pv_d0(o, vb0, pa0, pa1, pa2, pa3); partialSM(pB0, pB1, m_reg, mnB, alB);
    __syncthreads(); SWAIT(); SWRITE(0, SE);
    RESC(alB); __syncthreads();
    SBAR(); qkt(pA0, pA1, K_lds, qr, r32, hi);
    finishSM(pB0, pB1, alB, l_reg, pa0, pa1, pa2, pa3); SBAR();
    if (j + 3 < NT) SLOAD(SE, (j + 1 + SDEPTH) * KVBLK); SBAR();
    pv_d0(o, vb0 + (int)SHM_V, pa0, pa1, pa2, pa3); partialSM(pA0, pA1, m_reg, mnA, alA);
    __syncthreads(); SWAIT(); SWRITE(1, SO);
    RESC(alA); __syncthreads();
  }
  SBAR(); qkt(pB0, pB1, (bf16_t*)((char*)K_lds + SHM_K), qr, r32, hi);
  finishSM(pA0, pA1, alA, l_reg, pa0, pa1, pa2, pa3); SBAR();
  pv_d0(o, vb0, pa0, pa1, pa2, pa3); partialSM(pB0, pB1, m_reg, mnB, alB);
  __syncthreads(); RESC(alB);
  finishSM(pB0, pB1, alB, l_reg, pa0, pa1, pa2, pa3); SBAR();
  pv_d0(o, vb0 + (int)SHM_V, pa0, pa1, pa2, pa3);
  if (hi == 0) li_l[r32] = l_reg; asm volatile("s_waitcnt lgkmcnt(0)" ::: "memory");
  float rli[16];
#pragma unroll
  for (int r = 0; r < 16; ++r) rli[r] = __builtin_amdgcn_rcpf(li_l[crow(r, hi)]);
  bf16_t* Ow = Ob + (long)(wid * QBLK) * LDO;
#pragma unroll
  for (int r = 0; r < 16; ++r) { int orow = crow(r, hi);
    for (int d0 = 0; d0 < 4; ++d0) Ow[(long)orow * LDO + d0 * 32 + r32] = (bf16_t)f2bf(o[d0][r] * rli[r]); }
#undef SLOAD
#undef SWRITE
#undef SWAIT
#undef RESC
}
#undef KSWZ
#undef SBAR
}

__device__ __forceinline__ void phase_attention(const Params& p, LAS unsigned char* lds, int G, int c) {
    const bf16_t* Q = (const bf16_t*)(p.ws + WS_Q); const bf16_t* KA = (const bf16_t*)(p.ws + WS_KA); const bf16_t* VA = (const bf16_t*)(p.ws + WS_VA); bf16_t* AO = (bf16_t*)(p.ws + WS_AO);
    for (int u = c; u < 576; u += G) {
        size_t qrow, kvoff; int h, seq;
        if (u < 512) { const int qb = u & 7, g = (u >> 3) & 3, kvh = (u >> 5) & 1, b = u >> 6; h = kvh * 4 + g; qrow = (size_t)b * SEQ + qb * 256; kvoff = (size_t)b * KVL * 256 + kvh * 128; seq = KVL; }
        else { const int uc = u - 512, b = uc >> 3; h = uc & 7; qrow = (size_t)ML + b * CTXL; kvoff = (size_t)b * KVL * 256 + (h >> 2) * 128; seq = CTXL; }
        attn::attn_dense_body<DM, 256, 2048>(Q + qrow * DM + h * 128, KA + kvoff, VA + kvoff, AO + qrow * 2048 + h * 128, seq, (char*)lds);
        __syncthreads();
    }
}
__device__ __forceinline__ void phase_moe_prenorm(const Params& p, LAS unsigned char* lds, int layer, const float* X, int nrows, bf16_t* H2, int gw, int NGW, int lane) {
    LAS float* RT = (LAS float*)lds;
    const float* router = p.in[I_ROUTER] + (size_t)layer * 1024 * 16;
    for (int i = threadIdx.x; i < 16384; i += 512) { const int k = i >> 4, e = i & 15; RT[e * 1024 + k] = router[i]; }
    __syncthreads();
    const float* mod = (const float*)(p.ws + WS_MOD) + (size_t)layer * 9 * 6144;
    float* aff = (float*)(p.ws + WS_AFF);
    const float* g = p.in[I_NORMG] + (size_t)(layer * 2 + 1) * 1024;
    for (int row = gw; row < nrows; row += NGW) {
        const int mr = row < ML ? (row >> 11) : 8;
        const float* m = mod + (size_t)mr * 6144;
        f32x4 v[4]; ld_row_f32(X + (size_t)row * DM, lane, v);
        ada_row(v, g, m + 3072, m + 4096, lane);
        st_row_bf16(H2 + (size_t)row * DM, lane, v);
        float lg[16];
#pragma unroll
        for (int e = 0; e < 16; ++e) { float s = 0.f;
#pragma unroll
            for (int j = 0; j < 4; ++j) { const f32x4 r = *(const LAS f32x4*)(RT + e * 1024 + 256 * j + 4 * lane); s += (v[j].x * r.x + v[j].y * r.y) + (v[j].z * r.z + v[j].w * r.w); }
            lg[e] = wave_sum(s); asm volatile("" ::: "memory"); }
        float mx = lg[0];
#pragma unroll
        for (int e = 1; e < 16; ++e) mx = fmaxf(mx, lg[e]);
        float sum = 0.f;
#pragma unroll
        for (int e = 0; e < 16; ++e) { lg[e] = __expf(lg[e] - mx); sum += lg[e]; }
        const float rs = 1.0f / sum;
        float mine = 0.f;
#pragma unroll
        for (int e = 0; e < 16; ++e) mine = (lane == e) ? lg[e] * rs : mine;
        if (lane < 16) aff[(size_t)row * 16 + lane] = mine;
    }
}

__device__ __forceinline__ int block_exscan(int flag, volatile LAS int* sm, int wave, int lane, int& tot) {
    const unsigned long long bal = __ballot(flag != 0);
    const int pre = __popcll(bal & ((1ull << lane) - 1ull)), wtot = __popcll(bal);
    __syncthreads();
    if (lane == 0) sm[wave] = wtot;
    __syncthreads();
    int base = 0, t = 0;
#pragma unroll
    for (int w = 0; w < 8; ++w) { const int x = sm[w]; base += (w < wave) ? x : 0; t += x; }
    tot = t; return base + pre;
}
__device__ __forceinline__ int block_sum(int v, volatile LAS int* sm, int wave, int lane) {
    v = wave_sum_i(v);
    __syncthreads();
    if (lane == 0) sm[wave] = v;
    __syncthreads();
    int t = 0;
#pragma unroll
    for (int w = 0; w < 8; ++w) t += sm[w];
    return t;
}
__device__ __forceinline__ void phase_select(const Params& p, LAS unsigned char* lds, int ntasks, int SL, const bf16_t* H2, bf16_t* Xs, int G, int c, int wave, int lane) {
    volatile LAS int* sm = (volatile LAS int*)lds;
    volatile LAS int* rows = (volatile LAS int*)(lds + 256);
    const float* aff = (const float*)(p.ws + WS_AFF);
    int* tokslot = (int*)(p.ws + WS_TOKSLOT); float* selaff = (float*)(p.ws + WS_SELAFF);
    const int tid = threadIdx.x;
    for (int tk = c; tk < ntasks; tk += G) {
        const bool lat = tk < 128; const int tt = lat ? tk : tk - 128, b = tt >> 4, e = tt & 15;
        const int n = lat ? SEQ : CTXL, cap = lat ? CAPL : CAPC, rowbase = lat ? b * SEQ : ML + b * CTXL, slotbase = lat ? b * CAPL : NB * CAPL + b * CAPC;
        unsigned key[4]; bool valid[4];
#pragma unroll
        for (int i = 0; i < 4; ++i) { const int idx = tid + 512 * i; valid[i] = idx < n; key[i] = valid[i] ? __float_as_uint(aff[(size_t)(rowbase + idx) * 16 + e]) : 0u; }
        unsigned prefix = 0u;
        for (int bit = 30; bit >= 0; --bit) {
            const unsigned cand = prefix | (1u << bit); int cnt = 0;
#pragma unroll
            for (int i = 0; i < 4; ++i) cnt += (valid[i] && key[i] >= cand) ? 1 : 0;
            if (block_sum(cnt, sm, wave, lane) >= cap) prefix = cand;
        }
        int cg = 0;
#pragma unroll
        for (int i = 0; i < 4; ++i) cg += (valid[i] && key[i] > prefix) ? 1 : 0;
        const int need_eq = cap - block_sum(cg, sm, wave, lane);
        int eqbase = 0, selbase = 0;
#pragma unroll
        for (int i = 0; i < 4; ++i) {
            const bool gt = valid[i] && key[i] > prefix, eq = valid[i] && key[i] == prefix;
            int tot; const int er = eqbase + block_exscan(eq ? 1 : 0, sm, wave, lane, tot); eqbase += tot;
            const bool sel = gt || (eq && er < need_eq);
            int tot2; const int slot = selbase + block_exscan(sel ? 1 : 0, sm, wave, lane, tot2); selbase += tot2;
            if (valid[i]) { const int row = rowbase + tid + 512 * i;
                tokslot[(size_t)row * 16 + e] = sel ? slotbase + slot : -1;
                if (sel) { selaff[(size_t)e * SL + slotbase + slot] = __uint_as_float(key[i]); rows[slot] = row; } }
        }
        __syncthreads();
        for (int r = wave; r < cap; r += 8) {
            const bf16_t* src = H2 + (size_t)rows[r] * DM; bf16_t* dst = Xs + ((size_t)e * SL + slotbase + r) * DM;
            *(u32x4*)(dst + 8 * lane) = *(const u32x4*)(src + 8 * lane); *(u32x4*)(dst + 512 + 8 * lane) = *(const u32x4*)(src + 512 + 8 * lane);
        }
        __syncthreads();
    }
}

__device__ __forceinline__ void moe_gather_row(const int* tokslot, const bf16_t* Ys, int SL, int row, int lane, f32x4 (&acc)[4]) {
#pragma unroll
    for (int j = 0; j < 4; ++j) acc[j] = (f32x4){0.f, 0.f, 0.f, 0.f};
    const int* ts = tokslot + (size_t)row * 16;
    for (int e = 0; e < 16; ++e) { const int s = __builtin_amdgcn_readfirstlane(ts[e]);
        if (s >= 0) { const bf16_t* y = Ys + ((size_t)e * SL + s) * DM;
#pragma unroll
            for (int j = 0; j < 4; ++j) acc[j] += unpk4(*(const u32x2*)(y + 256 * j + 4 * lane)); } }
}

__device__ __forceinline__ void phase_combine0(const Params& p, int gw, int NGW, int lane) {
    const float* mod0 = (const float*)(p.ws + WS_MOD); const float* mod1 = mod0 + 9 * 6144;
    const float* X1 = (const float*)(p.ws + WS_X1); float* X2 = (float*)(p.ws + WS_X2); bf16_t* H = (bf16_t*)(p.ws + WS_H);
    const int* tokslot = (const int*)(p.ws + WS_TOKSLOT); const bf16_t* Ys = (const bf16_t*)(p.ws + WS_YS0);
    for (int row = gw; row < MT; row += NGW) {
        const int mr = row < ML ? (row >> 11) : 8;
        f32x4 acc[4]; moe_gather_row(tokslot, Ys, SL0, row, lane, acc);
        f32x4 v[4]; ld_row_f32(X1 + (size_t)row * DM, lane, v);
        const float* gt2 = mod0 + (size_t)mr * 6144 + 5120;
#pragma unroll
        for (int j = 0; j < 4; ++j) v[j] = v[j] + *(const f32x4*)(gt2 + 256 * j + 4 * lane) * acc[j];
        st_row_f32(X2 + (size_t)row * DM, lane, v);
        const float* m = mod1 + (size_t)mr * 6144;
        ada_row(v, p.in[I_NORMG] + 2 * 1024, m, m + 1024, lane);
        st_row_bf16(H + (size_t)row * DM, lane, v);
    }
}

__device__ __forceinline__ void phase_mixes(const Params& p, int gw, int NGW, int lane) {
    const bf16_t* H = (const bf16_t*)(p.ws + WS_H);
    bf16_t* XR = (bf16_t*)(p.ws + WS_XR); bf16_t* XK = (bf16_t*)(p.ws + WS_XK); bf16_t* XV = (bf16_t*)(p.ws + WS_XV);
    bf16_t* XW = (bf16_t*)(p.ws + WS_XW); bf16_t* XA = (bf16_t*)(p.ws + WS_XA); bf16_t* XG = (bf16_t*)(p.ws + WS_XG);
    const float* mu = p.in[I_MU];
    for (int row = gw; row < MT; row += NGW) {
        const bool lat = row < ML; const int t = lat ? (row & 2047) : ((row - ML) & 255), T = lat ? SEQ : CTXL;
        const bf16_t* hr = H + (size_t)row * DM;
        f32x4 h[4], hp[4], hn[4]; ld_row_bf16(hr, lane, h);
        if (t > 0) ld_row_bf16(hr - DM, lane, hp); else { for (int j = 0; j < 4; ++j) hp[j] = (f32x4){0.f, 0.f, 0.f, 0.f}; }
        if (t < T - 1) ld_row_bf16(hr + DM, lane, hn); else { for (int j = 0; j < 4; ++j) hn[j] = (f32x4){0.f, 0.f, 0.f, 0.f}; }
#pragma unroll
        for (int j = 0; j < 4; ++j) {
            const int c = 256 * j + 4 * lane; const f32x4 xx = (hp[j] + hn[j]) * 0.5f - h[j];
            *(u32x2*)(XW + (size_t)row * DM + c) = pk4(h[j] + xx * *(const f32x4*)(mu + 1 * 1024 + c));
            *(u32x2*)(XK + (size_t)row * DM + c) = pk4(h[j] + xx * *(const f32x4*)(mu + 2 * 1024 + c));
            *(u32x2*)(XV + (size_t)row * DM + c) = pk4(h[j] + xx * *(const f32x4*)(mu + 3 * 1024 + c));
            *(u32x2*)(XA + (size_t)row * DM + c) = pk4(h[j] + xx * *(const f32x4*)(mu + 4 * 1024 + c));
            if (lat) { *(u32x2*)(XR + (size_t)row * DM + c) = pk4(h[j] + xx * *(const f32x4*)(mu + 0 * 1024 + c));
                       *(u32x2*)(XG + (size_t)row * DM + c) = pk4(h[j] + xx * *(const f32x4*)(mu + 5 * 1024 + c)); }
        }
    }
}

__device__ __forceinline__ bf16x8 tanh8(bf16x8 x) {
    bf16x8 o;
#pragma unroll
    for (int j = 0; j < 8; ++j) o[j] = (short)f2bf(tanhf(bf2f((unsigned short)x[j])));
    return o;
}
__device__ __forceinline__ void phase_features(const Params& p, int gw, int NGW, int lane) {
    const bf16_t* Kb = (const bf16_t*)(p.ws + WS_KB); bf16_t* KK = (bf16_t*)(p.ws + WS_KK);
    const float* k_k = p.in[I_KK];
    for (int row = gw; row < MT; row += NGW) {
        const bf16_t* kr = Kb + (size_t)row * DM + 16 * lane;
        f32x4 v[4]; float ss = 0.f;
#pragma unroll
        for (int q = 0; q < 4; ++q) { v[q] = unpk4(*(const u32x2*)(kr + 4 * q)) * *(const f32x4*)(k_k + 16 * lane + 4 * q); ss += (v[q].x * v[q].x + v[q].y * v[q].y) + (v[q].z * v[q].z + v[q].w * v[q].w); }
        ss += __shfl_xor(ss, 1); ss += __shfl_xor(ss, 2);
        const float rn = 1.0f / sqrtf(fmaxf(ss, 1e-24f));
#pragma unroll
        for (int q = 0; q < 4; ++q) *(u32x2*)(KK + (size_t)row * DM + 16 * lane + 4 * q) = pk4(v[q] * rn);
    }
    const bf16_t* T1 = (const bf16_t*)(p.ws + WS_T1);
    bf16_t* LD = (bf16_t*)(p.ws + WS_LD); bf16_t* AA = (bf16_t*)(p.ws + WS_AA);
    const int fr = lane & 15, fq = lane >> 4;
    for (int it = gw; it < (MT / 16) * 8; it += NGW) {
        const int tt = it >> 3, cb = it & 7, tok = tt * 16 + fr;
#pragma unroll
        for (int kd = 0; kd < 4; ++kd) {
            const int kind = kd >> 1, d = kd & 1;
            const bf16_t* xrow = T1 + (size_t)kind * MT * 128 + (size_t)tok * 128 + d * 64 + 8 * fq;
            bf16x8 xb0 = *(const bf16x8*)(xrow), xb1 = *(const bf16x8*)(xrow + 32);
            if (kind == 0) { xb0 = tanh8(xb0); xb1 = tanh8(xb1); }
            const bf16_t* W = (const bf16_t*)(p.ws + (kind == 0 ? WS_W2T : WS_A2T)) + (size_t)d * 1024 * 64;
            const float* bias = (kind == 0 ? p.in[I_W0] : p.in[I_A0]) + d * 1024;
            bf16_t* O = (kind == 0 ? LD : AA) + (size_t)d * MT * DM;
#pragma unroll
            for (int ct = 0; ct < 8; ++ct) {
                const int ch0 = cb * 128 + ct * 16;
                const bf16_t* wr_ = W + (size_t)(ch0 + fr) * 64 + 8 * fq;
                const bf16x8 wa0 = *(const bf16x8*)(wr_), wa1 = *(const bf16x8*)(wr_ + 32);
                f32x4 acc = (f32x4){0.f, 0.f, 0.f, 0.f};
                acc = __builtin_amdgcn_mfma_f32_16x16x32_bf16(wa0, xb0, acc, 0, 0, 0);
                acc = __builtin_amdgcn_mfma_f32_16x16x32_bf16(wa1, xb1, acc, 0, 0, 0);
                const f32x4 bs = *(const f32x4*)(bias + ch0 + 4 * fq);
                f32x4 o;
#pragma unroll
                for (int r = 0; r < 4; ++r) { const float s = sigmoidf_(acc[r] + bs[r]); o[r] = kind == 0 ? -0.6065306597126334f * s : s; }
                *(u32x2*)(O + (size_t)tok * DM + ch0 + 4 * fq) = pk4(o);
            }
        }
    }
}
template <int CTRL> __device__ __forceinline__ float dpp_add(float v) { const int t = __builtin_amdgcn_update_dpp(0, __float_as_int(v), CTRL, 0xf, 0xf, false); return v + __int_as_float(t); }
__device__ __forceinline__ float allsum16(float v) { v = dpp_add<0xB1>(v); v = dpp_add<0x4E>(v); v = dpp_add<0x141>(v); v = dpp_add<0x140>(v); return v; }
constexpr int SC_CH = 32, SC_VEC = SC_CH * 64 * 4  , SC_BUF = 6 * SC_VEC, SC_YOFF = 2 * SC_BUF;
__device__ __forceinline__ void phase_scan(const Params& p, LAS unsigned char* lds, int G, int c, int wave, int lane) {
    const bf16_t* RB = (const bf16_t*)(p.ws + WS_RB); const bf16_t* KB = (const bf16_t*)(p.ws + WS_KB); const bf16_t* VB = (const bf16_t*)(p.ws + WS_VB);
    const bf16_t* KK = (const bf16_t*)(p.ws + WS_KK);
    const int tid = threadIdx.x, cg = lane & 15, rp = lane >> 4, r0 = wave * 8 + rp * 2;
    const int sstep = tid >> 4, sch = (tid & 15) * 4;
    for (int sid = c; sid < 256; sid += G) {
        const int d = sid & 1, h = (sid >> 1) & 15, b = sid >> 5;
        const bf16_t* LD = (const bf16_t*)(p.ws + WS_LD) + (size_t)d * MT * DM; const bf16_t* AA = (const bf16_t*)(p.ws + WS_AA) + (size_t)d * MT * DM;
        float* Y = (float*)(p.ws + WS_Y) + (size_t)d * ML * DM;
        const f32x4 ka4 = *(const f32x4*)(p.in[I_KA] + h * 64 + sch);
        f32x4 S0 = (f32x4){0.f, 0.f, 0.f, 0.f}, S1 = (f32x4){0.f, 0.f, 0.f, 0.f};
        u32x2 gk, gv, gr, gkk, gld, ga;
        int grow = 0;
#define SC_ROW(ci) do { const int g_ = (ci) * SC_CH + sstep; if (g_ < CTXL) { const int t_ = d ? (CTXL - 1 - g_) : g_; grow = ML + b * CTXL + t_; } else { const int gl_ = g_ - CTXL; const int t_ = d ? (SEQ - 1 - gl_) : gl_; grow = b * SEQ + t_; } } while (0)
#define SC_LOAD(ci) do { SC_ROW(ci); const size_t o_ = (size_t)grow * DM + h * 64 + sch; gk = *(const u32x2*)(KB + o_); gv = *(const u32x2*)(VB + o_); gkk = *(const u32x2*)(KK + o_); gld = *(const u32x2*)(LD + o_); ga = *(const u32x2*)(AA + o_); \
        gr = (grow < ML) ? *(const u32x2*)(RB + o_) : (u32x2){0u, 0u}; } while (0)
#define SC_WRITE(buf) do { LAS unsigned char* bb_ = lds + (buf) * SC_BUF + (sstep * 64 + sch) * 4; const f32x4 k_ = unpk4(gk), a_ = unpk4(ga), kk_ = unpk4(gkk), ld_ = unpk4(gld); \
        f32x4 w_; w_.x = __expf(ld_.x); w_.y = __expf(ld_.y); w_.z = __expf(ld_.z); w_.w = __expf(ld_.w); \
        *(LAS f32x4*)(bb_ + 0 * SC_VEC) = w_; *(LAS f32x4*)(bb_ + 1 * SC_VEC) = kk_; *(LAS f32x4*)(bb_ + 2 * SC_VEC) = kk_ * a_; \
        *(LAS f32x4*)(bb_ + 3 * SC_VEC) = k_ * ((a_ - 1.0f) * ka4 + 1.0f); *(LAS f32x4*)(bb_ + 4 * SC_VEC) = unpk4(gr); *(LAS f32x4*)(bb_ + 5 * SC_VEC) = unpk4(gv); } while (0)
        __syncthreads();
        SC_LOAD(0); SC_WRITE(0);
        __syncthreads();
        constexpr int NCH = (CTXL + SEQ) / SC_CH;
        for (int ci = 0; ci < NCH; ++ci) {
            const int buf = ci & 1;
            if (ci + 1 < NCH) SC_LOAD(ci + 1);
            const LAS unsigned char* bb = lds + buf * SC_BUF;
            LAS float* yb = (LAS float*)(lds + SC_YOFF);
            const bool emit = ci >= CTXL / SC_CH;
#pragma unroll 4
            for (int s = 0; s < SC_CH; ++s) {
                const f32x4 w4 = *(const LAS f32x4*)(bb + 0 * SC_VEC + (s * 64 + 4 * cg) * 4), kk4 = *(const LAS f32x4*)(bb + 1 * SC_VEC + (s * 64 + 4 * cg) * 4);
                const f32x4 b4 = *(const LAS f32x4*)(bb + 2 * SC_VEC + (s * 64 + 4 * cg) * 4), kd4 = *(const LAS f32x4*)(bb + 3 * SC_VEC + (s * 64 + 4 * cg) * 4);
                const f32x4 r4 = *(const LAS f32x4*)(bb + 4 * SC_VEC + (s * 64 + 4 * cg) * 4);
                const f32x2 v2 = *(const LAS f32x2*)(bb + 5 * SC_VEC + (s * 64 + r0) * 4);
                float sk0 = (S0.x * kk4.x + S0.y * kk4.y) + (S0.z * kk4.z + S0.w * kk4.w);
                float sk1 = (S1.x * kk4.x + S1.y * kk4.y) + (S1.z * kk4.z + S1.w * kk4.w);
                sk0 = allsum16(sk0); sk1 = allsum16(sk1);
                S0 = S0 * w4 + (kd4 * v2.x - b4 * sk0);
                S1 = S1 * w4 + (kd4 * v2.y - b4 * sk1);
                if (emit) {
                    float y0 = (S0.x * r4.x + S0.y * r4.y) + (S0.z * r4.z + S0.w * r4.w);
                    float y1 = (S1.x * r4.x + S1.y * r4.y) + (S1.z * r4.z + S1.w * r4.w);
                    y0 = allsum16(y0); y1 = allsum16(y1);
                    if (cg == 0) *(LAS f32x2*)(yb + s * 64 + r0) = (f32x2){y0, y1};
                }
            }
            __syncthreads();
            if (emit) { int yrow; { const int gl_ = ci * SC_CH + sstep - CTXL; const int t_ = d ? (SEQ - 1 - gl_) : gl_; yrow = b * SEQ + t_; }
                *(f32x4*)(Y + (size_t)yrow * DM + h * 64 + sch) = *(const LAS f32x4*)(yb + sstep * 64 + sch); }
            if (ci + 1 < NCH) SC_WRITE(buf ^ 1);
            __syncthreads();
        }
#undef SC_ROW
#undef SC_LOAD
#undef SC_WRITE
    }
}

constexpr int RO_STRIDE = 2064;
__device__ __forceinline__ bf16x8 sigm8(bf16x8 x) {
    bf16x8 o;
#pragma unroll
    for (int j = 0; j < 8; ++j) o[j] = (short)f2bf(sigmoidf_(bf2f((unsigned short)x[j])));
    return o;
}
__device__ __forceinline__ void phase_readout(const Params& p, LAS unsigned char* lds, int G, int c, int wave, int lane) {
    const bf16_t* T1g = (const bf16_t*)(p.ws + WS_T1) + (size_t)2 * MT * 128; const bf16_t* G2T = (const bf16_t*)(p.ws + WS_G2T);
    const bf16_t* RB = (const bf16_t*)(p.ws + WS_RB); const bf16_t* KB = (const bf16_t*)(p.ws + WS_KB); const bf16_t* VB = (const bf16_t*)(p.ws + WS_VB);
    const bf16_t* A0 = (const bf16_t*)(p.ws + WS_AA); const bf16_t* A1 = A0 + (size_t)MT * DM;
    const float* Y0 = (const float*)(p.ws + WS_Y); const float* Y1 = Y0 + (size_t)ML * DM;
    bf16_t* Z = (bf16_t*)(p.ws + WS_Z);
    const int fr = lane & 15, fq = lane >> 4;
    for (int tile = c; tile < ML / 32; tile += G) {
        const int tok0 = tile * 32;
        bf16x8 xb[2][4];
#pragma unroll
        for (int tt = 0; tt < 2; ++tt)
#pragma unroll
            for (int ks = 0; ks < 4; ++ks) xb[tt][ks] = sigm8(*(const bf16x8*)(T1g + (size_t)(tok0 + tt * 16 + fr) * 128 + 32 * ks + 8 * fq));
#pragma unroll
        for (int ct = 0; ct < 8; ++ct) {
            const int ch0 = wave * 128 + ct * 16;
            const bf16_t* wr_ = G2T + (size_t)(ch0 + fr) * 128 + 8 * fq;
            f32x4 acc0 = (f32x4){0.f, 0.f, 0.f, 0.f}, acc1 = (f32x4){0.f, 0.f, 0.f, 0.f};
#pragma unroll
            for (int ks = 0; ks < 4; ++ks) { const bf16x8 wa = *(const bf16x8*)(wr_ + 32 * ks);
                acc0 = __builtin_amdgcn_mfma_f32_16x16x32_bf16(wa, xb[0][ks], acc0, 0, 0, 0);
                acc1 = __builtin_amdgcn_mfma_f32_16x16x32_bf16(wa, xb[1][ks], acc1, 0, 0, 0); }
            *(LAS u32x2*)(lds + (fr) * RO_STRIDE + (ch0 + 4 * fq) * 2) = pk4(acc0);
            *(LAS u32x2*)(lds + (16 + fr) * RO_STRIDE + (ch0 + 4 * fq) * 2) = pk4(acc1);
        }
        __syncthreads();
        for (int i = 0; i < 4; ++i) {
            const int tl = wave * 4 + i, row = tok0 + tl; const size_t o = (size_t)row * DM + 16 * lane;
            f32x4 y[4]; float s = 0.f;
#pragma unroll
            for (int q = 0; q < 4; ++q) { y[q] = *(const f32x4*)(Y0 + o + 4 * q) + *(const f32x4*)(Y1 + o + 4 * q); s += (y[q].x + y[q].y) + (y[q].z + y[q].w); }
            s += __shfl_xor(s, 1); s += __shfl_xor(s, 2);
            const float mean = s * (1.0f / 64.0f); float vs = 0.f;
#pragma unroll
            for (int q = 0; q < 4; ++q) { y[q] = y[q] - mean; vs += (y[q].x * y[q].x + y[q].y * y[q].y) + (y[q].z * y[q].z + y[q].w * y[q].w); }
            vs += __shfl_xor(vs, 1); vs += __shfl_xor(vs, 2);
            const float rstd = 1.0f / sqrtf(vs * (1.0f / 64.0f) + 64e-5f);
            f32x4 r4[4], v4[4]; float bs = 0.f;
#pragma unroll
            for (int q = 0; q < 4; ++q) {
                const int cc = 16 * lane + 4 * q;
                r4[q] = unpk4(*(const u32x2*)(RB + o + 4 * q)); v4[q] = unpk4(*(const u32x2*)(VB + o + 4 * q));
                const f32x4 k4 = unpk4(*(const u32x2*)(KB + o + 4 * q)), a0 = unpk4(*(const u32x2*)(A0 + o + 4 * q)), a1 = unpk4(*(const u32x2*)(A1 + o + 4 * q));
                const f32x4 ka = *(const f32x4*)(p.in[I_KA] + cc), rk = *(const f32x4*)(p.in[I_RK] + cc);
                const f32x4 kds = k4 * ((a0 - 1.0f) * ka + 1.0f) + k4 * ((a1 - 1.0f) * ka + 1.0f);
                const f32x4 t = r4[q] * kds * rk; bs += (t.x + t.y) + (t.z + t.w);
            }
            bs += __shfl_xor(bs, 1); bs += __shfl_xor(bs, 2);
#pragma unroll
            for (int q = 0; q < 4; ++q) {
                const int cc = 16 * lane + 4 * q;
                const f32x4 lw = *(const f32x4*)(p.in[I_LNW] + cc), lb = *(const f32x4*)(p.in[I_LNB] + cc);
                const f32x4 g4 = unpk4(*(const LAS u32x2*)(lds + tl * RO_STRIDE + cc * 2));
                const f32x4 z = ((y[q] * rstd) * lw + lb + v4[q] * bs) * g4;
                *(u32x2*)(Z + o + 4 * q) = pk4(z);
            }
        }
        __syncthreads();
    }
}

__device__ __forceinline__ void phase_final(const Params& p, int gw, int NGW, int lane) {
    const float* mod1 = (const float*)(p.ws + WS_MOD) + 9 * 6144;
    const float* X3 = (const float*)(p.ws + WS_X3); const int* tokslot = (const int*)(p.ws + WS_TOKSLOT); const bf16_t* Ys = (const bf16_t*)(p.ws + WS_YS1);
    const float* fg = p.in[I_FINALG];
    for (int row = gw; row < ML; row += NGW) {
        const int mr = row >> 11;
        f32x4 acc[4]; moe_gather_row(tokslot, Ys, SL1, row, lane, acc);
        f32x4 v[4]; ld_row_f32(X3 + (size_t)row * DM, lane, v);
        const float* gt2 = mod1 + (size_t)mr * 6144 + 5120;
        float ss = 0.f;
#pragma unroll
        for (int j = 0; j < 4; ++j) { v[j] = v[j] + *(const f32x4*)(gt2 + 256 * j + 4 * lane) * acc[j]; ss += (v[j].x * v[j].x + v[j].y * v[j].y) + (v[j].z * v[j].z + v[j].w * v[j].w); }
        ss = wave_sum(ss);
        const float rinv = 1.0f / sqrtf(ss * (1.0f / DM) + 1e-6f);
#pragma unroll
        for (int j = 0; j < 4; ++j) v[j] = (v[j] * rinv) * *(const f32x4*)(fg + 256 * j + 4 * lane);
        st_row_f32(p.out + (size_t)row * DM, lane, v);
    }
}

constexpr int NPH = 22;
__global__ void __launch_bounds__(512, 2) mega_fwd(Params p) {
    extern __shared__ __attribute__((aligned(16))) unsigned char lds_raw[];
    LAS unsigned char* lds = (LAS unsigned char*)lds_raw;
    const int tid = threadIdx.x, lane = tid & 63, wave = __builtin_amdgcn_readfirstlane(tid >> 6);
    const int G = gridDim.x, bx = blockIdx.x, vcu = (G % 8 == 0) ? (bx % 8) * (G / 8) + bx / 8 : bx;
    const int gw = vcu * 8 + wave, NGW = G * 8;
    for (int u = tid; u < (LDS_BYTES - LDSCTL_OFF) / 4; u += 512) ((LAS unsigned*)(lds + LDSCTL_OFF))[u] = 0u;
    __syncthreads();
    const int lo = p.ph_lo, hi = p.ph_hi;
    XcdBarrier bar; bar.bar = (unsigned*)(p.ws + WS_CTL) + CTL_BAR_WORD; bar.x = 0; bar.st = (volatile LAS unsigned*)(lds + MISC_OFF + 32);
    if (hi - lo > 1) bar = xcd_barrier_post((unsigned*)(p.ws + WS_CTL) + CTL_BAR_WORD, (volatile LAS unsigned*)(lds + MISC_OFF + 32));
#ifndef PHMASK
#define PHMASK 0x3fffff
#endif
#define IN(k) (((PHMASK >> (k)) & 1) && lo <= (k) && (k) < hi)
#define SEAM(k) do { if (IN(k) && IN((k) + 1)) xcd_barrier(bar); } while (0)
    unsigned char* ws = p.ws;
    const float* gate1_l0 = (const float*)(ws + WS_MOD) + 2048; const float* gate1_l1 = (const float*)(ws + WS_MOD) + 9 * 6144 + 2048;

    if (IN(0)) { phase_prep(p, lds, gw, NGW, wave, lane); }
    SEAM(0);
    if (IN(1)) { phase_prenorm0(p, gw, NGW, lane); }
    SEAM(1);
    if (IN(2)) { OrderSingle S; S.init(ws + WS_H, ws + WS_WIN_T, MT, PROJ, 1024, G, bx); EpiStore E{(bf16_t*)(ws + WS_P), PROJ}; pg8::gemm_phase(lds, 1024, S, E); }
    SEAM(2);
    if (IN(3)) { phase_qkconv(p, gw, NGW, lane); }
    SEAM(3);
    if (IN(4)) { phase_attention(p, lds, G, vcu); }
    SEAM(4);
    if (IN(5)) { OrderSingle S; S.init(ws + WS_AO, ws + WS_WOUT_T, MT, 1024, 2048, G, bx); EpiResid E{p.in[I_X], p.in[I_CTX], (float*)(ws + WS_X1), gate1_l0}; pg8::gemm_phase(lds, 2048, S, E); }
    SEAM(5);
    if (IN(6)) { phase_moe_prenorm(p, lds, 0, (const float*)(ws + WS_X1), MT, (bf16_t*)(ws + WS_H), gw, NGW, lane); }
    SEAM(6);
    if (IN(7)) { phase_select(p, lds, 256, SL0, (const bf16_t*)(ws + WS_H), (bf16_t*)(ws + WS_XS0), G, bx, wave, lane); }
    SEAM(7);
    if (IN(8)) { OrderMoe S; S.init(ws + WS_XS0, ws + WS_WGU_T, 9, 8, 1024, G, vcu); EpiAct E{(bf16_t*)(ws + WS_ACT0)}; pg8::gemm_phase(lds, 1024, S, E); }
    SEAM(8);
    if (IN(9)) { OrderMoe S; S.init(ws + WS_ACT0, ws + WS_WD_T, 9, 4, 1024, G, vcu); EpiYs E{(bf16_t*)(ws + WS_YS0), (const float*)(ws + WS_SELAFF)}; pg8::gemm_phase(lds, 1024, S, E); }
    SEAM(9);
    if (IN(10)) { phase_combine0(p, gw, NGW, lane); }
    SEAM(10);
    if (IN(11)) { phase_mixes(p, gw, NGW, lane); }
    SEAM(11);
    if (IN(12)) { OrderRkv S; S.A0 = (const char*)(ws + WS_XR); S.A1 = (const char*)(ws + WS_XK); S.A2 = (const char*)(ws + WS_XV); S.A3 = (const char*)(ws + WS_XW); S.A4 = (const char*)(ws + WS_XA); S.A5 = (const char*)(ws + WS_XG);
        S.B0 = (const char*)(ws + WS_WR_T); S.B1 = (const char*)(ws + WS_WK_T); S.B2 = (const char*)(ws + WS_WV_T); S.B3 = (const char*)(ws + WS_WL1_T); S.G = G; S.c = vcu;
        EpiRkv E{(bf16_t*)(ws + WS_RB), (bf16_t*)(ws + WS_KB), (bf16_t*)(ws + WS_VB), (bf16_t*)(ws + WS_T1)}; pg8::gemm_phase(lds, 1024, S, E); }
    SEAM(12);
    if (IN(13)) { phase_features(p, gw, NGW, lane); }
    SEAM(13);
    if (IN(14)) { phase_scan(p, lds, G, bx, wave, lane); }
    SEAM(14);
    if (IN(15)) { phase_readout(p, lds, G, vcu, wave, lane); }
    SEAM(15);
    if (IN(16)) { OrderSingle S; S.init(ws + WS_Z, ws + WS_WO_T, ML, 1024, 1024, G, bx); EpiResid E{(const float*)(ws + WS_X2), (const float*)(ws + WS_X2) + (size_t)ML * DM, (float*)(ws + WS_X3), gate1_l1}; pg8::gemm_phase(lds, 1024, S, E); }
    SEAM(16);
    if (IN(17)) { phase_moe_prenorm(p, lds, 1, (const float*)(ws + WS_X3), ML, (bf16_t*)(ws + WS_H2), gw, NGW, lane);
        __syncthreads();
        LAS float* scr = (LAS float*)(lds + wave * 8448);
        for (int it = gw; it < P0_NMOE; it += NGW) moe_convert_item(p, 1, it, scr, lane); }
    SEAM(17);
    if (IN(18)) { phase_select(p, lds, 128, SL1, (const bf16_t*)(ws + WS_H2), (bf16_t*)(ws + WS_XS1), G, bx, wave, lane); }
    SEAM(18);
    if (IN(19)) { OrderMoe S; S.init(ws + WS_XS1, ws + WS_WGU_T, 8, 8, 1024, G, vcu); EpiAct E{(bf16_t*)(ws + WS_ACT1)}; pg8::gemm_phase(lds, 1024, S, E); }
    SEAM(19);
    if (IN(20)) { OrderMoe S; S.init(ws + WS_ACT1, ws + WS_WD_T, 8, 4, 1024, G, vcu); EpiYs E{(bf16_t*)(ws + WS_YS1), (const float*)(ws + WS_SELAFF)}; pg8::gemm_phase(lds, 1024, S, E); }
    SEAM(20);
    if (IN(21)) { phase_final(p, gw, NGW, lane); }
#undef IN
#undef SEAM
}

#ifndef MK_PER_PHASE
#define MK_PER_PHASE 1
#endif
extern "C" void kernel_launch(void* const* d_in, const int* in_sizes, int n_in, void* d_out, int out_size, void* d_ws, size_t ws_size, hipStream_t stream) {
    static int grid = 0;
    if (grid == 0) {
        if (n_in != 35 || out_size != ML * DM || ws_size < WS_END) { fprintf(stderr, "kernel_launch: unexpected shapes: n_in %d out %d ws %zu (need %zu)\n", n_in, out_size, ws_size, (size_t)WS_END); grid = -1; return; }
        int dev = 0, cus = 0;
        if (hipGetDevice(&dev) != hipSuccess || hipDeviceGetAttribute(&cus, hipDeviceAttributeMultiprocessorCount, dev) != hipSuccess) { grid = -1; return; }
        if (hipFuncSetAttribute((const void*)mega_fwd, hipFuncAttributeMaxDynamicSharedMemorySize, LDS_BYTES) != hipSuccess) { fprintf(stderr, "kernel_launch: hipFuncSetAttribute failed\n"); grid = -1; return; }
        int per_cu = 0; (void)hipOccupancyMaxActiveBlocksPerMultiprocessor(&per_cu, (const void*)mega_fwd, 512, LDS_BYTES); (void)hipGetLastError();
        if (per_cu < 1) fprintf(stderr, "kernel_launch: occupancy query reports %d blocks per CU\n", per_cu);
        grid = cus;
    }
    if (grid < 0) return;
    (void)in_sizes;
    (void)hipMemsetAsync((char*)d_ws + WS_CTL, 0, 1 * MiB, stream);
    Params a{};
    for (int i = 0; i < 35; ++i) a.in[i] = (const float*)d_in[i];
    a.out = (float*)d_out; a.ws = (unsigned char*)d_ws;
#if MK_PER_PHASE
    for (int ph = 0; ph < NPH; ++ph) { a.ph_lo = ph; a.ph_hi = ph + 1; hipLaunchKernelGGL(mega_fwd, dim3(grid), dim3(512), LDS_BYTES, stream, a); }
#else
    a.ph_lo = 0; a.ph_hi = NPH; hipLaunchKernelGGL(mega_fwd, dim3(grid), dim3(512), LDS_BYTES, stream, a);
#endif
    const hipError_t le = hipPeekAtLastError();
    if (le != hipSuccess) fprintf(stderr, "kernel_launch: launch failed: %s\n", hipGetErrorName(le));
}
```

```cpp
#include <hip/hip_runtime.h>
#include <cstdio>
#include <cstdint>

#define GAS __attribute__((address_space(1)))
#define LAS __attribute__((address_space(3)))
typedef unsigned short bf16_t;
typedef short bf16x8 __attribute__((ext_vector_type(8)));
typedef short s16x4 __attribute__((ext_vector_type(4)));
typedef float f32x4 __attribute__((ext_vector_type(4)));
typedef float f32x2 __attribute__((ext_vector_type(2)));
typedef float f32x8 __attribute__((ext_vector_type(8)));
typedef float f32x16 __attribute__((ext_vector_type(16)));
typedef unsigned u32x4 __attribute__((ext_vector_type(4)));
typedef unsigned u32x2 __attribute__((ext_vector_type(2)));

constexpr int NB = 8, SEQ = 2048, CTXL = 256, DM = 1024;
constexpr int ML = NB * SEQ, MC = NB * CTXL, MT = ML + MC;
constexpr int PROJ = 4608, NE = 16;
constexpr int KVL = CTXL + SEQ;
constexpr int CAPL = 256, CAPC = 32, SL0 = NB * CAPL + NB * CAPC  , SL1 = NB * CAPL  ;

constexpr size_t MiB = 1u << 20;
constexpr size_t WS_CTL = 0;
constexpr size_t CTL_BAR_WORD = 4096;
constexpr size_t WS_MOD = 512 * 1024;
constexpr size_t WS_AFF = 2 * MiB;
constexpr size_t WS_TOKSLOT = 4 * MiB;
constexpr size_t WS_SELAFF = 6 * MiB;
constexpr size_t WS_WIN_T = 8 * MiB;
constexpr size_t WS_WOUT_T = 17 * MiB;
constexpr size_t WS_WR_T = 21 * MiB, WS_WK_T = 23 * MiB, WS_WV_T = 25 * MiB, WS_WO_T = 27 * MiB;
constexpr size_t WS_WL1_T = 29 * MiB;
constexpr size_t WS_W2T = 31 * MiB;
constexpr size_t WS_A2T = WS_W2T + 256 * 1024, WS_G2T = WS_W2T + 512 * 1024;
constexpr size_t WS_WMOE = 32 * MiB;
constexpr size_t WS_WGU_T = WS_WMOE, WS_WD_T = WS_WMOE + 64 * MiB;
constexpr size_t AB = 128 * MiB;
constexpr size_t WS_P = AB + 0 * MiB;
constexpr size_t WS_H = AB + 162 * MiB;
constexpr size_t WS_AO = AB + 198 * MiB;
constexpr size_t WS_Q = AB + 270 * MiB;
constexpr size_t WS_KA = AB + 306 * MiB, WS_VA = AB + 315 * MiB;
constexpr size_t WS_X1 = AB + 0 * MiB;
constexpr size_t WS_XS0 = AB + 72 * MiB, WS_YS0 = AB + 72 * MiB;
constexpr size_t WS_ACT0 = AB + 198 * MiB;
constexpr size_t WS_X2 = AB + 308 * MiB;
constexpr size_t WS_XR = AB + 0 * MiB, WS_XK = AB + 32 * MiB, WS_XV = AB + 68 * MiB, WS_XW = AB + 104 * MiB, WS_XA = AB + 198 * MiB, WS_XG = AB + 234 * MiB;
constexpr size_t WS_RB = WS_WMOE, WS_KB = WS_WMOE + 32 * MiB, WS_T1 = WS_WMOE + 68 * MiB;
constexpr size_t WS_VB = AB + 380 * MiB;
constexpr size_t WS_KK = AB + 0 * MiB, WS_LD = AB + 36 * MiB, WS_AA = AB + 108 * MiB;
constexpr size_t WS_Y = AB + 180 * MiB;
constexpr size_t WS_Z = AB + 0 * MiB;
constexpr size_t WS_X3 = AB + 36 * MiB;
constexpr size_t WS_H2 = AB + 108 * MiB;
constexpr size_t WS_XS1 = AB + 180 * MiB, WS_YS1 = AB + 180 * MiB, WS_ACT1 = AB + 244 * MiB;
constexpr size_t WS_END = AB + 416 * MiB;

constexpr int RING_BYTES = 131072, LDSCTL_OFF = RING_BYTES, MISC_OFF = LDSCTL_OFF + 320, LDS_BYTES = 147456;

#define LDS_WAIT() asm volatile("s_waitcnt lgkmcnt(0)" ::: "memory")
#define VM_WAIT() asm volatile("s_waitcnt vmcnt(0)" ::: "memory")
__device__ __forceinline__ float bf2f(unsigned b) { return __uint_as_float(b << 16); }
__device__ __forceinline__ unsigned f2bf(float f) { unsigned u = __float_as_uint(f); return (u + 0x7fffu + ((u >> 16) & 1u)) >> 16; }
__device__ __forceinline__ unsigned pk2(float lo, float hi) { return f2bf(lo) | (f2bf(hi) << 16); }
__device__ __forceinline__ float wave_sum(float v) {
#pragma unroll
    for (int o = 1; o < 64; o <<= 1) v += __shfl_xor(v, o);
    return v;
}
__device__ __forceinline__ int wave_sum_i(int v) {
#pragma unroll
    for (int o = 1; o < 64; o <<= 1) v += __shfl_xor(v, o);
    return v;
}
__device__ __forceinline__ float sigmoidf_(float x) { return 1.0f / (1.0f + __expf(-x)); }
__device__ __forceinline__ f32x4 unpk4(u32x2 w) { return (f32x4){bf2f(w.x & 0xffffu), bf2f(w.x >> 16), bf2f(w.y & 0xffffu), bf2f(w.y >> 16)}; }
__device__ __forceinline__ u32x2 pk4(f32x4 v) { u32x2 w; w.x = pk2(v.x, v.y); w.y = pk2(v.z, v.w); return w; }

#define XB_TMO      128
#define XB_XCNT(j)  (256  + 64 * (j))
#define XB_XSUB(j)  (1280 + 64 * (j))
#define XB_XGEN(j)  (2304 + 64 * (j))
#define XB_TOP      3328
#define XB_TOPGEN   3392
#define XCD_BAR_WORDS 3456
#define XB_SPIN_CAP (1u << 18)
__device__ __forceinline__ unsigned xb_ld(unsigned* p)              { return __hip_atomic_load(p, __ATOMIC_RELAXED, __HIP_MEMORY_SCOPE_AGENT); }
__device__ __forceinline__ unsigned xb_add(unsigned* p, unsigned v) { return __hip_atomic_fetch_add(p, v, __ATOMIC_RELAXED, __HIP_MEMORY_SCOPE_AGENT); }
__device__ __forceinline__ unsigned xb_xcc_id() { return (unsigned)__builtin_amdgcn_s_getreg((3 << 11) | 20) & 0xFu; }
#define XB_SPIN(cond, bar) do { unsigned _sp = 0; while (cond) { __builtin_amdgcn_s_sleep(1); \
    if ((++_sp & 255u) == 0u) { if (xb_ld(&(bar)[XB_TMO])) break; if (_sp > XB_SPIN_CAP) { atomicAdd(&(bar)[XB_TMO], 1u); break; } } } } while (0)
struct XcdBarrier { unsigned* bar; unsigned x; volatile LAS unsigned* st; };
__device__ __forceinline__ XcdBarrier xcd_barrier_post(unsigned* bar, volatile LAS unsigned* st) {
    XcdBarrier b; b.bar = bar; b.x = xb_xcc_id(); b.st = st;
    if (threadIdx.x == 0) (void)xb_add(&bar[XB_XCNT(b.x)], 1u);
    return b;
}
__device__ __forceinline__ void xcd_barrier_complete(unsigned* bar, unsigned x, unsigned& nloc, unsigned& nx) {
    const unsigned G = gridDim.x * gridDim.y * gridDim.z;
    unsigned sum, cnt, mine, sp = 0u;
    for (;;) {
        sum = 0u; cnt = 0u; mine = 0u;
#pragma unroll
        for (unsigned j = 0; j < 16; ++j) { const unsigned c = xb_ld(&bar[XB_XCNT(j)]); sum += c; cnt += (c > 0u) ? 1u : 0u; mine = (j == x) ? c : mine; }
        if (sum == G) break;
        __builtin_amdgcn_s_sleep(1);
        if ((++sp & 255u) == 0u) { if (xb_ld(&bar[XB_TMO])) break; if (sp > XB_SPIN_CAP) { atomicAdd(&bar[XB_TMO], 1u); break; } }
    }
    nloc = mine > 0u ? mine : 1u; nx = cnt > 0u ? cnt : 1u;
}
__device__ __forceinline__ void xcd_barrier(const XcdBarrier& b) {
    asm volatile("s_waitcnt vmcnt(0)" ::: "memory");
    __syncthreads();
    if (threadIdx.x == 0) {
        unsigned* bar = b.bar;
        __builtin_amdgcn_s_waitcnt(0);
        unsigned nloc = b.st[0], nx = b.st[1];
        if (nloc == 0u) { xcd_barrier_complete(bar, b.x, nloc, nx); b.st[0] = nloc; b.st[1] = nx; }
        const unsigned old = xb_add(&bar[XB_XSUB(b.x)], 1u);
        const unsigned gen = old / nloc;
        if (old + 1u == (gen + 1u) * nloc) {
            __builtin_amdgcn_fence(__ATOMIC_RELEASE, "agent");
            asm volatile("s_waitcnt vmcnt(0)" ::: "memory");
            const unsigned og = xb_add(&bar[XB_TOP], 1u);
            const unsigned tg = og / nx;
            if (og + 1u == (tg + 1u) * nx) xb_add(&bar[XB_TOPGEN], 1u);
            else XB_SPIN(xb_ld(&bar[XB_TOPGEN]) == tg, bar);
            __builtin_amdgcn_fence(__ATOMIC_ACQUIRE, "agent");
            xb_add(&bar[XB_XGEN(b.x)], 1u);
            asm volatile("s_waitcnt vmcnt(0)" ::: "memory");
        } else {
            XB_SPIN(xb_ld(&bar[XB_XGEN(b.x)]) == gen, bar);
            __builtin_amdgcn_fence(__ATOMIC_ACQUIRE, "agent");
            asm volatile("s_waitcnt vmcnt(0)" ::: "memory");
        }
    }
    __syncthreads();
}

namespace pg8 {
constexpr int BM = 256, BK = 64, HALF = 128, HTB = HALF * BK * 2, STAGE_BYTES = 8 * HTB;
__host__ __device__ __forceinline__ int lds_byte(int r, int c) { const int st = (r >> 4) * 2 + (c >> 5), rr = r & 15, cc = c & 31, ob = rr * 64 + cc * 2; return st * 1024 + (ob ^ (((ob >> 9) & 1) << 5)); }
__host__ __device__ __forceinline__ void stage_rc(int b, int& R, int& C) { const int st = b / 1024, sb = b % 1024, swz = sb ^ (((sb >> 9) & 1) << 5); R = (st >> 1) * 16 + swz / 64; C = (st & 1) * 32 + (swz % 64) / 2; }
__host__ __device__ __forceinline__ int perm32(int rho) { const int n = rho >> 4, i = rho & 15; return 8 * (i >> 2) + 4 * n + (i & 3); }
struct Unit { int pm, pn, gi; };
__device__ __forceinline__ unsigned cvt_pk_bf16(float lo, float hi) { unsigned r; asm volatile("v_cvt_pk_bf16_f32 %0, %1, %2" : "=v"(r) : "v"(lo), "v"(hi)); return r; }

template <class Epi, class Sched>
__device__ __forceinline__ void gemm_phase(LAS unsigned char* lds, const int K, const Sched& S, const Epi& E) {
    const int tid = threadIdx.x, wid = __builtin_amdgcn_readfirstlane(tid >> 6), lane = tid & 63, wr = wid >> 2, wc = wid & 3, fr = lane & 15, fq = lane >> 4;
    const int nt = K / BK;
    unsigned voffA[2], voffB[2];
#pragma unroll
    for (int i = 0; i < 2; ++i) { int R, C; stage_rc(tid * 16 + i * 8192, R, C); const int Rb = Epi::PERM ? ((R & ~31) + perm32(R & 31)) : R;
        voffA[i] = (unsigned)(R * K + C) * 2u; voffB[i] = (unsigned)(Rb * K + C) * 2u; }
    const size_t kstep = (size_t)(BK * 2);
    const size_t hstep = (size_t)HALF * K * 2;
    const unsigned ldsw = (unsigned)wid * 1024u;
    const int aoff = lds_byte(wr * 64 + fr, fq * 8), boff = lds_byte(wc * 32 + fr, fq * 8);
#define PG8_SA(b, h) (((b) * 2 + (h)) * HTB)
#define PG8_SB(b, h) ((4 + (b) * 2 + (h)) * HTB)
#define PG8_STAGE(bufoff, gbase, voff) do { _Pragma("unroll") for (int _i = 0; _i < 2; ++_i) \
        __builtin_amdgcn_global_load_lds((const unsigned*)((const char*)(gbase) + (voff)[_i]), (LAS unsigned*)(lds + (bufoff) + ldsw + _i * 8192), 16, 0, 0); } while (0)
#define PG8_LDA(dst, b, h) do { _Pragma("unroll") for (int m = 0; m < 4; ++m) _Pragma("unroll") for (int k = 0; k < 2; ++k) dst[m][k] = *(const LAS bf16x8*)(lds + PG8_SA(b, h) + aoff + m * 2048 + k * 1024); } while (0)
#define PG8_LDB(dst, b, h) do { _Pragma("unroll") for (int n = 0; n < 2; ++n) _Pragma("unroll") for (int k = 0; k < 2; ++k) dst[n][k] = *(const LAS bf16x8*)(lds + PG8_SB(b, h) + boff + n * 2048 + k * 1024); } while (0)
#define PG8_MMA(ai, bj, At, Bt) do { __builtin_amdgcn_s_setprio(1); _Pragma("unroll") for (int m = 0; m < 4; ++m) _Pragma("unroll") for (int n = 0; n < 2; ++n) _Pragma("unroll") for (int k = 0; k < 2; ++k) \
        acc[ai][bj][m][n] = __builtin_amdgcn_mfma_f32_16x16x32_bf16(Bt[n][k], At[m][k], acc[ai][bj][m][n], 0, 0, 0); __builtin_amdgcn_s_setprio(0); } while (0)
#define PG8_WAIT_V(n) asm volatile("s_waitcnt vmcnt(" #n ")" ::: "memory")
#define PG8_WAIT_L(n) asm volatile("s_waitcnt lgkmcnt(" #n ")" ::: "memory")
#define PG8_BAR __builtin_amdgcn_s_barrier()
#define PG8_SCHED __builtin_amdgcn_sched_barrier(0)
    Unit cur, nxt; int ui = 0;
    if (!S.next(0, cur)) return;
    f32x4 acc[2][2][4][2];
#pragma unroll
    for (int a = 0; a < 2; ++a)
#pragma unroll
        for (int b = 0; b < 2; ++b)
#pragma unroll
            for (int m = 0; m < 4; ++m)
#pragma unroll
                for (int n = 0; n < 2; ++n) acc[a][b][m][n] = (f32x4){0.f, 0.f, 0.f, 0.f};
    bf16x8 At[4][2], B0[2][2], B1[2][2];
    const char* cA = S.a_base(cur); const char* cB = S.b_base(cur);
    PG8_STAGE(PG8_SB(0, 0), cB, voffB); PG8_STAGE(PG8_SA(0, 0), cA, voffA); PG8_STAGE(PG8_SB(0, 1), cB + hstep, voffB); PG8_STAGE(PG8_SA(0, 1), cA + hstep, voffA);
    if (wr == 1) PG8_BAR;
    PG8_WAIT_V(4); PG8_BAR;
    PG8_STAGE(PG8_SB(1, 0), cB + kstep, voffB); PG8_STAGE(PG8_SA(1, 0), cA + kstep, voffA); PG8_STAGE(PG8_SB(1, 1), cB + hstep + kstep, voffB);
    PG8_WAIT_V(6); PG8_BAR;
    for (;;) {
        const bool has_next = S.next(ui + 1, nxt);
        const char* nA = has_next ? S.a_base(nxt) : cA; const char* nB = has_next ? S.b_base(nxt) : cB;
        for (int t = 0; t < nt; t += 2) {
            const bool last = (t == nt - 2);
            const char* a1 = cA + (size_t)(t + 1) * kstep;
            const char* a2 = last ? nA : cA + (size_t)(t + 2) * kstep; const char* b2 = last ? nB : cB + (size_t)(t + 2) * kstep;
            const char* a3 = a2 + kstep; const char* b3 = b2 + kstep;
            PG8_LDB(B0, 0, 0); PG8_SCHED; PG8_LDA(At, 0, 0); PG8_STAGE(PG8_SA(1, 1), a1 + hstep, voffA);
            PG8_WAIT_L(8); PG8_BAR; PG8_WAIT_L(0); PG8_MMA(0, 0, At, B0); PG8_BAR; PG8_SCHED;
            PG8_LDB(B1, 0, 1); PG8_STAGE(PG8_SB(0, 0), b2, voffB);
            PG8_BAR; PG8_WAIT_L(0); PG8_MMA(0, 1, At, B1); PG8_BAR;
            PG8_LDA(At, 0, 1); PG8_STAGE(PG8_SA(0, 0), a2, voffA);
            PG8_BAR; PG8_WAIT_L(0); PG8_MMA(1, 0, At, B0); PG8_BAR; PG8_SCHED;
            PG8_STAGE(PG8_SB(0, 1), b2 + hstep, voffB);
            PG8_WAIT_V(6); PG8_BAR; PG8_MMA(1, 1, At, B1); PG8_BAR;
            PG8_LDB(B0, 1, 0); PG8_SCHED; PG8_LDA(At, 1, 0); PG8_STAGE(PG8_SA(0, 1), a2 + hstep, voffA);
            PG8_WAIT_L(8); PG8_BAR; PG8_WAIT_L(0); PG8_MMA(0, 0, At, B0); PG8_BAR; PG8_SCHED;
            PG8_LDB(B1, 1, 1); PG8_STAGE(PG8_SB(1, 0), b3, voffB);
            PG8_BAR; PG8_WAIT_L(0); PG8_MMA(0, 1, At, B1); PG8_BAR;
            PG8_LDA(At, 1, 1); PG8_STAGE(PG8_SA(1, 0), a3, voffA);
            PG8_BAR; PG8_WAIT_L(0); PG8_MMA(1, 0, At, B0); PG8_BAR; PG8_SCHED;
            PG8_STAGE(PG8_SB(1, 1), b3 + hstep, voffB);
            PG8_WAIT_V(6); PG8_BAR; PG8_MMA(1, 1, At, B1); PG8_BAR;
        }
        E(acc, cur, wr, wc, fr, fq);
        if (!has_next) break;
#pragma unroll
        for (int a = 0; a < 2; ++a)
#pragma unroll
            for (int b = 0; b < 2; ++b)
#pragma unroll
                for (int m = 0; m < 4; ++m)
#pragma unroll
                    for (int n = 0; n < 2; ++n) acc[a][b][m][n] = (f32x4){0.f, 0.f, 0.f, 0.f};
        cur = nxt; cA = nA; cB = nB; ++ui;
    }
    PG8_WAIT_V(0);
    if (wr == 0) PG8_BAR;
    PG8_BAR;
#undef PG8_SA
#undef PG8_SB
#undef PG8_STAGE
#undef PG8_LDA
#undef PG8_LDB
#undef PG8_MMA
#undef PG8_WAIT_V
#undef PG8_WAIT_L
#undef PG8_BAR
#undef PG8_SCHED
}
}
struct Params { const float* in[35]; float* out; unsigned char* ws; int ph_lo, ph_hi; };
enum { I_X = 0, I_C, I_CTX, I_CCTX, I_ADAW, I_ADAB, I_NORMG, I_FINALG, I_WIN, I_WOUT, I_QG, I_KG, I_CONVW, I_MU, I_WR, I_WK, I_WV, I_WO, I_W0, I_W1, I_W2,
       I_A0, I_A1, I_A2, I_G1, I_G2, I_KK, I_KA, I_RK, I_LNW, I_LNB, I_ROUTER, I_WGATE, I_WUP, I_WDOWN };

struct OrderSingle {
    const char* A; const char* Bt; int nM, nN, nwg, G, c; size_t tstep;
    __device__ __forceinline__ void init(const void* A_, const void* Bt_, int M, int N, int K, int G_, int c_) { A = (const char*)A_; Bt = (const char*)Bt_; nM = M / 256; nN = N / 256; nwg = nM * nN; G = G_; c = c_; tstep = (size_t)256 * K * 2; }
    __device__ __forceinline__ bool next(int i, pg8::Unit& u) const {
        const long L = (long)i * G + c; if (L >= nwg) return false;
        int wgid = (int)L; { const int q = nwg / 8, r = nwg % 8, xcd = wgid % 8, off = wgid / 8; wgid = (xcd < r ? xcd * (q + 1) : r * (q + 1) + (xcd - r) * q) + off; }
        const int nig = 8 * nN, gid = wgid / nig, fm = gid * 8, gsz = (nM - fm) < 8 ? (nM - fm) : 8;
        u.pm = fm + ((wgid % nig) % gsz); u.pn = (wgid % nig) / gsz; u.gi = 0; return true;
    }
    __device__ __forceinline__ const char* a_base(const pg8::Unit& u) const { return A + (size_t)u.pm * tstep; }
    __device__ __forceinline__ const char* b_base(const pg8::Unit& u) const { return Bt + (size_t)u.pn * tstep; }
};
struct OrderMoe {
    const char* A; const char* Bt; int PM, PN, nwg, G, c; size_t tstep;
    __device__ __forceinline__ void init(const void* A_, const void* Bt_, int PM_, int PN_, int K, int G_, int c_) { A = (const char*)A_; Bt = (const char*)Bt_; PM = PM_; PN = PN_; nwg = NE * PM * PN; G = G_; c = c_; tstep = (size_t)256 * K * 2; }
    __device__ __forceinline__ bool next(int i, pg8::Unit& u) const {
        const int L = i * G + c; if (L >= nwg) return false;
        const int per = PM * PN, e = L / per, r = L % per; u.pm = e * PM + (r % PM); u.pn = e * PN + (r / PM); u.gi = e; return true;
    }
    __device__ __forceinline__ const char* a_base(const pg8::Unit& u) const { return A + (size_t)u.pm * tstep; }
    __device__ __forceinline__ const char* b_base(const pg8::Unit& u) const { return Bt + (size_t)u.pn * tstep; }
};
struct OrderRkv {
    const char *A0, *A1, *A2, *A3, *A4, *A5, *B0, *B1, *B2, *B3; int G, c;
    __device__ __forceinline__ bool next(int i, pg8::Unit& u) const {
        int L = i * G + c; if (L >= 1040) return false;
        int gi, nM;
        if (L < 256) { gi = 0; nM = 64; } else if (L < 544) { gi = 1; nM = 72; L -= 256; } else if (L < 832) { gi = 2; nM = 72; L -= 544; }
        else if (L < 904) { gi = 3; nM = 72; L -= 832; } else if (L < 976) { gi = 4; nM = 72; L -= 904; } else { gi = 5; nM = 64; L -= 976; }
        u.gi = gi; u.pm = L % nM; u.pn = L / nM; return true;
    }
    __device__ __forceinline__ const char* a_base(const pg8::Unit& u) const {
        const char* a = u.gi == 0 ? A0 : u.gi == 1 ? A1 : u.gi == 2 ? A2 : u.gi == 3 ? A3 : u.gi == 4 ? A4 : A5; return a + (size_t)u.pm * (256 * 1024 * 2); }
    __device__ __forceinline__ const char* b_base(const pg8::Unit& u) const {
        const char* b = u.gi == 0 ? B0 : u.gi == 1 ? B1 : u.gi == 2 ? B2 : B3 + (size_t)(u.gi - 3) * (256 * 1024 * 2); return b + (size_t)u.pn * (256 * 1024 * 2); }
};

typedef f32x4 Acc[2][2][4][2];
__device__ __forceinline__ u32x4 pack8(f32x4 v0, f32x4 v1) { u32x4 w; w.x = pg8::cvt_pk_bf16(v0[0], v0[1]); w.y = pg8::cvt_pk_bf16(v0[2], v0[3]); w.z = pg8::cvt_pk_bf16(v1[0], v1[1]); w.w = pg8::cvt_pk_bf16(v1[2], v1[3]); return w; }
struct EpiStore {
    static constexpr bool PERM = true;
    bf16_t* O; int ldc;
    __device__ __forceinline__ void operator()(const Acc& acc, const pg8::Unit& u, int wr, int wc, int fr, int fq) const {
        const int row0 = u.pm * 256 + wr * 64 + fr, col0 = u.pn * 256 + wc * 32 + 8 * fq;
#pragma unroll
        for (int ai = 0; ai < 2; ++ai)
#pragma unroll
            for (int m = 0; m < 4; ++m) { bf16_t* rowp = O + (size_t)(row0 + ai * 128 + m * 16) * ldc + col0;
#pragma unroll
                for (int bj = 0; bj < 2; ++bj) *(u32x4*)(rowp + bj * 128) = pack8(acc[ai][bj][m][0], acc[ai][bj][m][1]); }
    }
};
struct EpiResid {
    static constexpr bool PERM = false;
    const float* baseL; const float* baseC; float* O; const float* gate;
    __device__ __forceinline__ void operator()(const Acc& acc, const pg8::Unit& u, int wr, int wc, int fr, int fq) const {
        const int row0 = u.pm * 256 + wr * 64 + fr, col0 = u.pn * 256 + wc * 32 + 4 * fq;
        const int mr = u.pm < 64 ? (u.pm >> 3) : 8;
        const float* gt = gate + (size_t)mr * 6144;
        f32x4 g4[2][2];
#pragma unroll
        for (int bj = 0; bj < 2; ++bj)
#pragma unroll
            for (int n = 0; n < 2; ++n) g4[bj][n] = *(const f32x4*)(gt + col0 + bj * 128 + n * 16);
#pragma unroll
        for (int ai = 0; ai < 2; ++ai)
#pragma unroll
            for (int m = 0; m < 4; ++m) { const int row = row0 + ai * 128 + m * 16;
                const float* bp = (row < ML ? baseL + (size_t)row * DM : baseC + (size_t)(row - ML) * DM) + col0; float* op = O + (size_t)row * DM + col0;
#pragma unroll
                for (int bj = 0; bj < 2; ++bj)
#pragma unroll
                    for (int n = 0; n < 2; ++n) { const f32x4 b = *(const f32x4*)(bp + bj * 128 + n * 16); *(f32x4*)(op + bj * 128 + n * 16) = b + g4[bj][n] * acc[ai][bj][m][n]; }
                asm volatile("" ::: "memory"); }
    }
};
struct EpiAct {
    static constexpr bool PERM = true;
    bf16_t* O;
    __device__ __forceinline__ void operator()(const Acc& acc, const pg8::Unit& u, int wr, int wc, int fr, int fq) const {
        const int row0 = u.pm * 256 + wr * 64 + fr, f0 = (u.pn & 7) * 128 + wc * 32 + 8 * fq;
#pragma unroll
        for (int ai = 0; ai < 2; ++ai)
#pragma unroll
            for (int m = 0; m < 4; ++m) { bf16_t* rowp = O + (size_t)(row0 + ai * 128 + m * 16) * DM + f0;
                f32x4 o[2];
#pragma unroll
                for (int n = 0; n < 2; ++n) { const f32x4 g = acc[ai][0][m][n], up = acc[ai][1][m][n];
#pragma unroll
                    for (int j = 0; j < 4; ++j) o[n][j] = g[j] * sigmoidf_(g[j]) * up[j]; }
                *(u32x4*)rowp = pack8(o[0], o[1]); }
    }
};
struct EpiYs {
    static constexpr bool PERM = true;
    bf16_t* O; const float* selaff;
    __device__ __forceinline__ void operator()(const Acc& acc, const pg8::Unit& u, int wr, int wc, int fr, int fq) const {
        const int row0 = u.pm * 256 + wr * 64 + fr, col0 = (u.pn & 3) * 256 + wc * 32 + 8 * fq;
#pragma unroll
        for (int ai = 0; ai < 2; ++ai)
#pragma unroll
            for (int m = 0; m < 4; ++m) { const int row = row0 + ai * 128 + m * 16; const float s = selaff[row]; bf16_t* rowp = O + (size_t)row * DM + col0;
#pragma unroll
                for (int bj = 0; bj < 2; ++bj) *(u32x4*)(rowp + bj * 128) = pack8(acc[ai][bj][m][0] * s, acc[ai][bj][m][1] * s); }
    }
};
struct EpiRkv {
    static constexpr bool PERM = true;
    bf16_t *R, *K, *V, *T1;
    __device__ __forceinline__ void operator()(const Acc& acc, const pg8::Unit& u, int wr, int wc, int fr, int fq) const {
        const int row0 = u.pm * 256 + wr * 64 + fr;
        if (u.gi < 3) {
            bf16_t* O = u.gi == 0 ? R : u.gi == 1 ? K : V; const int col0 = u.pn * 256 + wc * 32 + 8 * fq;
#pragma unroll
            for (int ai = 0; ai < 2; ++ai)
#pragma unroll
                for (int m = 0; m < 4; ++m) { bf16_t* rowp = O + (size_t)(row0 + ai * 128 + m * 16) * DM + col0;
#pragma unroll
                    for (int bj = 0; bj < 2; ++bj) *(u32x4*)(rowp + bj * 128) = pack8(acc[ai][bj][m][0], acc[ai][bj][m][1]); }
        } else {
            bf16_t* O = T1 + (size_t)(u.gi - 3) * MT * 128; const int col0 = wc * 32 + 8 * fq;
#pragma unroll
            for (int ai = 0; ai < 2; ++ai)
#pragma unroll
                for (int m = 0; m < 4; ++m) *(u32x4*)(O + (size_t)(row0 + ai * 128 + m * 16) * 128 + col0) = pack8(acc[ai][0][m][0], acc[ai][0][m][1]);
        }
    }
};
__device__ __forceinline__ void ld_row_f32(const float* p, int lane, f32x4 (&v)[4]) {
#pragma unroll
    for (int j = 0; j < 4; ++j) v[j] = *(const f32x4*)(p + 256 * j + 4 * lane);
}
__device__ __forceinline__ void ld_row_bf16(const bf16_t* p, int lane, f32x4 (&v)[4]) {
#pragma unroll
    for (int j = 0; j < 4; ++j) v[j] = unpk4(*(const u32x2*)(p + 256 * j + 4 * lane));
}
__device__ __forceinline__ void st_row_f32(float* p, int lane, const f32x4 (&v)[4]) {
#pragma unroll
    for (int j = 0; j < 4; ++j) *(f32x4*)(p + 256 * j + 4 * lane) = v[j];
}
__device__ __forceinline__ void st_row_bf16(bf16_t* p, int lane, const f32x4 (&v)[4]) {
#pragma unroll
    for (int j = 0; j < 4; ++j) *(u32x2*)(p + 256 * j + 4 * lane) = pk4(v[j]);
}
__device__ __forceinline__ void ada_row(f32x4 (&v)[4], const float* g, const float* sh, const float* sc, int lane) {
    float ss = 0.f;
#pragma unroll
    for (int j = 0; j < 4; ++j) ss += (v[j].x * v[j].x + v[j].y * v[j].y) + (v[j].z * v[j].z + v[j].w * v[j].w);
    ss = wave_sum(ss);
    const float rinv = 1.0f / sqrtf(ss * (1.0f / DM) + 1e-6f);
#pragma unroll
    for (int j = 0; j < 4; ++j) { const f32x4 gg = *(const f32x4*)(g + 256 * j + 4 * lane), s = *(const f32x4*)(sc + 256 * j + 4 * lane), h = *(const f32x4*)(sh + 256 * j + 4 * lane);
        v[j] = (v[j] * rinv) * gg * (s + 1.0f) + h; }
}

__device__ __forceinline__ void transpose_item(const float* W, int N, bf16_t* WT, int ldk, LAS float* scr, int k0, int n0, int drow0, int lane) {
#pragma unroll 8
    for (int i = 0; i < 32; ++i) { const int kk = 2 * i + (lane >> 5); scr[kk * 33 + (lane & 31)] = W[(size_t)(k0 + kk) * N + n0 + (lane & 31)]; }
    LDS_WAIT(); asm volatile("" ::: "memory");
    const int c = lane & 7;
#pragma unroll
    for (int j = 0; j < 4; ++j) { const int n = (lane >> 3) + 8 * j; const LAS float* s = scr + (8 * c) * 33 + n;
        u32x4 o; o.x = pk2(s[0 * 33], s[1 * 33]); o.y = pk2(s[2 * 33], s[3 * 33]); o.z = pk2(s[4 * 33], s[5 * 33]); o.w = pk2(s[6 * 33], s[7 * 33]);
        *(u32x4*)(WT + (size_t)(drow0 + n) * ldk + k0 + 8 * c) = o; }
    LDS_WAIT(); asm volatile("" ::: "memory");
}
__device__ __forceinline__ void moe_convert_item(const Params& p, int layer, int it, LAS float* scr, int lane) {
    const int e = it / 1536, r = it % 1536, which = r / 512, li = r % 512, k0 = 64 * (li / 32), n0 = 32 * (li % 32);
    const size_t woff = (size_t)(layer * NE + e) * 1024 * 1024;
    if (which == 0)      transpose_item(p.in[I_WGATE] + woff, 1024, (bf16_t*)(p.ws + WS_WGU_T) + (size_t)e * 2048 * 1024, 1024, scr, k0, n0, (n0 >> 7) * 256 + (n0 & 127), lane);
    else if (which == 1) transpose_item(p.in[I_WUP] + woff, 1024, (bf16_t*)(p.ws + WS_WGU_T) + (size_t)e * 2048 * 1024, 1024, scr, k0, n0, (n0 >> 7) * 256 + 128 + (n0 & 127), lane);
    else                 transpose_item(p.in[I_WDOWN] + woff, 1024, (bf16_t*)(p.ws + WS_WD_T) + (size_t)e * 1024 * 1024, 1024, scr, k0, n0, n0, lane);
}
__device__ __forceinline__ void small_convert_item(const Params& p, int it, LAS float* scr, int lane) {
    const float* W; int K, N, ldk; bf16_t* WT; int base;
    unsigned char* ws = p.ws;
    if (it < 2304)      { base = 0;    W = p.in[I_WIN];  K = 1024; N = 4608; WT = (bf16_t*)(ws + WS_WIN_T);  ldk = 1024; }
    else if (it < 3328) { base = 2304; W = p.in[I_WOUT]; K = 2048; N = 1024; WT = (bf16_t*)(ws + WS_WOUT_T); ldk = 2048; }
    else if (it < 3840) { base = 3328; W = p.in[I_WR];   K = 1024; N = 1024; WT = (bf16_t*)(ws + WS_WR_T);   ldk = 1024; }
    else if (it < 4352) { base = 3840; W = p.in[I_WK];   K = 1024; N = 1024; WT = (bf16_t*)(ws + WS_WK_T);   ldk = 1024; }
    else if (it < 4864) { base = 4352; W = p.in[I_WV];   K = 1024; N = 1024; WT = (bf16_t*)(ws + WS_WV_T);   ldk = 1024; }
    else if (it < 5376) { base = 4864; W = p.in[I_WO];   K = 1024; N = 1024; WT = (bf16_t*)(ws + WS_WO_T);   ldk = 1024; }
    else if (it < 5408) { base = 5376; W = p.in[I_W1];             K = 1024; N = 64;  WT = (bf16_t*)(ws + WS_WL1_T);                      ldk = 1024; }
    else if (it < 5440) { base = 5408; W = p.in[I_W1] + 1024 * 64; K = 1024; N = 64;  WT = (bf16_t*)(ws + WS_WL1_T) + 64 * 1024;          ldk = 1024; }
    else if (it < 5472) { base = 5440; W = p.in[I_A1];             K = 1024; N = 64;  WT = (bf16_t*)(ws + WS_WL1_T) + 256 * 1024;         ldk = 1024; }
    else if (it < 5504) { base = 5472; W = p.in[I_A1] + 1024 * 64; K = 1024; N = 64;  WT = (bf16_t*)(ws + WS_WL1_T) + (256 + 64) * 1024;  ldk = 1024; }
    else if (it < 5568) { base = 5504; W = p.in[I_G1];             K = 1024; N = 128; WT = (bf16_t*)(ws + WS_WL1_T) + 512 * 1024;         ldk = 1024; }
    else if (it < 5600) { base = 5568; W = p.in[I_W2];             K = 64;   N = 1024; WT = (bf16_t*)(ws + WS_W2T);                       ldk = 64; }
    else if (it < 5632) { base = 5600; W = p.in[I_W2] + 64 * 1024; K = 64;   N = 1024; WT = (bf16_t*)(ws + WS_W2T) + 1024 * 64;           ldk = 64; }
    else if (it < 5664) { base = 5632; W = p.in[I_A2];             K = 64;   N = 1024; WT = (bf16_t*)(ws + WS_A2T);                       ldk = 64; }
    else if (it < 5696) { base = 5664; W = p.in[I_A2] + 64 * 1024; K = 64;   N = 1024; WT = (bf16_t*)(ws + WS_A2T) + 1024 * 64;           ldk = 64; }
    else                { base = 5696; W = p.in[I_G2];             K = 128;  N = 1024; WT = (bf16_t*)(ws + WS_G2T);                       ldk = 128; }
    const int li = it - base, nblk = N / 32, k0 = 64 * (li / nblk), n0 = 32 * (li % nblk);
    (void)K;
    transpose_item(W, N, WT, ldk, scr, k0, n0, n0, lane);
}
constexpr int P0_NMOD = 768, P0_NSMALL = 5760, P0_NZERO = 384, P0_NMOE = 16 * 1536;
__device__ __forceinline__ void phase_prep(const Params& p, LAS unsigned char* lds, int gw, int NGW, int wave, int lane) {
    LAS float* scr = (LAS float*)(lds + wave * 8448);
    LAS float* S = (LAS float*)(lds + 69632);
    for (int i = threadIdx.x; i < 9 * 1024; i += 512) { const float c = i < 8192 ? p.in[I_C][i] : p.in[I_CCTX][i - 8192]; S[i] = c / (1.0f + __expf(-c)); }
    __syncthreads();
    float* mod = (float*)(p.ws + WS_MOD);
    const int NIT = P0_NMOD + P0_NSMALL + P0_NZERO + P0_NMOE;
    for (int it = gw; it < NIT; it += NGW) {
        if (it < P0_NMOD) {
            const int l = it / 384, r = it % 384, nch = r >> 2, kq = r & 3, n = nch * 64 + lane, kb = kq * 256;
            const float* w = p.in[I_ADAW] + ((size_t)l * 1024 + kb) * 6144 + n;
            float acc[9];
#pragma unroll
            for (int r9 = 0; r9 < 9; ++r9) acc[r9] = 0.f;
            for (int k = 0; k < 256; k += 8) {
                float wv[8];
#pragma unroll
                for (int u = 0; u < 8; ++u) wv[u] = w[(size_t)(k + u) * 6144];
#pragma unroll
                for (int u = 0; u < 8; ++u)
#pragma unroll
                    for (int r9 = 0; r9 < 9; ++r9) acc[r9] += S[r9 * 1024 + kb + k + u] * wv[u];
            }
            const float bias = kq == 0 ? p.in[I_ADAB][l * 6144 + n] : 0.f;
#pragma unroll
            for (int r9 = 0; r9 < 9; ++r9) atomicAdd(&mod[(size_t)(l * 9 + r9) * 6144 + n], acc[r9] + bias);
        } else if (it < P0_NMOD + P0_NSMALL) {
            small_convert_item(p, it - P0_NMOD, scr, lane);
        } else if (it < P0_NMOD + P0_NSMALL + P0_NZERO) {
            const int r = it - P0_NMOD - P0_NSMALL, g = r >> 7, row = 128 + (r & 127);
            bf16_t* dst = (bf16_t*)(p.ws + WS_WL1_T) + (size_t)(g * 256 + row) * 1024;
            *(u32x4*)(dst + lane * 8) = (u32x4){0u, 0u, 0u, 0u}; *(u32x4*)(dst + 512 + lane * 8) = (u32x4){0u, 0u, 0u, 0u};
        } else {
            moe_convert_item(p, 0, it - P0_NMOD - P0_NSMALL - P0_NZERO, scr, lane);
        }
    }
}

__device__ __forceinline__ void phase_prenorm0(const Params& p, int gw, int NGW, int lane) {
    const float* mod = (const float*)(p.ws + WS_MOD);
    bf16_t* H = (bf16_t*)(p.ws + WS_H);
    for (int row = gw; row < MT; row += NGW) {
        const float* xr = row < ML ? p.in[I_X] + (size_t)row * DM : p.in[I_CTX] + (size_t)(row - ML) * DM;
        const int mr = row < ML ? (row >> 11) : 8;
        const float* m = mod + (size_t)mr * 6144;
        f32x4 v[4]; ld_row_f32(xr, lane, v);
        ada_row(v, p.in[I_NORMG], m, m + 1024, lane);
        st_row_bf16(H + (size_t)row * DM, lane, v);
    }
}

__device__ __forceinline__ void phase_qkconv(const Params& p, int gw, int NGW, int lane) {
    const bf16_t* P = (const bf16_t*)(p.ws + WS_P);
    bf16_t* Q = (bf16_t*)(p.ws + WS_Q); bf16_t* KA = (bf16_t*)(p.ws + WS_KA); bf16_t* VA = (bf16_t*)(p.ws + WS_VA); bf16_t* AO = (bf16_t*)(p.ws + WS_AO);
    const float qg1 = p.in[I_QG][lane], qg2 = p.in[I_QG][64 + lane], kg1 = p.in[I_KG][lane], kg2 = p.in[I_KG][64 + lane];
    const float inv = powf(10000.0f, -(float)(lane & 31) / 32.0f);
    const float* cw = p.in[I_CONVW];
    for (int row = gw; row < MT; row += NGW) {
        const bool lat = row < ML;
        const int b = lat ? (row >> 11) : ((row - ML) >> 8), t = lat ? (row & 2047) : ((row - ML) & 255), T = lat ? SEQ : CTXL;
        const bf16_t* pr = P + (size_t)row * PROJ;
        float cs = 1.f, sn = 0.f;
        if (lat) { const float pos = (float)(lane < 32 ? (t >> 6) : (t & 63)); const float ang = pos * inv; cs = cosf(ang); sn = sinf(ang); }
#pragma unroll
        for (int hd = 0; hd < 8; ++hd) {
            const float x1 = bf2f(pr[hd * 128 + lane]), x2 = bf2f(pr[hd * 128 + 64 + lane]);
            const float ss = wave_sum(x1 * x1 + x2 * x2);
            const float rinv = 1.0f / sqrtf(ss * (1.0f / 128.0f) + 1e-6f);
            const float y1 = x1 * rinv * qg1, y2 = x2 * rinv * qg2;
            Q[(size_t)row * DM + hd * 128 + lane] = (bf16_t)f2bf(y1 * cs - y2 * sn);
            Q[(size_t)row * DM + hd * 128 + 64 + lane] = (bf16_t)f2bf(y2 * cs + y1 * sn);
        }
        const size_t kvrow = ((size_t)b * KVL + (lat ? CTXL + t : t)) * 256;
#pragma unroll
        for (int kh = 0; kh < 2; ++kh) {
            const float x1 = bf2f(pr[1024 + kh * 128 + lane]), x2 = bf2f(pr[1024 + kh * 128 + 64 + lane]);
            const float ss = wave_sum(x1 * x1 + x2 * x2);
            const float rinv = 1.0f / sqrtf(ss * (1.0f / 128.0f) + 1e-6f);
            const float y1 = x1 * rinv * kg1, y2 = x2 * rinv * kg2;
            KA[kvrow + kh * 128 + lane] = (bf16_t)f2bf(y1 * cs - y2 * sn);
            KA[kvrow + kh * 128 + 64 + lane] = (bf16_t)f2bf(y2 * cs + y1 * sn);
        }
        *(u32x2*)(VA + kvrow + 4 * lane) = *(const u32x2*)(pr + 1280 + 4 * lane);
        const bf16_t* pp = (t > 0) ? pr - PROJ : pr; const bf16_t* pn = (t < T - 1) ? pr + PROJ : pr;
        const float mp = (t > 0) ? 1.f : 0.f, mn = (t < T - 1) ? 1.f : 0.f;
#pragma unroll
        for (int q4 = 0; q4 < 4; ++q4) {
            const int c = 16 * lane + 4 * q4;
            const f32x4 gb = unpk4(*(const u32x2*)(pr + 1536 + c)), gc = unpk4(*(const u32x2*)(pr + 2560 + c)), xc = unpk4(*(const u32x2*)(pr + 3584 + c));
            const f32x4 gcp = unpk4(*(const u32x2*)(pp + 2560 + c)), xcp = unpk4(*(const u32x2*)(pp + 3584 + c));
            const f32x4 gcn = unpk4(*(const u32x2*)(pn + 2560 + c)), xcn = unpk4(*(const u32x2*)(pn + 3584 + c));
            const f32x4 w0 = *(const f32x4*)(cw + c), w1 = *(const f32x4*)(cw + 1024 + c), w2 = *(const f32x4*)(cw + 2048 + c);
            const f32x4 o = gb * ((gcp * xcp) * mp * w0 + (gc * xc) * w1 + (gcn * xcn) * mn * w2);
            *(u32x2*)(AO + (size_t)row * 2048 + 1024 + c) = pk4(o);
        }
    }
}

namespace attn {
constexpr int D = 128, NW = 8, QBLK = 32, KVBLK = 64;
constexpr float SCALE = 0.088388347648318440f;
constexpr float THR = 8.f;
constexpr size_t SHM_V = KVBLK * D * 2, SHM_K = KVBLK * D * 2, SHM_ATTN = 2 * SHM_V + 2 * SHM_K + NW * 64 * 4;
#define KSWZ(row, colB) ((row) * 256 + ((colB) ^ (((row) & 7) << 4)))
#define SBAR() __builtin_amdgcn_sched_barrier(0)
__device__ __forceinline__ int crow(int r, int hi) { return (r & 3) + 8 * (r >> 2) + 4 * hi; }
__device__ __forceinline__ unsigned cvtpk(float lo, float hi) { unsigned r; asm volatile("v_cvt_pk_bf16_f32 %0, %1, %2" : "=v"(r) : "v"(lo), "v"(hi)); return r; }
__device__ __forceinline__ void partialSM(f32x16& p0, f32x16& p1, float& m_reg, float& mn, float& alpha) {
  constexpr float C = SCALE * 1.4426950408889634f;
  float pmax = p0[0]; for (int r = 1; r < 16; ++r) pmax = fmaxf(pmax, p0[r]); for (int r = 0; r < 16; ++r) pmax = fmaxf(pmax, p1[r]);
  { auto rr = __builtin_amdgcn_permlane32_swap(__float_as_uint(pmax), __float_as_uint(pmax), false, false);
    pmax = fmaxf(__uint_as_float(rr[0]), __uint_as_float(rr[1])); }
  if (__builtin_expect(__all(pmax - m_reg <= THR / SCALE), 1)) { mn = m_reg; alpha = 1.f; }
  else { mn = fmaxf(m_reg, pmax); alpha = __builtin_amdgcn_exp2f((m_reg - mn) * C); m_reg = mn; }
  float mnC = -mn * C;
  for (int r = 0; r < 16; ++r) p0[r] = fmaf(p0[r], C, mnC); for (int r = 0; r < 16; ++r) p1[r] = fmaf(p1[r], C, mnC);
  for (int r = 0; r < 16; ++r) p0[r] = __builtin_amdgcn_exp2f(p0[r]);
}
__device__ __forceinline__ void finishSM(f32x16& p0, f32x16& p1, float alpha, float& l_reg, bf16x8& pa0, bf16x8& pa1, bf16x8& pa2, bf16x8& pa3) {
  for (int r = 0; r < 16; ++r) p1[r] = __builtin_amdgcn_exp2f(p1[r]);
  float ps = 0; for (int r = 0; r < 16; ++r) ps += p0[r]; for (int r = 0; r < 16; ++r) ps += p1[r];
  { auto rr = __builtin_amdgcn_permlane32_swap(__float_as_uint(ps), __float_as_uint(ps), false, false);
    ps = __uint_as_float(rr[0]) + __uint_as_float(rr[1]); }
  l_reg = l_reg * alpha + ps;
#define PK4(P, BASE, OUT) do { unsigned a0 = cvtpk(P[BASE + 0], P[BASE + 1]), a1 = cvtpk(P[BASE + 2], P[BASE + 3]);   \
    unsigned b0 = cvtpk(P[BASE + 4], P[BASE + 5]), b1 = cvtpk(P[BASE + 6], P[BASE + 7]);                              \
    auto r0 = __builtin_amdgcn_permlane32_swap(a0, b0, false, false); auto r1 = __builtin_amdgcn_permlane32_swap(a1, b1, false, false); \
    u32x4 w = {r0[0], r1[0], r0[1], r1[1]}; OUT = *reinterpret_cast<bf16x8*>(&w); } while (0)
  PK4(p0, 0, pa0); PK4(p0, 8, pa1); PK4(p1, 0, pa2); PK4(p1, 8, pa3);
#undef PK4
}
__device__ __forceinline__ void qkt(f32x16& p0, f32x16& p1, const bf16_t* Ks, const bf16x8* qr, int r32, int hi) {
  p0 = f32x16{}; p1 = f32x16{};
  for (int d0 = 0; d0 < 8; ++d0) { int cb = (d0 * 16 + hi * 8) * 2;
    bf16x8 b0 = *reinterpret_cast<const bf16x8*>((const char*)Ks + KSWZ(r32, cb));
    bf16x8 b1 = *reinterpret_cast<const bf16x8*>((const char*)Ks + KSWZ(32 + r32, cb));
    p0 = __builtin_amdgcn_mfma_f32_32x32x16_bf16(b0, qr[d0], p0, 0, 0, 0);
    p1 = __builtin_amdgcn_mfma_f32_32x32x16_bf16(b1, qr[d0], p1, 0, 0, 0); }
}
__device__ __forceinline__ int v_st(int k, int c) { const int kk = (k & ~0xC) | ((k & 4) << 1) | ((k & 8) >> 1); return ((kk >> 3) * 4 + (c >> 5)) * 512 + ((kk & 7) * 32 + (c & 31)) * 2; }
__device__ __forceinline__ int v_rd_base(int lane) { return ((lane & 3) << 3) | (((lane >> 2) & 3) << 6) | (((lane >> 4) & 1) << 5) | (((lane >> 5) & 1) << 8); }
constexpr int v_rd_off(int d0, int ks, int half) { return d0 * 512 + ks * 4096 + half * 2048; }
template <int OFF> __device__ __forceinline__ s16x4 tr_read(int vb) {
  s16x4 r; asm volatile("ds_read_b64_tr_b16 %0, %1 offset:%2" : "=&v"(r) : "v"(vb), "i"(OFF) : "memory"); return r;
}
template <int D0> __device__ __forceinline__ void pv_one(f32x16& od, int vb, bf16x8 pa0, bf16x8 pa1, bf16x8 pa2, bf16x8 pa3) {
  const s16x4 l0 = tr_read<v_rd_off(D0, 0, 0)>(vb), h0 = tr_read<v_rd_off(D0, 0, 1)>(vb), l1 = tr_read<v_rd_off(D0, 1, 0)>(vb), h1 = tr_read<v_rd_off(D0, 1, 1)>(vb);
  const s16x4 l2 = tr_read<v_rd_off(D0, 2, 0)>(vb), h2 = tr_read<v_rd_off(D0, 2, 1)>(vb), l3 = tr_read<v_rd_off(D0, 3, 0)>(vb), h3 = tr_read<v_rd_off(D0, 3, 1)>(vb);
  asm volatile("s_waitcnt lgkmcnt(0)" ::: "memory"); SBAR();
#define PK(L, H) (bf16x8){L[0], L[1], L[2], L[3], H[0], H[1], H[2], H[3]}
  od = __builtin_amdgcn_mfma_f32_32x32x16_bf16(pa0, PK(l0, h0), od, 0, 0, 0);
  od = __builtin_amdgcn_mfma_f32_32x32x16_bf16(pa1, PK(l1, h1), od, 0, 0, 0);
  od = __builtin_amdgcn_mfma_f32_32x32x16_bf16(pa2, PK(l2, h2), od, 0, 0, 0);
  od = __builtin_amdgcn_mfma_f32_32x32x16_bf16(pa3, PK(l3, h3), od, 0, 0, 0);
#undef PK
}
__device__ __forceinline__ void pv_d0(f32x16* o, int vb, bf16x8 pa0, bf16x8 pa1, bf16x8 pa2, bf16x8 pa3) {
  pv_one<0>(o[0], vb, pa0, pa1, pa2, pa3); pv_one<1>(o[1], vb, pa0, pa1, pa2, pa3); pv_one<2>(o[2], vb, pa0, pa1, pa2, pa3); pv_one<3>(o[3], vb, pa0, pa1, pa2, pa3);
}
template <int LDQ, int LDK, int LDO>
__device__ __forceinline__ void attn_dense_body(const bf16_t* __restrict__ Qb, const bf16_t* __restrict__ Kh, const bf16_t* __restrict__ Vh,
                                                bf16_t* __restrict__ Ob, int seq, char* lds) {
  constexpr int SDEPTH = 2;
  const int tid = threadIdx.x, wid = tid >> 6, lane = tid & 63, r32 = lane & 31, hi = lane >> 5;
  bf16_t* V_lds = (bf16_t*)lds; bf16_t* K_lds = (bf16_t*)(lds + 2 * SHM_V);
  float* ws = (float*)(lds + 2 * SHM_V + 2 * SHM_K) + wid * 64; float* li_l = ws; float* al_l = ws + 32;
  float m_reg = -1e30f, l_reg = 0; f32x16 o[4] = {}; bf16x8 qr[8];
  const bf16_t* Qw = Qb + (long)(wid * QBLK + r32) * LDQ + hi * 8;
#pragma unroll
  for (int d0 = 0; d0 < 8; ++d0) qr[d0] = *reinterpret_cast<const bf16x8*>(Qw + d0 * 16);
  const int sr = tid >> 4, sc = (tid & 15) * 8, vst0 = v_st(sr, sc), vst1 = v_st(32 + sr, sc);
  const int vb0 = (int)(uintptr_t)V_lds + v_rd_base(lane);
  struct { bf16x8 vs0, vs1, ks0, ks1; } sr_[SDEPTH];
#define SLOAD(i, k0) do { sr_[i].vs0 = *reinterpret_cast<const bf16x8*>(&Vh[(long)((k0) + sr) * LDK + sc]); sr_[i].vs1 = *reinterpret_cast<const bf16x8*>(&Vh[(long)((k0) + 32 + sr) * LDK + sc]); \
    sr_[i].ks0 = *reinterpret_cast<const bf16x8*>(&Kh[(long)((k0) + sr) * LDK + sc]); sr_[i].ks1 = *reinterpret_cast<const bf16x8*>(&Kh[(long)((k0) + 32 + sr) * LDK + sc]); } while (0)
#define SWRITE(b, i) do { *(bf16x8*)((char*)V_lds + (b) * SHM_V + vst0) = sr_[i].vs0;          \
    *(bf16x8*)((char*)V_lds + (b) * SHM_V + vst1) = sr_[i].vs1; int kc = sc * 2;               \
    *(bf16x8*)((char*)K_lds + (b) * SHM_K + KSWZ(sr, kc)) = sr_[i].ks0;                       \
    *(bf16x8*)((char*)K_lds + (b) * SHM_K + KSWZ(32 + sr, kc)) = sr_[i].ks1; } while (0)
#define SWAIT() do { asm volatile("s_waitcnt vmcnt(4)" ::: "memory"); } while (0)
#define RESC(a) do { if (__any((a) < 1.f)) { if (hi == 0) al_l[r32] = (a); asm volatile("s_waitcnt lgkmcnt(0)" ::: "memory"); \
    for (int d = 0; d < 4; ++d) for (int r = 0; r < 16; ++r) o[d][r] *= al_l[crow(r, hi)]; } } while (0)
  f32x16 pA0, pA1, pB0, pB1; float mnA, mnB, alA, alB; bf16x8 pa0, pa1, pa2, pa3; const int NT = seq / KVBLK;
  constexpr int SE = 0, SO = SDEPTH - 1;
  SLOAD(SE, 0); asm volatile("s_waitcnt vmcnt(0)" ::: "memory"); SWRITE(0, SE); __syncthreads();
  qkt(pA0, pA1, K_lds, qr, r32, hi); partialSM(pA0, pA1, m_reg, mnA, alA);
  SLOAD(SO, KVBLK); if (2 < NT) SLOAD(SE, 2 * KVBLK);
  SWAIT(); SWRITE(1, SO); __syncthreads();
  for (int j = 1; j + 1 < NT; j += 2) {
    SBAR(); qkt(pB0, pB1, (bf16_t*)((char*)K_lds + SHM_K), qr, r32, hi);
    finishSM(pA0, pA1, alA, l_reg, pa0, pa1, pa2, pa3); SBAR();
    SLOAD(SO, (j + SDEPTH) * KVBLK); SBAR();
    pv_d0(o, vb0, pa0, pa1, pa2, pa3); partialSM(pB0, pB1, m_reg, mnB, alB);
    __syncthreads(); SWAIT(); SWRITE(0, SE);
    RESC(alB); __syncthreads();
    SBAR(); qkt(pA0, pA1, K_lds, qr, r32, hi);
    finishSM(pB0, pB1, alB, l_reg, pa0, pa1, pa2, pa3); SBAR();
    if (j + 3 < NT) SLOAD(SE, (j + 1 + SDEPTH) * KVBLK); SBAR();
    pv_d0(o, vb0 + (int)SHM_V, pa0, pa1, pa2, pa3); partialSM(pA0, pA1, m_reg, mnA, alA);
    __syncthreads(); SWAIT(); SWRITE(1, SO);
    RESC(alA); __syncthreads();
  }
  SBAR(); qkt(pB0, pB1, (bf16_t*)((char*)K_lds + SHM_K), qr, r32, hi);
  finishSM(pA0, pA1, alA, l_reg, pa0, pa1, pa2, pa3); SBAR();
  pv_d0(o, vb0, pa0, pa1, pa2, pa3); partialSM(pB0, pB1, m_reg, mnB, alB);
  __syncthreads(); RESC(alB);
  finishSM(pB0, pB1, alB, l_reg, pa0, pa1, pa2, pa3); SBAR();
  pv_d0(o, vb0 + (int)SHM_V, pa0, pa1, pa2, pa3);
  if (hi == 0) li_l[r32] = l_reg; asm volatile("s_waitcnt lgkmcnt(0)" ::: "memory");
  float rli[16];
#pragma unroll
  for (int r = 0; r < 16; ++r) rli[r] = __builtin_amdgcn_rcpf(li_l[crow(r, hi)]);
  bf16_t* Ow = Ob + (long)(wid * QBLK) * LDO;
#pragma unroll
  for (int r = 0; r < 16; ++r) { int orow = crow(r, hi);
    for (int d0 = 0; d0 < 4; ++d0) Ow[(long)orow * LDO + d0 * 32 + r32] = (bf16_t)f2bf(o[d0][r] * rli[r]); }
#undef SLOAD
#undef SWRITE
#undef SWAIT
#undef RESC
}
#undef KSWZ
#undef SBAR
}

__device__ __forceinline__ void phase_attention(const Params& p, LAS unsigned char* lds, int G, int c) {
    const bf16_t* Q = (const bf16_t*)(p.ws + WS_Q); const bf16_t* KA = (const bf16_t*)(p.ws + WS_KA); const bf16_t* VA = (const bf16_t*)(p.ws + WS_VA); bf16_t* AO = (bf16_t*)(p.ws + WS_AO);
    for (int u = c; u < 576; u += G) {
        size_t qrow, kvoff; int h, seq;
        if (u < 512) { const int qb = u & 7, g = (u >> 3) & 3, kvh = (u >> 5) & 1, b = u >> 6; h = kvh * 4 + g; qrow = (size_t)b * SEQ + qb * 256; kvoff = (size_t)b * KVL * 256 + kvh * 128; seq = KVL; }
        else { const int uc = u - 512, b = uc >> 3; h = uc & 7; qrow = (size_t)ML + b * CTXL; kvoff = (size_t)b * KVL * 256 + (h >> 2) * 128; seq = CTXL; }
        attn::attn_dense_body<DM, 256, 2048>(Q + qrow * DM + h * 128, KA + kvoff, VA + kvoff, AO + qrow * 2048 + h * 128, seq, (char*)lds);
        __syncthreads();
    }
}
__device__ __forceinline__ void phase_moe_prenorm(const Params& p, LAS unsigned char* lds, int layer, const float* X, int nrows, bf16_t* H2, int gw, int NGW, int lane) {
    LAS float* RT = (LAS float*)lds;
    const float* router = p.in[I_ROUTER] + (size_t)layer * 1024 * 16;
    for (int i = threadIdx.x; i < 16384; i += 512) { const int k = i >> 4, e = i & 15; RT[e * 1024 + k] = router[i]; }
    __syncthreads();
    const float* mod = (const float*)(p.ws + WS_MOD) + (size_t)layer * 9 * 6144;
    float* aff = (float*)(p.ws + WS_AFF);
    const float* g = p.in[I_NORMG] + (size_t)(layer * 2 + 1) * 1024;
    for (int row = gw; row < nrows; row += NGW) {
        const int mr = row < ML ? (row >> 11) : 8;
        const float* m = mod + (size_t)mr * 6144;
        f32x4 v[4]; ld_row_f32(X + (size_t)row * DM, lane, v);
        ada_row(v, g, m + 3072, m + 4096, lane);
        st_row_bf16(H2 + (size_t)row * DM, lane, v);
        float lg[16];
#pragma unroll
        for (int e = 0; e < 16; ++e) { float s = 0.f;
#pragma unroll
            for (int j = 0; j < 4; ++j) { const f32x4 r = *(const LAS f32x4*)(RT + e * 1024 + 256 * j + 4 * lane); s += (v[j].x * r.x + v[j].y * r.y) + (v[j].z * r.z + v[j].w * r.w); }
            lg[e] = wave_sum(s); asm volatile("" ::: "memory"); }
        float mx = lg[0];
#pragma unroll
        for (int e = 1; e < 16; ++e) mx = fmaxf(mx, lg[e]);
        float sum = 0.f;
#pragma unroll
        for (int e = 0; e < 16; ++e) { lg[e] = __expf(lg[e] - mx); sum += lg[e]; }
        const float rs = 1.0f / sum;
        float mine = 0.f;
#pragma unroll
        for (int e = 0; e < 16; ++e) mine = (lane == e) ? lg[e] * rs : mine;
        if (lane < 16) aff[(size_t)row * 16 + lane] = mine;
    }
}

__device__ __forceinline__ int block_exscan(int flag, volatile LAS int* sm, int wave, int lane, int& tot) {
    const unsigned long long bal = __ballot(flag != 0);
    const int pre = __popcll(bal & ((1ull << lane) - 1ull)), wtot = __popcll(bal);
    __syncthreads();
    if (lane == 0) sm[wave] = wtot;
    __syncthreads();
    int base = 0, t = 0;
#pragma unroll
    for (int w = 0; w < 8; ++w) { const int x = sm[w]; base += (w < wave) ? x : 0; t += x; }
    tot = t; return base + pre;
}
__device__ __forceinline__ int block_sum(int v, volatile LAS int* sm, int wave, int lane) {
    v = wave_sum_i(v);
    __syncthreads();
    if (lane == 0) sm[wave] = v;
    __syncthreads();
    int t = 0;
#pragma unroll
    for (int w = 0; w < 8; ++w) t += sm[w];
    return t;
}
__device__ __forceinline__ void phase_select(const Params& p, LAS unsigned char* lds, int ntasks, int SL, const bf16_t* H2, bf16_t* Xs, int G, int c, int wave, int lane) {
    volatile LAS int* sm = (volatile LAS int*)lds;
    volatile LAS int* rows = (volatile LAS int*)(lds + 256);
    const float* aff = (const float*)(p.ws + WS_AFF);
    int* tokslot = (int*)(p.ws + WS_TOKSLOT); float* selaff = (float*)(p.ws + WS_SELAFF);
    const int tid = threadIdx.x;
    for (int tk = c; tk < ntasks; tk += G) {
        const bool lat = tk < 128; const int tt = lat ? tk : tk - 128, b = tt >> 4, e = tt & 15;
        const int n = lat ? SEQ : CTXL, cap = lat ? CAPL : CAPC, rowbase = lat ? b * SEQ : ML + b * CTXL, slotbase = lat ? b * CAPL : NB * CAPL + b * CAPC;
        unsigned key[4]; bool valid[4];
#pragma unroll
        for (int i = 0; i < 4; ++i) { const int idx = tid + 512 * i; valid[i] = idx < n; key[i] = valid[i] ? __float_as_uint(aff[(size_t)(rowbase + idx) * 16 + e]) : 0u; }
        unsigned prefix = 0u;
        for (int bit = 30; bit >= 0; --bit) {
            const unsigned cand = prefix | (1u << bit); int cnt = 0;
#pragma unroll
            for (int i = 0; i < 4; ++i) cnt += (valid[i] && key[i] >= cand) ? 1 : 0;
            if (block_sum(cnt, sm, wave, lane) >= cap) prefix = cand;
        }
        int cg = 0;
#pragma unroll
        for (int i = 0; i < 4; ++i) cg += (valid[i] && key[i] > prefix) ? 1 : 0;
        const int need_eq = cap - block_sum(cg, sm, wave, lane);
        int eqbase = 0, selbase = 0;
#pragma unroll
        for (int i = 0; i < 4; ++i) {
            const bool gt = valid[i] && key[i] > prefix, eq = valid[i] && key[i] == prefix;
            int tot; const int er = eqbase + block_exscan(eq ? 1 : 0, sm, wave, lane, tot); eqbase += tot;
            const bool sel = gt || (eq && er < need_eq);
            int tot2; const int slot = selbase + block_exscan(sel ? 1 : 0, sm, wave, lane, tot2); selbase += tot2;
            if (valid[i]) { const int row = rowbase + tid + 512 * i;
                tokslot[(size_t)row * 16 + e] = sel ? slotbase + slot : -1;
                if (sel) { selaff[(size_t)e * SL + slotbase + slot] = __uint_as_float(key[i]); rows[slot] = row; } }
        }
        __syncthreads();
        for (int r = wave; r < cap; r += 8) {
            const bf16_t* src = H2 + (size_t)rows[r] * DM; bf16_t* dst = Xs + ((size_t)e * SL + slotbase + r) * DM;
            *(u32x4*)(dst + 8 * lane) = *(const u32x4*)(src + 8 * lane); *(u32x4*)(dst + 512 + 8 * lane) = *(const u32x4*)(src + 512 + 8 * lane);
        }
        __syncthreads();
    }
}

__device__ __forceinline__ void moe_gather_row(const int* tokslot, const bf16_t* Ys, int SL, int row, int lane, f32x4 (&acc)[4]) {
#pragma unroll
    for (int j = 0; j < 4; ++j) acc[j] = (f32x4){0.f, 0.f, 0.f, 0.f};
    const int* ts = tokslot + (size_t)row * 16;
    for (int e = 0; e < 16; ++e) { const int s = __builtin_amdgcn_readfirstlane(ts[e]);
        if (s >= 0) { const bf16_t* y = Ys + ((size_t)e * SL + s) * DM;
#pragma unroll
            for (int j = 0; j < 4; ++j) acc[j] += unpk4(*(const u32x2*)(y + 256 * j + 4 * lane)); } }
}

__device__ __forceinline__ void phase_combine0(const Params& p, int gw, int NGW, int lane) {
    const float* mod0 = (const float*)(p.ws + WS_MOD); const float* mod1 = mod0 + 9 * 6144;
    const float* X1 = (const float*)(p.ws + WS_X1); float* X2 = (float*)(p.ws + WS_X2); bf16_t* H = (bf16_t*)(p.ws + WS_H);
    const int* tokslot = (const int*)(p.ws + WS_TOKSLOT); const bf16_t* Ys = (const bf16_t*)(p.ws + WS_YS0);
    for (int row = gw; row < MT; row += NGW) {
        const int mr = row < ML ? (row >> 11) : 8;
        f32x4 acc[4]; moe_gather_row(tokslot, Ys, SL0, row, lane, acc);
        f32x4 v[4]; ld_row_f32(X1 + (size_t)row * DM, lane, v);
        const float* gt2 = mod0 + (size_t)mr * 6144 + 5120;
#pragma unroll
        for (int j = 0; j < 4; ++j) v[j] = v[j] + *(const f32x4*)(gt2 + 256 * j + 4 * lane) * acc[j];
        st_row_f32(X2 + (size_t)row * DM, lane, v);
        const float* m = mod1 + (size_t)mr * 6144;
        ada_row(v, p.in[I_NORMG] + 2 * 1024, m, m + 1024, lane);
        st_row_bf16(H + (size_t)row * DM, lane, v);
    }
}

__device__ __forceinline__ void phase_mixes(const Params& p, int gw, int NGW, int lane) {
    const bf16_t* H = (const bf16_t*)(p.ws + WS_H);
    bf16_t* XR = (bf16_t*)(p.ws + WS_XR); bf16_t* XK = (bf16_t*)(p.ws + WS_XK); bf16_t* XV = (bf16_t*)(p.ws + WS_XV);
    bf16_t* XW = (bf16_t*)(p.ws + WS_XW); bf16_t* XA = (bf16_t*)(p.ws + WS_XA); bf16_t* XG = (bf16_t*)(p.ws + WS_XG);
    const float* mu = p.in[I_MU];
    for (int row = gw; row < MT; row += NGW) {
        const bool lat = row < ML; const int t = lat ? (row & 2047) : ((row - ML) & 255), T = lat ? SEQ : CTXL;
        const bf16_t* hr = H + (size_t)row * DM;
        f32x4 h[4], hp[4], hn[4]; ld_row_bf16(hr, lane, h);
        if (t > 0) ld_row_bf16(hr - DM, lane, hp); else { for (int j = 0; j < 4; ++j) hp[j] = (f32x4){0.f, 0.f, 0.f, 0.f}; }
        if (t < T - 1) ld_row_bf16(hr + DM, lane, hn); else { for (int j = 0; j < 4; ++j) hn[j] = (f32x4){0.f, 0.f, 0.f, 0.f}; }
#pragma unroll
        for (int j = 0; j < 4; ++j) {
            const int c = 256 * j + 4 * lane; const f32x4 xx = (hp[j] + hn[j]) * 0.5f - h[j];
            *(u32x2*)(XW + (size_t)row * DM + c) = pk4(h[j] + xx * *(const f32x4*)(mu + 1 * 1024 + c));
            *(u32x2*)(XK + (size_t)row * DM + c) = pk4(h[j] + xx * *(const f32x4*)(mu + 2 * 1024 + c));
            *(u32x2*)(XV + (size_t)row * DM + c) = pk4(h[j] + xx * *(const f32x4*)(mu + 3 * 1024 + c));
            *(u32x2*)(XA + (size_t)row * DM + c) = pk4(h[j] + xx * *(const f32x4*)(mu + 4 * 1024 + c));
            if (lat) { *(u32x2*)(XR + (size_t)row * DM + c) = pk4(h[j] + xx * *(const f32x4*)(mu + 0 * 1024 + c));
                       *(u32x2*)(XG + (size_t)row * DM + c) = pk4(h[j] + xx * *(const f32x4*)(mu + 5 * 1024 + c)); }
        }
    }
}

__device__ __forceinline__ bf16x8 tanh8(bf16x8 x) {
    bf16x8 o;
#pragma unroll
    for (int j = 0; j < 8; ++j) o[j] = (short)f2bf(tanhf(bf2f((unsigned short)x[j])));
    return o;
}
__device__ __forceinline__ void phase_features(const Params& p, int gw, int NGW, int lane) {
    const bf16_t* Kb = (const bf16_t*)(p.ws + WS_KB); bf16_t* KK = (bf16_t*)(p.ws + WS_KK);
    const float* k_k = p.in[I_KK];
    for (int row = gw; row < MT; row += NGW) {
        const bf16_t* kr = Kb + (size_t)row * DM + 16 * lane;
        f32x4 v[4]; float ss = 0.f;
#pragma unroll
        for (int q = 0; q < 4; ++q) { v[q] = unpk4(*(const u32x2*)(kr + 4 * q)) * *(const f32x4*)(k_k + 16 * lane + 4 * q); ss += (v[q].x * v[q].x + v[q].y * v[q].y) + (v[q].z * v[q].z + v[q].w * v[q].w); }
        ss += __shfl_xor(ss, 1); ss += __shfl_xor(ss, 2);
        const float rn = 1.0f / sqrtf(fmaxf(ss, 1e-24f));
#pragma unroll
        for (int q = 0; q < 4; ++q) *(u32x2*)(KK + (size_t)row * DM + 16 * lane + 4 * q) = pk4(v[q] * rn);
    }
    const bf16_t* T1 = (const bf16_t*)(p.ws + WS_T1);
    bf16_t* LD = (bf16_t*)(p.ws + WS_LD); bf16_t* AA = (bf16_t*)(p.ws + WS_AA);
    const int fr = lane & 15, fq = lane >> 4;
    for (int it = gw; it < (MT / 16) * 8; it += NGW) {
        const int tt = it >> 3, cb = it & 7, tok = tt * 16 + fr;
#pragma unroll
        for (int kd = 0; kd < 4; ++kd) {
            const int kind = kd >> 1, d = kd & 1;
            const bf16_t* xrow = T1 + (size_t)kind * MT * 128 + (size_t)tok * 128 + d * 64 + 8 * fq;
            bf16x8 xb0 = *(const bf16x8*)(xrow), xb1 = *(const bf16x8*)(xrow + 32);
            if (kind == 0) { xb0 = tanh8(xb0); xb1 = tanh8(xb1); }
            const bf16_t* W = (const bf16_t*)(p.ws + (kind == 0 ? WS_W2T : WS_A2T)) + (size_t)d * 1024 * 64;
            const float* bias = (kind == 0 ? p.in[I_W0] : p.in[I_A0]) + d * 1024;
            bf16_t* O = (kind == 0 ? LD : AA) + (size_t)d * MT * DM;
#pragma unroll
            for (int ct = 0; ct < 8; ++ct) {
                const int ch0 = cb * 128 + ct * 16;
                const bf16_t* wr_ = W + (size_t)(ch0 + fr) * 64 + 8 * fq;
                const bf16x8 wa0 = *(const bf16x8*)(wr_), wa1 = *(const bf16x8*)(wr_ + 32);
                f32x4 acc = (f32x4){0.f, 0.f, 0.f, 0.f};
                acc = __builtin_amdgcn_mfma_f32_16x16x32_bf16(wa0, xb0, acc, 0, 0, 0);
                acc = __builtin_amdgcn_mfma_f32_16x16x32_bf16(wa1, xb1, acc, 0, 0, 0);
                const f32x4 bs = *(const f32x4*)(bias + ch0 + 4 * fq);
                f32x4 o;
#pragma unroll
                for (int r = 0; r < 4; ++r) { const float s = sigmoidf_(acc[r] + bs[r]); o[r] = kind == 0 ? -0.6065306597126334f * s : s; }
                *(u32x2*)(O + (size_t)tok * DM + ch0 + 4 * fq) = pk4(o);
            }
        }
    }
}
template <int CTRL> __device__ __forceinline__ float dpp_add(float v) { const int t = __builtin_amdgcn_update_dpp(0, __float_as_int(v), CTRL, 0xf, 0xf, false); return v + __int_as_float(t); }
__device__ __forceinline__ float allsum16(float v) { v = dpp_add<0xB1>(v); v = dpp_add<0x4E>(v); v = dpp_add<0x141>(v); v = dpp_add<0x140>(v); return v; }
constexpr int SC_CH = 32, SC_VEC = SC_CH * 64 * 4  , SC_BUF = 6 * SC_VEC, SC_YOFF = 2 * SC_BUF;
__device__ __forceinline__ void phase_scan(const Params& p, LAS unsigned char* lds, int G, int c, int wave, int lane) {
    const bf16_t* RB = (const bf16_t*)(p.ws + WS_RB); const bf16_t* KB = (const bf16_t*)(p.ws + WS_KB); const bf16_t* VB = (const bf16_t*)(p.ws + WS_VB);
    const bf16_t* KK = (const bf16_t*)(p.ws + WS_KK);
    const int tid = threadIdx.x, cg = lane & 15, rp = lane >> 4, r0 = wave * 8 + rp * 2;
    const int sstep = tid >> 4, sch = (tid & 15) * 4;
    for (int sid = c; sid < 256; sid += G) {
        const int d = sid & 1, h = (sid >> 1) & 15, b = sid >> 5;
        const bf16_t* LD = (const bf16_t*)(p.ws + WS_LD) + (size_t)d * MT * DM; const bf16_t* AA = (const bf16_t*)(p.ws + WS_AA) + (size_t)d * MT * DM;
        float* Y = (float*)(p.ws + WS_Y) + (size_t)d * ML * DM;
        const f32x4 ka4 = *(const f32x4*)(p.in[I_KA] + h * 64 + sch);
        f32x4 S0 = (f32x4){0.f, 0.f, 0.f, 0.f}, S1 = (f32x4){0.f, 0.f, 0.f, 0.f};
        u32x2 gk, gv, gr, gkk, gld, ga;
        int grow = 0;
#define SC_ROW(ci) do { const int g_ = (ci) * SC_CH + sstep; if (g_ < CTXL) { const int t_ = d ? (CTXL - 1 - g_) : g_; grow = ML + b * CTXL + t_; } else { const int gl_ = g_ - CTXL; const int t_ = d ? (SEQ - 1 - gl_) : gl_; grow = b * SEQ + t_; } } while (0)
#define SC_LOAD(ci) do { SC_ROW(ci); const size_t o_ = (size_t)grow * DM + h * 64 + sch; gk = *(const u32x2*)(KB + o_); gv = *(const u32x2*)(VB + o_); gkk = *(const u32x2*)(KK + o_); gld = *(const u32x2*)(LD + o_); ga = *(const u32x2*)(AA + o_); \
        gr = (grow < ML) ? *(const u32x2*)(RB + o_) : (u32x2){0u, 0u}; } while (0)
#define SC_WRITE(buf) do { LAS unsigned char* bb_ = lds + (buf) * SC_BUF + (sstep * 64 + sch) * 4; const f32x4 k_ = unpk4(gk), a_ = unpk4(ga), kk_ = unpk4(gkk), ld_ = unpk4(gld); \
        f32x4 w_; w_.x = __expf(ld_.x); w_.y = __expf(ld_.y); w_.z = __expf(ld_.z); w_.w = __expf(ld_.w); \
        *(LAS f32x4*)(bb_ + 0 * SC_VEC) = w_; *(LAS f32x4*)(bb_ + 1 * SC_VEC) = kk_; *(LAS f32x4*)(bb_ + 2 * SC_VEC) = kk_ * a_; \
        *(LAS f32x4*)(bb_ + 3 * SC_VEC) = k_ * ((a_ - 1.0f) * ka4 + 1.0f); *(LAS f32x4*)(bb_ + 4 * SC_VEC) = unpk4(gr); *(LAS f32x4*)(bb_ + 5 * SC_VEC) = unpk4(gv); } while (0)
        __syncthreads();
        SC_LOAD(0); SC_WRITE(0);
        __syncthreads();
        constexpr int NCH = (CTXL + SEQ) / SC_CH;
        for (int ci = 0; ci < NCH; ++ci) {
            const int buf = ci & 1;
            if (ci + 1 < NCH) SC_LOAD(ci + 1);
            const LAS unsigned char* bb = lds + buf * SC_BUF;
            LAS float* yb = (LAS float*)(lds + SC_YOFF);
            const bool emit = ci >= CTXL / SC_CH;
#pragma unroll 4
            for (int s = 0; s < SC_CH; ++s) {
                const f32x4 w4 = *(const LAS f32x4*)(bb + 0 * SC_VEC + (s * 64 + 4 * cg) * 4), kk4 = *(const LAS f32x4*)(bb + 1 * SC_VEC + (s * 64 + 4 * cg) * 4);
                const f32x4 b4 = *(const LAS f32x4*)(bb + 2 * SC_VEC + (s * 64 + 4 * cg) * 4), kd4 = *(const LAS f32x4*)(bb + 3 * SC_VEC + (s * 64 + 4 * cg) * 4);
                const f32x4 r4 = *(const LAS f32x4*)(bb + 4 * SC_VEC + (s * 64 + 4 * cg) * 4);
                const f32x2 v2 = *(const LAS f32x2*)(bb + 5 * SC_VEC + (s * 64 + r0) * 4);
                float sk0 = (S0.x * kk4.x + S0.y * kk4.y) + (S0.z * kk4.z + S0.w * kk4.w);
                float sk1 = (S1.x * kk4.x + S1.y * kk4.y) + (S1.z * kk4.z + S1.w * kk4.w);
                sk0 = allsum16(sk0); sk1 = allsum16(sk1);
                S0 = S0 * w4 + (kd4 * v2.x - b4 * sk0);
                S1 = S1 * w4 + (kd4 * v2.y - b4 * sk1);
                if (emit) {
                    float y0 = (S0.x * r4.x + S0.y * r4.y) + (S0.z * r4.z + S0.w * r4.w);
                    float y1 = (S1.x * r4.x + S1.y * r4.y) + (S1.z * r4.z + S1.w * r4.w);
                    y0 = allsum16(y0); y1 = allsum16(y1);
                    if (cg == 0) *(LAS f32x2*)(yb + s * 64 + r0) = (f32x2){y0, y1};
                }
            }
            __syncthreads();
            if (emit) { int yrow; { const int gl_ = ci * SC_CH + sstep - CTXL; const int t_ = d ? (SEQ - 1 - gl_) : gl_; yrow = b * SEQ + t_; }
                *(f32x4*)(Y + (size_t)yrow * DM + h * 64 + sch) = *(const LAS f32x4*)(yb + sstep * 64 + sch); }
            if (ci + 1 < NCH) SC_WRITE(buf ^ 1);
            __syncthreads();
        }
#undef SC_ROW
#undef SC_LOAD
#undef SC_WRITE
    }
}

constexpr int RO_STRIDE = 2064;
__device__ __forceinline__ bf16x8 sigm8(bf16x8 x) {
    bf16x8 o;
#pragma unroll
    for (int j = 0; j < 8; ++j) o[j] = (short)f2bf(sigmoidf_(bf2f((unsigned short)x[j])));
    return o;
}
__device__ __forceinline__ void phase_readout(const Params& p, LAS unsigned char* lds, int G, int c, int wave, int lane) {
    const bf16_t* T1g = (const bf16_t*)(p.ws + WS_T1) + (size_t)2 * MT * 128; const bf16_t* G2T = (const bf16_t*)(p.ws + WS_G2T);
    const bf16_t* RB = (const bf16_t*)(p.ws + WS_RB); const bf16_t* KB = (const bf16_t*)(p.ws + WS_KB); const bf16_t* VB = (const bf16_t*)(p.ws + WS_VB);
    const bf16_t* A0 = (const bf16_t*)(p.ws + WS_AA); const bf16_t* A1 = A0 + (size_t)MT * DM;
    const float* Y0 = (const float*)(p.ws + WS_Y); const float* Y1 = Y0 + (size_t)ML * DM;
    bf16_t* Z = (bf16_t*)(p.ws + WS_Z);
    const int fr = lane & 15, fq = lane >> 4;
    for (int tile = c; tile < ML / 32; tile += G) {
        const int tok0 = tile * 32;
        bf16x8 xb[2][4];
#pragma unroll
        for (int tt = 0; tt < 2; ++tt)
#pragma unroll
            for (int ks = 0; ks < 4; ++ks) xb[tt][ks] = sigm8(*(const bf16x8*)(T1g + (size_t)(tok0 + tt * 16 + fr) * 128 + 32 * ks + 8 * fq));
#pragma unroll
        for (int ct = 0; ct < 8; ++ct) {
            const int ch0 = wave * 128 + ct * 16;
            const bf16_t* wr_ = G2T + (size_t)(ch0 + fr) * 128 + 8 * fq;
            f32x4 acc0 = (f32x4){0.f, 0.f, 0.f, 0.f}, acc1 = (f32x4){0.f, 0.f, 0.f, 0.f};
#pragma unroll
            for (int ks = 0; ks < 4; ++ks) { const bf16x8 wa = *(const bf16x8*)(wr_ + 32 * ks);
                acc0 = __builtin_amdgcn_mfma_f32_16x16x32_bf16(wa, xb[0][ks], acc0, 0, 0, 0);
                acc1 = __builtin_amdgcn_mfma_f32_16x16x32_bf16(wa, xb[1][ks], acc1, 0, 0, 0); }
            *(LAS u32x2*)(lds + (fr) * RO_STRIDE + (ch0 + 4 * fq) * 2) = pk4(acc0);
            *(LAS u32x2*)(lds + (16 + fr) * RO_STRIDE + (ch0 + 4 * fq) * 2) = pk4(acc1);
        }
        __syncthreads();
        for (int i = 0; i < 4; ++i) {
            const int tl = wave * 4 + i, row = tok0 + tl; const size_t o = (size_t)row * DM + 16 * lane;
            f32x4 y[4]; float s = 0.f;
#pragma unroll
            for (int q = 0; q < 4; ++q) { y[q] = *(const f32x4*)(Y0 + o + 4 * q) + *(const f32x4*)(Y1 + o + 4 * q); s += (y[q].x + y[q].y) + (y[q].z + y[q].w); }
            s += __shfl_xor(s, 1); s += __shfl_xor(s, 2);
            const float mean = s * (1.0f / 64.0f); float vs = 0.f;
#pragma unroll
            for (int q = 0; q < 4; ++q) { y[q] = y[q] - mean; vs += (y[q].x * y[q].x + y[q].y * y[q].y) + (y[q].z * y[q].z + y[q].w * y[q].w); }
            vs += __shfl_xor(vs, 1); vs += __shfl_xor(vs, 2);
            const float rstd = 1.0f / sqrtf(vs * (1.0f / 64.0f) + 64e-5f);
            f32x4 r4[4], v4[4]; float bs = 0.f;
#pragma unroll
            for (int q = 0; q < 4; ++q) {
                const int cc = 16 * lane + 4 * q;
                r4[q] = unpk4(*(const u32x2*)(RB + o + 4 * q)); v4[q] = unpk4(*(const u32x2*)(VB + o + 4 * q));
                const f32x4 k4 = unpk4(*(const u32x2*)(KB + o + 4 * q)), a0 = unpk4(*(const u32x2*)(A0 + o + 4 * q)), a1 = unpk4(*(const u32x2*)(A1 + o + 4 * q));
                const f32x4 ka = *(const f32x4*)(p.in[I_KA] + cc), rk = *(const f32x4*)(p.in[I_RK] + cc);
                const f32x4 kds = k4 * ((a0 - 1.0f) * ka + 1.0f) + k4 * ((a1 - 1.0f) * ka + 1.0f);
                const f32x4 t = r4[q] * kds * rk; bs += (t.x + t.y) + (t.z + t.w);
            }
            bs += __shfl_xor(bs, 1); bs += __shfl_xor(bs, 2);
#pragma unroll
            for (int q = 0; q < 4; ++q) {
                const int cc = 16 * lane + 4 * q;
                const f32x4 lw = *(const f32x4*)(p.in[I_LNW] + cc), lb = *(const f32x4*)(p.in[I_LNB] + cc);
                const f32x4 g4 = unpk4(*(const LAS u32x2*)(lds + tl * RO_STRIDE + cc * 2));
                const f32x4 z = ((y[q] * rstd) * lw + lb + v4[q] * bs) * g4;
                *(u32x2*)(Z + o + 4 * q) = pk4(z);
            }
        }
        __syncthreads();
    }
}

__device__ __forceinline__ void phase_final(const Params& p, int gw, int NGW, int lane) {
    const float* mod1 = (const float*)(p.ws + WS_MOD) + 9 * 6144;
    const float* X3 = (const float*)(p.ws + WS_X3); const int* tokslot = (const int*)(p.ws + WS_TOKSLOT); const bf16_t* Ys = (const bf16_t*)(p.ws + WS_YS1);
    const float* fg = p.in[I_FINALG];
    for (int row = gw; row < ML; row += NGW) {
        const int mr = row >> 11;
        f32x4 acc[4]; moe_gather_row(tokslot, Ys, SL1, row, lane, acc);
        f32x4 v[4]; ld_row_f32(X3 + (size_t)row * DM, lane, v);
        const float* gt2 = mod1 + (size_t)mr * 6144 + 5120;
        float ss = 0.f;
#pragma unroll
        for (int j = 0; j < 4; ++j) { v[j] = v[j] + *(const f32x4*)(gt2 + 256 * j + 4 * lane) * acc[j]; ss += (v[j].x * v[j].x + v[j].y * v[j].y) + (v[j].z * v[j].z + v[j].w * v[j].w); }
        ss = wave_sum(ss);
        const float rinv = 1.0f / sqrtf(ss * (1.0f / DM) + 1e-6f);
#pragma unroll
        for (int j = 0; j < 4; ++j) v[j] = (v[j] * rinv) * *(const f32x4*)(fg + 256 * j + 4 * lane);
        st_row_f32(p.out + (size_t)row * DM, lane, v);
    }
}

constexpr int NPH = 22;
__global__ void __launch_bounds__(512, 2) mega_fwd(Params p) {
    extern __shared__ __attribute__((aligned(16))) unsigned char lds_raw[];
    LAS unsigned char* lds = (LAS unsigned char*)lds_raw;
    const int tid = threadIdx.x, lane = tid & 63, wave = __builtin_amdgcn_readfirstlane(tid >> 6);
    const int G = gridDim.x, bx = blockIdx.x, vcu = (G % 8 == 0) ? (bx % 8) * (G / 8) + bx / 8 : bx;
    const int gw = vcu * 8 + wave, NGW = G * 8;
    for (int u = tid; u < (LDS_BYTES - LDSCTL_OFF) / 4; u += 512) ((LAS unsigned*)(lds + LDSCTL_OFF))[u] = 0u;
    __syncthreads();
    const int lo = p.ph_lo, hi = p.ph_hi;
    XcdBarrier bar; bar.bar = (unsigned*)(p.ws + WS_CTL) + CTL_BAR_WORD; bar.x = 0; bar.st = (volatile LAS unsigned*)(lds + MISC_OFF + 32);
    if (hi - lo > 1) bar = xcd_barrier_post((unsigned*)(p.ws + WS_CTL) + CTL_BAR_WORD, (volatile LAS unsigned*)(lds + MISC_OFF + 32));
#ifndef PHMASK
#define PHMASK 0x3fffff
#endif
#define IN(k) (((PHMASK >> (k)) & 1) && lo <= (k) && (k) < hi)
#define SEAM(k) do { if (IN(k) && IN((k) + 1)) xcd_barrier(bar); } while (0)
    unsigned char* ws = p.ws;
    const float* gate1_l0 = (const float*)(ws + WS_MOD) + 2048; const float* gate1_l1 = (const float*)(ws + WS_MOD) + 9 * 6144 + 2048;

    if (IN(0)) { phase_prep(p, lds, gw, NGW, wave, lane); }
    SEAM(0);
    if (IN(1)) { phase_prenorm0(p, gw, NGW, lane); }
    SEAM(1);
    if (IN(2)) { OrderSingle S; S.init(ws + WS_H, ws + WS_WIN_T, MT, PROJ, 1024, G, bx); EpiStore E{(bf16_t*)(ws + WS_P), PROJ}; pg8::gemm_phase(lds, 1024, S, E); }
    SEAM(2);
    if (IN(3)) { phase_qkconv(p, gw, NGW, lane); }
    SEAM(3);
    if (IN(4)) { phase_attention(p, lds, G, vcu); }
    SEAM(4);
    if (IN(5)) { OrderSingle S; S.init(ws + WS_AO, ws + WS_WOUT_T, MT, 1024, 2048, G, bx); EpiResid E{p.in[I_X], p.in[I_CTX], (float*)(ws + WS_X1), gate1_l0}; pg8::gemm_phase(lds, 2048, S, E); }
    SEAM(5);
    if (IN(6)) { phase_moe_prenorm(p, lds, 0, (const float*)(ws + WS_X1), MT, (bf16_t*)(ws + WS_H), gw, NGW, lane); }
    SEAM(6);
    if (IN(7)) { phase_select(p, lds, 256, SL0, (const bf16_t*)(ws + WS_H), (bf16_t*)(ws + WS_XS0), G, bx, wave, lane); }
    SEAM(7);
    if (IN(8)) { OrderMoe S; S.init(ws + WS_XS0, ws + WS_WGU_T, 9, 8, 1024, G, vcu); EpiAct E{(bf16_t*)(ws + WS_ACT0)}; pg8::gemm_phase(lds, 1024, S, E); }
    SEAM(8);
    if (IN(9)) { OrderMoe S; S.init(ws + WS_ACT0, ws + WS_WD_T, 9, 4, 1024, G, vcu); EpiYs E{(bf16_t*)(ws + WS_YS0), (const float*)(ws + WS_SELAFF)}; pg8::gemm_phase(lds, 1024, S, E); }
    SEAM(9);
    if (IN(10)) { phase_combine0(p, gw, NGW, lane); }
    SEAM(10);
    if (IN(11)) { phase_mixes(p, gw, NGW, lane); }
    SEAM(11);
    if (IN(12)) { OrderRkv S; S.A0 = (const char*)(ws + WS_XR); S.A1 = (const char*)(ws + WS_XK); S.A2 = (const char*)(ws + WS_XV); S.A3 = (const char*)(ws + WS_XW); S.A4 = (const char*)(ws + WS_XA); S.A5 = (const char*)(ws + WS_XG);
        S.B0 = (const char*)(ws + WS_WR_T); S.B1 = (const char*)(ws + WS_WK_T); S.B2 = (const char*)(ws + WS_WV_T); S.B3 = (const char*)(ws + WS_WL1_T); S.G = G; S.c = vcu;
        EpiRkv E{(bf16_t*)(ws + WS_RB), (bf16_t*)(ws + WS_KB), (bf16_t*)(ws + WS_VB), (bf16_t*)(ws + WS_T1)}; pg8::gemm_phase(lds, 1024, S, E); }
    SEAM(12);
    if (IN(13)) { phase_features(p, gw, NGW, lane); }
    SEAM(13);
    if (IN(14)) { phase_scan(p, lds, G, bx, wave, lane); }
    SEAM(14);
    if (IN(15)) { phase_readout(p, lds, G, vcu, wave, lane); }
    SEAM(15);
    if (IN(16)) { OrderSingle S; S.init(ws + WS_Z, ws + WS_WO_T, ML, 1024, 1024, G, bx); EpiResid E{(const float*)(ws + WS_X2), (const float*)(ws + WS_X2) + (size_t)ML * DM, (float*)(ws + WS_X3), gate1_l1}; pg8::gemm_phase(lds, 1024, S, E); }
    SEAM(16);
    if (IN(17)) { phase_moe_prenorm(p, lds, 1, (const float*)(ws + WS_X3), ML, (bf16_t*)(ws + WS_H2), gw, NGW, lane);
        __syncthreads();
        LAS float* scr = (LAS float*)(lds + wave * 8448);
        for (int it = gw; it < P0_NMOE; it += NGW) moe_convert_item(p, 1, it, scr, lane); }
    SEAM(17);
    if (IN(18)) { phase_select(p, lds, 128, SL1, (const bf16_t*)(ws + WS_H2), (bf16_t*)(ws + WS_XS1), G, bx, wave, lane); }
    SEAM(18);
    if (IN(19)) { OrderMoe S; S.init(ws + WS_XS1, ws + WS_WGU_T, 8, 8, 1024, G, vcu); EpiAct E{(bf16_t*)(ws + WS_ACT1)}; pg8::gemm_phase(lds, 1024, S, E); }
    SEAM(19);
    if (IN(20)) { OrderMoe S; S.init(ws + WS_ACT1, ws + WS_WD_T, 8, 4, 1024, G, vcu); EpiYs E{(bf16_t*)(ws + WS_YS1), (const float*)(ws + WS_SELAFF)}; pg8::gemm_phase(lds, 1024, S, E); }
    SEAM(20);
    if (IN(21)) { phase_final(p, gw, NGW, lane); }
#undef IN
#undef SEAM
}

#ifndef MK_PER_PHASE
#define MK_PER_PHASE 0
#endif
extern "C" void kernel_launch(void* const* d_in, const int* in_sizes, int n_in, void* d_out, int out_size, void* d_ws, size_t ws_size, hipStream_t stream) {
    static int grid = 0;
    if (grid == 0) {
        if (n_in != 35 || out_size != ML * DM || ws_size < WS_END) { fprintf(stderr, "kernel_launch: unexpected shapes: n_in %d out %d ws %zu (need %zu)\n", n_in, out_size, ws_size, (size_t)WS_END); grid = -1; return; }
        int dev = 0, cus = 0;
        if (hipGetDevice(&dev) != hipSuccess || hipDeviceGetAttribute(&cus, hipDeviceAttributeMultiprocessorCount, dev) != hipSuccess) { grid = -1; return; }
        if (hipFuncSetAttribute((const void*)mega_fwd, hipFuncAttributeMaxDynamicSharedMemorySize, LDS_BYTES) != hipSuccess) { fprintf(stderr, "kernel_launch: hipFuncSetAttribute failed\n"); grid = -1; return; }
        int per_cu = 0; (void)hipOccupancyMaxActiveBlocksPerMultiprocessor(&per_cu, (const void*)mega_fwd, 512, LDS_BYTES); (void)hipGetLastError();
        if (per_cu < 1) fprintf(stderr, "kernel_launch: occupancy query reports %d blocks per CU\n", per_cu);
        grid = cus;
    }
    if (grid < 0) return;
    (void)in_sizes;
    (void)hipMemsetAsync((char*)d_ws + WS_CTL, 0, 1 * MiB, stream);
    Params a{};
    for (int i = 0; i < 35; ++i) a.in[i] = (const float*)d_in[i];
    a.out = (float*)d_out; a.ws = (unsigned char*)d_ws;
#if MK_PER_PHASE
    for (int ph = 0; ph < NPH; ++ph) { a.ph_lo = ph; a.ph_hi = ph + 1; hipLaunchKernelGGL(mega_fwd, dim3(grid), dim3(512), LDS_BYTES, stream, a); }
#else
    a.ph_lo = 0; a.ph_hi = NPH; hipLaunchKernelGGL(mega_fwd, dim3(grid), dim3(512), LDS_BYTES, stream, a);
#endif
    const hipError_t le = hipPeekAtLastError();
    if (le != hipSuccess) fprintf(stderr, "kernel_launch: launch failed: %s\n", hipGetErrorName(le));
}
```

```cpp
#include <hip/hip_runtime.h>
#include <cstdio>
#include <cstdint>

#define GAS __attribute__((address_space(1)))
#define LAS __attribute__((address_space(3)))
typedef unsigned short bf16_t;
typedef short bf16x8 __attribute__((ext_vector_type(8)));
typedef short s16x4 __attribute__((ext_vector_type(4)));
typedef float f32x4 __attribute__((ext_vector_type(4)));
typedef float f32x2 __attribute__((ext_vector_type(2)));
typedef float f32x8 __attribute__((ext_vector_type(8)));
typedef float f32x16 __attribute__((ext_vector_type(16)));
typedef unsigned u32x4 __attribute__((ext_vector_type(4)));
typedef unsigned u32x2 __attribute__((ext_vector_type(2)));

constexpr int NB = 8, SEQ = 2048, CTXL = 256, DM = 1024;
constexpr int ML = NB * SEQ, MC = NB * CTXL, MT = ML + MC;
constexpr int PROJ = 4608, NE = 16;
constexpr int KVL = CTXL + SEQ;
constexpr int CAPL = 256, CAPC = 32, SL0 = NB * CAPL + NB * CAPC  , SL1 = NB * CAPL  ;

constexpr size_t MiB = 1u << 20;
constexpr size_t WS_CTL = 0;
constexpr size_t CTL_BAR_WORD = 4096;
constexpr size_t WS_MOD = 512 * 1024;
constexpr size_t WS_ROPE = 1 * MiB;
constexpr size_t WS_AFF = 2 * MiB;
constexpr size_t WS_TOKSLOT = 4 * MiB;
constexpr size_t WS_SELAFF = 6 * MiB;
constexpr size_t WS_SELROW = 7 * MiB;
constexpr size_t WS_WIN_T = 8 * MiB;
constexpr size_t WS_WOUT_T = 17 * MiB;
constexpr size_t WS_WR_T = 21 * MiB, WS_WK_T = 23 * MiB, WS_WV_T = 25 * MiB, WS_WO_T = 27 * MiB;
constexpr size_t WS_WL1_T = 29 * MiB;
constexpr size_t WS_W2T = 31 * MiB;
constexpr size_t WS_A2T = WS_W2T + 256 * 1024, WS_G2T = WS_W2T + 512 * 1024;
constexpr size_t WS_WMOE = 32 * MiB;
constexpr size_t WS_WGU_T = WS_WMOE, WS_WD_T = WS_WMOE + 64 * MiB;
constexpr size_t AB = 128 * MiB;
constexpr size_t WS_P = AB + 0 * MiB;
constexpr size_t WS_H = AB + 162 * MiB;
constexpr size_t WS_AO = AB + 198 * MiB;
constexpr size_t WS_Q = AB + 270 * MiB;
constexpr size_t WS_KA = AB + 306 * MiB, WS_VA = AB + 315 * MiB;
constexpr size_t WS_X1 = AB + 0 * MiB;
constexpr size_t WS_XS0 = AB + 72 * MiB, WS_YS0 = AB + 72 * MiB;
constexpr size_t WS_ACT0 = AB + 198 * MiB;
constexpr size_t WS_X2 = AB + 36 * MiB;
constexpr size_t WS_WGU1 = AB + 324 * MiB, WS_WD1 = AB + 388 * MiB;
constexpr size_t WS_H1 = AB + 144 * MiB;
constexpr size_t WS_XR = AB + 0 * MiB, WS_XK = AB + 72 * MiB, WS_XV = AB + 108 * MiB, WS_XW = AB + 180 * MiB, WS_XA = AB + 216 * MiB, WS_XG = AB + 252 * MiB;
constexpr size_t WS_RB = WS_WMOE, WS_KB = WS_WMOE + 32 * MiB, WS_T1 = WS_WMOE + 68 * MiB;
constexpr size_t WS_VB = AB + 284 * MiB;
constexpr size_t WS_KK = AB + 72 * MiB, WS_LD = AB + 108 * MiB, WS_AA = AB + 180 * MiB;
constexpr size_t WS_Y0 = AB + 0 * MiB, WS_Y1 = AB + 252 * MiB;
constexpr size_t WS_BON = AB + 320 * MiB;
constexpr size_t WS_Z = AB + 72 * MiB;
constexpr size_t WS_X3 = AB + 104 * MiB;
constexpr size_t WS_H2 = AB + 136 * MiB;
constexpr size_t WS_ACT1 = AB + 180 * MiB, WS_YS1 = AB + 252 * MiB;
constexpr size_t WS_END = AB + 420 * MiB;

constexpr int RING_BYTES = 151552, LDSCTL_OFF = RING_BYTES, MISC_OFF = LDSCTL_OFF + 320, LDS_BYTES = 163840;

__device__ __forceinline__ int tid_opaque() { int t = (int)threadIdx.x; asm volatile("" : "+v"(t)); return t; }
#define TID_ tid_opaque()
#define LDS_WAIT() asm volatile("s_waitcnt lgkmcnt(0)" ::: "memory")
#define VM_WAIT() asm volatile("s_waitcnt vmcnt(0)" ::: "memory")
__device__ __forceinline__ float bf2f(unsigned b) { return __uint_as_float(b << 16); }
__device__ __forceinline__ unsigned f2bf(float f) { unsigned u = __float_as_uint(f); return (u + 0x7fffu + ((u >> 16) & 1u)) >> 16; }
typedef __bf16 bf16n2 __attribute__((ext_vector_type(2)));
__device__ __forceinline__ unsigned pk2(float lo, float hi) { const f32x2 v = {lo, hi}; return __builtin_bit_cast(unsigned, __builtin_convertvector(v, bf16n2)); }
__device__ __forceinline__ float wave_sum(float v) {
#pragma unroll
    for (int o = 1; o < 64; o <<= 1) v += __shfl_xor(v, o);
    return v;
}
__device__ __forceinline__ int wave_sum_i(int v) {
#pragma unroll
    for (int o = 1; o < 64; o <<= 1) v += __shfl_xor(v, o);
    return v;
}
__device__ __forceinline__ float rcpf_(float x) { return __builtin_amdgcn_rcpf(x); }
__device__ __forceinline__ float rsqf_(float x) { return __builtin_amdgcn_rsqf(x); }
__device__ __forceinline__ float sigmoidf_(float x) { return rcpf_(1.0f + __expf(-x)); }
template <int CTRL> __device__ __forceinline__ float dpp_mov(float v) { return __int_as_float(__builtin_amdgcn_update_dpp(__float_as_int(v), __float_as_int(v), CTRL, 0xf, 0xf, true)); }
__device__ __forceinline__ float allsum16(float v) { v += dpp_mov<0xB1>(v); v += dpp_mov<0x4E>(v); v += dpp_mov<0x141>(v); v += dpp_mov<0x140>(v); return v; }
__device__ __forceinline__ f32x4 unpk4(u32x2 w) { return (f32x4){bf2f(w.x & 0xffffu), bf2f(w.x >> 16), bf2f(w.y & 0xffffu), bf2f(w.y >> 16)}; }
__device__ __forceinline__ void unpk8(u32x4 w, float (&o)[8]) {
#pragma unroll
    for (int m = 0; m < 4; ++m) { o[2 * m] = bf2f(w[m] & 0xffffu); o[2 * m + 1] = bf2f(w[m] >> 16); }
}
__device__ __forceinline__ u32x4 pk8(const float (&v)[8]) { u32x4 w; w.x = pk2(v[0], v[1]); w.y = pk2(v[2], v[3]); w.z = pk2(v[4], v[5]); w.w = pk2(v[6], v[7]); return w; }
__device__ __forceinline__ u32x2 pk4(f32x4 v) { u32x2 w; w.x = pk2(v.x, v.y); w.y = pk2(v.z, v.w); return w; }

#define XB_TMO      128
#define XB_XCNT(j)  (256  + 64 * (j))
#define XB_XSUB(j)  (1280 + 64 * (j))
#define XB_XGEN(j)  (2304 + 64 * (j))
#define XB_TOP      3328
#define XB_TOPGEN   3392
#define XCD_BAR_WORDS 3456
#define XB_SPIN_CAP (1u << 18)
__device__ __forceinline__ unsigned xb_ld(unsigned* p)              { return __hip_atomic_load(p, __ATOMIC_RELAXED, __HIP_MEMORY_SCOPE_AGENT); }
__device__ __forceinline__ unsigned xb_add(unsigned* p, unsigned v) { return __hip_atomic_fetch_add(p, v, __ATOMIC_RELAXED, __HIP_MEMORY_SCOPE_AGENT); }
__device__ __forceinline__ unsigned xb_xcc_id() { return (unsigned)__builtin_amdgcn_s_getreg((3 << 11) | 20) & 0xFu; }
#define XB_SPIN(cond, bar) do { unsigned _sp = 0; while (cond) { __builtin_amdgcn_s_sleep(1); \
    if ((++_sp & 255u) == 0u) { if (xb_ld(&(bar)[XB_TMO])) break; if (_sp > XB_SPIN_CAP) { atomicAdd(&(bar)[XB_TMO], 1u); break; } } } } while (0)
struct XcdBarrier { unsigned* bar; unsigned x; volatile LAS unsigned* st; };
__device__ __forceinline__ XcdBarrier xcd_barrier_post(unsigned* bar, volatile LAS unsigned* st) {
    XcdBarrier b; b.bar = bar; b.x = xb_xcc_id(); b.st = st;
    if (threadIdx.x == 0) (void)xb_add(&bar[XB_XCNT(b.x)], 1u);
    return b;
}
__device__ __forceinline__ void xcd_barrier_complete(unsigned* bar, unsigned x, unsigned& nloc, unsigned& nx) {
    const unsigned G = gridDim.x * gridDim.y * gridDim.z;
    unsigned sum, cnt, mine, sp = 0u;
    for (;;) {
        sum = 0u; cnt = 0u; mine = 0u;
#pragma unroll
        for (unsigned j = 0; j < 16; ++j) { const unsigned c = xb_ld(&bar[XB_XCNT(j)]); sum += c; cnt += (c > 0u) ? 1u : 0u; mine = (j == x) ? c : mine; }
        if (sum == G) break;
        __builtin_amdgcn_s_sleep(1);
        if ((++sp & 255u) == 0u) { if (xb_ld(&bar[XB_TMO])) break; if (sp > XB_SPIN_CAP) { atomicAdd(&bar[XB_TMO], 1u); break; } }
    }
    nloc = mine > 0u ? mine : 1u; nx = cnt > 0u ? cnt : 1u;
}
__device__ __forceinline__ void xcd_barrier(const XcdBarrier& b) {
    asm volatile("s_waitcnt vmcnt(0)" ::: "memory");
    __syncthreads();
    if (threadIdx.x == 0) {
        unsigned* bar = b.bar;
        __builtin_amdgcn_s_waitcnt(0);
        unsigned nloc = b.st[0], nx = b.st[1];
        if (nloc == 0u) { xcd_barrier_complete(bar, b.x, nloc, nx); b.st[0] = nloc; b.st[1] = nx; }
        const unsigned old = xb_add(&bar[XB_XSUB(b.x)], 1u);
        const unsigned gen = old / nloc;
        if (old + 1u == (gen + 1u) * nloc) {
            __builtin_amdgcn_fence(__ATOMIC_RELEASE, "agent");
            asm volatile("s_waitcnt vmcnt(0)" ::: "memory");
            const unsigned og = xb_add(&bar[XB_TOP], 1u);
            const unsigned tg = og / nx;
            if (og + 1u == (tg + 1u) * nx) xb_add(&bar[XB_TOPGEN], 1u);
            else XB_SPIN(xb_ld(&bar[XB_TOPGEN]) == tg, bar);
            __builtin_amdgcn_fence(__ATOMIC_ACQUIRE, "agent");
            xb_add(&bar[XB_XGEN(b.x)], 1u);
            asm volatile("s_waitcnt vmcnt(0)" ::: "memory");
        } else {
            XB_SPIN(xb_ld(&bar[XB_XGEN(b.x)]) == gen, bar);
            __builtin_amdgcn_fence(__ATOMIC_ACQUIRE, "agent");
            asm volatile("s_waitcnt vmcnt(0)" ::: "memory");
        }
    }
    __syncthreads();
}

namespace pg8 {
constexpr int BM = 256, BK = 64, HALF = 128, HTB = HALF * BK * 2, STAGE_BYTES = 8 * HTB;
__host__ __device__ __forceinline__ int lds_byte(int r, int c) { const int st = (r >> 4) * 2 + (c >> 5), rr = r & 15, cc = c & 31, ob = rr * 64 + cc * 2; return st * 1024 + (ob ^ (((ob >> 9) & 1) << 5)); }
__host__ __device__ __forceinline__ void stage_rc(int b, int& R, int& C) { const int st = b / 1024, sb = b % 1024, swz = sb ^ (((sb >> 9) & 1) << 5); R = (st >> 1) * 16 + swz / 64; C = (st & 1) * 32 + (swz % 64) / 2; }
__host__ __device__ __forceinline__ int perm32(int rho) { const int n = rho >> 4, i = rho & 15; return 8 * (i >> 2) + 4 * n + (i & 3); }
struct Unit { int pm, pn, gi; };
__device__ __forceinline__ unsigned cvt_pk_bf16(float lo, float hi) { return ::pk2(lo, hi); }

template <class Epi, class Sched, bool GATHER = false>
__device__ __forceinline__ void gemm_phase(LAS unsigned char* lds, const int K, const Sched& S, const Epi& E) {
    const int tid = TID_, wid = __builtin_amdgcn_readfirstlane(tid >> 6), lane = tid & 63, wr = wid >> 2, wc = wid & 3, fr = lane & 15, fq = lane >> 4;
    const int nt = K / BK;
    unsigned voffA[2], voffB[2];
#pragma unroll
    for (int i = 0; i < 2; ++i) { int R, C; stage_rc(tid * 16 + i * 8192, R, C); const int Rb = Epi::PERM ? ((R & ~31) + perm32(R & 31)) : R;
        voffA[i] = (unsigned)(R * K + C) * 2u; voffB[i] = (unsigned)(Rb * K + C) * 2u; }
    const size_t kstep = (size_t)(BK * 2);
    const size_t hstep = (size_t)HALF * K * 2;
    const unsigned ldsw = (unsigned)wid * 1024u;
    const int aoff = lds_byte(wr * 64 + fr, fq * 8), boff = lds_byte(wc * 32 + fr, fq * 8);
#define PG8_SA(b, h) (((b) * 2 + (h)) * HTB)
#define PG8_SB(b, h) ((4 + (b) * 2 + (h)) * HTB)
#define PG8_STAGE(bufoff, gbase, voff) do { _Pragma("unroll") for (int _i = 0; _i < 2; ++_i) \
        __builtin_amdgcn_global_load_lds((const unsigned*)((const char*)(gbase) + (voff)[_i]), (LAS unsigned*)(lds + (bufoff) + ldsw + _i * 8192), 16, 0, 0); } while (0)
#define PG8_LDA(dst, b, h) do { _Pragma("unroll") for (int m = 0; m < 4; ++m) _Pragma("unroll") for (int k = 0; k < 2; ++k) dst[m][k] = *(const LAS bf16x8*)(lds + PG8_SA(b, h) + aoff + m * 2048 + k * 1024); } while (0)
#define PG8_LDB(dst, b, h) do { _Pragma("unroll") for (int n = 0; n < 2; ++n) _Pragma("unroll") for (int k = 0; k < 2; ++k) dst[n][k] = *(const LAS bf16x8*)(lds + PG8_SB(b, h) + boff + n * 2048 + k * 1024); } while (0)
#define PG8_MMA(ai, bj, At, Bt) do { __builtin_amdgcn_s_setprio(1); _Pragma("unroll") for (int m = 0; m < 4; ++m) _Pragma("unroll") for (int n = 0; n < 2; ++n) _Pragma("unroll") for (int k = 0; k < 2; ++k) \
        acc[ai][bj][m][n] = __builtin_amdgcn_mfma_f32_16x16x32_bf16(Bt[n][k], At[m][k], acc[ai][bj][m][n], 0, 0, 0); __builtin_amdgcn_s_setprio(0); } while (0)
#define PG8_WAIT_V(n) asm volatile("s_waitcnt vmcnt(" #n ")" ::: "memory")
#define PG8_WAIT_L(n) asm volatile("s_waitcnt lgkmcnt(" #n ")" ::: "memory")
#define PG8_BAR __builtin_amdgcn_s_barrier()
#define PG8_SCHED __builtin_amdgcn_sched_barrier(0)
    Unit cur, nxt; int ui = 0;
    int gR[2], gC[2];
#pragma unroll
    for (int i = 0; i < 2; ++i) stage_rc(tid * 16 + i * 8192, gR[i], gC[i]);
    unsigned vA[2][2] = {{0u, 0u}, {0u, 0u}}, vN[2][2] = {{0u, 0u}, {0u, 0u}};
    if constexpr (GATHER) {
        LAS int* gidx = (LAS int*)(lds + STAGE_BYTES);
        Unit gu; for (int i = 0; S.next(i, gu); ++i) if (tid < 256) gidx[i * 256 + tid] = S.rowidx[gu.pm * 256 + tid];
        __syncthreads();
    }
#define PG8_GIDX(dst, unit_i) do { if constexpr (GATHER) { const LAS int* gi_ = (const LAS int*)(lds + STAGE_BYTES) + (unit_i) * 256; _Pragma("unroll") for (int h_ = 0; h_ < 2; ++h_) _Pragma("unroll") for (int i_ = 0; i_ < 2; ++i_) \
        dst[h_][i_] = (unsigned)gi_[h_ * 128 + gR[i_]] * (unsigned)(K * 2) + (unsigned)(gC[i_] * 2); } } while (0)
    if (!S.next(0, cur)) return;
    PG8_GIDX(vA, 0);
    f32x4 acc[2][2][4][2];
#pragma unroll
    for (int a = 0; a < 2; ++a)
#pragma unroll
        for (int b = 0; b < 2; ++b)
#pragma unroll
            for (int m = 0; m < 4; ++m)
#pragma unroll
                for (int n = 0; n < 2; ++n) acc[a][b][m][n] = (f32x4){0.f, 0.f, 0.f, 0.f};
    bf16x8 At[4][2], B0[2][2], B1[2][2];
    const char* cA; if constexpr (GATHER) cA = S.gbase; else cA = S.a_base(cur);
    const char* cB = S.b_base(cur);
#define PG8_STAGE_A(bufoff, ap, h, v) do { if constexpr (GATHER) { PG8_STAGE(bufoff, ap, (v)[h]); } else { PG8_STAGE(bufoff, (ap) + (h) * hstep, voffA); } } while (0)
    PG8_STAGE(PG8_SB(0, 0), cB, voffB); PG8_STAGE_A(PG8_SA(0, 0), cA, 0, vA); PG8_STAGE(PG8_SB(0, 1), cB + hstep, voffB); PG8_STAGE_A(PG8_SA(0, 1), cA, 1, vA);
    if (wr == 1) PG8_BAR;
    PG8_WAIT_V(4); PG8_BAR;
    PG8_STAGE(PG8_SB(1, 0), cB + kstep, voffB); PG8_STAGE_A(PG8_SA(1, 0), cA + kstep, 0, vA); PG8_STAGE(PG8_SB(1, 1), cB + hstep + kstep, voffB);
    PG8_WAIT_V(6); PG8_BAR;
    for (;;) {
        const bool has_next = S.next(ui + 1, nxt);
        const char* nA = cA; if constexpr (!GATHER) { if (has_next) nA = S.a_base(nxt); }
        const char* nB = has_next ? S.b_base(nxt) : cB;
        if constexpr (GATHER) { if (has_next) PG8_GIDX(vN, ui + 1); else {
#pragma unroll
            for (int h_ = 0; h_ < 2; ++h_)
#pragma unroll
                for (int i_ = 0; i_ < 2; ++i_) vN[h_][i_] = vA[h_][i_]; } }
        for (int t = 0; t < nt; t += 2) {
            const bool last = (t == nt - 2);
            const char* a1 = cA + (size_t)(t + 1) * kstep;
            const char* a2 = last ? nA : cA + (size_t)(t + 2) * kstep; const char* b2 = last ? nB : cB + (size_t)(t + 2) * kstep;
            const char* a3 = a2 + kstep; const char* b3 = b2 + kstep;
            unsigned v2[2][2];
#pragma unroll
            for (int h_ = 0; h_ < 2; ++h_)
#pragma unroll
                for (int i_ = 0; i_ < 2; ++i_) v2[h_][i_] = last ? vN[h_][i_] : vA[h_][i_];
            PG8_LDB(B0, 0, 0); PG8_SCHED; PG8_LDA(At, 0, 0); PG8_STAGE_A(PG8_SA(1, 1), a1, 1, vA);
            PG8_WAIT_L(8); PG8_BAR; PG8_WAIT_L(0); PG8_MMA(0, 0, At, B0); PG8_BAR; PG8_SCHED;
            PG8_LDB(B1, 0, 1); PG8_STAGE(PG8_SB(0, 0), b2, voffB);
            PG8_BAR; PG8_WAIT_L(0); PG8_MMA(0, 1, At, B1); PG8_BAR;
            PG8_LDA(At, 0, 1); PG8_STAGE_A(PG8_SA(0, 0), a2, 0, v2);
            PG8_BAR; PG8_WAIT_L(0); PG8_MMA(1, 0, At, B0); PG8_BAR; PG8_SCHED;
            PG8_STAGE(PG8_SB(0, 1), b2 + hstep, voffB);
            PG8_WAIT_V(6); PG8_BAR; PG8_MMA(1, 1, At, B1); PG8_BAR;
            PG8_LDB(B0, 1, 0); PG8_SCHED; PG8_LDA(At, 1, 0); PG8_STAGE_A(PG8_SA(0, 1), a2, 1, v2);
            PG8_WAIT_L(8); PG8_BAR; PG8_WAIT_L(0); PG8_MMA(0, 0, At, B0); PG8_BAR; PG8_SCHED;
            PG8_LDB(B1, 1, 1); PG8_STAGE(PG8_SB(1, 0), b3, voffB);
            PG8_BAR; PG8_WAIT_L(0); PG8_MMA(0, 1, At, B1); PG8_BAR;
            PG8_LDA(At, 1, 1); PG8_STAGE_A(PG8_SA(1, 0), a3, 0, v2);
            PG8_BAR; PG8_WAIT_L(0); PG8_MMA(1, 0, At, B0); PG8_BAR; PG8_SCHED;
            PG8_STAGE(PG8_SB(1, 1), b3 + hstep, voffB);
            PG8_WAIT_V(6); PG8_BAR; PG8_MMA(1, 1, At, B1); PG8_BAR;
        }
        E(acc, cur, wr, wc, fr, fq);
        if (!has_next) break;
#pragma unroll
        for (int a = 0; a < 2; ++a)
#pragma unroll
            for (int b = 0; b < 2; ++b)
#pragma unroll
                for (int m = 0; m < 4; ++m)
#pragma unroll
                    for (int n = 0; n < 2; ++n) acc[a][b][m][n] = (f32x4){0.f, 0.f, 0.f, 0.f};
        cur = nxt; cA = nA; cB = nB; ++ui;
#pragma unroll
        for (int h_ = 0; h_ < 2; ++h_)
#pragma unroll
            for (int i_ = 0; i_ < 2; ++i_) vA[h_][i_] = vN[h_][i_];
    }
    PG8_WAIT_V(0);
    if (wr == 0) PG8_BAR;
    PG8_BAR;
#undef PG8_SA
#undef PG8_STAGE_A
#undef PG8_GIDX
#undef PG8_SB
#undef PG8_STAGE
#undef PG8_LDA
#undef PG8_LDB
#undef PG8_MMA
#undef PG8_WAIT_V
#undef PG8_WAIT_L
#undef PG8_BAR
#undef PG8_SCHED
}
}
struct Params { const float* in[35]; float* out; unsigned char* ws; int ph_lo, ph_hi; };
enum { I_X = 0, I_C, I_CTX, I_CCTX, I_ADAW, I_ADAB, I_NORMG, I_FINALG, I_WIN, I_WOUT, I_QG, I_KG, I_CONVW, I_MU, I_WR, I_WK, I_WV, I_WO, I_W0, I_W1, I_W2,
       I_A0, I_A1, I_A2, I_G1, I_G2, I_KK, I_KA, I_RK, I_LNW, I_LNB, I_ROUTER, I_WGATE, I_WUP, I_WDOWN };

struct OrderSingle {
    const char* A; const char* Bt; int nM, nN, nwg, G, c, rep; size_t tstep;
    __device__ __forceinline__ void init(const void* A_, const void* Bt_, int M, int N, int K, int G_, int c_, int rep_ = 1) { rep = rep_; A = (const char*)A_; Bt = (const char*)Bt_; nM = M / 256; nN = N / 256; nwg = nM * nN; G = G_; c = c_; tstep = (size_t)256 * K * 2; }
    __device__ __forceinline__ bool next(int i, pg8::Unit& u) const {
        long L = (long)i * G + c; if (L >= (long)nwg * rep) return false; L %= nwg;
        int wgid = (int)L; { const int q = nwg / 8, r = nwg % 8, xcd = wgid % 8, off = wgid / 8; wgid = (xcd < r ? xcd * (q + 1) : r * (q + 1) + (xcd - r) * q) + off; }
        const int nig = 8 * nN, gid = wgid / nig, fm = gid * 8, gsz = (nM - fm) < 8 ? (nM - fm) : 8;
        u.pm = fm + ((wgid % nig) % gsz); u.pn = (wgid % nig) / gsz; u.gi = 0; return true;
    }
    __device__ __forceinline__ const char* a_base(const pg8::Unit& u) const { return A + (size_t)u.pm * tstep; }
    __device__ __forceinline__ const char* b_base(const pg8::Unit& u) const { return Bt + (size_t)u.pn * tstep; }
};
struct OrderMoe {
    const char* A; const char* Bt; int PM, PN, nwg, G, c, rep; size_t tstep; const char* gbase; const int* rowidx;
    __device__ __forceinline__ void init(const void* A_, const void* Bt_, int PM_, int PN_, int K, int G_, int c_, int rep_ = 1) { rep = rep_; gbase = (const char*)A_; rowidx = nullptr; A = (const char*)A_; Bt = (const char*)Bt_; PM = PM_; PN = PN_; nwg = NE * PM * PN; G = G_; c = c_; tstep = (size_t)256 * K * 2; }
    __device__ __forceinline__ bool next(int i, pg8::Unit& u) const {
        int L = i * G + c; if (L >= nwg * rep) return false; L %= nwg;
        const int per = PM * PN, e = L / per, r = L % per; u.pm = e * PM + (r % PM); u.pn = e * PN + (r / PM); u.gi = e; return true;
    }
    __device__ __forceinline__ const char* a_base(const pg8::Unit& u) const { return A + (size_t)u.pm * tstep; }
    __device__ __forceinline__ const char* b_base(const pg8::Unit& u) const { return Bt + (size_t)u.pn * tstep; }
};
struct OrderRkv {
    const char *A0, *A1, *A2, *A3, *A4, *A5, *B0, *B1, *B2, *B3; int G, c, rep;
    __device__ __forceinline__ bool next(int i, pg8::Unit& u) const {
        int L = i * G + c; if (L >= 1040 * rep) return false; L %= 1040;
        int gi, nM;
        if (L < 256) { gi = 0; nM = 64; } else if (L < 544) { gi = 1; nM = 72; L -= 256; } else if (L < 832) { gi = 2; nM = 72; L -= 544; }
        else if (L < 904) { gi = 3; nM = 72; L -= 832; } else if (L < 976) { gi = 4; nM = 72; L -= 904; } else { gi = 5; nM = 64; L -= 976; }
        u.gi = gi; u.pm = L % nM; u.pn = L / nM; return true;
    }
    __device__ __forceinline__ const char* a_base(const pg8::Unit& u) const {
        const char* a = u.gi == 0 ? A0 : u.gi == 1 ? A1 : u.gi == 2 ? A2 : u.gi == 3 ? A3 : u.gi == 4 ? A4 : A5; return a + (size_t)u.pm * (256 * 1024 * 2); }
    __device__ __forceinline__ const char* b_base(const pg8::Unit& u) const {
        const char* b = u.gi == 0 ? B0 : u.gi == 1 ? B1 : u.gi == 2 ? B2 : B3 + (size_t)(u.gi - 3) * (256 * 1024 * 2); return b + (size_t)u.pn * (256 * 1024 * 2); }
};

typedef f32x4 Acc[2][2][4][2];
__device__ __forceinline__ u32x4 pack8(f32x4 v0, f32x4 v1) { u32x4 w; w.x = pg8::cvt_pk_bf16(v0[0], v0[1]); w.y = pg8::cvt_pk_bf16(v0[2], v0[3]); w.z = pg8::cvt_pk_bf16(v1[0], v1[1]); w.w = pg8::cvt_pk_bf16(v1[2], v1[3]); return w; }
struct EpiStore {
    static constexpr bool PERM = true;
    bf16_t* O; int ldc;
    __device__ __forceinline__ void operator()(const Acc& acc, const pg8::Unit& u, int wr, int wc, int fr, int fq) const {
        const int row0 = u.pm * 256 + wr * 64 + fr, col0 = u.pn * 256 + wc * 32 + 8 * fq;
#pragma unroll
        for (int ai = 0; ai < 2; ++ai)
#pragma unroll
            for (int m = 0; m < 4; ++m) { bf16_t* rowp = O + (size_t)(row0 + ai * 128 + m * 16) * ldc + col0;
#pragma unroll
                for (int bj = 0; bj < 2; ++bj) *(u32x4*)(rowp + bj * 128) = pack8(acc[ai][bj][m][0], acc[ai][bj][m][1]); }
    }
};
template <bool BASE_BF16>
struct EpiResid {
    static constexpr bool PERM = true;
    const void* baseL; const void* baseC; bf16_t* O; const float* gate;
    __device__ __forceinline__ void operator()(const Acc& acc, const pg8::Unit& u, int wr, int wc, int fr, int fq) const {
        const int row0 = u.pm * 256 + wr * 64 + fr, col0 = u.pn * 256 + wc * 32 + 8 * fq;
        const int mr = u.pm < 64 ? (u.pm >> 3) : 8;
        const float* gt = gate + (size_t)mr * 6144;
        f32x4 g4[2][2];
#pragma unroll
        for (int bj = 0; bj < 2; ++bj)
#pragma unroll
            for (int n = 0; n < 2; ++n) g4[bj][n] = *(const f32x4*)(gt + col0 + bj * 128 + n * 4);
#pragma unroll
        for (int ai = 0; ai < 2; ++ai)
#pragma unroll
            for (int m = 0; m < 4; ++m) { const int row = row0 + ai * 128 + m * 16; bf16_t* op = O + (size_t)row * DM + col0;
#pragma unroll
                for (int bj = 0; bj < 2; ++bj) { f32x4 b0, b1;
                    if (BASE_BF16) { const bf16_t* bp = (row < ML ? (const bf16_t*)baseL + (size_t)row * DM : (const bf16_t*)baseC + (size_t)(row - ML) * DM) + col0 + bj * 128;
                        const u32x4 w = *(const u32x4*)bp; b0 = unpk4((u32x2){w.x, w.y}); b1 = unpk4((u32x2){w.z, w.w}); }
                    else { const float* bp = (row < ML ? (const float*)baseL + (size_t)row * DM : (const float*)baseC + (size_t)(row - ML) * DM) + col0 + bj * 128;
                        b0 = *(const f32x4*)bp; b1 = *(const f32x4*)(bp + 4); }
                    *(u32x4*)(op + bj * 128) = pack8(b0 + g4[bj][0] * acc[ai][bj][m][0], b1 + g4[bj][1] * acc[ai][bj][m][1]); }
                asm volatile("" ::: "memory"); }
    }
};
struct EpiAct {
    static constexpr bool PERM = true;
    bf16_t* O;
    __device__ __forceinline__ void operator()(const Acc& acc, const pg8::Unit& u, int wr, int wc, int fr, int fq) const {
        const int row0 = u.pm * 256 + wr * 64 + fr, f0 = (u.pn & 7) * 128 + wc * 32 + 8 * fq;
#pragma unroll
        for (int ai = 0; ai < 2; ++ai)
#pragma unroll
            for (int m = 0; m < 4; ++m) { bf16_t* rowp = O + (size_t)(row0 + ai * 128 + m * 16) * DM + f0;
                f32x4 o[2];
#pragma unroll
                for (int n = 0; n < 2; ++n) { const f32x4 g = acc[ai][0][m][n], up = acc[ai][1][m][n];
#pragma unroll
                    for (int j = 0; j < 4; ++j) o[n][j] = g[j] * sigmoidf_(g[j]) * up[j]; }
                *(u32x4*)rowp = pack8(o[0], o[1]); }
    }
};
struct EpiYs {
    static constexpr bool PERM = true;
    bf16_t* O; const float* selaff;
    __device__ __forceinline__ void operator()(const Acc& acc, const pg8::Unit& u, int wr, int wc, int fr, int fq) const {
        const int row0 = u.pm * 256 + wr * 64 + fr, col0 = (u.pn & 3) * 256 + wc * 32 + 8 * fq;
#pragma unroll
        for (int ai = 0; ai < 2; ++ai)
#pragma unroll
            for (int m = 0; m < 4; ++m) { const int row = row0 + ai * 128 + m * 16; const float s = selaff[row]; bf16_t* rowp = O + (size_t)row * DM + col0;
#pragma unroll
                for (int bj = 0; bj < 2; ++bj) *(u32x4*)(rowp + bj * 128) = pack8(acc[ai][bj][m][0] * s, acc[ai][bj][m][1] * s); }
    }
};
struct EpiRkv {
    static constexpr bool PERM = true;
    bf16_t *R, *K, *V, *T1;
    __device__ __forceinline__ void operator()(const Acc& acc, const pg8::Unit& u, int wr, int wc, int fr, int fq) const {
        const int row0 = u.pm * 256 + wr * 64 + fr;
        if (u.gi < 3) {
            bf16_t* O = u.gi == 0 ? R : u.gi == 1 ? K : V; const int col0 = u.pn * 256 + wc * 32 + 8 * fq;
#pragma unroll
            for (int ai = 0; ai < 2; ++ai)
#pragma unroll
                for (int m = 0; m < 4; ++m) { bf16_t* rowp = O + (size_t)(row0 + ai * 128 + m * 16) * DM + col0;
#pragma unroll
                    for (int bj = 0; bj < 2; ++bj) *(u32x4*)(rowp + bj * 128) = pack8(acc[ai][bj][m][0], acc[ai][bj][m][1]); }
        } else {
            bf16_t* O = T1 + (size_t)(u.gi - 3) * MT * 128; const int col0 = wc * 32 + 8 * fq;
#pragma unroll
            for (int ai = 0; ai < 2; ++ai)
#pragma unroll
                for (int m = 0; m < 4; ++m) *(u32x4*)(O + (size_t)(row0 + ai * 128 + m * 16) * 128 + col0) = pack8(acc[ai][0][m][0], acc[ai][0][m][1]);
        }
    }
};
__device__ __forceinline__ void ld_row_f32(const float* p, int lane, f32x4 (&v)[4]) {
#pragma unroll
    for (int j = 0; j < 4; ++j) v[j] = *(const f32x4*)(p + 256 * j + 4 * lane);
}
__device__ __forceinline__ void ld_row_bf16(const bf16_t* p, int lane, f32x4 (&v)[4]) {
#pragma unroll
    for (int j = 0; j < 4; ++j) v[j] = unpk4(*(const u32x2*)(p + 256 * j + 4 * lane));
}
__device__ __forceinline__ void st_row_f32(float* p, int lane, const f32x4 (&v)[4]) {
#pragma unroll
    for (int j = 0; j < 4; ++j) *(f32x4*)(p + 256 * j + 4 * lane) = v[j];
}
__device__ __forceinline__ void st_row_bf16(bf16_t* p, int lane, const f32x4 (&v)[4]) {
#pragma unroll
    for (int j = 0; j < 4; ++j) *(u32x2*)(p + 256 * j + 4 * lane) = pk4(v[j]);
}
template <int R>
__device__ __forceinline__ void ada_rows(f32x4 (&v)[R][4], const float* g, const float* const (&sh)[R], const float* const (&sc)[R], int lane) {
    float ss[R];
#pragma unroll
    for (int r = 0; r < R; ++r) { ss[r] = 0.f;
#pragma unroll
        for (int j = 0; j < 4; ++j) ss[r] += (v[r][j].x * v[r][j].x + v[r][j].y * v[r][j].y) + (v[r][j].z * v[r][j].z + v[r][j].w * v[r][j].w); }
#pragma unroll
    for (int o = 1; o < 64; o <<= 1) {
#pragma unroll
        for (int r = 0; r < R; ++r) ss[r] += __shfl_xor(ss[r], o); }
#pragma unroll
    for (int j = 0; j < 4; ++j) { const f32x4 gg = *(const f32x4*)(g + 256 * j + 4 * lane);
#pragma unroll
        for (int r = 0; r < R; ++r) { const float rinv = rsqf_(ss[r] * (1.0f / DM) + 1e-6f);
            const f32x4 s = *(const f32x4*)(sc[r] + 256 * j + 4 * lane), h = *(const f32x4*)(sh[r] + 256 * j + 4 * lane);
            v[r][j] = (v[r][j] * rinv) * gg * (s + 1.0f) + h; } }
}

__device__ __forceinline__ void transpose_item64(const float* W, int N, bf16_t* WT, int ldk, LAS float* scr, int k0, int n0, int drow0, int lane) {
    float tv[64];
#pragma unroll
    for (int i = 0; i < 64; ++i) tv[i] = W[(size_t)(k0 + i) * N + n0 + lane];
#pragma unroll
    for (int i = 0; i < 64; ++i) scr[i * 65 + lane] = tv[i];
    LDS_WAIT(); asm volatile("" ::: "memory");
    const int c = lane & 7;
#pragma unroll
    for (int j = 0; j < 8; ++j) { const int n = (lane >> 3) + 8 * j; const LAS float* s = scr + (8 * c) * 65 + n;
        u32x4 o; o.x = pk2(s[0 * 65], s[1 * 65]); o.y = pk2(s[2 * 65], s[3 * 65]); o.z = pk2(s[4 * 65], s[5 * 65]); o.w = pk2(s[6 * 65], s[7 * 65]);
        *(u32x4*)(WT + (size_t)(drow0 + n) * ldk + k0 + 8 * c) = o; }
    LDS_WAIT(); asm volatile("" ::: "memory");
}
__device__ __forceinline__ void transpose_item(const float* W, int N, bf16_t* WT, int ldk, LAS float* scr, int k0, int n0, int drow0, int lane) {
#pragma unroll 8
    for (int i = 0; i < 32; ++i) { const int kk = 2 * i + (lane >> 5); scr[kk * 33 + (lane & 31)] = W[(size_t)(k0 + kk) * N + n0 + (lane & 31)]; }
    LDS_WAIT(); asm volatile("" ::: "memory");
    const int c = lane & 7;
#pragma unroll
    for (int j = 0; j < 4; ++j) { const int n = (lane >> 3) + 8 * j; const LAS float* s = scr + (8 * c) * 33 + n;
        u32x4 o; o.x = pk2(s[0 * 33], s[1 * 33]); o.y = pk2(s[2 * 33], s[3 * 33]); o.z = pk2(s[4 * 33], s[5 * 33]); o.w = pk2(s[6 * 33], s[7 * 33]);
        *(u32x4*)(WT + (size_t)(drow0 + n) * ldk + k0 + 8 * c) = o; }
    LDS_WAIT(); asm volatile("" ::: "memory");
}
__device__ __forceinline__ void moe_convert_item(const Params& p, int layer, int it, LAS float* scr, int lane) {
    const int e = it / 768, r = it % 768, which = r / 256, li = r % 256, k0 = 64 * (li / 16), n0 = 64 * (li % 16);
    const size_t woff = (size_t)(layer * NE + e) * 1024 * 1024;
    if (which == 0)      transpose_item64(p.in[I_WGATE] + woff, 1024, (bf16_t*)(p.ws + (layer ? WS_WGU1 : WS_WGU_T)) + (size_t)e * 2048 * 1024, 1024, scr, k0, n0, (n0 >> 7) * 256 + (n0 & 127), lane);
    else if (which == 1) transpose_item64(p.in[I_WUP] + woff, 1024, (bf16_t*)(p.ws + (layer ? WS_WGU1 : WS_WGU_T)) + (size_t)e * 2048 * 1024, 1024, scr, k0, n0, (n0 >> 7) * 256 + 128 + (n0 & 127), lane);
    else                 transpose_item64(p.in[I_WDOWN] + woff, 1024, (bf16_t*)(p.ws + (layer ? WS_WD1 : WS_WD_T)) + (size_t)e * 1024 * 1024, 1024, scr, k0, n0, n0, lane);
}
constexpr int P0_NMOD = 768, P0_NSMALL = 5760, P0_NZERO = 384, P0_NMOE = 16 * 768;
#ifndef P2_CONV_ITEMS
#define P2_CONV_ITEMS 3584
#endif
#ifndef P5_CONV_ITEMS
#define P5_CONV_ITEMS 12288
#endif
#ifndef L1_A
#define L1_A 1800
#endif
#ifndef L1_B
#define L1_B 4600
#endif
#ifndef L1_C
#define L1_C 8100
#endif
constexpr int P8_GEMM_WGS = 231, P9_GEMM_WGS = 192, P12_GEMM_WGS = 208;
constexpr int P2_GEMM_WGS = 216;
constexpr int P5_GEMM_WGS = 144;
constexpr int CTL_Q0 = 8192, CTL_DONE = 8256;
__device__ __forceinline__ void moe_fill(const Params& p, LAS unsigned char* lds, int layer, unsigned* qword, unsigned* done, int G, int wave, int lane) {
    volatile LAS int* jw = (volatile LAS int*)(lds + 133120);
    LAS float* scr = (LAS float*)(lds + wave * 16640);
    constexpr int NJOBS = P0_NMOE / 8;
    __syncthreads();
    if (done && TID_ == 0) __hip_atomic_fetch_add(done, 1u, __ATOMIC_RELAXED, __HIP_MEMORY_SCOPE_AGENT);
    for (;;) {
        if (TID_ == 0) {
            bool go = true;
            if (done) go = __hip_atomic_load(done, __ATOMIC_RELAXED, __HIP_MEMORY_SCOPE_AGENT) < (unsigned)G;
            int j = NJOBS;
            if (go && __hip_atomic_load(qword, __ATOMIC_RELAXED, __HIP_MEMORY_SCOPE_AGENT) < (unsigned)NJOBS) j = (int)__hip_atomic_fetch_add(qword, 1u, __ATOMIC_RELAXED, __HIP_MEMORY_SCOPE_AGENT);
            *jw = j;
        }
        __syncthreads();
        const int j = *jw;
        __syncthreads();
        if (j >= NJOBS) break;
        moe_convert_item(p, layer, j * 8 + wave, scr, lane);
    }
}
__device__ __forceinline__ void small_convert_item(const Params& p, int it, LAS float* scr, int lane) {
    const float* W; int K, N, ldk; bf16_t* WT; int base;
    unsigned char* ws = p.ws;
    if (it < 2304)      { base = 0;    W = p.in[I_WIN];  K = 1024; N = 4608; WT = (bf16_t*)(ws + WS_WIN_T);  ldk = 1024; }
    else if (it < 3328) { base = 2304; W = p.in[I_WOUT]; K = 2048; N = 1024; WT = (bf16_t*)(ws + WS_WOUT_T); ldk = 2048; }
    else if (it < 3840) { base = 3328; W = p.in[I_WR];   K = 1024; N = 1024; WT = (bf16_t*)(ws + WS_WR_T);   ldk = 1024; }
    else if (it < 4352) { base = 3840; W = p.in[I_WK];   K = 1024; N = 1024; WT = (bf16_t*)(ws + WS_WK_T);   ldk = 1024; }
    else if (it < 4864) { base = 4352; W = p.in[I_WV];   K = 1024; N = 1024; WT = (bf16_t*)(ws + WS_WV_T);   ldk = 1024; }
    else if (it < 5376) { base = 4864; W = p.in[I_WO];   K = 1024; N = 1024; WT = (bf16_t*)(ws + WS_WO_T);   ldk = 1024; }
    else if (it < 5408) { base = 5376; W = p.in[I_W1];             K = 1024; N = 64;  WT = (bf16_t*)(ws + WS_WL1_T);                      ldk = 1024; }
    else if (it < 5440) { base = 5408; W = p.in[I_W1] + 1024 * 64; K = 1024; N = 64;  WT = (bf16_t*)(ws + WS_WL1_T) + 64 * 1024;          ldk = 1024; }
    else if (it < 5472) { base = 5440; W = p.in[I_A1];             K = 1024; N = 64;  WT = (bf16_t*)(ws + WS_WL1_T) + 256 * 1024;         ldk = 1024; }
    else if (it < 5504) { base = 5472; W = p.in[I_A1] + 1024 * 64; K = 1024; N = 64;  WT = (bf16_t*)(ws + WS_WL1_T) + (256 + 64) * 1024;  ldk = 1024; }
    else if (it < 5568) { base = 5504; W = p.in[I_G1];             K = 1024; N = 128; WT = (bf16_t*)(ws + WS_WL1_T) + 512 * 1024;         ldk = 1024; }
    else if (it < 5600) { base = 5568; W = p.in[I_W2];             K = 64;   N = 1024; WT = (bf16_t*)(ws + WS_W2T);                       ldk = 64; }
    else if (it < 5632) { base = 5600; W = p.in[I_W2] + 64 * 1024; K = 64;   N = 1024; WT = (bf16_t*)(ws + WS_W2T) + 1024 * 64;           ldk = 64; }
    else if (it < 5664) { base = 5632; W = p.in[I_A2];             K = 64;   N = 1024; WT = (bf16_t*)(ws + WS_A2T);                       ldk = 64; }
    else if (it < 5696) { base = 5664; W = p.in[I_A2] + 64 * 1024; K = 64;   N = 1024; WT = (bf16_t*)(ws + WS_A2T) + 1024 * 64;           ldk = 64; }
    else                { base = 5696; W = p.in[I_G2];             K = 128;  N = 1024; WT = (bf16_t*)(ws + WS_G2T);                       ldk = 128; }
    const int li = it - base, nblk = N / 32, k0 = 64 * (li / nblk), n0 = 32 * (li % nblk);
    (void)K;
    transpose_item(W, N, WT, ldk, scr, k0, n0, n0, lane);
}
__device__ __forceinline__ void phase_prep(const Params& p, LAS unsigned char* lds, int gw, int NGW, int wave, int lane, bool skip_mod) {
    LAS float* S = (LAS float*)lds;
    for (int i = TID_; i < 9 * 1024; i += 512) { const float c = i < 8192 ? p.in[I_C][i] : p.in[I_CCTX][i - 8192]; S[i] = c * sigmoidf_(c); }
    __syncthreads();
    float* mod = (float*)(p.ws + WS_MOD);
    if (!skip_mod) {
        LAS float* part = (LAS float*)(lds + 36864);
        for (int it = blockIdx.x; it < 192; it += gridDim.x) {
            const int l = it / 96, nch = it % 96, n = nch * 64 + lane, kb = wave * 128;
            const float* w = p.in[I_ADAW] + ((size_t)l * 1024 + kb) * 6144 + n;
            float acc[9];
#pragma unroll
            for (int r9 = 0; r9 < 9; ++r9) acc[r9] = 0.f;
            for (int k = 0; k < 128; k += 32) {
                float wv[32];
#pragma unroll
                for (int u = 0; u < 32; ++u) wv[u] = w[(size_t)(k + u) * 6144];
#pragma unroll
                for (int u = 0; u < 32; ++u)
#pragma unroll
                    for (int r9 = 0; r9 < 9; ++r9) acc[r9] += S[r9 * 1024 + kb + k + u] * wv[u];
            }
#pragma unroll
            for (int r9 = 0; r9 < 9; ++r9) part[(wave * 9 + r9) * 64 + lane] = acc[r9];
            __syncthreads();
            for (int o = TID_; o < 576; o += 512) { const int r9 = o >> 6, col = o & 63; float s = p.in[I_ADAB][l * 6144 + nch * 64 + col];
#pragma unroll
                for (int w8 = 0; w8 < 8; ++w8) s += part[(w8 * 9 + r9) * 64 + col];
                mod[(size_t)(l * 9 + r9) * 6144 + nch * 64 + col] = s; }
            __syncthreads();
        }
    }
    __syncthreads();
    LAS float* scr = (LAS float*)(lds + wave * 16640);
    const int NIT = P0_NSMALL + P0_NZERO + P0_NMOE - P5_CONV_ITEMS;
    for (int it = gw; it < NIT; it += NGW) {
        if (it < P0_NSMALL) {
            small_convert_item(p, it, scr, lane);
        } else if (it < P0_NSMALL + P0_NZERO) {
            const int r = it - P0_NSMALL, g = r >> 7, row = 128 + (r & 127);
            bf16_t* dst = (bf16_t*)(p.ws + WS_WL1_T) + (size_t)(g * 256 + row) * 1024;
            *(u32x4*)(dst + lane * 8) = (u32x4){0u, 0u, 0u, 0u}; *(u32x4*)(dst + 512 + lane * 8) = (u32x4){0u, 0u, 0u, 0u};
        } else {
            moe_convert_item(p, 0, P5_CONV_ITEMS + it - P0_NSMALL - P0_NZERO, scr, lane);
        }
    }
    float* rope = (float*)(p.ws + WS_ROPE);
    for (int idx = gw * 64 + lane; idx < SEQ * 64; idx += NGW * 64) { const int t = idx >> 6, j = idx & 63;
        const float ang = (float)(j < 32 ? (t >> 6) : (t & 63)) * powf(10000.0f, -(float)(j & 31) / 32.0f);
        rope[idx] = cosf(ang); rope[SEQ * 64 + idx] = sinf(ang); }
}

__device__ __forceinline__ void phase_prenorm0(const Params& p, int gw, int NGW, int lane) {
    const float* mod = (const float*)(p.ws + WS_MOD);
    bf16_t* H = (bf16_t*)(p.ws + WS_H);
    constexpr int R = 4;
    for (int row0 = gw * R; row0 < MT; row0 += NGW * R) {
        const float* xr = row0 < ML ? p.in[I_X] + (size_t)row0 * DM : p.in[I_CTX] + (size_t)(row0 - ML) * DM;
        const int mr = row0 < ML ? (row0 >> 11) : 8;
        const float* m = mod + (size_t)mr * 6144;
        f32x4 v[R][4];
#pragma unroll
        for (int r = 0; r < R; ++r) ld_row_f32(xr + (size_t)r * DM, lane, v[r]);
        const float* const sh[R] = {m, m, m, m}; const float* const sc[R] = {m + 1024, m + 1024, m + 1024, m + 1024};
        ada_rows<R>(v, p.in[I_NORMG], sh, sc, lane);
#pragma unroll
        for (int r = 0; r < R; ++r) st_row_bf16(H + (size_t)(row0 + r) * DM, lane, v[r]);
    }
}

__device__ __forceinline__ void phase_qkconv(const Params& p, int gw, int NGW, int lane) {
    const bf16_t* P = (const bf16_t*)(p.ws + WS_P);
    bf16_t* Q = (bf16_t*)(p.ws + WS_Q); bf16_t* KA = (bf16_t*)(p.ws + WS_KA); bf16_t* VA = (bf16_t*)(p.ws + WS_VA); bf16_t* AO = (bf16_t*)(p.ws + WS_AO);
    const float* rope = (const float*)(p.ws + WS_ROPE);
    const int i16 = lane & 15, dlo = 8 * (i16 & 7);
    const float sgn = i16 < 8 ? -1.f : 1.f;
    float qg[8], kg[8];
#pragma unroll
    for (int j = 0; j < 8; ++j) { qg[j] = p.in[I_QG][8 * i16 + j]; kg[j] = p.in[I_KG][8 * i16 + j]; }
    for (int row0 = gw * 2; row0 < MT; row0 += NGW * 2) {
        u32x4 ra[2], rb[2], rk[2]; f32x4 cs[2][2], sn[2][2];
#pragma unroll
        for (int r = 0; r < 2; ++r) { const int row = row0 + r; const bf16_t* pr = P + (size_t)row * PROJ;
            ra[r] = *(const u32x4*)(pr + 8 * lane); rb[r] = *(const u32x4*)(pr + 512 + 8 * lane); rk[r] = *(const u32x4*)(pr + 1024 + 8 * lane);
            if (row < ML) { const float* cp = rope + (size_t)(row & 2047) * 64 + dlo; cs[r][0] = *(const f32x4*)cp; cs[r][1] = *(const f32x4*)(cp + 4); sn[r][0] = *(const f32x4*)(cp + SEQ * 64); sn[r][1] = *(const f32x4*)(cp + SEQ * 64 + 4); }
            else { cs[r][0] = (f32x4){1.f, 1.f, 1.f, 1.f}; cs[r][1] = cs[r][0]; sn[r][0] = (f32x4){0.f, 0.f, 0.f, 0.f}; sn[r][1] = sn[r][0]; } }
#pragma unroll
        for (int r = 0; r < 2; ++r) {
            const int row = row0 + r; const bool lat = row < ML;
            const int b = lat ? (row >> 11) : ((row - ML) >> 8), t = lat ? (row & 2047) : ((row - ML) & 255);
            const size_t kvrow = ((size_t)b * KVL + (lat ? CTXL + t : t)) * 256;
#pragma unroll
            for (int part = 0; part < 3; ++part) {
                float x[8], o[8]; unpk8(part == 0 ? ra[r] : part == 1 ? rb[r] : rk[r], x);
                float ss = 0.f;
#pragma unroll
                for (int j = 0; j < 8; ++j) ss += x[j] * x[j];
                const float rinv = rsqf_(allsum16(ss) * (1.0f / 128.0f) + 1e-6f);
#pragma unroll
                for (int j = 0; j < 8; ++j) { const float y = x[j] * rinv * (part == 2 ? kg[j] : qg[j]); const float other = dpp_mov<0x128>(y);
                    o[j] = y * cs[r][j >> 2][j & 3] + sgn * other * sn[r][j >> 2][j & 3]; }
                if (part == 0) *(u32x4*)(Q + (size_t)row * DM + 8 * lane) = pk8(o);
                else if (part == 1) *(u32x4*)(Q + (size_t)row * DM + 512 + 8 * lane) = pk8(o);
                else { if (lane < 32) *(u32x4*)(KA + kvrow + 8 * lane) = pk8(o); else *(u32x4*)(VA + kvrow + 8 * (lane - 32)) = rk[r]; }
            }
        }
    }
    f32x4 w0[4], w1[4], w2[4];
#pragma unroll
    for (int q4 = 0; q4 < 4; ++q4) { const int c = 16 * lane + 4 * q4; w0[q4] = *(const f32x4*)(p.in[I_CONVW] + c); w1[q4] = *(const f32x4*)(p.in[I_CONVW] + 1024 + c); w2[q4] = *(const f32x4*)(p.in[I_CONVW] + 2048 + c); }
    for (int row0 = gw * 2; row0 < MT; row0 += NGW * 2) {
        const bool lat = row0 < ML; const int t0 = lat ? (row0 & 2047) : ((row0 - ML) & 255), T = lat ? SEQ : CTXL;
        const bf16_t* pr = P + (size_t)row0 * PROJ + 16 * lane;
        u32x4 gc[4][2], xc[4][2], gb[2][2];
#pragma unroll
        for (int r = 0; r < 4; ++r) { const bool ok = (r != 0 || t0 > 0) && (r != 3 || t0 + 2 < T); const bf16_t* q = pr + (ptrdiff_t)(r - 1) * PROJ;
#pragma unroll
            for (int hh = 0; hh < 2; ++hh) { gc[r][hh] = ok ? *(const u32x4*)(q + 2560 + 8 * hh) : (u32x4){0u, 0u, 0u, 0u}; xc[r][hh] = ok ? *(const u32x4*)(q + 3584 + 8 * hh) : (u32x4){0u, 0u, 0u, 0u}; } }
#pragma unroll
        for (int r = 0; r < 2; ++r)
#pragma unroll
            for (int hh = 0; hh < 2; ++hh) gb[r][hh] = *(const u32x4*)(pr + (size_t)r * PROJ + 1536 + 8 * hh);
#pragma unroll
        for (int hh = 0; hh < 2; ++hh) {
            float u[4][8];
#pragma unroll
            for (int r = 0; r < 4; ++r) { float a[8], b[8]; unpk8(gc[r][hh], a); unpk8(xc[r][hh], b);
#pragma unroll
                for (int j = 0; j < 8; ++j) u[r][j] = a[j] * b[j]; }
#pragma unroll
            for (int r = 0; r < 2; ++r) { float g[8], o[8]; unpk8(gb[r][hh], g);
#pragma unroll
                for (int j = 0; j < 8; ++j) { const int q4 = 2 * hh + (j >> 2), e = j & 3; o[j] = g[j] * (u[r][j] * w0[q4][e] + u[r + 1][j] * w1[q4][e] + u[r + 2][j] * w2[q4][e]); }
                *(u32x4*)(AO + (size_t)(row0 + r) * 2048 + 1024 + 16 * lane + 8 * hh) = pk8(o); }
        }
    }
}

namespace attn {
constexpr int D = 128, NW = 8, QBLK = 32, KVBLK = 64;
constexpr float SCALE = 0.088388347648318440f;
constexpr float THR = 8.f;
constexpr size_t SHM_V = KVBLK * D * 2, SHM_K = KVBLK * D * 2, SHM_ATTN = 2 * SHM_V + 2 * SHM_K + NW * 64 * 4;
#define KSWZ(row, colB) ((row) * 256 + ((colB) ^ (((row) & 7) << 4)))
#define SBAR() __builtin_amdgcn_sched_barrier(0)
__device__ __forceinline__ int crow(int r, int hi) { return (r & 3) + 8 * (r >> 2) + 4 * hi; }
__device__ __forceinline__ unsigned cvtpk(float lo, float hi) { unsigned r; asm volatile("v_cvt_pk_bf16_f32 %0, %1, %2" : "=v"(r) : "v"(lo), "v"(hi)); return r; }
__device__ __forceinline__ void partialSM(f32x16& p0, f32x16& p1, float& m_reg, float& mn, float& alpha) {
  constexpr float C = SCALE * 1.4426950408889634f;
  float pmax = p0[0]; for (int r = 1; r < 16; ++r) pmax = fmaxf(pmax, p0[r]); for (int r = 0; r < 16; ++r) pmax = fmaxf(pmax, p1[r]);
  { auto rr = __builtin_amdgcn_permlane32_swap(__float_as_uint(pmax), __float_as_uint(pmax), false, false);
    pmax = fmaxf(__uint_as_float(rr[0]), __uint_as_float(rr[1])); }
  if (__builtin_expect(__all(pmax - m_reg <= THR / SCALE), 1)) { mn = m_reg; alpha = 1.f; }
  else { mn = fmaxf(m_reg, pmax); alpha = __builtin_amdgcn_exp2f((m_reg - mn) * C); m_reg = mn; }
  float mnC = -mn * C;
  for (int r = 0; r < 16; ++r) p0[r] = fmaf(p0[r], C, mnC); for (int r = 0; r < 16; ++r) p1[r] = fmaf(p1[r], C, mnC);
  for (int r = 0; r < 16; ++r) p0[r] = __builtin_amdgcn_exp2f(p0[r]);
}
__device__ __forceinline__ void finishSM(f32x16& p0, f32x16& p1, float alpha, float& l_reg, bf16x8& pa0, bf16x8& pa1, bf16x8& pa2, bf16x8& pa3) {
  for (int r = 0; r < 16; ++r) p1[r] = __builtin_amdgcn_exp2f(p1[r]);
  float ps = 0; for (int r = 0; r < 16; ++r) ps += p0[r]; for (int r = 0; r < 16; ++r) ps += p1[r];
  { auto rr = __builtin_amdgcn_permlane32_swap(__float_as_uint(ps), __float_as_uint(ps), false, false);
    ps = __uint_as_float(rr[0]) + __uint_as_float(rr[1]); }
  l_reg = l_reg * alpha + ps;
#define PK4(P, BASE, OUT) do { unsigned a0 = cvtpk(P[BASE + 0], P[BASE + 1]), a1 = cvtpk(P[BASE + 2], P[BASE + 3]);   \
    unsigned b0 = cvtpk(P[BASE + 4], P[BASE + 5]), b1 = cvtpk(P[BASE + 6], P[BASE + 7]);                              \
    auto r0 = __builtin_amdgcn_permlane32_swap(a0, b0, false, false); auto r1 = __builtin_amdgcn_permlane32_swap(a1, b1, false, false); \
    u32x4 w = {r0[0], r1[0], r0[1], r1[1]}; OUT = *reinterpret_cast<bf16x8*>(&w); } while (0)
  PK4(p0, 0, pa0); PK4(p0, 8, pa1); PK4(p1, 0, pa2); PK4(p1, 8, pa3);
#undef PK4
}
__device__ __forceinline__ void qkt(f32x16& p0, f32x16& p1, const bf16_t* Ks, const bf16x8* qr, int r32, int hi) {
  p0 = f32x16{}; p1 = f32x16{};
  for (int d0 = 0; d0 < 8; ++d0) { int cb = (d0 * 16 + hi * 8) * 2;
    bf16x8 b0 = *reinterpret_cast<const bf16x8*>((const char*)Ks + KSWZ(r32, cb));
    bf16x8 b1 = *reinterpret_cast<const bf16x8*>((const char*)Ks + KSWZ(32 + r32, cb));
    p0 = __builtin_amdgcn_mfma_f32_32x32x16_bf16(b0, qr[d0], p0, 0, 0, 0);
    p1 = __builtin_amdgcn_mfma_f32_32x32x16_bf16(b1, qr[d0], p1, 0, 0, 0); }
}
__device__ __forceinline__ int v_st(int k, int c) { const int kk = (k & ~0xC) | ((k & 4) << 1) | ((k & 8) >> 1); return ((kk >> 3) * 4 + (c >> 5)) * 512 + ((kk & 7) * 32 + (c & 31)) * 2; }
__device__ __forceinline__ int v_rd_base(int lane) { return ((lane & 3) << 3) | (((lane >> 2) & 3) << 6) | (((lane >> 4) & 1) << 5) | (((lane >> 5) & 1) << 8); }
constexpr int v_rd_off(int d0, int ks, int half) { return d0 * 512 + ks * 4096 + half * 2048; }
template <int OFF> __device__ __forceinline__ s16x4 tr_read(int vb) {
  s16x4 r; asm volatile("ds_read_b64_tr_b16 %0, %1 offset:%2" : "=&v"(r) : "v"(vb), "i"(OFF) : "memory"); return r;
}
template <int D0> __device__ __forceinline__ void pv_one(f32x16& od, int vb, bf16x8 pa0, bf16x8 pa1, bf16x8 pa2, bf16x8 pa3) {
  const s16x4 l0 = tr_read<v_rd_off(D0, 0, 0)>(vb), h0 = tr_read<v_rd_off(D0, 0, 1)>(vb), l1 = tr_read<v_rd_off(D0, 1, 0)>(vb), h1 = tr_read<v_rd_off(D0, 1, 1)>(vb);
  const s16x4 l2 = tr_read<v_rd_off(D0, 2, 0)>(vb), h2 = tr_read<v_rd_off(D0, 2, 1)>(vb), l3 = tr_read<v_rd_off(D0, 3, 0)>(vb), h3 = tr_read<v_rd_off(D0, 3, 1)>(vb);
  asm volatile("s_waitcnt lgkmcnt(0)" ::: "memory"); SBAR();
#define PK(L, H) (bf16x8){L[0], L[1], L[2], L[3], H[0], H[1], H[2], H[3]}
  od = __builtin_amdgcn_mfma_f32_32x32x16_bf16(pa0, PK(l0, h0), od, 0, 0, 0);
  od = __builtin_amdgcn_mfma_f32_32x32x16_bf16(pa1, PK(l1, h1), od, 0, 0, 0);
  od = __builtin_amdgcn_mfma_f32_32x32x16_bf16(pa2, PK(l2, h2), od, 0, 0, 0);
  od = __builtin_amdgcn_mfma_f32_32x32x16_bf16(pa3, PK(l3, h3), od, 0, 0, 0);
#undef PK
}
__device__ __forceinline__ void pv_d0(f32x16* o, int vb, bf16x8 pa0, bf16x8 pa1, bf16x8 pa2, bf16x8 pa3) {
  pv_one<0>(o[0], vb, pa0, pa1, pa2, pa3); pv_one<1>(o[1], vb, pa0, pa1, pa2, pa3); pv_one<2>(o[2], vb, pa0, pa1, pa2, pa3); pv_one<3>(o[3], vb, pa0, pa1, pa2, pa3);
}
template <int LDQ, int LDK, int LDO>
__device__ __forceinline__ void attn_dense_body(const bf16_t* __restrict__ Qb, const bf16_t* __restrict__ Kh, const bf16_t* __restrict__ Vh,
                                                bf16_t* __restrict__ Ob, int seq, char* lds) {
  constexpr int SDEPTH = 2;
  const int tid = TID_, wid = tid >> 6, lane = tid & 63, r32 = lane & 31, hi = lane >> 5;
  bf16_t* V_lds = (bf16_t*)lds; bf16_t* K_lds = (bf16_t*)(lds + 2 * SHM_V);
  float* ws = (float*)(lds + 2 * SHM_V + 2 * SHM_K) + wid * 64; float* li_l = ws; float* al_l = ws + 32;
  float m_reg = -1e30f, l_reg = 0; f32x16 o[4] = {}; bf16x8 qr[8];
  const bf16_t* Qw = Qb + (long)(wid * QBLK + r32) * LDQ + hi * 8;
#pragma unroll
  for (int d0 = 0; d0 < 8; ++d0) qr[d0] = *reinterpret_cast<const bf16x8*>(Qw + d0 * 16);
  const int sr = tid >> 4, sc = (tid & 15) * 8, vst0 = v_st(sr, sc), vst1 = v_st(32 + sr, sc);
  const int vb0 = (int)(uintptr_t)V_lds + v_rd_base(lane);
  struct { bf16x8 vs0, vs1, ks0, ks1; } sr_[SDEPTH];
#define SLOAD(i, k0) do { sr_[i].vs0 = *reinterpret_cast<const bf16x8*>(&Vh[(long)((k0) + sr) * LDK + sc]); sr_[i].vs1 = *reinterpret_cast<const bf16x8*>(&Vh[(long)((k0) + 32 + sr) * LDK + sc]); \
    sr_[i].ks0 = *reinterpret_cast<const bf16x8*>(&Kh[(long)((k0) + sr) * LDK + sc]); sr_[i].ks1 = *reinterpret_cast<const bf16x8*>(&Kh[(long)((k0) + 32 + sr) * LDK + sc]); } while (0)
#define SWRITE(b, i) do { *(bf16x8*)((char*)V_lds + (b) * SHM_V + vst0) = sr_[i].vs0;          \
    *(bf16x8*)((char*)V_lds + (b) * SHM_V + vst1) = sr_[i].vs1; int kc = sc * 2;               \
    *(bf16x8*)((char*)K_lds + (b) * SHM_K + KSWZ(sr, kc)) = sr_[i].ks0;                       \
    *(bf16x8*)((char*)K_lds + (b) * SHM_K + KSWZ(32 + sr, kc)) = sr_[i].ks1; } while (0)
#define SWAIT() do { asm volatile("s_waitcnt vmcnt(4)" ::: "memory"); } while (0)
#define RESC(a) do { if (__any((a) < 1.f)) { if (hi == 0) al_l[r32] = (a); asm volatile("s_waitcnt lgkmcnt(0)" ::: "memory"); \
    for (int d = 0; d < 4; ++d) for (int r = 0; r < 16; ++r) o[d][r] *= al_l[crow(r, hi)]; } } while (0)
  f32x16 pA0, pA1, pB0, pB1; float mnA, mnB, alA, alB; bf16x8 pa0, pa1, pa2, pa3; const int NT = seq / KVBLK;
  constexpr int SE = 0, SO = SDEPTH - 1;
  SLOAD(SE, 0); asm volatile("s_waitcnt vmcnt(0)" ::: "memory"); SWRITE(0, SE); __syncthreads();
  qkt(pA0, pA1, K_lds, qr, r32, hi); partialSM(pA0, pA1, m_reg, mnA, alA);
  SLOAD(SO, KVBLK); if (2 < NT) SLOAD(SE, 2 * KVBLK);
  SWAIT(); SWRITE(1, SO); __syncthreads();
  for (int j = 1; j + 1 < NT; j += 2) {
    SBAR(); qkt(pB0, pB1, (bf16_t*)((char*)K_lds + SHM_K), qr, r32, hi);
    finishSM(pA0, pA1, alA, l_reg, pa0, pa1, pa2, pa3); SBAR();
    SLOAD(SO, (j + SDEPTH) * KVBLK); SBAR();
    pv_d0(o, vb0, pa0, pa1, pa2, pa3); partialSM(pB0, pB1, m_reg, mnB, alB);
    __syncthreads(); SWAIT(); SWRITE(0, SE);
    RESC(alB); __syncthreads();
    SBAR(); qkt(pA0, pA1, K_lds, qr, r32, hi);
    finishSM(pB0, pB1, alB, l_reg, pa0, pa1, pa2, pa3); SBAR();
    if (j + 3 < NT) SLOAD(SE, (j + 1 + SDEPTH) * KVBLK); SBAR();
    pv_d0(o, vb0 + (int)SHM_V, pa0, pa1, pa2, pa3); partialSM(pA0, pA1, m_reg, mnA, alA);
    __syncthreads(); SWAIT(); SWRITE(1, SO);
    RESC(alA); __syncthreads();
  }
  SBAR(); qkt(pB0, pB1, (bf16_t*)((char*)K_lds + SHM_K), qr, r32, hi);
  finishSM(pA0, pA1, alA, l_reg, pa0, pa1, pa2, pa3); SBAR();
  pv_d0(o, vb0, pa0, pa1, pa2, pa3); partialSM(pB0, pB1, m_reg, mnB, alB);
  __syncthreads(); RESC(alB);
  finishSM(pB0, pB1, alB, l_reg, pa0, pa1, pa2, pa3); SBAR();
  pv_d0(o, vb0 + (int)SHM_V, pa0, pa1, pa2, pa3);
  if (hi == 0) li_l[r32] = l_reg; asm volatile("s_waitcnt lgkmcnt(0)" ::: "memory");
  float rli[16];
#pragma unroll
  for (int r = 0; r < 16; ++r) rli[r] = __builtin_amdgcn_rcpf(li_l[crow(r, hi)]);
  bf16_t* Ow = Ob + (long)(wid * QBLK) * LDO;
#pragma unroll
  for (int r = 0; r < 16; ++r) { int orow = crow(r, hi);
    for (int d0 = 0; d0 < 4; ++d0) Ow[(long)orow * LDO + d0 * 32 + r32] = (bf16_t)f2bf(o[d0][r] * rli[r]); }
#undef SLOAD
#undef SWRITE
#undef SWAIT
#undef RESC
}
#undef KSWZ
#undef SBAR
}

__device__ __forceinline__ void phase_attention(const Params& p, LAS unsigned char* lds, int G, int c) {
    const bf16_t* Q = (const bf16_t*)(p.ws + WS_Q); const bf16_t* KA = (const bf16_t*)(p.ws + WS_KA); const bf16_t* VA = (const bf16_t*)(p.ws + WS_VA); bf16_t* AO = (bf16_t*)(p.ws + WS_AO);
    for (int u = c; u < 576; u += G) {
        size_t qrow, kvoff; int h, seq;
        if (u < 512) { const int qb = u & 7, g = (u >> 3) & 3, kvh = (u >> 5) & 1, b = u >> 6; h = kvh * 4 + g; qrow = (size_t)b * SEQ + qb * 256; kvoff = (size_t)b * KVL * 256 + kvh * 128; seq = KVL; }
        else { const int uc = u - 512, b = uc >> 3; h = uc & 7; qrow = (size_t)ML + b * CTXL; kvoff = (size_t)b * KVL * 256 + (h >> 2) * 128; seq = CTXL; }
        attn::attn_dense_body<DM, 256, 2048>(Q + qrow * DM + h * 128, KA + kvoff, VA + kvoff, AO + qrow * 2048 + h * 128, seq, (char*)lds);
        __syncthreads();
    }
}
__device__ __forceinline__ void phase_moe_prenorm(const Params& p, LAS unsigned char* lds, int layer, const bf16_t* X, int nrows, bf16_t* H2, int gw, int NGW, int lane) {
    LAS float* RT = (LAS float*)lds;
    const float* router = p.in[I_ROUTER] + (size_t)layer * 1024 * 16;
    for (int i = TID_; i < 16384; i += 512) { const int k = i >> 4, e = i & 15; RT[e * 1024 + k] = router[i]; }
    __syncthreads();
    const float* mod = (const float*)(p.ws + WS_MOD) + (size_t)layer * 9 * 6144;
    float* aff = (float*)(p.ws + WS_AFF);
    const float* g = p.in[I_NORMG] + (size_t)(layer * 2 + 1) * 1024;
    constexpr int R = 4;
    for (int row0 = gw * R; row0 < nrows; row0 += NGW * R) {
        const int mr = row0 < ML ? (row0 >> 11) : 8;
        const float* m = mod + (size_t)mr * 6144;
        f32x4 v[R][4];
#pragma unroll
        for (int r = 0; r < R; ++r) ld_row_bf16(X + (size_t)(row0 + r) * DM, lane, v[r]);
        const float* const sh[R] = {m + 3072, m + 3072, m + 3072, m + 3072}; const float* const sc[R] = {m + 4096, m + 4096, m + 4096, m + 4096};
        ada_rows<R>(v, g, sh, sc, lane);
#pragma unroll
        for (int r = 0; r < R; ++r) st_row_bf16(H2 + (size_t)(row0 + r) * DM, lane, v[r]);
        float lg[R][16];
#pragma unroll
        for (int e = 0; e < 16; ++e) {
#pragma unroll
            for (int r = 0; r < R; ++r) lg[r][e] = 0.f;
#pragma unroll
            for (int j = 0; j < 4; ++j) { const f32x4 rt = *(const LAS f32x4*)(RT + e * 1024 + 256 * j + 4 * lane);
#pragma unroll
                for (int r = 0; r < R; ++r) lg[r][e] += (v[r][j].x * rt.x + v[r][j].y * rt.y) + (v[r][j].z * rt.z + v[r][j].w * rt.w); }
            asm volatile("" ::: "memory"); }
        float lgt[R];
#pragma unroll
        for (int r = 0; r < R; ++r) {
            float p8[8], p4[4], p2[2];
#pragma unroll
            for (int i = 0; i < 8; ++i) { const bool up = (lane & 32) != 0; const float keep = up ? lg[r][i + 8] : lg[r][i], send = up ? lg[r][i] : lg[r][i + 8]; p8[i] = keep + __shfl_xor(send, 32); }
#pragma unroll
            for (int i = 0; i < 4; ++i) { const bool up = (lane & 16) != 0; const float keep = up ? p8[i + 4] : p8[i], send = up ? p8[i] : p8[i + 4]; p4[i] = keep + __shfl_xor(send, 16); }
#pragma unroll
            for (int i = 0; i < 2; ++i) { const bool up = (lane & 8) != 0; const float keep = up ? p4[i + 2] : p4[i], send = up ? p4[i] : p4[i + 2]; p2[i] = keep + __shfl_xor(send, 8); }
            { const bool up = (lane & 4) != 0; const float keep = up ? p2[1] : p2[0], send = up ? p2[0] : p2[1]; lgt[r] = keep + __shfl_xor(send, 4); }
            lgt[r] += __shfl_xor(lgt[r], 2); lgt[r] += __shfl_xor(lgt[r], 1);
        }
        const int myexp = ((lane >> 5) & 1) * 8 + ((lane >> 4) & 1) * 4 + ((lane >> 3) & 1) * 2 + ((lane >> 2) & 1);
#pragma unroll
        for (int r = 0; r < R; ++r) {
            float mx = lgt[r];
#pragma unroll
            for (int o = 4; o < 64; o <<= 1) mx = fmaxf(mx, __shfl_xor(mx, o));
            const float ex = __expf(lgt[r] - mx); float sum = ex;
#pragma unroll
            for (int o = 4; o < 64; o <<= 1) sum += __shfl_xor(sum, o);
            if ((lane & 3) == 0) aff[(size_t)(row0 + r) * 16 + myexp] = ex * rcpf_(sum);
        }
    }
}

__device__ __forceinline__ int block_exscan(int flag, volatile LAS int* sm, int wave, int lane, int& tot) {
    const unsigned long long bal = __ballot(flag != 0);
    const int pre = __popcll(bal & ((1ull << lane) - 1ull)), wtot = __popcll(bal);
    __syncthreads();
    if (lane == 0) sm[wave] = wtot;
    __syncthreads();
    int base = 0, t = 0;
#pragma unroll
    for (int w = 0; w < 8; ++w) { const int x = sm[w]; base += (w < wave) ? x : 0; t += x; }
    tot = t; return base + pre;
}
__device__ __forceinline__ int block_sum(int v, volatile LAS int* sm, int wave, int lane) {
    v = wave_sum_i(v);
    __syncthreads();
    if (lane == 0) sm[wave] = v;
    __syncthreads();
    int t = 0;
#pragma unroll
    for (int w = 0; w < 8; ++w) t += sm[w];
    return t;
}
__device__ __forceinline__ void phase_select(const Params& p, LAS unsigned char* lds, int ntasks, int SL, int G, int c, int wave, int lane) {
    volatile LAS int* sm = (volatile LAS int*)lds;
    const float* aff = (const float*)(p.ws + WS_AFF);
    int* tokslot = (int*)(p.ws + WS_TOKSLOT); float* selaff = (float*)(p.ws + WS_SELAFF); int* selrow = (int*)(p.ws + WS_SELROW);
    const int tid = TID_;
    for (int tk = c; tk < ntasks; tk += G) {
        const bool lat = tk < 128; const int tt = lat ? tk : tk - 128, b = tt >> 4, e = tt & 15;
        const int n = lat ? SEQ : CTXL, cap = lat ? CAPL : CAPC, rowbase = lat ? b * SEQ : ML + b * CTXL, slotbase = lat ? b * CAPL : NB * CAPL + b * CAPC;
        unsigned key[4]; bool valid[4];
#pragma unroll
        for (int i = 0; i < 4; ++i) { const int idx = tid + 512 * i; valid[i] = idx < n; key[i] = valid[i] ? __float_as_uint(aff[(size_t)(rowbase + idx) * 16 + e]) : 0u; }
        unsigned prefix = 0u;
        for (int bit = 30; bit >= 0; --bit) {
            const unsigned cand = prefix | (1u << bit); int cnt = 0;
#pragma unroll
            for (int i = 0; i < 4; ++i) cnt += (valid[i] && key[i] >= cand) ? 1 : 0;
            if (block_sum(cnt, sm, wave, lane) >= cap) prefix = cand;
        }
        int cg = 0;
#pragma unroll
        for (int i = 0; i < 4; ++i) cg += (valid[i] && key[i] > prefix) ? 1 : 0;
        const int need_eq = cap - block_sum(cg, sm, wave, lane);
        int eqbase = 0, selbase = 0;
#pragma unroll
        for (int i = 0; i < 4; ++i) {
            const bool gt = valid[i] && key[i] > prefix, eq = valid[i] && key[i] == prefix;
            int tot; const int er = eqbase + block_exscan(eq ? 1 : 0, sm, wave, lane, tot); eqbase += tot;
            const bool sel = gt || (eq && er < need_eq);
            int tot2; const int slot = selbase + block_exscan(sel ? 1 : 0, sm, wave, lane, tot2); selbase += tot2;
            if (valid[i]) { const int row = rowbase + tid + 512 * i;
                tokslot[(size_t)row * 16 + e] = sel ? slotbase + slot : -1;
                if (sel) { selaff[(size_t)e * SL + slotbase + slot] = __uint_as_float(key[i]); selrow[(size_t)e * SL + slotbase + slot] = row; } }
        }
        __syncthreads();
    }
}

template <int R>
__device__ __forceinline__ void moe_gather_rows(const int* tokslot, const bf16_t* Ys, int SL, int row0, int lane, f32x4 (&acc)[R][4]) {
    int mys[R]; unsigned m[R]; unsigned any = 0u;
#pragma unroll
    for (int r = 0; r < R; ++r) { mys[r] = tokslot[(size_t)(row0 + r) * 16 + (lane & 15)];
#pragma unroll
        for (int j = 0; j < 4; ++j) acc[r][j] = (f32x4){0.f, 0.f, 0.f, 0.f}; }
#pragma unroll
    for (int r = 0; r < R; ++r) { m[r] = (unsigned)(__ballot(mys[r] >= 0) & 0xffffull); any |= m[r]; }
    while (any) {
        any = 0u;
#pragma unroll
        for (int r = 0; r < R; ++r) if (m[r]) { const int e = __builtin_ctz(m[r]); m[r] &= m[r] - 1u; any |= m[r]; const int s = __shfl(mys[r], e);
            const bf16_t* y = Ys + ((size_t)e * SL + s) * DM;
#pragma unroll
            for (int j = 0; j < 4; ++j) acc[r][j] += unpk4(*(const u32x2*)(y + 256 * j + 4 * lane)); }
    }
}

__device__ __forceinline__ void phase_combine0(const Params& p, int gw, int NGW, int lane) {
    const float* mod0 = (const float*)(p.ws + WS_MOD); const float* mod1 = mod0 + 9 * 6144;
    const bf16_t* X1 = (const bf16_t*)(p.ws + WS_X1); bf16_t* X2 = (bf16_t*)(p.ws + WS_X2); bf16_t* H = (bf16_t*)(p.ws + WS_H1);
    const int* tokslot = (const int*)(p.ws + WS_TOKSLOT); const bf16_t* Ys = (const bf16_t*)(p.ws + WS_YS0);
    constexpr int R = 4;
    for (int row0 = gw * R; row0 < MT; row0 += NGW * R) {
        const int mr = row0 < ML ? (row0 >> 11) : 8;
        f32x4 v[R][4];
#pragma unroll
        for (int r = 0; r < R; ++r) ld_row_bf16(X1 + (size_t)(row0 + r) * DM, lane, v[r]);
        f32x4 acc[R][4]; moe_gather_rows<R>(tokslot, Ys, SL0, row0, lane, acc);
        const float* gt2 = mod0 + (size_t)mr * 6144 + 5120;
#pragma unroll
        for (int j = 0; j < 4; ++j) { const f32x4 g4 = *(const f32x4*)(gt2 + 256 * j + 4 * lane);
#pragma unroll
            for (int r = 0; r < R; ++r) v[r][j] = v[r][j] + g4 * acc[r][j]; }
#pragma unroll
        for (int r = 0; r < R; ++r) st_row_bf16(X2 + (size_t)(row0 + r) * DM, lane, v[r]);
        const float* m = mod1 + (size_t)mr * 6144;
        const float* const sh[R] = {m, m, m, m}; const float* const sc[R] = {m + 1024, m + 1024, m + 1024, m + 1024};
        ada_rows<R>(v, p.in[I_NORMG] + 2 * 1024, sh, sc, lane);
#pragma unroll
        for (int r = 0; r < R; ++r) st_row_bf16(H + (size_t)(row0 + r) * DM, lane, v[r]);
    }
}

__device__ __forceinline__ void phase_mixes(const Params& p, int gw, int NGW, int lane) {
    const bf16_t* H = (const bf16_t*)(p.ws + WS_H1);
    bf16_t* XR = (bf16_t*)(p.ws + WS_XR); bf16_t* XK = (bf16_t*)(p.ws + WS_XK); bf16_t* XV = (bf16_t*)(p.ws + WS_XV);
    bf16_t* XW = (bf16_t*)(p.ws + WS_XW); bf16_t* XA = (bf16_t*)(p.ws + WS_XA); bf16_t* XG = (bf16_t*)(p.ws + WS_XG);
    const float* mu = p.in[I_MU];
    constexpr int R = 4;
    for (int row0 = gw * R; row0 < MT; row0 += NGW * R) {
        const bool lat = row0 < ML; const int t0 = lat ? (row0 & 2047) : ((row0 - ML) & 255), T = lat ? SEQ : CTXL;
        const bf16_t* hr = H + (size_t)row0 * DM;
#pragma unroll
        for (int j = 0; j < 4; ++j) {
            const int c = 256 * j + 4 * lane;
            u32x2 raw[R + 2];
#pragma unroll
            for (int r = 0; r < R; ++r) raw[r + 1] = *(const u32x2*)(hr + (size_t)r * DM + c);
            raw[0] = (t0 > 0) ? *(const u32x2*)(hr - DM + c) : (u32x2){0u, 0u};
            raw[R + 1] = (t0 + R < T) ? *(const u32x2*)(hr + (size_t)R * DM + c) : (u32x2){0u, 0u};
            const f32x4 m0 = *(const f32x4*)(mu + 0 * 1024 + c), m1 = *(const f32x4*)(mu + 1 * 1024 + c), m2 = *(const f32x4*)(mu + 2 * 1024 + c);
            const f32x4 m3 = *(const f32x4*)(mu + 3 * 1024 + c), m4 = *(const f32x4*)(mu + 4 * 1024 + c), m5 = *(const f32x4*)(mu + 5 * 1024 + c);
#pragma unroll
            for (int r = 0; r < R; ++r) {
                const f32x4 h = unpk4(raw[r + 1]); const f32x4 xx = (unpk4(raw[r]) + unpk4(raw[r + 2])) * 0.5f - h; const size_t o = (size_t)(row0 + r) * DM + c;
                *(u32x2*)(XW + o) = pk4(h + xx * m1); *(u32x2*)(XK + o) = pk4(h + xx * m2); *(u32x2*)(XV + o) = pk4(h + xx * m3); *(u32x2*)(XA + o) = pk4(h + xx * m4);
                if (lat) { *(u32x2*)(XR + o) = pk4(h + xx * m0); *(u32x2*)(XG + o) = pk4(h + xx * m5); }
            }
        }
    }
}

__device__ __forceinline__ bf16x8 tanh8(bf16x8 x) {
    bf16x8 o;
#pragma unroll
    for (int j = 0; j < 8; ++j) { const float v = bf2f((unsigned short)x[j]); o[j] = (short)f2bf(1.0f - 2.0f * rcpf_(1.0f + __expf(2.0f * v))); }
    return o;
}
__device__ __forceinline__ void phase_features(const Params& p, int gw, int NGW, int lane) {
    const bf16_t* T1 = (const bf16_t*)(p.ws + WS_T1);
    bf16_t* LD = (bf16_t*)(p.ws + WS_LD); bf16_t* AA = (bf16_t*)(p.ws + WS_AA);
    const int fr = lane & 15, fq = lane >> 4;
    constexpr int NTT = MT / 16;
    for (int task = gw; task < 2048; task += NGW) {
        const int cb = task & 7, kd = (task >> 3) & 3, rng = task >> 5;
        const int kind = kd >> 1, d = kd & 1;
        const bf16_t* W = (const bf16_t*)(p.ws + (kind == 0 ? WS_W2T : WS_A2T)) + (size_t)d * 1024 * 64;
        const float* bias = (kind == 0 ? p.in[I_W0] : p.in[I_A0]) + d * 1024;
        bf16_t* O = (kind == 0 ? LD : AA) + (size_t)d * MT * DM;
        bf16x8 wa[8][2]; f32x4 bs[8];
#pragma unroll
        for (int ct = 0; ct < 8; ++ct) { const int pgrp = ct >> 2, m = ct & 3;
            const bf16_t* wr_ = W + (size_t)(cb * 128 + 64 * pgrp + 16 * (fr >> 2) + 4 * m + (fr & 3)) * 64 + 8 * fq; wa[ct][0] = *(const bf16x8*)(wr_); wa[ct][1] = *(const bf16x8*)(wr_ + 32);
            bs[ct] = *(const f32x4*)(bias + cb * 128 + 64 * pgrp + 16 * fq + 4 * m); }
        const bf16_t* xbase = T1 + (size_t)kind * MT * 128 + d * 64 + 8 * fq;
        const int tt0 = rng * (NTT / 64);
        bf16x8 xn0 = *(const bf16x8*)(xbase + (size_t)(tt0 * 16 + fr) * 128), xn1 = *(const bf16x8*)(xbase + (size_t)(tt0 * 16 + fr) * 128 + 32);
        for (int i = 0; i < NTT / 64; ++i) {
            const int tok = (tt0 + i) * 16 + fr;
            bf16x8 xb0 = xn0, xb1 = xn1;
            if (i + 1 < NTT / 64) { xn0 = *(const bf16x8*)(xbase + (size_t)(tok + 16) * 128); xn1 = *(const bf16x8*)(xbase + (size_t)(tok + 16) * 128 + 32); }
            if (kind == 0) { xb0 = tanh8(xb0); xb1 = tanh8(xb1); }
#pragma unroll
            for (int pgrp = 0; pgrp < 2; ++pgrp) {
                float o[16];
#pragma unroll
                for (int m = 0; m < 4; ++m) { const int ct = pgrp * 4 + m;
                    f32x4 acc = (f32x4){0.f, 0.f, 0.f, 0.f};
                    acc = __builtin_amdgcn_mfma_f32_16x16x32_bf16(wa[ct][0], xb0, acc, 0, 0, 0);
                    acc = __builtin_amdgcn_mfma_f32_16x16x32_bf16(wa[ct][1], xb1, acc, 0, 0, 0);
#pragma unroll
                    for (int r = 0; r < 4; ++r) { const float sg = sigmoidf_(acc[r] + bs[ct][r]); o[4 * m + r] = kind == 0 ? -0.6065306597126334f * sg : sg; } }
                bf16_t* op = O + (size_t)tok * DM + cb * 128 + 64 * pgrp + 16 * fq;
                u32x4 w0, w1;
#pragma unroll
                for (int e = 0; e < 4; ++e) { w0[e] = pk2(o[2 * e], o[2 * e + 1]); w1[e] = pk2(o[8 + 2 * e], o[8 + 2 * e + 1]); }
                *(u32x4*)op = w0; *(u32x4*)(op + 8) = w1;
            }
        }
    }
}
namespace cs {
constexpr int O_V = 0, O_KQ = 2048, O_RQ = 4096, O_KKP = 6144, O_NBKP = 8192, O_KK = 10240, O_BK = 12288, O_GC = 14336, O_AT = 14592, O_ANA4 = 15104, O_AA1 = 15616, O_AA3 = 16128, SLOT = 16640;
constexpr int NSLOT = 8, WOFF = NSLOT * SLOT  , CNT_OFF = WOFF + 16384  ,
              CST_OFF = CNT_OFF + 64  ;
constexpr int NCHUNK = (CTXL + SEQ) / 16, NROUND = NCHUNK / 4;
static_assert(CST_OFF + 1280 <= RING_BYTES, "LDS");
__device__ __forceinline__ s16x4 pkbf(f32x4 v) { u32x2 w; w.x = pg8::cvt_pk_bf16(v.x, v.y); w.y = pg8::cvt_pk_bf16(v.z, v.w); return __builtin_bit_cast(s16x4, w); }
__device__ __forceinline__ f32x4 mfma16(s16x4 a, s16x4 b, f32x4 c) { return __builtin_amdgcn_mfma_f32_16x16x16bf16_1k(a, b, c, 0, 0, 0); }
__device__ __forceinline__ bf16x8 cat8(s16x4 a, s16x4 b) { return (bf16x8){a[0], a[1], a[2], a[3], b[0], b[1], b[2], b[3]}; }
__device__ __forceinline__ int step_row(int c, int s, int b, int d) { const int g = c * 16 + s; if (g < CTXL) return ML + b * CTXL + (d ? (CTXL - 1 - g) : g); const int gl = g - CTXL; return b * SEQ + (d ? (SEQ - 1 - gl) : gl); }
struct Raw { bf16x8 xw[2], xa[2]; u32x4 kb[2], vb[2], rb[2]; };
__device__ __forceinline__ void unpack16(const u32x4 (&w)[2], float (&o)[16]) {
#pragma unroll
    for (int m = 0; m < 8; ++m) { const unsigned x = w[m >> 2][m & 3]; o[2 * m] = bf2f(x & 0xffffu); o[2 * m + 1] = bf2f(x >> 16); }
}
__device__ __forceinline__ void pack16(const float (&v)[16], u32x4& lo, u32x4& hi) {
#pragma unroll
    for (int m = 0; m < 4; ++m) { lo[m] = pg8::cvt_pk_bf16(v[2 * m], v[2 * m + 1]); hi[m] = pg8::cvt_pk_bf16(v[8 + 2 * m], v[8 + 2 * m + 1]); }
}
}
__device__ __forceinline__ void phase_scan(const Params& p, LAS unsigned char* lds, int G, int c, int wave, int lane, int variant = 0) {
    using namespace cs;
    const bf16_t* RB = (const bf16_t*)(p.ws + WS_RB); const bf16_t* KB = (const bf16_t*)(p.ws + WS_KB); const bf16_t* VB = (const bf16_t*)(p.ws + WS_VB);
    const int fr = lane & 15, fq = lane >> 4;
    for (int sid = c; sid < 256; sid += G) {
        const int d = sid & 1, h = (sid >> 1) & 15, b = sid >> 5;
        const bf16_t* T1w = (const bf16_t*)(p.ws + WS_T1); const bf16_t* T1a = T1w + (size_t)MT * 128;
        const bf16_t* W2h = (const bf16_t*)(p.ws + WS_W2T) + ((size_t)d * 1024 + h * 64) * 64; const bf16_t* A2h = (const bf16_t*)(p.ws + WS_A2T) + ((size_t)d * 1024 + h * 64) * 64;
        const float* w0h = p.in[I_W0] + d * 1024 + h * 64; const float* a0h = p.in[I_A0] + d * 1024 + h * 64;
        bf16_t* Y = (bf16_t*)(p.ws + (variant ? WS_KK : (d ? WS_Y1 : WS_Y0)));
        __syncthreads();
        {   const int t_ = TID_;
            if (t_ == 0) *(volatile LAS unsigned*)(lds + cs::CNT_OFF) = 0u;
#pragma unroll
            for (int i = 0; i < 2; ++i) { const int q_ = t_ + 512 * i, m_ = q_ >> 9, ch_ = (q_ >> 3) & 63, c8_ = q_ & 7;
                *(LAS u32x4*)(lds + WOFF + m_ * 8192 + ch_ * 128 + ((c8_ ^ (ch_ & 7)) << 4)) = *(const u32x4*)((m_ ? A2h : W2h) + (size_t)ch_ * 64 + 8 * c8_); }
            if (t_ < 320) { const int a_ = t_ >> 6, c_ = t_ & 63; const float* src_ = a_ == 0 ? p.in[I_KK] + h * 64 : a_ == 1 ? p.in[I_KA] + h * 64 : a_ == 2 ? p.in[I_RK] + h * 64 : a_ == 3 ? w0h : a0h;
                *(LAS float*)(lds + CST_OFF + t_ * 4) = src_[c_]; }
        }
        __syncthreads();
        if (wave >= 4) {
            const int pw = wave - 4, step = lane >> 2, qt = lane & 3;
            float* BON = (float*)(p.ws + (variant ? WS_KK + 33 * MiB : WS_BON)) + (size_t)d * ML * 16;
            const LAS float* cst = (const LAS float*)(lds + CST_OFF);
            Raw raw, nxt;
#define CS_LOAD(raw, ch) do { const int row_ = step_row((ch), step, b, d); const size_t o_ = (size_t)row_ * DM + h * 64 + 16 * qt; \
            raw.kb[0] = *(const u32x4*)(KB + o_); raw.kb[1] = *(const u32x4*)(KB + o_ + 8); \
            raw.vb[0] = *(const u32x4*)(VB + o_); raw.vb[1] = *(const u32x4*)(VB + o_ + 8); \
            if (row_ < ML) { raw.rb[0] = *(const u32x4*)(RB + o_); raw.rb[1] = *(const u32x4*)(RB + o_ + 8); } else { raw.rb[0] = (u32x4){0u, 0u, 0u, 0u}; raw.rb[1] = (u32x4){0u, 0u, 0u, 0u}; } \
            const size_t x_ = (size_t)step_row((ch), fr, b, d) * 128 + d * 64 + 8 * fq; \
            raw.xw[0] = *(const bf16x8*)(T1w + x_); raw.xw[1] = *(const bf16x8*)(T1w + x_ + 32); raw.xa[0] = *(const bf16x8*)(T1a + x_); raw.xa[1] = *(const bf16x8*)(T1a + x_ + 32); } while (0)
            CS_LOAD(nxt, pw);
            for (int g = -1; g + 1 < NROUND; ++g) {
                const int ch = 4 * (g + 1) + pw;
                LAS unsigned char* slot = lds + (((g + 1) & 1) * 4 + pw) * SLOT;
                raw = nxt;
                if (ch + 4 < NCHUNK) CS_LOAD(nxt, ch + 4);
                if (!(variant & 1)) {
                {
                    const bf16x8 xw0 = tanh8(raw.xw[0]), xw1 = tanh8(raw.xw[1]);
#pragma unroll
                    for (int ct = 0; ct < 4; ++ct) {
                        const int chl = 16 * ct + fr; const LAS unsigned char* wrow = lds + WOFF + chl * 128;
                        const int o0 = (fq ^ (chl & 7)) << 4, o1 = ((4 + fq) ^ (chl & 7)) << 4;
                        f32x4 aw = (f32x4){0.f, 0.f, 0.f, 0.f}, aa_ = aw;
                        aw = __builtin_amdgcn_mfma_f32_16x16x32_bf16(*(const LAS bf16x8*)(wrow + o0), xw0, aw, 0, 0, 0); aw = __builtin_amdgcn_mfma_f32_16x16x32_bf16(*(const LAS bf16x8*)(wrow + o1), xw1, aw, 0, 0, 0);
                        aa_ = __builtin_amdgcn_mfma_f32_16x16x32_bf16(*(const LAS bf16x8*)(wrow + 8192 + o0), raw.xa[0], aa_, 0, 0, 0); aa_ = __builtin_amdgcn_mfma_f32_16x16x32_bf16(*(const LAS bf16x8*)(wrow + 8192 + o1), raw.xa[1], aa_, 0, 0, 0);
                        const f32x4 wb = *(const LAS f32x4*)(cst + 192 + 16 * ct + 4 * fq), ab = *(const LAS f32x4*)(cst + 256 + 16 * ct + 4 * fq);
                        f32x4 ldv, aav;
#pragma unroll
                        for (int r = 0; r < 4; ++r) { ldv[r] = -0.6065306597126334f * sigmoidf_(aw[r] + wb[r]); aav[r] = sigmoidf_(aa_[r] + ab[r]); }
                        *(LAS u32x2*)(slot + O_KK + fr * 128 + (16 * ct + 4 * fq) * 2) = pk4(ldv); *(LAS u32x2*)(slot + O_BK + fr * 128 + (16 * ct + 4 * fq) * 2) = pk4(aav);
                    }
                }
                {
                    float lgv = 0.f;
#pragma unroll
                    for (int t = 0; t < 16; ++t) { lgv += bf2f(*(const LAS unsigned short*)(slot + O_KK + t * 128 + lane * 2)); *(LAS float*)(slot + O_KKP + (t * 64 + lane) * 4) = lgv; }
                    *(LAS float*)(slot + O_GC + lane * 4) = __expf(lgv); }
                float rn;
                {
                    float ss = 0.f;
#pragma unroll
                    for (int hh = 0; hh < 2; ++hh) { float kbv[8]; unpk8(raw.kb[hh], kbv);
#pragma unroll
                        for (int i = 0; i < 8; ++i) { const float t = kbv[i] * cst[16 * qt + 8 * hh + i]; ss += t * t; } }
                    ss += dpp_mov<0xB1>(ss); ss += dpp_mov<0x4E>(ss);
                    rn = rsqf_(fmaxf(ss, 1e-24f));
                }
                u32x4 ldw[2], aaw[2]; f32x4 lgq[4];
#pragma unroll
                for (int hh = 0; hh < 2; ++hh) { ldw[hh] = *(const LAS u32x4*)(slot + O_KK + step * 128 + qt * 32 + 16 * hh); aaw[hh] = *(const LAS u32x4*)(slot + O_BK + step * 128 + qt * 32 + 16 * hh); }
#pragma unroll
                for (int qq = 0; qq < 4; ++qq) lgq[qq] = *(const LAS f32x4*)(slot + O_KKP + (step * 64 + 16 * qt + 4 * qq) * 4);
                asm volatile("s_waitcnt lgkmcnt(0)" ::: "memory");
                float bsum = 0.f;
                const int sw = (qt ^ ((step >> 1) & 3)) << 5, rowo = step * 128 + sw, hbit = (step >> 3) & 1;
#pragma unroll
                for (int qq = 0; qq < 4; ++qq) {
                    const int hh = qq >> 1, sub = qq & 1;
                    const f32x4 lg4 = lgq[qq], gc4 = *(const LAS f32x4*)(slot + O_GC + (16 * qt + 4 * qq) * 4);
                    const u32x2 ldp = sub ? (u32x2){ldw[hh].z, ldw[hh].w} : (u32x2){ldw[hh].x, ldw[hh].y}, aap = sub ? (u32x2){aaw[hh].z, aaw[hh].w} : (u32x2){aaw[hh].x, aaw[hh].y};
                    const u32x2 kbp = sub ? (u32x2){raw.kb[hh].z, raw.kb[hh].w} : (u32x2){raw.kb[hh].x, raw.kb[hh].y}, rbp = sub ? (u32x2){raw.rb[hh].z, raw.rb[hh].w} : (u32x2){raw.rb[hh].x, raw.rb[hh].y};
                    const f32x4 ld4 = unpk4(ldp), aa4 = unpk4(aap), kb4 = unpk4(kbp), rr4 = unpk4(rbp);
                    const int c0 = 16 * qt + 4 * qq;
                    const f32x4 kkw = *(const LAS f32x4*)(cst + c0), kaw = *(const LAS f32x4*)(cst + 64 + c0), rkw = *(const LAS f32x4*)(cst + 128 + c0);
                    f32x4 oKq, oRq, oKk, oBk, oKkp, oNBkp;
#pragma unroll
                    for (int i = 0; i < 4; ++i) {
                        const float e0 = __expf(lg4[i]), em = rcpf_(e0), e1 = __expf(lg4[i] - ld4[i]);
                        const float kk = kb4[i] * kkw[i] * rn;
                        const float beta = kk * aa4[i], kt_ = kb4[i] * ((aa4[i] - 1.0f) * kaw[i] + 1.0f);
                        oKq[i] = kk * e1; oRq[i] = rr4[i] * e0; oKk[i] = kt_ * em; oBk[i] = beta * em; oKkp[i] = oKk[i] * gc4[i]; oNBkp[i] = -(oBk[i] * gc4[i]);
                        bsum += rr4[i] * kt_ * rkw[i]; }
                    const int ho = (hh ^ hbit) * 16 + sub * 8;
                    *(LAS u32x2*)(slot + O_KQ + rowo + ho) = pk4(oKq); *(LAS u32x2*)(slot + O_RQ + rowo + ho) = pk4(oRq);
                    *(LAS u32x2*)(slot + O_KK + rowo + ho) = pk4(oKk); *(LAS u32x2*)(slot + O_BK + rowo + ho) = pk4(oBk);
                    *(LAS u32x2*)(slot + O_KKP + rowo + qq * 8) = pk4(oKkp); *(LAS u32x2*)(slot + O_NBKP + rowo + qq * 8) = pk4(oNBkp);
                }
                *(LAS u32x4*)(slot + O_V + rowo) = raw.vb[0]; *(LAS u32x4*)(slot + O_V + rowo + 16) = raw.vb[1];
                bsum += dpp_mov<0xB1>(bsum); bsum += dpp_mov<0x4E>(bsum);
                { const int brow = step_row(ch, step, b, d); if (qt == 0 && brow < ML) BON[(size_t)brow * 16 + h] = bsum; }
                }
                __syncthreads();
            }
            __syncthreads();
#undef CS_LOAD
        } else {
            const int j = wave;
            f32x4 z[4];
#pragma unroll
            for (int kt = 0; kt < 4; ++kt) z[kt] = (f32x4){0.f, 0.f, 0.f, 0.f};
            const int trr = 4 * fq + (fr >> 2);
            const int trbase = trr * 128 + 8 * (fr & 3), trsw = (trr >> 1) & 3;
            const int rdsw = (fr >> 1) & 3, rdq = (fq ^ (((fr >> 3) & 1) << 1)) << 3;
            __syncthreads();
            volatile LAS unsigned* ccnt = (volatile LAS unsigned*)(lds + CNT_OFF);
            for (int g = 0; g < NROUND; ++g) {
                if (!(variant & 2)) {   LAS unsigned char* dslot = lds + ((g & 1) * 4 + j) * SLOT;
                s16x4 rKq[4], rRq[4], rKk[4], rBk[4];
#pragma unroll
                for (int kt = 0; kt < 4; ++kt) { const int off = fr * 128 + ((kt ^ ((fr >> 1) & 3)) << 5) + ((fq ^ (((fr >> 3) & 1) << 1)) << 3);
                    rKq[kt] = *(const LAS s16x4*)(dslot + O_KQ + off); rRq[kt] = *(const LAS s16x4*)(dslot + O_RQ + off); rKk[kt] = *(const LAS s16x4*)(dslot + O_KK + off); rBk[kt] = *(const LAS s16x4*)(dslot + O_BK + off); }
                f32x4 dL = (f32x4){0.f, 0.f, 0.f, 0.f}, dLt = dL, dA1t = dL, dA3t = dL, dA4t = dL;
#pragma unroll
                for (int kt = 0; kt < 4; ++kt) { dL = mfma16(rKq[kt], rBk[kt], dL); dLt = mfma16(rBk[kt], rKq[kt], dLt); dA1t = mfma16(rKk[kt], rKq[kt], dA1t); dA3t = mfma16(rKk[kt], rRq[kt], dA3t); dA4t = mfma16(rBk[kt], rRq[kt], dA4t); }
                f32x4 dN, dNt, a1, a3, na4, eye;
#pragma unroll
                for (int r = 0; r < 4; ++r) { const int ROW = 4 * fq + r, COL = fr;
                    dN[r] = ROW > COL ? -dL[r] : 0.f; dNt[r] = COL > ROW ? -dLt[r] : 0.f; a1[r] = COL > ROW ? dA1t[r] : 0.f; a3[r] = COL >= ROW ? dA3t[r] : 0.f; na4[r] = COL >= ROW ? -dA4t[r] : 0.f; eye[r] = ROW == COL ? 1.f : 0.f; }
                const f32x4 z4 = (f32x4){0.f, 0.f, 0.f, 0.f};
                const s16x4 bN = pkbf(dN), bNt = pkbf(dNt);
                const f32x4 dN2 = mfma16(bNt, bN, z4), dN2t = mfma16(bN, bNt, z4);
                const s16x4 bN2 = pkbf(dN2), bN2t = pkbf(dN2t);
                const f32x4 dN4 = mfma16(bN2t, bN2, z4), dN4t = mfma16(bN2, bN2t, z4);
                const f32x4 dN8 = mfma16(pkbf(dN4t), pkbf(dN4), z4);
                const f32x4 q1 = mfma16(pkbf(eye + dN2), pkbf(eye + dNt), z4);
                const f32x4 q2 = mfma16(pkbf(eye + dN4), pkbf(q1), z4);
                const f32x4 tT = mfma16(pkbf(eye + dN8), pkbf(q2), z4);
                *(LAS s16x4*)(dslot + O_AT + lane * 8) = pkbf(tT); *(LAS s16x4*)(dslot + O_ANA4 + lane * 8) = pkbf(na4);
                *(LAS s16x4*)(dslot + O_AA1 + lane * 8) = pkbf(a1); *(LAS s16x4*)(dslot + O_AA3 + lane * 8) = pkbf(a3);
                }
                asm volatile("s_waitcnt lgkmcnt(0)" ::: "memory");
                if (lane == 0) __hip_atomic_fetch_add((LAS unsigned*)(lds + CNT_OFF), 1u, __ATOMIC_RELAXED, __HIP_MEMORY_SCOPE_WORKGROUP);
                while (*ccnt < 4u * (unsigned)(g + 1)) __builtin_amdgcn_s_sleep(0);
                asm volatile("" ::: "memory");
                if (!(variant & 4))
#pragma unroll
                for (int cc = 0; cc < 4; ++cc) {
                    const int ch = 4 * g + cc; const bool emit = ch >= CTXL / 16;
                    const LAS unsigned char* slot = lds + ((g & 1) * 4 + cc) * SLOT;
                    const s16x4 aT = *(const LAS s16x4*)(slot + O_AT + lane * 8), anA4 = *(const LAS s16x4*)(slot + O_ANA4 + lane * 8);
                    const s16x4 aA1 = *(const LAS s16x4*)(slot + O_AA1 + lane * 8), aA3 = *(const LAS s16x4*)(slot + O_AA3 + lane * 8);
                    const s16x4 vcol = __builtin_amdgcn_ds_read_tr16_b64_v4i16((LAS s16x4*)(slot + O_V + trbase + ((j ^ trsw) << 5)));
                    const f32x4 z4 = (f32x4){0.f, 0.f, 0.f, 0.f};
                    f32x4 acc = mfma16(aA1, vcol, z4), accY = z4;
                    if (emit) accY = mfma16(aA3, vcol, z4);
#pragma unroll
                    for (int pr = 0; pr < 2; ++pr) {
                        const int o0 = fr * 128 + (((2 * pr) ^ rdsw) << 5) + rdq, o1 = fr * 128 + (((2 * pr + 1) ^ rdsw) << 5) + rdq;
                        const bf16x8 bz = cat8(pkbf(z[2 * pr]), pkbf(z[2 * pr + 1]));
                        const bf16x8 aq = cat8(*(const LAS s16x4*)(slot + O_KQ + o0), *(const LAS s16x4*)(slot + O_KQ + o1));
                        acc = __builtin_amdgcn_mfma_f32_16x16x32_bf16(aq, bz, acc, 0, 0, 0);
                        if (emit) { const bf16x8 ar = cat8(*(const LAS s16x4*)(slot + O_RQ + o0), *(const LAS s16x4*)(slot + O_RQ + o1));
                            accY = __builtin_amdgcn_mfma_f32_16x16x32_bf16(ar, bz, accY, 0, 0, 0); }
                    }
                    const f32x4 U = mfma16(aT, pkbf(acc), z4);
                    const s16x4 ub = pkbf(U);
                    if (emit) { accY = mfma16(anA4, ub, accY);
#pragma unroll
                        for (int r = 0; r < 4; ++r) Y[(size_t)step_row(ch, 4 * fq + r, b, d) * DM + h * 64 + 16 * j + fr] = (bf16_t)f2bf(accY[r]); }
                    const bf16x8 bvu = cat8(vcol, ub);
#pragma unroll
                    for (int kt = 0; kt < 4; ++kt) {
                        const int to = trbase + ((kt ^ trsw) << 5);
                        const bf16x8 ak = cat8(__builtin_amdgcn_ds_read_tr16_b64_v4i16((LAS s16x4*)(slot + O_KKP + to)), __builtin_amdgcn_ds_read_tr16_b64_v4i16((LAS s16x4*)(slot + O_NBKP + to)));
                        const f32x4 gcv = *(const LAS f32x4*)(slot + O_GC + (16 * kt + 4 * fq) * 4);
                        z[kt] = __builtin_amdgcn_mfma_f32_16x16x32_bf16(ak, bvu, z[kt] * gcv, 0, 0, 0);
                    }
                }
                __syncthreads();
            }
        }
    }
}

constexpr int RO_STRIDE = 2064;
__device__ __forceinline__ bf16x8 sigm8(bf16x8 x) {
    bf16x8 o;
#pragma unroll
    for (int j = 0; j < 8; ++j) o[j] = (short)f2bf(sigmoidf_(bf2f((unsigned short)x[j])));
    return o;
}
__device__ __forceinline__ void phase_readout(const Params& p, LAS unsigned char* lds, int G, int c, int wave, int lane) {
    const bf16_t* T1g = (const bf16_t*)(p.ws + WS_T1) + (size_t)2 * MT * 128; const bf16_t* G2T = (const bf16_t*)(p.ws + WS_G2T);
    const bf16_t* RB = (const bf16_t*)(p.ws + WS_RB); const bf16_t* KB = (const bf16_t*)(p.ws + WS_KB); const bf16_t* VB = (const bf16_t*)(p.ws + WS_VB);
    const float* BON0 = (const float*)(p.ws + WS_BON); const float* BON1 = BON0 + (size_t)ML * 16;
    const bf16_t* Y0 = (const bf16_t*)(p.ws + WS_Y0); const bf16_t* Y1 = (const bf16_t*)(p.ws + WS_Y1);
    bf16_t* Z = (bf16_t*)(p.ws + WS_Z);
    const int fr = lane & 15, fq = lane >> 4;
    for (int tile = c; tile < ML / 32; tile += G) {
        const int tok0 = tile * 32;
        bf16x8 xb[2][4];
#pragma unroll
        for (int tt = 0; tt < 2; ++tt)
#pragma unroll
            for (int ks = 0; ks < 4; ++ks) xb[tt][ks] = sigm8(*(const bf16x8*)(T1g + (size_t)(tok0 + tt * 16 + fr) * 128 + 32 * ks + 8 * fq));
#pragma unroll
        for (int ct = 0; ct < 8; ++ct) {
            const int ch0 = wave * 128 + ct * 16;
            const bf16_t* wr_ = G2T + (size_t)(ch0 + fr) * 128 + 8 * fq;
            f32x4 acc0 = (f32x4){0.f, 0.f, 0.f, 0.f}, acc1 = (f32x4){0.f, 0.f, 0.f, 0.f};
#pragma unroll
            for (int ks = 0; ks < 4; ++ks) { const bf16x8 wa = *(const bf16x8*)(wr_ + 32 * ks);
                acc0 = __builtin_amdgcn_mfma_f32_16x16x32_bf16(wa, xb[0][ks], acc0, 0, 0, 0);
                acc1 = __builtin_amdgcn_mfma_f32_16x16x32_bf16(wa, xb[1][ks], acc1, 0, 0, 0); }
            *(LAS u32x2*)(lds + (fr) * RO_STRIDE + (ch0 + 4 * fq) * 2) = pk4(acc0);
            *(LAS u32x2*)(lds + (16 + fr) * RO_STRIDE + (ch0 + 4 * fq) * 2) = pk4(acc1);
        }
        __syncthreads();
        for (int i = 0; i < 4; ++i) {
            const int tl = wave * 4 + i, row = tok0 + tl; const size_t o = (size_t)row * DM + 16 * lane;
            f32x4 y[4]; float s = 0.f;
#pragma unroll
            for (int q = 0; q < 4; ++q) { y[q] = unpk4(*(const u32x2*)(Y0 + o + 4 * q)) + unpk4(*(const u32x2*)(Y1 + o + 4 * q)); s += (y[q].x + y[q].y) + (y[q].z + y[q].w); }
            s += __shfl_xor(s, 1); s += __shfl_xor(s, 2);
            const float mean = s * (1.0f / 64.0f); float vs = 0.f;
#pragma unroll
            for (int q = 0; q < 4; ++q) { y[q] = y[q] - mean; vs += (y[q].x * y[q].x + y[q].y * y[q].y) + (y[q].z * y[q].z + y[q].w * y[q].w); }
            vs += __shfl_xor(vs, 1); vs += __shfl_xor(vs, 2);
            const float rstd = rsqf_(vs * (1.0f / 64.0f) + 64e-5f);
            f32x4 v4[4];
#pragma unroll
            for (int q = 0; q < 4; ++q) v4[q] = unpk4(*(const u32x2*)(VB + o + 4 * q));
            const float bs = BON0[(size_t)row * 16 + (lane >> 2)] + BON1[(size_t)row * 16 + (lane >> 2)];
#pragma unroll
            for (int q = 0; q < 4; ++q) {
                const int cc = 16 * lane + 4 * q;
                const f32x4 lw = *(const f32x4*)(p.in[I_LNW] + cc), lb = *(const f32x4*)(p.in[I_LNB] + cc);
                const f32x4 g4 = unpk4(*(const LAS u32x2*)(lds + tl * RO_STRIDE + cc * 2));
                const f32x4 z = ((y[q] * rstd) * lw + lb + v4[q] * bs) * g4;
                *(u32x2*)(Z + o + 4 * q) = pk4(z);
            }
        }
        __syncthreads();
    }
}

__device__ __forceinline__ void phase_final(const Params& p, int gw, int NGW, int lane) {
    const float* mod1 = (const float*)(p.ws + WS_MOD) + 9 * 6144;
    const bf16_t* X3 = (const bf16_t*)(p.ws + WS_X3); const int* tokslot = (const int*)(p.ws + WS_TOKSLOT); const bf16_t* Ys = (const bf16_t*)(p.ws + WS_YS1);
    const float* fg = p.in[I_FINALG];
    constexpr int R = 4;
    for (int row0 = gw * R; row0 < ML; row0 += NGW * R) {
        const int mr = row0 >> 11;
        f32x4 v[R][4];
#pragma unroll
        for (int r = 0; r < R; ++r) ld_row_bf16(X3 + (size_t)(row0 + r) * DM, lane, v[r]);
        f32x4 acc[R][4]; moe_gather_rows<R>(tokslot, Ys, SL1, row0, lane, acc);
        const float* gt2 = mod1 + (size_t)mr * 6144 + 5120;
        float ss[R];
#pragma unroll
        for (int r = 0; r < R; ++r) ss[r] = 0.f;
#pragma unroll
        for (int j = 0; j < 4; ++j) { const f32x4 g4 = *(const f32x4*)(gt2 + 256 * j + 4 * lane);
#pragma unroll
            for (int r = 0; r < R; ++r) { v[r][j] = v[r][j] + g4 * acc[r][j]; ss[r] += (v[r][j].x * v[r][j].x + v[r][j].y * v[r][j].y) + (v[r][j].z * v[r][j].z + v[r][j].w * v[r][j].w); } }
#pragma unroll
        for (int o = 1; o < 64; o <<= 1) {
#pragma unroll
            for (int r = 0; r < R; ++r) ss[r] += __shfl_xor(ss[r], o); }
#pragma unroll
        for (int j = 0; j < 4; ++j) { const f32x4 f4 = *(const f32x4*)(fg + 256 * j + 4 * lane);
#pragma unroll
            for (int r = 0; r < R; ++r) v[r][j] = (v[r][j] * rsqf_(ss[r] * (1.0f / DM) + 1e-6f)) * f4; }
#pragma unroll
        for (int r = 0; r < R; ++r) st_row_f32(p.out + (size_t)(row0 + r) * DM, lane, v[r]);
    }
}

constexpr int NPH = 22;
__global__ void __launch_bounds__(512, 2) mega_fwd(Params p) {
    extern __shared__ __attribute__((aligned(16))) unsigned char lds_raw[];
    LAS unsigned char* lds = (LAS unsigned char*)lds_raw;
    const int tid = threadIdx.x, wave = __builtin_amdgcn_readfirstlane(tid >> 6);
    const int G = gridDim.x, bx = blockIdx.x, vcu = (G % 8 == 0) ? (bx % 8) * (G / 8) + bx / 8 : bx;
    const int gw = vcu * 8 + wave, NGW = G * 8;
    for (int u = tid; u < (LDS_BYTES - LDSCTL_OFF) / 4; u += 512) ((LAS unsigned*)(lds + LDSCTL_OFF))[u] = 0u;
    __syncthreads();
    const int lo = p.ph_lo, hi = p.ph_hi;
    XcdBarrier bar; bar.bar = (unsigned*)(p.ws + WS_CTL) + CTL_BAR_WORD; bar.x = 0; bar.st = (volatile LAS unsigned*)(lds + MISC_OFF + 32);
    if (hi - lo > 1) bar = xcd_barrier_post((unsigned*)(p.ws + WS_CTL) + CTL_BAR_WORD, (volatile LAS unsigned*)(lds + MISC_OFF + 32));
#ifndef PHMASK
#define PHMASK 0x3fffff
#endif
#define IN(k) (((PHMASK >> (k)) & 1) && lo <= (k) && (k) < hi)
#define SEAM(k) do { if (IN(k) && IN((k) + 1)) xcd_barrier(bar); } while (0)
#ifndef SCANVAR
#define SCANVAR 0
#endif
#ifndef FILLMASK
#define FILLMASK 0
#endif
#ifndef DUPMASK
#define DUPMASK 0
#endif
#define DUP(k) (((DUPMASK >> (k)) & 1) != 0)
    unsigned char* ws = p.ws;
#define ctlw ((unsigned*)(p.ws + WS_CTL))
#define gate1_l0 ((const float*)(ws + WS_MOD) + 2048)
#define gate1_l1 ((const float*)(ws + WS_MOD) + 9 * 6144 + 2048)

#define LANE_ (TID_ & 63)
    if (IN(0)) for (int rep_ = 0; rep_ < (DUP(0) ? 2 : 1); ++rep_) { if (rep_) xcd_barrier(bar); phase_prep(p, lds, gw, NGW, wave, LANE_, rep_ != 0); }
    SEAM(0);
    if (IN(1)) for (int rep_ = 0; rep_ < (DUP(1) ? 2 : 1); ++rep_) { if (rep_) xcd_barrier(bar); phase_prenorm0(p, gw, NGW, LANE_); }
    SEAM(1);
    if (IN(2)) { const int rep_ = DUP(2) ? 2 : 1;
        const bool split = (G > P2_GEMM_WGS) && P2_CONV_ITEMS > 0;
        if (!split || bx < P2_GEMM_WGS) { OrderSingle S; S.init(ws + WS_H, ws + WS_WIN_T, MT, PROJ, 1024, split ? P2_GEMM_WGS : G, bx, rep_); EpiStore E{(bf16_t*)(ws + WS_P), PROJ}; pg8::gemm_phase(lds, 1024, S, E); }
        else { LAS float* scr = (LAS float*)(lds + wave * 16640); const int ncw = (G - P2_GEMM_WGS) * 8, cw = (bx - P2_GEMM_WGS) * 8 + wave;
            for (int rr = 0; rr < rep_; ++rr) for (int it = cw; it < P2_CONV_ITEMS; it += ncw) moe_convert_item(p, 0, it, scr, LANE_); } if (!split) { __syncthreads(); LAS float* scr = (LAS float*)(lds + wave * 16640); for (int it = 0 + gw; it < P2_CONV_ITEMS; it += NGW) moe_convert_item(p, 0, it, scr, LANE_); } if (FILLMASK & 1) moe_fill(p, lds, 0, ctlw + CTL_Q0, ctlw + CTL_DONE, G, wave, LANE_); }
    SEAM(2);
    if (IN(3)) for (int rep_ = 0; rep_ < (DUP(3) ? 2 : 1); ++rep_) { if (rep_) xcd_barrier(bar); phase_qkconv(p, gw, NGW, LANE_); }
    SEAM(3);
    if (IN(4)) for (int rep_ = 0; rep_ < (DUP(4) ? 2 : 1); ++rep_) { if (rep_) xcd_barrier(bar); phase_attention(p, lds, G, vcu); if (FILLMASK & 2) moe_fill(p, lds, 0, ctlw + CTL_Q0, ctlw + CTL_DONE + 64, G, wave, LANE_); }
    SEAM(4);
    if (IN(5)) { const int rep_ = DUP(5) ? 2 : 1;
        const bool split = (G > P5_GEMM_WGS) && P5_CONV_ITEMS > 0;
        if (!split || bx < P5_GEMM_WGS) { OrderSingle S; S.init(ws + WS_AO, ws + WS_WOUT_T, MT, 1024, 2048, split ? P5_GEMM_WGS : G, bx, rep_); EpiResid<false> E{p.in[I_X], p.in[I_CTX], (bf16_t*)(ws + WS_X1), gate1_l0}; pg8::gemm_phase(lds, 2048, S, E); }
        else { LAS float* scr = (LAS float*)(lds + wave * 16640); const int ncw = (G - P5_GEMM_WGS) * 8, cw = (bx - P5_GEMM_WGS) * 8 + wave;
            for (int rr = 0; rr < rep_; ++rr) for (int it = P2_CONV_ITEMS + cw; it < P5_CONV_ITEMS; it += ncw) moe_convert_item(p, 0, it, scr, LANE_); } if (!split) { __syncthreads(); LAS float* scr = (LAS float*)(lds + wave * 16640); for (int it = P2_CONV_ITEMS + gw; it < P5_CONV_ITEMS; it += NGW) moe_convert_item(p, 0, it, scr, LANE_); } if (FILLMASK & 4) moe_fill(p, lds, 0, ctlw + CTL_Q0, ctlw + CTL_DONE + 128, G, wave, LANE_); }
    SEAM(5);
    if (IN(6)) for (int rep_ = 0; rep_ < (DUP(6) ? 2 : 1); ++rep_) { if (rep_) xcd_barrier(bar); phase_moe_prenorm(p, lds, 0, (const bf16_t*)(ws + WS_X1), MT, (bf16_t*)(ws + WS_H), gw, NGW, LANE_); }
    SEAM(6);
    if (IN(7)) for (int rep_ = 0; rep_ < (DUP(7) ? 2 : 1); ++rep_) { if (rep_) xcd_barrier(bar); phase_select(p, lds, 256, SL0, G, bx, wave, LANE_); }
    SEAM(7);
    if (IN(8)) { const int rep_ = DUP(8) ? 2 : 1; const bool split = G > P8_GEMM_WGS; if (!split || vcu < P8_GEMM_WGS) { OrderMoe S; S.init(ws + WS_H, ws + WS_WGU_T, 9, 8, 1024, split ? P8_GEMM_WGS : G, vcu, rep_); S.rowidx = (const int*)(ws + WS_SELROW); EpiAct E{(bf16_t*)(ws + WS_ACT0)}; pg8::gemm_phase<EpiAct, OrderMoe, true>(lds, 1024, S, E); } else { LAS float* scr = (LAS float*)(lds + wave * 16640); const int ncw = (G - P8_GEMM_WGS) * 8, cw = (vcu - P8_GEMM_WGS) * 8 + wave; for (int rr = 0; rr < rep_; ++rr) for (int it = 0 + cw; it < L1_A; it += ncw) moe_convert_item(p, 1, it, scr, LANE_); } if (!split) { __syncthreads(); LAS float* scr = (LAS float*)(lds + wave * 16640); for (int it = 0 + gw; it < L1_A; it += NGW) moe_convert_item(p, 1, it, scr, LANE_); } }
    SEAM(8);
    if (IN(9)) { const int rep_ = DUP(9) ? 2 : 1; const bool split = G > P9_GEMM_WGS; if (!split || vcu < P9_GEMM_WGS) { OrderMoe S; S.init(ws + WS_ACT0, ws + WS_WD_T, 9, 4, 1024, split ? P9_GEMM_WGS : G, vcu, rep_); EpiYs E{(bf16_t*)(ws + WS_YS0), (const float*)(ws + WS_SELAFF)}; pg8::gemm_phase(lds, 1024, S, E); } else { LAS float* scr = (LAS float*)(lds + wave * 16640); const int ncw = (G - P9_GEMM_WGS) * 8, cw = (vcu - P9_GEMM_WGS) * 8 + wave; for (int rr = 0; rr < rep_; ++rr) for (int it = L1_A + cw; it < L1_B; it += ncw) moe_convert_item(p, 1, it, scr, LANE_); } if (!split) { __syncthreads(); LAS float* scr = (LAS float*)(lds + wave * 16640); for (int it = L1_A + gw; it < L1_B; it += NGW) moe_convert_item(p, 1, it, scr, LANE_); } }
    SEAM(9);
    if (IN(10)) for (int rep_ = 0; rep_ < (DUP(10) ? 2 : 1); ++rep_) { if (rep_) xcd_barrier(bar); phase_combine0(p, gw, NGW, LANE_); }
    SEAM(10);
    if (IN(11)) for (int rep_ = 0; rep_ < (DUP(11) ? 2 : 1); ++rep_) { if (rep_) xcd_barrier(bar); phase_mixes(p, gw, NGW, LANE_); }
    SEAM(11);
    if (IN(12)) { const int rep_ = DUP(12) ? 2 : 1; const bool split = G > P12_GEMM_WGS; if (!split || vcu < P12_GEMM_WGS) { OrderRkv S; S.A0 = (const char*)(ws + WS_XR); S.A1 = (const char*)(ws + WS_XK); S.A2 = (const char*)(ws + WS_XV); S.A3 = (const char*)(ws + WS_XW); S.A4 = (const char*)(ws + WS_XA); S.A5 = (const char*)(ws + WS_XG);
        S.B0 = (const char*)(ws + WS_WR_T); S.B1 = (const char*)(ws + WS_WK_T); S.B2 = (const char*)(ws + WS_WV_T); S.B3 = (const char*)(ws + WS_WL1_T); S.G = split ? P12_GEMM_WGS : G; S.c = vcu; S.rep = rep_;
        EpiRkv E{(bf16_t*)(ws + WS_RB), (bf16_t*)(ws + WS_KB), (bf16_t*)(ws + WS_VB), (bf16_t*)(ws + WS_T1)}; pg8::gemm_phase(lds, 1024, S, E); } else { LAS float* scr = (LAS float*)(lds + wave * 16640); const int ncw = (G - P12_GEMM_WGS) * 8, cw = (vcu - P12_GEMM_WGS) * 8 + wave; for (int rr = 0; rr < rep_; ++rr) for (int it = L1_B + cw; it < L1_C; it += ncw) moe_convert_item(p, 1, it, scr, LANE_); } if (!split) { __syncthreads(); LAS float* scr = (LAS float*)(lds + wave * 16640); for (int it = L1_B + gw; it < L1_C; it += NGW) moe_convert_item(p, 1, it, scr, LANE_); } }
    SEAM(12);
    if (IN(13)) for (int rep_ = 0; rep_ < (DUP(13) ? 2 : 1); ++rep_) { if (rep_) xcd_barrier(bar);   }
    SEAM(13);
    if (IN(14)) for (int rep_ = 0; rep_ < (DUP(14) ? 2 : 1); ++rep_) { if (rep_) xcd_barrier(bar); phase_scan(p, lds, G, bx, wave, LANE_, rep_ ? SCANVAR : 0); }
    SEAM(14);
    if (IN(15)) for (int rep_ = 0; rep_ < (DUP(15) ? 2 : 1); ++rep_) { if (rep_) xcd_barrier(bar); phase_readout(p, lds, G, vcu, wave, LANE_); }
    SEAM(15);
    if (IN(16)) { const int rep_ = DUP(16) ? 2 : 1; OrderSingle S; S.init(ws + WS_Z, ws + WS_WO_T, ML, 1024, 1024, G, bx, rep_); EpiResid<true> E{ws + WS_X2, ws + WS_X2, (bf16_t*)(ws + WS_X3), gate1_l1}; pg8::gemm_phase(lds, 1024, S, E); }
    SEAM(16);
    if (IN(17)) for (int rep_ = 0; rep_ < (DUP(17) ? 2 : 1); ++rep_) { if (rep_) xcd_barrier(bar); phase_moe_prenorm(p, lds, 1, (const bf16_t*)(ws + WS_X3), ML, (bf16_t*)(ws + WS_H2), gw, NGW, LANE_);
        __syncthreads();
        LAS float* scr = (LAS float*)(lds + wave * 16640);
        for (int it = L1_C + gw; it < P0_NMOE; it += NGW) moe_convert_item(p, 1, it, scr, LANE_); }
    SEAM(17);
    if (IN(18)) for (int rep_ = 0; rep_ < (DUP(18) ? 2 : 1); ++rep_) { if (rep_) xcd_barrier(bar); phase_select(p, lds, 128, SL1, G, bx, wave, LANE_); }
    SEAM(18);
    if (IN(19)) { const int rep_ = DUP(19) ? 2 : 1; OrderMoe S; S.init(ws + WS_H2, ws + WS_WGU1, 8, 8, 1024, G, vcu, rep_); S.rowidx = (const int*)(ws + WS_SELROW); EpiAct E{(bf16_t*)(ws + WS_ACT1)}; pg8::gemm_phase<EpiAct, OrderMoe, true>(lds, 1024, S, E); }
    SEAM(19);
    if (IN(20)) { const int rep_ = DUP(20) ? 2 : 1; OrderMoe S; S.init(ws + WS_ACT1, ws + WS_WD1, 8, 4, 1024, G, vcu, rep_); EpiYs E{(bf16_t*)(ws + WS_YS1), (const float*)(ws + WS_SELAFF)}; pg8::gemm_phase(lds, 1024, S, E); }
    SEAM(20);
    if (IN(21)) for (int rep_ = 0; rep_ < (DUP(21) ? 2 : 1); ++rep_) { if (rep_) xcd_barrier(bar); phase_final(p, gw, NGW, LANE_); }
#undef IN
#undef SEAM
}

#ifndef MK_PER_PHASE
#define MK_PER_PHASE 0
#endif
extern "C" void kernel_launch(void* const* d_in, const int* in_sizes, int n_in, void* d_out, int out_size, void* d_ws, size_t ws_size, hipStream_t stream) {
    static int grid = 0;
    if (grid == 0) {
        if (n_in != 35 || out_size != ML * DM || ws_size < WS_END) { fprintf(stderr, "kernel_launch: unexpected shapes: n_in %d out %d ws %zu (need %zu)\n", n_in, out_size, ws_size, (size_t)WS_END); grid = -1; return; }
        int dev = 0, cus = 0;
        if (hipGetDevice(&dev) != hipSuccess || hipDeviceGetAttribute(&cus, hipDeviceAttributeMultiprocessorCount, dev) != hipSuccess) { grid = -1; return; }
        if (hipFuncSetAttribute((const void*)mega_fwd, hipFuncAttributeMaxDynamicSharedMemorySize, LDS_BYTES) != hipSuccess) { fprintf(stderr, "kernel_launch: hipFuncSetAttribute failed\n"); grid = -1; return; }
        int per_cu = 0; (void)hipOccupancyMaxActiveBlocksPerMultiprocessor(&per_cu, (const void*)mega_fwd, 512, LDS_BYTES); (void)hipGetLastError();
        if (per_cu < 1) fprintf(stderr, "kernel_launch: occupancy query reports %d blocks per CU\n", per_cu);
        grid = cus;
    }
    if (grid < 0) return;
    (void)in_sizes;
    (void)hipMemsetAsync((char*)d_ws + WS_CTL, 0, 1 * MiB, stream);
    Params a{};
    for (int i = 0; i < 35; ++i) a.in[i] = (const float*)d_in[i];
    a.out = (float*)d_out; a.ws = (unsigned char*)d_ws;
#if MK_PER_PHASE
    for (int ph = 0; ph < NPH; ++ph) { a.ph_lo = ph; a.ph_hi = ph + 1; hipLaunchKernelGGL(mega_fwd, dim3(grid), dim3(512), LDS_BYTES, stream, a); }
#else
    a.ph_lo = 0; a.ph_hi = NPH; hipLaunchKernelGGL(mega_fwd, dim3(grid), dim3(512), LDS_BYTES, stream, a);
#endif
    const hipError_t le = hipPeekAtLastError();
    if (le != hipSuccess) fprintf(stderr, "kernel_launch: launch failed: %s\n", hipGetErrorName(le));
}
```

```cpp
#include <hip/hip_runtime.h>
#include <cstdio>
#include <cstdint>

#define GAS __attribute__((address_space(1)))
#define LAS __attribute__((address_space(3)))
typedef unsigned short bf16_t;
typedef short bf16x8 __attribute__((ext_vector_type(8)));
typedef short s16x4 __attribute__((ext_vector_type(4)));
typedef float f32x4 __attribute__((ext_vector_type(4)));
typedef float f32x2 __attribute__((ext_vector_type(2)));
typedef float f32x8 __attribute__((ext_vector_type(8)));
typedef float f32x16 __attribute__((ext_vector_type(16)));
typedef unsigned u32x4 __attribute__((ext_vector_type(4)));
typedef unsigned u32x2 __attribute__((ext_vector_type(2)));

constexpr int NB = 8, SEQ = 2048, CTXL = 256, DM = 1024;
constexpr int ML = NB * SEQ, MC = NB * CTXL, MT = ML + MC;
constexpr int PROJ = 4608, NE = 16;
constexpr int KVL = CTXL + SEQ;
constexpr int CAPL = 256, CAPC = 32, SL0 = NB * CAPL + NB * CAPC  , SL1 = NB * CAPL  ;

constexpr size_t MiB = 1u << 20;
constexpr size_t WS_CTL = 0;
constexpr size_t CTL_BAR_WORD = 4096;
constexpr size_t WS_MOD = 512 * 1024;
constexpr size_t WS_ROPE = 1 * MiB;
constexpr size_t WS_AFF = 2 * MiB;
constexpr size_t WS_TOKSLOT = 4 * MiB;
constexpr size_t WS_SELAFF = 6 * MiB;
constexpr size_t WS_SELROW = 7 * MiB;
constexpr size_t WS_WIN_T = 8 * MiB;
constexpr size_t WS_WOUT_T = 17 * MiB;
constexpr size_t WS_WR_T = 21 * MiB, WS_WK_T = 23 * MiB, WS_WV_T = 25 * MiB, WS_WO_T = 27 * MiB;
constexpr size_t WS_WL1_T = 29 * MiB;
constexpr size_t WS_W2T = 31 * MiB;
constexpr size_t WS_A2T = WS_W2T + 256 * 1024, WS_G2T = WS_W2T + 512 * 1024;
constexpr size_t WS_WMOE = 32 * MiB;
constexpr size_t WS_WGU_T = WS_WMOE, WS_WD_T = WS_WMOE + 64 * MiB;
constexpr size_t AB = 128 * MiB;
constexpr size_t WS_P = AB + 0 * MiB;
constexpr size_t WS_H = AB + 162 * MiB;
constexpr size_t WS_AO = AB + 198 * MiB;
constexpr size_t WS_Q = AB + 270 * MiB;
constexpr size_t WS_KA = AB + 306 * MiB, WS_VA = AB + 315 * MiB;
constexpr size_t WS_X1 = AB + 0 * MiB;
constexpr size_t WS_XS0 = AB + 72 * MiB, WS_YS0 = AB + 72 * MiB;
constexpr size_t WS_ACT0 = AB + 198 * MiB;
constexpr size_t WS_X2 = AB + 36 * MiB;
constexpr size_t WS_WGU1 = AB + 324 * MiB, WS_WD1 = AB + 388 * MiB;
constexpr size_t WS_XR = WS_WMOE, WS_XW = AB + 144 * MiB, WS_XA = AB + 180 * MiB, WS_XG = AB + 216 * MiB, WS_XV = AB + 248 * MiB, WS_XK = AB + 284 * MiB;
constexpr size_t WS_KB = AB + 0 * MiB, WS_RB = AB + 72 * MiB, WS_VB = AB + 104 * MiB, WS_T1 = WS_WMOE + 32 * MiB;
constexpr size_t WS_KK = AB + 284 * MiB;
constexpr size_t WS_Y0 = AB + 144 * MiB, WS_Y1 = AB + 176 * MiB;
constexpr size_t WS_BON = AB + 320 * MiB;
constexpr size_t WS_Z = AB + 208 * MiB;
constexpr size_t WS_X3 = AB + 240 * MiB;
constexpr size_t WS_H2 = AB + 272 * MiB;
constexpr size_t WS_ACT1 = AB + 72 * MiB, WS_YS1 = AB + 144 * MiB;
constexpr size_t WS_END = AB + 420 * MiB;

constexpr int RING_BYTES = 151552, LDSCTL_OFF = RING_BYTES, MISC_OFF = LDSCTL_OFF + 320, LDS_BYTES = 163840;

__device__ __forceinline__ int tid_opaque() { int t = (int)threadIdx.x; asm volatile("" : "+v"(t)); return t; }
#define TID_ tid_opaque()
#define LDS_WAIT() asm volatile("s_waitcnt lgkmcnt(0)" ::: "memory")
#define VM_WAIT() asm volatile("s_waitcnt vmcnt(0)" ::: "memory")
__device__ __forceinline__ float bf2f(unsigned b) { return __uint_as_float(b << 16); }
__device__ __forceinline__ unsigned f2bf(float f) { unsigned u = __float_as_uint(f); return (u + 0x7fffu + ((u >> 16) & 1u)) >> 16; }
typedef __bf16 bf16n2 __attribute__((ext_vector_type(2)));
__device__ __forceinline__ unsigned pk2(float lo, float hi) { const f32x2 v = {lo, hi}; return __builtin_bit_cast(unsigned, __builtin_convertvector(v, bf16n2)); }
__device__ __forceinline__ float wave_sum(float v) {
#pragma unroll
    for (int o = 1; o < 64; o <<= 1) v += __shfl_xor(v, o);
    return v;
}
__device__ __forceinline__ int wave_sum_i(int v) {
#pragma unroll
    for (int o = 1; o < 64; o <<= 1) v += __shfl_xor(v, o);
    return v;
}
__device__ __forceinline__ float rcpf_(float x) { return __builtin_amdgcn_rcpf(x); }
__device__ __forceinline__ float rsqf_(float x) { return __builtin_amdgcn_rsqf(x); }
__device__ __forceinline__ float sigmoidf_(float x) { return rcpf_(1.0f + __expf(-x)); }
template <int CTRL> __device__ __forceinline__ float dpp_mov(float v) { return __int_as_float(__builtin_amdgcn_update_dpp(__float_as_int(v), __float_as_int(v), CTRL, 0xf, 0xf, true)); }
__device__ __forceinline__ float allsum16(float v) { v += dpp_mov<0xB1>(v); v += dpp_mov<0x4E>(v); v += dpp_mov<0x141>(v); v += dpp_mov<0x140>(v); return v; }
__device__ __forceinline__ f32x4 unpk4(u32x2 w) { return (f32x4){bf2f(w.x & 0xffffu), bf2f(w.x >> 16), bf2f(w.y & 0xffffu), bf2f(w.y >> 16)}; }
__device__ __forceinline__ void unpk8(u32x4 w, float (&o)[8]) {
#pragma unroll
    for (int m = 0; m < 4; ++m) { o[2 * m] = bf2f(w[m] & 0xffffu); o[2 * m + 1] = bf2f(w[m] >> 16); }
}
__device__ __forceinline__ u32x4 pk8(const float (&v)[8]) { u32x4 w; w.x = pk2(v[0], v[1]); w.y = pk2(v[2], v[3]); w.z = pk2(v[4], v[5]); w.w = pk2(v[6], v[7]); return w; }
__device__ __forceinline__ u32x2 pk4(f32x4 v) { u32x2 w; w.x = pk2(v.x, v.y); w.y = pk2(v.z, v.w); return w; }

#define XB_TMO      128
#define XB_XCNT(j)  (256  + 64 * (j))
#define XB_XSUB(j)  (1280 + 64 * (j))
#define XB_XGEN(j)  (2304 + 64 * (j))
#define XB_TOP      3328
#define XB_TOPGEN   3392
#define XCD_BAR_WORDS 3456
#define XB_SPIN_CAP (1u << 18)
__device__ __forceinline__ unsigned xb_ld(unsigned* p)              { return __hip_atomic_load(p, __ATOMIC_RELAXED, __HIP_MEMORY_SCOPE_AGENT); }
__device__ __forceinline__ unsigned xb_add(unsigned* p, unsigned v) { return __hip_atomic_fetch_add(p, v, __ATOMIC_RELAXED, __HIP_MEMORY_SCOPE_AGENT); }
__device__ __forceinline__ unsigned xb_xcc_id() { return (unsigned)__builtin_amdgcn_s_getreg((3 << 11) | 20) & 0xFu; }
#define XB_SPIN(cond, bar) do { unsigned _sp = 0; while (cond) { __builtin_amdgcn_s_sleep(1); \
    if ((++_sp & 255u) == 0u) { if (xb_ld(&(bar)[XB_TMO])) break; if (_sp > XB_SPIN_CAP) { atomicAdd(&(bar)[XB_TMO], 1u); break; } } } } while (0)
struct XcdBarrier { unsigned* bar; unsigned x; volatile LAS unsigned* st; };
__device__ __forceinline__ XcdBarrier xcd_barrier_post(unsigned* bar, volatile LAS unsigned* st) {
    XcdBarrier b; b.bar = bar; b.x = xb_xcc_id(); b.st = st;
    if (threadIdx.x == 0) (void)xb_add(&bar[XB_XCNT(b.x)], 1u);
    return b;
}
__device__ __forceinline__ void xcd_barrier_complete(unsigned* bar, unsigned x, unsigned& nloc, unsigned& nx) {
    const unsigned G = gridDim.x * gridDim.y * gridDim.z;
    unsigned sum, cnt, mine, sp = 0u;
    for (;;) {
        sum = 0u; cnt = 0u; mine = 0u;
#pragma unroll
        for (unsigned j = 0; j < 16; ++j) { const unsigned c = xb_ld(&bar[XB_XCNT(j)]); sum += c; cnt += (c > 0u) ? 1u : 0u; mine = (j == x) ? c : mine; }
        if (sum == G) break;
        __builtin_amdgcn_s_sleep(1);
        if ((++sp & 255u) == 0u) { if (xb_ld(&bar[XB_TMO])) break; if (sp > XB_SPIN_CAP) { atomicAdd(&bar[XB_TMO], 1u); break; } }
    }
    nloc = mine > 0u ? mine : 1u; nx = cnt > 0u ? cnt : 1u;
}
__device__ __forceinline__ void xcd_barrier(const XcdBarrier& b) {
    asm volatile("s_waitcnt vmcnt(0)" ::: "memory");
    __syncthreads();
    if (threadIdx.x == 0) {
        unsigned* bar = b.bar;
        __builtin_amdgcn_s_waitcnt(0);
        unsigned nloc = b.st[0], nx = b.st[1];
        if (nloc == 0u) { xcd_barrier_complete(bar, b.x, nloc, nx); b.st[0] = nloc; b.st[1] = nx; }
        const unsigned old = xb_add(&bar[XB_XSUB(b.x)], 1u);
        const unsigned gen = old / nloc;
        if (old + 1u == (gen + 1u) * nloc) {
            __builtin_amdgcn_fence(__ATOMIC_RELEASE, "agent");
            asm volatile("s_waitcnt vmcnt(0)" ::: "memory");
            const unsigned og = xb_add(&bar[XB_TOP], 1u);
            const unsigned tg = og / nx;
            if (og + 1u == (tg + 1u) * nx) xb_add(&bar[XB_TOPGEN], 1u);
            else XB_SPIN(xb_ld(&bar[XB_TOPGEN]) == tg, bar);
            __builtin_amdgcn_fence(__ATOMIC_ACQUIRE, "agent");
            xb_add(&bar[XB_XGEN(b.x)], 1u);
            asm volatile("s_waitcnt vmcnt(0)" ::: "memory");
        } else {
            XB_SPIN(xb_ld(&bar[XB_XGEN(b.x)]) == gen, bar);
            __builtin_amdgcn_fence(__ATOMIC_ACQUIRE, "agent");
            asm volatile("s_waitcnt vmcnt(0)" ::: "memory");
        }
    }
    __syncthreads();
}

namespace pg8 {
constexpr int BM = 256, BK = 64, HALF = 128, HTB = HALF * BK * 2, STAGE_BYTES = 8 * HTB;
__host__ __device__ __forceinline__ int lds_byte(int r, int c) { const int st = (r >> 4) * 2 + (c >> 5), rr = r & 15, cc = c & 31, ob = rr * 64 + cc * 2; return st * 1024 + (ob ^ (((ob >> 9) & 1) << 5)); }
__host__ __device__ __forceinline__ void stage_rc(int b, int& R, int& C) { const int st = b / 1024, sb = b % 1024, swz = sb ^ (((sb >> 9) & 1) << 5); R = (st >> 1) * 16 + swz / 64; C = (st & 1) * 32 + (swz % 64) / 2; }
__host__ __device__ __forceinline__ int perm32(int rho) { const int n = rho >> 4, i = rho & 15; return 8 * (i >> 2) + 4 * n + (i & 3); }
struct Unit { int pm, pn, gi; };
__device__ __forceinline__ unsigned cvt_pk_bf16(float lo, float hi) { return ::pk2(lo, hi); }

template <class Epi, class Sched, bool GATHER = false>
__device__ __forceinline__ void gemm_phase(LAS unsigned char* lds, const int K, const Sched& S, const Epi& E) {
    const int tid = TID_, wid = __builtin_amdgcn_readfirstlane(tid >> 6), lane = tid & 63, wr = wid >> 2, wc = wid & 3, fr = lane & 15, fq = lane >> 4;
    const int nt = K / BK;
    unsigned voffA[2], voffB[2];
#pragma unroll
    for (int i = 0; i < 2; ++i) { int R, C; stage_rc(tid * 16 + i * 8192, R, C); const int Rb = Epi::PERM ? ((R & ~31) + perm32(R & 31)) : R;
        voffA[i] = (unsigned)(R * K + C) * 2u; voffB[i] = (unsigned)(Rb * K + C) * 2u; }
    const size_t kstep = (size_t)(BK * 2);
    const size_t hstep = (size_t)HALF * K * 2;
    const unsigned ldsw = (unsigned)wid * 1024u;
    const int aoff = lds_byte(wr * 64 + fr, fq * 8), boff = lds_byte(wc * 32 + fr, fq * 8);
#define PG8_SA(b, h) (((b) * 2 + (h)) * HTB)
#define PG8_SB(b, h) ((4 + (b) * 2 + (h)) * HTB)
#define PG8_STAGE(bufoff, gbase, voff) do { _Pragma("unroll") for (int _i = 0; _i < 2; ++_i) \
        __builtin_amdgcn_global_load_lds((const unsigned*)((const char*)(gbase) + (voff)[_i]), (LAS unsigned*)(lds + (bufoff) + ldsw + _i * 8192), 16, 0, 0); } while (0)
#define PG8_LDA(dst, b, h) do { _Pragma("unroll") for (int m = 0; m < 4; ++m) _Pragma("unroll") for (int k = 0; k < 2; ++k) dst[m][k] = *(const LAS bf16x8*)(lds + PG8_SA(b, h) + aoff + m * 2048 + k * 1024); } while (0)
#define PG8_LDB(dst, b, h) do { _Pragma("unroll") for (int n = 0; n < 2; ++n) _Pragma("unroll") for (int k = 0; k < 2; ++k) dst[n][k] = *(const LAS bf16x8*)(lds + PG8_SB(b, h) + boff + n * 2048 + k * 1024); } while (0)
#define PG8_MMA(ai, bj, At, Bt) do { __builtin_amdgcn_s_setprio(1); _Pragma("unroll") for (int m = 0; m < 4; ++m) _Pragma("unroll") for (int n = 0; n < 2; ++n) _Pragma("unroll") for (int k = 0; k < 2; ++k) \
        acc[ai][bj][m][n] = __builtin_amdgcn_mfma_f32_16x16x32_bf16(Bt[n][k], At[m][k], acc[ai][bj][m][n], 0, 0, 0); __builtin_amdgcn_s_setprio(0); } while (0)
#define PG8_WAIT_V(n) asm volatile("s_waitcnt vmcnt(" #n ")" ::: "memory")
#define PG8_WAIT_L(n) asm volatile("s_waitcnt lgkmcnt(" #n ")" ::: "memory")
#define PG8_BAR __builtin_amdgcn_s_barrier()
#define PG8_SCHED __builtin_amdgcn_sched_barrier(0)
    Unit cur, nxt; int ui = 0;
    int gR[2], gC[2];
#pragma unroll
    for (int i = 0; i < 2; ++i) stage_rc(tid * 16 + i * 8192, gR[i], gC[i]);
    unsigned vA[2][2] = {{0u, 0u}, {0u, 0u}}, vN[2][2] = {{0u, 0u}, {0u, 0u}};
    if constexpr (GATHER) {
        LAS int* gidx = (LAS int*)(lds + STAGE_BYTES);
        Unit gu; for (int i = 0; S.next(i, gu); ++i) if (tid < 256) gidx[i * 256 + tid] = S.rowidx[gu.pm * 256 + tid];
        __syncthreads();
    }
#define PG8_GIDX(dst, unit_i) do { if constexpr (GATHER) { const LAS int* gi_ = (const LAS int*)(lds + STAGE_BYTES) + (unit_i) * 256; _Pragma("unroll") for (int h_ = 0; h_ < 2; ++h_) _Pragma("unroll") for (int i_ = 0; i_ < 2; ++i_) \
        dst[h_][i_] = (unsigned)gi_[h_ * 128 + gR[i_]] * (unsigned)(K * 2) + (unsigned)(gC[i_] * 2); } } while (0)
    if (!S.next(0, cur)) return;
    PG8_GIDX(vA, 0);
    f32x4 acc[2][2][4][2];
#pragma unroll
    for (int a = 0; a < 2; ++a)
#pragma unroll
        for (int b = 0; b < 2; ++b)
#pragma unroll
            for (int m = 0; m < 4; ++m)
#pragma unroll
                for (int n = 0; n < 2; ++n) acc[a][b][m][n] = (f32x4){0.f, 0.f, 0.f, 0.f};
    bf16x8 At[4][2], B0[2][2], B1[2][2];
    const char* cA; if constexpr (GATHER) cA = S.gbase; else cA = S.a_base(cur);
    const char* cB = S.b_base(cur);
#define PG8_STAGE_A(bufoff, ap, h, v) do { if constexpr (GATHER) { PG8_STAGE(bufoff, ap, (v)[h]); } else { PG8_STAGE(bufoff, (ap) + (h) * hstep, voffA); } } while (0)
    PG8_STAGE(PG8_SB(0, 0), cB, voffB); PG8_STAGE_A(PG8_SA(0, 0), cA, 0, vA); PG8_STAGE(PG8_SB(0, 1), cB + hstep, voffB); PG8_STAGE_A(PG8_SA(0, 1), cA, 1, vA);
    if (wr == 1) PG8_BAR;
    PG8_WAIT_V(4); PG8_BAR;
    PG8_STAGE(PG8_SB(1, 0), cB + kstep, voffB); PG8_STAGE_A(PG8_SA(1, 0), cA + kstep, 0, vA); PG8_STAGE(PG8_SB(1, 1), cB + hstep + kstep, voffB);
    PG8_WAIT_V(6); PG8_BAR;
    for (;;) {
        const bool has_next = S.next(ui + 1, nxt);
        const char* nA = cA; if constexpr (!GATHER) { if (has_next) nA = S.a_base(nxt); }
        const char* nB = has_next ? S.b_base(nxt) : cB;
        if constexpr (GATHER) { if (has_next) PG8_GIDX(vN, ui + 1); else {
#pragma unroll
            for (int h_ = 0; h_ < 2; ++h_)
#pragma unroll
                for (int i_ = 0; i_ < 2; ++i_) vN[h_][i_] = vA[h_][i_]; } }
        for (int t = 0; t < nt; t += 2) {
            const bool last = (t == nt - 2);
            const char* a1 = cA + (size_t)(t + 1) * kstep;
            const char* a2 = last ? nA : cA + (size_t)(t + 2) * kstep; const char* b2 = last ? nB : cB + (size_t)(t + 2) * kstep;
            const char* a3 = a2 + kstep; const char* b3 = b2 + kstep;
            unsigned v2[2][2];
#pragma unroll
            for (int h_ = 0; h_ < 2; ++h_)
#pragma unroll
                for (int i_ = 0; i_ < 2; ++i_) v2[h_][i_] = last ? vN[h_][i_] : vA[h_][i_];
            PG8_LDB(B0, 0, 0); PG8_SCHED; PG8_LDA(At, 0, 0); PG8_STAGE_A(PG8_SA(1, 1), a1, 1, vA);
            PG8_WAIT_L(8); PG8_BAR; PG8_WAIT_L(0); PG8_MMA(0, 0, At, B0); PG8_BAR; PG8_SCHED;
            PG8_LDB(B1, 0, 1); PG8_STAGE(PG8_SB(0, 0), b2, voffB);
            PG8_BAR; PG8_WAIT_L(0); PG8_MMA(0, 1, At, B1); PG8_BAR;
            PG8_LDA(At, 0, 1); PG8_STAGE_A(PG8_SA(0, 0), a2, 0, v2);
            PG8_BAR; PG8_WAIT_L(0); PG8_MMA(1, 0, At, B0); PG8_BAR; PG8_SCHED;
            PG8_STAGE(PG8_SB(0, 1), b2 + hstep, voffB);
            PG8_WAIT_V(6); PG8_BAR; PG8_MMA(1, 1, At, B1); PG8_BAR;
            PG8_LDB(B0, 1, 0); PG8_SCHED; PG8_LDA(At, 1, 0); PG8_STAGE_A(PG8_SA(0, 1), a2, 1, v2);
            PG8_WAIT_L(8); PG8_BAR; PG8_WAIT_L(0); PG8_MMA(0, 0, At, B0); PG8_BAR; PG8_SCHED;
            PG8_LDB(B1, 1, 1); PG8_STAGE(PG8_SB(1, 0), b3, voffB);
            PG8_BAR; PG8_WAIT_L(0); PG8_MMA(0, 1, At, B1); PG8_BAR;
            PG8_LDA(At, 1, 1); PG8_STAGE_A(PG8_SA(1, 0), a3, 0, v2);
            PG8_BAR; PG8_WAIT_L(0); PG8_MMA(1, 0, At, B0); PG8_BAR; PG8_SCHED;
            PG8_STAGE(PG8_SB(1, 1), b3 + hstep, voffB);
            PG8_WAIT_V(6); PG8_BAR; PG8_MMA(1, 1, At, B1); PG8_BAR;
        }
        E(acc, cur, wr, wc, fr, fq);
        if (!has_next) break;
#pragma unroll
        for (int a = 0; a < 2; ++a)
#pragma unroll
            for (int b = 0; b < 2; ++b)
#pragma unroll
                for (int m = 0; m < 4; ++m)
#pragma unroll
                    for (int n = 0; n < 2; ++n) acc[a][b][m][n] = (f32x4){0.f, 0.f, 0.f, 0.f};
        cur = nxt; cA = nA; cB = nB; ++ui;
#pragma unroll
        for (int h_ = 0; h_ < 2; ++h_)
#pragma unroll
            for (int i_ = 0; i_ < 2; ++i_) vA[h_][i_] = vN[h_][i_];
    }
    PG8_WAIT_V(0);
    if (wr == 0) PG8_BAR;
    PG8_BAR;
#undef PG8_SA
#undef PG8_STAGE_A
#undef PG8_GIDX
#undef PG8_SB
#undef PG8_STAGE
#undef PG8_LDA
#undef PG8_LDB
#undef PG8_MMA
#undef PG8_WAIT_V
#undef PG8_WAIT_L
#undef PG8_BAR
#undef PG8_SCHED
}
}
struct Params { const float* in[35]; float* out; unsigned char* ws; int ph_lo, ph_hi; };
enum { I_X = 0, I_C, I_CTX, I_CCTX, I_ADAW, I_ADAB, I_NORMG, I_FINALG, I_WIN, I_WOUT, I_QG, I_KG, I_CONVW, I_MU, I_WR, I_WK, I_WV, I_WO, I_W0, I_W1, I_W2,
       I_A0, I_A1, I_A2, I_G1, I_G2, I_KK, I_KA, I_RK, I_LNW, I_LNB, I_ROUTER, I_WGATE, I_WUP, I_WDOWN };

struct OrderSingle {
    const char* A; const char* Bt; int nM, nN, nwg, G, c, rep; size_t tstep;
    __device__ __forceinline__ void init(const void* A_, const void* Bt_, int M, int N, int K, int G_, int c_, int rep_ = 1) { rep = rep_; A = (const char*)A_; Bt = (const char*)Bt_; nM = M / 256; nN = N / 256; nwg = nM * nN; G = G_; c = c_; tstep = (size_t)256 * K * 2; }
    __device__ __forceinline__ bool next(int i, pg8::Unit& u) const {
        long L = (long)i * G + c; if (L >= (long)nwg * rep) return false; L %= nwg;
        int wgid = (int)L; { const int q = nwg / 8, r = nwg % 8, xcd = wgid % 8, off = wgid / 8; wgid = (xcd < r ? xcd * (q + 1) : r * (q + 1) + (xcd - r) * q) + off; }
        const int nig = 8 * nN, gid = wgid / nig, fm = gid * 8, gsz = (nM - fm) < 8 ? (nM - fm) : 8;
        u.pm = fm + ((wgid % nig) % gsz); u.pn = (wgid % nig) / gsz; u.gi = 0; return true;
    }
    __device__ __forceinline__ const char* a_base(const pg8::Unit& u) const { return A + (size_t)u.pm * tstep; }
    __device__ __forceinline__ const char* b_base(const pg8::Unit& u) const { return Bt + (size_t)u.pn * tstep; }
};
struct OrderMoe {
    const char* A; const char* Bt; int PM, PN, nwg, G, c, rep; size_t tstep; const char* gbase; const int* rowidx;
    __device__ __forceinline__ void init(const void* A_, const void* Bt_, int PM_, int PN_, int K, int G_, int c_, int rep_ = 1) { rep = rep_; gbase = (const char*)A_; rowidx = nullptr; A = (const char*)A_; Bt = (const char*)Bt_; PM = PM_; PN = PN_; nwg = NE * PM * PN; G = G_; c = c_; tstep = (size_t)256 * K * 2; }
    __device__ __forceinline__ bool next(int i, pg8::Unit& u) const {
        int L = i * G + c; if (L >= nwg * rep) return false; L %= nwg;
        const int per = PM * PN, e = L / per, r = L % per; u.pm = e * PM + (r % PM); u.pn = e * PN + (r / PM); u.gi = e; return true;
    }
    __device__ __forceinline__ const char* a_base(const pg8::Unit& u) const { return A + (size_t)u.pm * tstep; }
    __device__ __forceinline__ const char* b_base(const pg8::Unit& u) const { return Bt + (size_t)u.pn * tstep; }
};
struct OrderRkv {
    const char *A0, *A1, *A2, *A3, *A4, *A5, *B0, *B1, *B2, *B3; int G, c, rep;
    __device__ __forceinline__ bool next(int i, pg8::Unit& u) const {
        int L = i * G + c; if (L >= 1040 * rep) return false; L %= 1040;
        int gi, nM;
        if (L < 256) { gi = 0; nM = 64; } else if (L < 544) { gi = 1; nM = 72; L -= 256; } else if (L < 832) { gi = 2; nM = 72; L -= 544; }
        else if (L < 904) { gi = 3; nM = 72; L -= 832; } else if (L < 976) { gi = 4; nM = 72; L -= 904; } else { gi = 5; nM = 64; L -= 976; }
        u.gi = gi; u.pm = L % nM; u.pn = L / nM; return true;
    }
    __device__ __forceinline__ const char* a_base(const pg8::Unit& u) const {
        const char* a = u.gi == 0 ? A0 : u.gi == 1 ? A1 : u.gi == 2 ? A2 : u.gi == 3 ? A3 : u.gi == 4 ? A4 : A5; return a + (size_t)u.pm * (256 * 1024 * 2); }
    __device__ __forceinline__ const char* b_base(const pg8::Unit& u) const {
        const char* b = u.gi == 0 ? B0 : u.gi == 1 ? B1 : u.gi == 2 ? B2 : B3 + (size_t)(u.gi - 3) * (256 * 1024 * 2); return b + (size_t)u.pn * (256 * 1024 * 2); }
};

typedef f32x4 Acc[2][2][4][2];
__device__ __forceinline__ u32x4 pack8(f32x4 v0, f32x4 v1) { u32x4 w; w.x = pg8::cvt_pk_bf16(v0[0], v0[1]); w.y = pg8::cvt_pk_bf16(v0[2], v0[3]); w.z = pg8::cvt_pk_bf16(v1[0], v1[1]); w.w = pg8::cvt_pk_bf16(v1[2], v1[3]); return w; }
struct EpiStore {
    static constexpr bool PERM = true;
    bf16_t* O; int ldc;
    __device__ __forceinline__ void operator()(const Acc& acc, const pg8::Unit& u, int wr, int wc, int fr, int fq) const {
        const int row0 = u.pm * 256 + wr * 64 + fr, col0 = u.pn * 256 + wc * 32 + 8 * fq;
#pragma unroll
        for (int ai = 0; ai < 2; ++ai)
#pragma unroll
            for (int m = 0; m < 4; ++m) { bf16_t* rowp = O + (size_t)(row0 + ai * 128 + m * 16) * ldc + col0;
#pragma unroll
                for (int bj = 0; bj < 2; ++bj) *(u32x4*)(rowp + bj * 128) = pack8(acc[ai][bj][m][0], acc[ai][bj][m][1]); }
    }
};
template <bool BASE_BF16>
struct EpiResid {
    static constexpr bool PERM = true;
    const void* baseL; const void* baseC; bf16_t* O; const float* gate;
    __device__ __forceinline__ void operator()(const Acc& acc, const pg8::Unit& u, int wr, int wc, int fr, int fq) const {
        const int row0 = u.pm * 256 + wr * 64 + fr, col0 = u.pn * 256 + wc * 32 + 8 * fq;
        const int mr = u.pm < 64 ? (u.pm >> 3) : 8;
        const float* gt = gate + (size_t)mr * 6144;
        f32x4 g4[2][2];
#pragma unroll
        for (int bj = 0; bj < 2; ++bj)
#pragma unroll
            for (int n = 0; n < 2; ++n) g4[bj][n] = *(const f32x4*)(gt + col0 + bj * 128 + n * 4);
#pragma unroll
        for (int ai = 0; ai < 2; ++ai)
#pragma unroll
            for (int m = 0; m < 4; ++m) { const int row = row0 + ai * 128 + m * 16; bf16_t* op = O + (size_t)row * DM + col0;
#pragma unroll
                for (int bj = 0; bj < 2; ++bj) { f32x4 b0, b1;
                    if (BASE_BF16) { const bf16_t* bp = (row < ML ? (const bf16_t*)baseL + (size_t)row * DM : (const bf16_t*)baseC + (size_t)(row - ML) * DM) + col0 + bj * 128;
                        const u32x4 w = *(const u32x4*)bp; b0 = unpk4((u32x2){w.x, w.y}); b1 = unpk4((u32x2){w.z, w.w}); }
                    else { const float* bp = (row < ML ? (const float*)baseL + (size_t)row * DM : (const float*)baseC + (size_t)(row - ML) * DM) + col0 + bj * 128;
                        b0 = *(const f32x4*)bp; b1 = *(const f32x4*)(bp + 4); }
                    *(u32x4*)(op + bj * 128) = pack8(b0 + g4[bj][0] * acc[ai][bj][m][0], b1 + g4[bj][1] * acc[ai][bj][m][1]); }
                asm volatile("" ::: "memory"); }
    }
};
struct EpiAct {
    static constexpr bool PERM = true;
    bf16_t* O;
    __device__ __forceinline__ void operator()(const Acc& acc, const pg8::Unit& u, int wr, int wc, int fr, int fq) const {
        const int row0 = u.pm * 256 + wr * 64 + fr, f0 = (u.pn & 7) * 128 + wc * 32 + 8 * fq;
#pragma unroll
        for (int ai = 0; ai < 2; ++ai)
#pragma unroll
            for (int m = 0; m < 4; ++m) { bf16_t* rowp = O + (size_t)(row0 + ai * 128 + m * 16) * DM + f0;
                f32x4 o[2];
#pragma unroll
                for (int n = 0; n < 2; ++n) { const f32x4 g = acc[ai][0][m][n], up = acc[ai][1][m][n];
#pragma unroll
                    for (int j = 0; j < 4; ++j) o[n][j] = g[j] * sigmoidf_(g[j]) * up[j]; }
                *(u32x4*)rowp = pack8(o[0], o[1]); }
    }
};
struct EpiYs {
    static constexpr bool PERM = true;
    bf16_t* O; const float* selaff;
    __device__ __forceinline__ void operator()(const Acc& acc, const pg8::Unit& u, int wr, int wc, int fr, int fq) const {
        const int row0 = u.pm * 256 + wr * 64 + fr, col0 = (u.pn & 3) * 256 + wc * 32 + 8 * fq;
#pragma unroll
        for (int ai = 0; ai < 2; ++ai)
#pragma unroll
            for (int m = 0; m < 4; ++m) { const int row = row0 + ai * 128 + m * 16; const float s = selaff[row]; bf16_t* rowp = O + (size_t)row * DM + col0;
#pragma unroll
                for (int bj = 0; bj < 2; ++bj) *(u32x4*)(rowp + bj * 128) = pack8(acc[ai][bj][m][0] * s, acc[ai][bj][m][1] * s); }
    }
};
struct EpiRkv {
    static constexpr bool PERM = true;
    bf16_t *R, *K, *V, *T1;
    __device__ __forceinline__ void operator()(const Acc& acc, const pg8::Unit& u, int wr, int wc, int fr, int fq) const {
        const int row0 = u.pm * 256 + wr * 64 + fr;
        if (u.gi < 3) {
            bf16_t* O = u.gi == 0 ? R : u.gi == 1 ? K : V; const int col0 = u.pn * 256 + wc * 32 + 8 * fq;
#pragma unroll
            for (int ai = 0; ai < 2; ++ai)
#pragma unroll
                for (int m = 0; m < 4; ++m) { bf16_t* rowp = O + (size_t)(row0 + ai * 128 + m * 16) * DM + col0;
#pragma unroll
                    for (int bj = 0; bj < 2; ++bj) *(u32x4*)(rowp + bj * 128) = pack8(acc[ai][bj][m][0], acc[ai][bj][m][1]); }
        } else {
            bf16_t* O = T1 + (size_t)(u.gi - 3) * MT * 128; const int col0 = wc * 32 + 8 * fq;
#pragma unroll
            for (int ai = 0; ai < 2; ++ai)
#pragma unroll
                for (int m = 0; m < 4; ++m) *(u32x4*)(O + (size_t)(row0 + ai * 128 + m * 16) * 128 + col0) = pack8(acc[ai][0][m][0], acc[ai][0][m][1]);
        }
    }
};
__device__ __forceinline__ void ld_row_f32(const float* p, int lane, f32x4 (&v)[4]) {
#pragma unroll
    for (int j = 0; j < 4; ++j) v[j] = *(const f32x4*)(p + 256 * j + 4 * lane);
}
__device__ __forceinline__ void ld_row_bf16(const bf16_t* p, int lane, f32x4 (&v)[4]) {
#pragma unroll
    for (int j = 0; j < 4; ++j) v[j] = unpk4(*(const u32x2*)(p + 256 * j + 4 * lane));
}
__device__ __forceinline__ void st_row_f32(float* p, int lane, const f32x4 (&v)[4]) {
#pragma unroll
    for (int j = 0; j < 4; ++j) *(f32x4*)(p + 256 * j + 4 * lane) = v[j];
}
__device__ __forceinline__ void st_row_bf16(bf16_t* p, int lane, const f32x4 (&v)[4]) {
#pragma unroll
    for (int j = 0; j < 4; ++j) *(u32x2*)(p + 256 * j + 4 * lane) = pk4(v[j]);
}
template <int R>
__device__ __forceinline__ void ada_rows(f32x4 (&v)[R][4], const float* g, const float* const (&sh)[R], const float* const (&sc)[R], int lane) {
    float ss[R];
#pragma unroll
    for (int r = 0; r < R; ++r) { ss[r] = 0.f;
#pragma unroll
        for (int j = 0; j < 4; ++j) ss[r] += (v[r][j].x * v[r][j].x + v[r][j].y * v[r][j].y) + (v[r][j].z * v[r][j].z + v[r][j].w * v[r][j].w); }
#pragma unroll
    for (int o = 1; o < 64; o <<= 1) {
#pragma unroll
        for (int r = 0; r < R; ++r) ss[r] += __shfl_xor(ss[r], o); }
#pragma unroll
    for (int j = 0; j < 4; ++j) { const f32x4 gg = *(const f32x4*)(g + 256 * j + 4 * lane);
#pragma unroll
        for (int r = 0; r < R; ++r) { const float rinv = rsqf_(ss[r] * (1.0f / DM) + 1e-6f);
            const f32x4 s = *(const f32x4*)(sc[r] + 256 * j + 4 * lane), h = *(const f32x4*)(sh[r] + 256 * j + 4 * lane);
            v[r][j] = (v[r][j] * rinv) * gg * (s + 1.0f) + h; } }
}

__device__ __forceinline__ void transpose_item64(const float* W, int N, bf16_t* WT, int ldk, LAS float* scr, int k0, int n0, int drow0, int lane) {
    float tv[64];
#pragma unroll
    for (int i = 0; i < 64; ++i) tv[i] = W[(size_t)(k0 + i) * N + n0 + lane];
#pragma unroll
    for (int i = 0; i < 64; ++i) scr[i * 65 + lane] = tv[i];
    LDS_WAIT(); asm volatile("" ::: "memory");
    const int c = lane & 7;
#pragma unroll
    for (int j = 0; j < 8; ++j) { const int n = (lane >> 3) + 8 * j; const LAS float* s = scr + (8 * c) * 65 + n;
        u32x4 o; o.x = pk2(s[0 * 65], s[1 * 65]); o.y = pk2(s[2 * 65], s[3 * 65]); o.z = pk2(s[4 * 65], s[5 * 65]); o.w = pk2(s[6 * 65], s[7 * 65]);
        *(u32x4*)(WT + (size_t)(drow0 + n) * ldk + k0 + 8 * c) = o; }
    LDS_WAIT(); asm volatile("" ::: "memory");
}
__device__ __forceinline__ void transpose_item(const float* W, int N, bf16_t* WT, int ldk, LAS float* scr, int k0, int n0, int drow0, int lane) {
#pragma unroll 8
    for (int i = 0; i < 32; ++i) { const int kk = 2 * i + (lane >> 5); scr[kk * 33 + (lane & 31)] = W[(size_t)(k0 + kk) * N + n0 + (lane & 31)]; }
    LDS_WAIT(); asm volatile("" ::: "memory");
    const int c = lane & 7;
#pragma unroll
    for (int j = 0; j < 4; ++j) { const int n = (lane >> 3) + 8 * j; const LAS float* s = scr + (8 * c) * 33 + n;
        u32x4 o; o.x = pk2(s[0 * 33], s[1 * 33]); o.y = pk2(s[2 * 33], s[3 * 33]); o.z = pk2(s[4 * 33], s[5 * 33]); o.w = pk2(s[6 * 33], s[7 * 33]);
        *(u32x4*)(WT + (size_t)(drow0 + n) * ldk + k0 + 8 * c) = o; }
    LDS_WAIT(); asm volatile("" ::: "memory");
}
__device__ __forceinline__ void moe_convert_item(const Params& p, int layer, int it, LAS float* scr, int lane) {
    const int e = it / 768, r = it % 768, which = r / 256, li = r % 256, k0 = 64 * (li / 16), n0 = 64 * (li % 16);
    const size_t woff = (size_t)(layer * NE + e) * 1024 * 1024;
    if (which == 0)      transpose_item64(p.in[I_WGATE] + woff, 1024, (bf16_t*)(p.ws + (layer ? WS_WGU1 : WS_WGU_T)) + (size_t)e * 2048 * 1024, 1024, scr, k0, n0, (n0 >> 7) * 256 + (n0 & 127), lane);
    else if (which == 1) transpose_item64(p.in[I_WUP] + woff, 1024, (bf16_t*)(p.ws + (layer ? WS_WGU1 : WS_WGU_T)) + (size_t)e * 2048 * 1024, 1024, scr, k0, n0, (n0 >> 7) * 256 + 128 + (n0 & 127), lane);
    else                 transpose_item64(p.in[I_WDOWN] + woff, 1024, (bf16_t*)(p.ws + (layer ? WS_WD1 : WS_WD_T)) + (size_t)e * 1024 * 1024, 1024, scr, k0, n0, n0, lane);
}
constexpr int P0_NMOD = 768, P0_NSMALL = 5760, P0_NZERO = 384, P0_NMOE = 16 * 768;
#ifndef P2_CONV_ITEMS
#define P2_CONV_ITEMS 3584
#endif
#ifndef P5_CONV_ITEMS
#define P5_CONV_ITEMS 12288
#endif
#ifndef L1_A
#define L1_A 1800
#endif
#ifndef L1_B
#define L1_B 4600
#endif
#ifndef L1_C
#define L1_C 8100
#endif
constexpr int P8_GEMM_WGS = 231, P9_GEMM_WGS = 192, P12_GEMM_WGS = 208;
constexpr int P2_GEMM_WGS = 216;
constexpr int P5_GEMM_WGS = 144;
constexpr int CTL_Q0 = 8192, CTL_DONE = 8256;
__device__ __forceinline__ void moe_fill(const Params& p, LAS unsigned char* lds, int layer, unsigned* qword, unsigned* done, int G, int wave, int lane) {
    volatile LAS int* jw = (volatile LAS int*)(lds + 133120);
    LAS float* scr = (LAS float*)(lds + wave * 16640);
    constexpr int NJOBS = P0_NMOE / 8;
    __syncthreads();
    if (done && TID_ == 0) __hip_atomic_fetch_add(done, 1u, __ATOMIC_RELAXED, __HIP_MEMORY_SCOPE_AGENT);
    for (;;) {
        if (TID_ == 0) {
            bool go = true;
            if (done) go = __hip_atomic_load(done, __ATOMIC_RELAXED, __HIP_MEMORY_SCOPE_AGENT) < (unsigned)G;
            int j = NJOBS;
            if (go && __hip_atomic_load(qword, __ATOMIC_RELAXED, __HIP_MEMORY_SCOPE_AGENT) < (unsigned)NJOBS) j = (int)__hip_atomic_fetch_add(qword, 1u, __ATOMIC_RELAXED, __HIP_MEMORY_SCOPE_AGENT);
            *jw = j;
        }
        __syncthreads();
        const int j = *jw;
        __syncthreads();
        if (j >= NJOBS) break;
        moe_convert_item(p, layer, j * 8 + wave, scr, lane);
    }
}
__device__ __forceinline__ void small_convert_item(const Params& p, int it, LAS float* scr, int lane) {
    const float* W; int K, N, ldk; bf16_t* WT; int base;
    unsigned char* ws = p.ws;
    if (it < 2304)      { base = 0;    W = p.in[I_WIN];  K = 1024; N = 4608; WT = (bf16_t*)(ws + WS_WIN_T);  ldk = 1024; }
    else if (it < 3328) { base = 2304; W = p.in[I_WOUT]; K = 2048; N = 1024; WT = (bf16_t*)(ws + WS_WOUT_T); ldk = 2048; }
    else if (it < 3840) { base = 3328; W = p.in[I_WR];   K = 1024; N = 1024; WT = (bf16_t*)(ws + WS_WR_T);   ldk = 1024; }
    else if (it < 4352) { base = 3840; W = p.in[I_WK];   K = 1024; N = 1024; WT = (bf16_t*)(ws + WS_WK_T);   ldk = 1024; }
    else if (it < 4864) { base = 4352; W = p.in[I_WV];   K = 1024; N = 1024; WT = (bf16_t*)(ws + WS_WV_T);   ldk = 1024; }
    else if (it < 5376) { base = 4864; W = p.in[I_WO];   K = 1024; N = 1024; WT = (bf16_t*)(ws + WS_WO_T);   ldk = 1024; }
    else if (it < 5408) { base = 5376; W = p.in[I_W1];             K = 1024; N = 64;  WT = (bf16_t*)(ws + WS_WL1_T);                      ldk = 1024; }
    else if (it < 5440) { base = 5408; W = p.in[I_W1] + 1024 * 64; K = 1024; N = 64;  WT = (bf16_t*)(ws + WS_WL1_T) + 64 * 1024;          ldk = 1024; }
    else if (it < 5472) { base = 5440; W = p.in[I_A1];             K = 1024; N = 64;  WT = (bf16_t*)(ws + WS_WL1_T) + 256 * 1024;         ldk = 1024; }
    else if (it < 5504) { base = 5472; W = p.in[I_A1] + 1024 * 64; K = 1024; N = 64;  WT = (bf16_t*)(ws + WS_WL1_T) + (256 + 64) * 1024;  ldk = 1024; }
    else if (it < 5568) { base = 5504; W = p.in[I_G1];             K = 1024; N = 128; WT = (bf16_t*)(ws + WS_WL1_T) + 512 * 1024;         ldk = 1024; }
    else if (it < 5600) { base = 5568; W = p.in[I_W2];             K = 64;   N = 1024; WT = (bf16_t*)(ws + WS_W2T);                       ldk = 64; }
    else if (it < 5632) { base = 5600; W = p.in[I_W2] + 64 * 1024; K = 64;   N = 1024; WT = (bf16_t*)(ws + WS_W2T) + 1024 * 64;           ldk = 64; }
    else if (it < 5664) { base = 5632; W = p.in[I_A2];             K = 64;   N = 1024; WT = (bf16_t*)(ws + WS_A2T);                       ldk = 64; }
    else if (it < 5696) { base = 5664; W = p.in[I_A2] + 64 * 1024; K = 64;   N = 1024; WT = (bf16_t*)(ws + WS_A2T) + 1024 * 64;           ldk = 64; }
    else                { base = 5696; W = p.in[I_G2];             K = 128;  N = 1024; WT = (bf16_t*)(ws + WS_G2T);                       ldk = 128; }
    const int li = it - base, nblk = N / 32, k0 = 64 * (li / nblk), n0 = 32 * (li % nblk);
    (void)K;
    transpose_item(W, N, WT, ldk, scr, k0, n0, n0, lane);
}
__device__ __forceinline__ void phase_prep(const Params& p, LAS unsigned char* lds, int gw, int NGW, int wave, int lane, bool skip_mod) {
    LAS float* S = (LAS float*)lds;
    for (int i = TID_; i < 9 * 1024; i += 512) { const float c = i < 8192 ? p.in[I_C][i] : p.in[I_CCTX][i - 8192]; S[i] = c * sigmoidf_(c); }
    __syncthreads();
    float* mod = (float*)(p.ws + WS_MOD);
    if (!skip_mod) {
        LAS float* part = (LAS float*)(lds + 36864);
        for (int it = blockIdx.x; it < 192; it += gridDim.x) {
            const int l = it / 96, nch = it % 96, n = nch * 64 + lane, kb = wave * 128;
            const float* w = p.in[I_ADAW] + ((size_t)l * 1024 + kb) * 6144 + n;
            float acc[9];
#pragma unroll
            for (int r9 = 0; r9 < 9; ++r9) acc[r9] = 0.f;
            for (int k = 0; k < 128; k += 32) {
                float wv[32];
#pragma unroll
                for (int u = 0; u < 32; ++u) wv[u] = w[(size_t)(k + u) * 6144];
#pragma unroll
                for (int u = 0; u < 32; ++u)
#pragma unroll
                    for (int r9 = 0; r9 < 9; ++r9) acc[r9] += S[r9 * 1024 + kb + k + u] * wv[u];
            }
#pragma unroll
            for (int r9 = 0; r9 < 9; ++r9) part[(wave * 9 + r9) * 64 + lane] = acc[r9];
            __syncthreads();
            for (int o = TID_; o < 576; o += 512) { const int r9 = o >> 6, col = o & 63; float s = p.in[I_ADAB][l * 6144 + nch * 64 + col];
#pragma unroll
                for (int w8 = 0; w8 < 8; ++w8) s += part[(w8 * 9 + r9) * 64 + col];
                mod[(size_t)(l * 9 + r9) * 6144 + nch * 64 + col] = s; }
            __syncthreads();
        }
    }
    __syncthreads();
    LAS float* scr = (LAS float*)(lds + wave * 16640);
    const int NIT = P0_NSMALL + P0_NZERO + P0_NMOE - P5_CONV_ITEMS;
    for (int it = gw; it < NIT; it += NGW) {
        if (it < P0_NSMALL) {
            small_convert_item(p, it, scr, lane);
        } else if (it < P0_NSMALL + P0_NZERO) {
            const int r = it - P0_NSMALL, g = r >> 7, row = 128 + (r & 127);
            bf16_t* dst = (bf16_t*)(p.ws + WS_WL1_T) + (size_t)(g * 256 + row) * 1024;
            *(u32x4*)(dst + lane * 8) = (u32x4){0u, 0u, 0u, 0u}; *(u32x4*)(dst + 512 + lane * 8) = (u32x4){0u, 0u, 0u, 0u};
        } else {
            moe_convert_item(p, 0, P5_CONV_ITEMS + it - P0_NSMALL - P0_NZERO, scr, lane);
        }
    }
    float* rope = (float*)(p.ws + WS_ROPE);
    for (int idx = gw * 64 + lane; idx < SEQ * 64; idx += NGW * 64) { const int t = idx >> 6, j = idx & 63;
        const float ang = (float)(j < 32 ? (t >> 6) : (t & 63)) * powf(10000.0f, -(float)(j & 31) / 32.0f);
        rope[idx] = cosf(ang); rope[SEQ * 64 + idx] = sinf(ang); }
}

__device__ __forceinline__ void phase_prenorm0(const Params& p, int gw, int NGW, int lane) {
    const float* mod = (const float*)(p.ws + WS_MOD);
    bf16_t* H = (bf16_t*)(p.ws + WS_H);
    constexpr int R = 4;
    for (int row0 = gw * R; row0 < MT; row0 += NGW * R) {
        const float* xr = row0 < ML ? p.in[I_X] + (size_t)row0 * DM : p.in[I_CTX] + (size_t)(row0 - ML) * DM;
        const int mr = row0 < ML ? (row0 >> 11) : 8;
        const float* m = mod + (size_t)mr * 6144;
        f32x4 v[R][4];
#pragma unroll
        for (int r = 0; r < R; ++r) ld_row_f32(xr + (size_t)r * DM, lane, v[r]);
        const float* const sh[R] = {m, m, m, m}; const float* const sc[R] = {m + 1024, m + 1024, m + 1024, m + 1024};
        ada_rows<R>(v, p.in[I_NORMG], sh, sc, lane);
#pragma unroll
        for (int r = 0; r < R; ++r) st_row_bf16(H + (size_t)(row0 + r) * DM, lane, v[r]);
    }
}

__device__ __forceinline__ void phase_qkconv(const Params& p, int gw, int NGW, int lane) {
    const bf16_t* P = (const bf16_t*)(p.ws + WS_P);
    bf16_t* Q = (bf16_t*)(p.ws + WS_Q); bf16_t* KA = (bf16_t*)(p.ws + WS_KA); bf16_t* VA = (bf16_t*)(p.ws + WS_VA); bf16_t* AO = (bf16_t*)(p.ws + WS_AO);
    const float* rope = (const float*)(p.ws + WS_ROPE);
    const int i16 = lane & 15, dlo = 8 * (i16 & 7);
    const float sgn = i16 < 8 ? -1.f : 1.f;
    float qg[8], kg[8];
#pragma unroll
    for (int j = 0; j < 8; ++j) { qg[j] = p.in[I_QG][8 * i16 + j]; kg[j] = p.in[I_KG][8 * i16 + j]; }
    for (int row0 = gw * 2; row0 < MT; row0 += NGW * 2) {
        u32x4 ra[2], rb[2], rk[2]; f32x4 cs[2][2], sn[2][2];
#pragma unroll
        for (int r = 0; r < 2; ++r) { const int row = row0 + r; const bf16_t* pr = P + (size_t)row * PROJ;
            ra[r] = *(const u32x4*)(pr + 8 * lane); rb[r] = *(const u32x4*)(pr + 512 + 8 * lane); rk[r] = *(const u32x4*)(pr + 1024 + 8 * lane);
            if (row < ML) { const float* cp = rope + (size_t)(row & 2047) * 64 + dlo; cs[r][0] = *(const f32x4*)cp; cs[r][1] = *(const f32x4*)(cp + 4); sn[r][0] = *(const f32x4*)(cp + SEQ * 64); sn[r][1] = *(const f32x4*)(cp + SEQ * 64 + 4); }
            else { cs[r][0] = (f32x4){1.f, 1.f, 1.f, 1.f}; cs[r][1] = cs[r][0]; sn[r][0] = (f32x4){0.f, 0.f, 0.f, 0.f}; sn[r][1] = sn[r][0]; } }
#pragma unroll
        for (int r = 0; r < 2; ++r) {
            const int row = row0 + r; const bool lat = row < ML;
            const int b = lat ? (row >> 11) : ((row - ML) >> 8), t = lat ? (row & 2047) : ((row - ML) & 255);
            const size_t kvrow = ((size_t)b * KVL + (lat ? CTXL + t : t)) * 256;
#pragma unroll
            for (int part = 0; part < 3; ++part) {
                float x[8], o[8]; unpk8(part == 0 ? ra[r] : part == 1 ? rb[r] : rk[r], x);
                float ss = 0.f;
#pragma unroll
                for (int j = 0; j < 8; ++j) ss += x[j] * x[j];
                const float rinv = rsqf_(allsum16(ss) * (1.0f / 128.0f) + 1e-6f);
#pragma unroll
                for (int j = 0; j < 8; ++j) { const float y = x[j] * rinv * (part == 2 ? kg[j] : qg[j]); const float other = dpp_mov<0x128>(y);
                    o[j] = y * cs[r][j >> 2][j & 3] + sgn * other * sn[r][j >> 2][j & 3]; }
                if (part == 0) *(u32x4*)(Q + (size_t)row * DM + 8 * lane) = pk8(o);
                else if (part == 1) *(u32x4*)(Q + (size_t)row * DM + 512 + 8 * lane) = pk8(o);
                else { if (lane < 32) *(u32x4*)(KA + kvrow + 8 * lane) = pk8(o); else *(u32x4*)(VA + kvrow + 8 * (lane - 32)) = rk[r]; }
            }
        }
    }
    f32x4 w0[4], w1[4], w2[4];
#pragma unroll
    for (int q4 = 0; q4 < 4; ++q4) { const int c = 16 * lane + 4 * q4; w0[q4] = *(const f32x4*)(p.in[I_CONVW] + c); w1[q4] = *(const f32x4*)(p.in[I_CONVW] + 1024 + c); w2[q4] = *(const f32x4*)(p.in[I_CONVW] + 2048 + c); }
    for (int row0 = gw * 2; row0 < MT; row0 += NGW * 2) {
        const bool lat = row0 < ML; const int t0 = lat ? (row0 & 2047) : ((row0 - ML) & 255), T = lat ? SEQ : CTXL;
        const bf16_t* pr = P + (size_t)row0 * PROJ + 16 * lane;
        u32x4 gc[4][2], xc[4][2], gb[2][2];
#pragma unroll
        for (int r = 0; r < 4; ++r) { const bool ok = (r != 0 || t0 > 0) && (r != 3 || t0 + 2 < T); const bf16_t* q = pr + (ptrdiff_t)(r - 1) * PROJ;
#pragma unroll
            for (int hh = 0; hh < 2; ++hh) { gc[r][hh] = ok ? *(const u32x4*)(q + 2560 + 8 * hh) : (u32x4){0u, 0u, 0u, 0u}; xc[r][hh] = ok ? *(const u32x4*)(q + 3584 + 8 * hh) : (u32x4){0u, 0u, 0u, 0u}; } }
#pragma unroll
        for (int r = 0; r < 2; ++r)
#pragma unroll
            for (int hh = 0; hh < 2; ++hh) gb[r][hh] = *(const u32x4*)(pr + (size_t)r * PROJ + 1536 + 8 * hh);
#pragma unroll
        for (int hh = 0; hh < 2; ++hh) {
            float u[4][8];
#pragma unroll
            for (int r = 0; r < 4; ++r) { float a[8], b[8]; unpk8(gc[r][hh], a); unpk8(xc[r][hh], b);
#pragma unroll
                for (int j = 0; j < 8; ++j) u[r][j] = a[j] * b[j]; }
#pragma unroll
            for (int r = 0; r < 2; ++r) { float g[8], o[8]; unpk8(gb[r][hh], g);
#pragma unroll
                for (int j = 0; j < 8; ++j) { const int q4 = 2 * hh + (j >> 2), e = j & 3; o[j] = g[j] * (u[r][j] * w0[q4][e] + u[r + 1][j] * w1[q4][e] + u[r + 2][j] * w2[q4][e]); }
                *(u32x4*)(AO + (size_t)(row0 + r) * 2048 + 1024 + 16 * lane + 8 * hh) = pk8(o); }
        }
    }
}

namespace attn {
constexpr int D = 128, NW = 8, QBLK = 32, KVBLK = 64;
constexpr float SCALE = 0.088388347648318440f;
constexpr float THR = 8.f;
constexpr size_t SHM_V = KVBLK * D * 2, SHM_K = KVBLK * D * 2, SHM_ATTN = 2 * SHM_V + 2 * SHM_K + NW * 64 * 4;
#define KSWZ(row, colB) ((row) * 256 + ((colB) ^ (((row) & 7) << 4)))
#define SBAR() __builtin_amdgcn_sched_barrier(0)
__device__ __forceinline__ int crow(int r, int hi) { return (r & 3) + 8 * (r >> 2) + 4 * hi; }
__device__ __forceinline__ unsigned cvtpk(float lo, float hi) { unsigned r; asm volatile("v_cvt_pk_bf16_f32 %0, %1, %2" : "=v"(r) : "v"(lo), "v"(hi)); return r; }
__device__ __forceinline__ void partialSM(f32x16& p0, f32x16& p1, float& m_reg, float& mn, float& alpha) {
  constexpr float C = SCALE * 1.4426950408889634f;
  float pmax = p0[0]; for (int r = 1; r < 16; ++r) pmax = fmaxf(pmax, p0[r]); for (int r = 0; r < 16; ++r) pmax = fmaxf(pmax, p1[r]);
  { auto rr = __builtin_amdgcn_permlane32_swap(__float_as_uint(pmax), __float_as_uint(pmax), false, false);
    pmax = fmaxf(__uint_as_float(rr[0]), __uint_as_float(rr[1])); }
  if (__builtin_expect(__all(pmax - m_reg <= THR / SCALE), 1)) { mn = m_reg; alpha = 1.f; }
  else { mn = fmaxf(m_reg, pmax); alpha = __builtin_amdgcn_exp2f((m_reg - mn) * C); m_reg = mn; }
  float mnC = -mn * C;
  for (int r = 0; r < 16; ++r) p0[r] = fmaf(p0[r], C, mnC); for (int r = 0; r < 16; ++r) p1[r] = fmaf(p1[r], C, mnC);
  for (int r = 0; r < 16; ++r) p0[r] = __builtin_amdgcn_exp2f(p0[r]);
}
__device__ __forceinline__ void finishSM(f32x16& p0, f32x16& p1, float alpha, float& l_reg, bf16x8& pa0, bf16x8& pa1, bf16x8& pa2, bf16x8& pa3) {
  for (int r = 0; r < 16; ++r) p1[r] = __builtin_amdgcn_exp2f(p1[r]);
  float ps = 0; for (int r = 0; r < 16; ++r) ps += p0[r]; for (int r = 0; r < 16; ++r) ps += p1[r];
  { auto rr = __builtin_amdgcn_permlane32_swap(__float_as_uint(ps), __float_as_uint(ps), false, false);
    ps = __uint_as_float(rr[0]) + __uint_as_float(rr[1]); }
  l_reg = l_reg * alpha + ps;
#define PK4(P, BASE, OUT) do { unsigned a0 = cvtpk(P[BASE + 0], P[BASE + 1]), a1 = cvtpk(P[BASE + 2], P[BASE + 3]);   \
    unsigned b0 = cvtpk(P[BASE + 4], P[BASE + 5]), b1 = cvtpk(P[BASE + 6], P[BASE + 7]);                              \
    auto r0 = __builtin_amdgcn_permlane32_swap(a0, b0, false, false); auto r1 = __builtin_amdgcn_permlane32_swap(a1, b1, false, false); \
    u32x4 w = {r0[0], r1[0], r0[1], r1[1]}; OUT = *reinterpret_cast<bf16x8*>(&w); } while (0)
  PK4(p0, 0, pa0); PK4(p0, 8, pa1); PK4(p1, 0, pa2); PK4(p1, 8, pa3);
#undef PK4
}
__device__ __forceinline__ void qkt(f32x16& p0, f32x16& p1, const bf16_t* Ks, const bf16x8* qr, int r32, int hi) {
  p0 = f32x16{}; p1 = f32x16{};
  for (int d0 = 0; d0 < 8; ++d0) { int cb = (d0 * 16 + hi * 8) * 2;
    bf16x8 b0 = *reinterpret_cast<const bf16x8*>((const char*)Ks + KSWZ(r32, cb));
    bf16x8 b1 = *reinterpret_cast<const bf16x8*>((const char*)Ks + KSWZ(32 + r32, cb));
    p0 = __builtin_amdgcn_mfma_f32_32x32x16_bf16(b0, qr[d0], p0, 0, 0, 0);
    p1 = __builtin_amdgcn_mfma_f32_32x32x16_bf16(b1, qr[d0], p1, 0, 0, 0); }
}
__device__ __forceinline__ int v_st(int k, int c) { const int kk = (k & ~0xC) | ((k & 4) << 1) | ((k & 8) >> 1); return ((kk >> 3) * 4 + (c >> 5)) * 512 + ((kk & 7) * 32 + (c & 31)) * 2; }
__device__ __forceinline__ int v_rd_base(int lane) { return ((lane & 3) << 3) | (((lane >> 2) & 3) << 6) | (((lane >> 4) & 1) << 5) | (((lane >> 5) & 1) << 8); }
constexpr int v_rd_off(int d0, int ks, int half) { return d0 * 512 + ks * 4096 + half * 2048; }
template <int OFF> __device__ __forceinline__ s16x4 tr_read(int vb) {
  s16x4 r; asm volatile("ds_read_b64_tr_b16 %0, %1 offset:%2" : "=&v"(r) : "v"(vb), "i"(OFF) : "memory"); return r;
}
template <int D0> __device__ __forceinline__ void pv_one(f32x16& od, int vb, bf16x8 pa0, bf16x8 pa1, bf16x8 pa2, bf16x8 pa3) {
  const s16x4 l0 = tr_read<v_rd_off(D0, 0, 0)>(vb), h0 = tr_read<v_rd_off(D0, 0, 1)>(vb), l1 = tr_read<v_rd_off(D0, 1, 0)>(vb), h1 = tr_read<v_rd_off(D0, 1, 1)>(vb);
  const s16x4 l2 = tr_read<v_rd_off(D0, 2, 0)>(vb), h2 = tr_read<v_rd_off(D0, 2, 1)>(vb), l3 = tr_read<v_rd_off(D0, 3, 0)>(vb), h3 = tr_read<v_rd_off(D0, 3, 1)>(vb);
  asm volatile("s_waitcnt lgkmcnt(0)" ::: "memory"); SBAR();
#define PK(L, H) (bf16x8){L[0], L[1], L[2], L[3], H[0], H[1], H[2], H[3]}
  od = __builtin_amdgcn_mfma_f32_32x32x16_bf16(pa0, PK(l0, h0), od, 0, 0, 0);
  od = __builtin_amdgcn_mfma_f32_32x32x16_bf16(pa1, PK(l1, h1), od, 0, 0, 0);
  od = __builtin_amdgcn_mfma_f32_32x32x16_bf16(pa2, PK(l2, h2), od, 0, 0, 0);
  od = __builtin_amdgcn_mfma_f32_32x32x16_bf16(pa3, PK(l3, h3), od, 0, 0, 0);
#undef PK
}
__device__ __forceinline__ void pv_d0(f32x16* o, int vb, bf16x8 pa0, bf16x8 pa1, bf16x8 pa2, bf16x8 pa3) {
  pv_one<0>(o[0], vb, pa0, pa1, pa2, pa3); pv_one<1>(o[1], vb, pa0, pa1, pa2, pa3); pv_one<2>(o[2], vb, pa0, pa1, pa2, pa3); pv_one<3>(o[3], vb, pa0, pa1, pa2, pa3);
}
template <int LDQ, int LDK, int LDO>
__device__ __forceinline__ void attn_dense_body(const bf16_t* __restrict__ Qb, const bf16_t* __restrict__ Kh, const bf16_t* __restrict__ Vh,
                                                bf16_t* __restrict__ Ob, int seq, char* lds) {
  constexpr int SDEPTH = 2;
  const int tid = TID_, wid = tid >> 6, lane = tid & 63, r32 = lane & 31, hi = lane >> 5;
  bf16_t* V_lds = (bf16_t*)lds; bf16_t* K_lds = (bf16_t*)(lds + 2 * SHM_V);
  float* ws = (float*)(lds + 2 * SHM_V + 2 * SHM_K) + wid * 64; float* li_l = ws; float* al_l = ws + 32;
  float m_reg = -1e30f, l_reg = 0; f32x16 o[4] = {}; bf16x8 qr[8];
  const bf16_t* Qw = Qb + (long)(wid * QBLK + r32) * LDQ + hi * 8;
#pragma unroll
  for (int d0 = 0; d0 < 8; ++d0) qr[d0] = *reinterpret_cast<const bf16x8*>(Qw + d0 * 16);
  const int sr = tid >> 4, sc = (tid & 15) * 8, vst0 = v_st(sr, sc), vst1 = v_st(32 + sr, sc);
  const int vb0 = (int)(uintptr_t)V_lds + v_rd_base(lane);
  struct { bf16x8 vs0, vs1, ks0, ks1; } sr_[SDEPTH];
#define SLOAD(i, k0) do { sr_[i].vs0 = *reinterpret_cast<const bf16x8*>(&Vh[(long)((k0) + sr) * LDK + sc]); sr_[i].vs1 = *reinterpret_cast<const bf16x8*>(&Vh[(long)((k0) + 32 + sr) * LDK + sc]); \
    sr_[i].ks0 = *reinterpret_cast<const bf16x8*>(&Kh[(long)((k0) + sr) * LDK + sc]); sr_[i].ks1 = *reinterpret_cast<const bf16x8*>(&Kh[(long)((k0) + 32 + sr) * LDK + sc]); } while (0)
#define SWRITE(b, i) do { *(bf16x8*)((char*)V_lds + (b) * SHM_V + vst0) = sr_[i].vs0;          \
    *(bf16x8*)((char*)V_lds + (b) * SHM_V + vst1) = sr_[i].vs1; int kc = sc * 2;               \
    *(bf16x8*)((char*)K_lds + (b) * SHM_K + KSWZ(sr, kc)) = sr_[i].ks0;                       \
    *(bf16x8*)((char*)K_lds + (b) * SHM_K + KSWZ(32 + sr, kc)) = sr_[i].ks1; } while (0)
#define SWAIT() do { asm volatile("s_waitcnt vmcnt(4)" ::: "memory"); } while (0)
#define RESC(a) do { if (__any((a) < 1.f)) { if (hi == 0) al_l[r32] = (a); asm volatile("s_waitcnt lgkmcnt(0)" ::: "memory"); \
    for (int d = 0; d < 4; ++d) for (int r = 0; r < 16; ++r) o[d][r] *= al_l[crow(r, hi)]; } } while (0)
  f32x16 pA0, pA1, pB0, pB1; float mnA, mnB, alA, alB; bf16x8 pa0, pa1, pa2, pa3; const int NT = seq / KVBLK;
  constexpr int SE = 0, SO = SDEPTH - 1;
  SLOAD(SE, 0); asm volatile("s_waitcnt vmcnt(0)" ::: "memory"); SWRITE(0, SE); __syncthreads();
  qkt(pA0, pA1, K_lds, qr, r32, hi); partialSM(pA0, pA1, m_reg, mnA, alA);
  SLOAD(SO, KVBLK); if (2 < NT) SLOAD(SE, 2 * KVBLK);
  SWAIT(); SWRITE(1, SO); __syncthreads();
  for (int j = 1; j + 1 < NT; j += 2) {
    SBAR(); qkt(pB0, pB1, (bf16_t*)((char*)K_lds + SHM_K), qr, r32, hi);
    finishSM(pA0, pA1, alA, l_reg, pa0, pa1, pa2, pa3); SBAR();
    SLOAD(SO, (j + SDEPTH) * KVBLK); SBAR();
    pv_d0(o, vb0, pa0, pa1, pa2, pa3); partialSM(pB0, pB1, m_reg, mnB, alB);
    __syncthreads(); SWAIT(); SWRITE(0, SE);
    RESC(alB); __syncthreads();
    SBAR(); qkt(pA0, pA1, K_lds, qr, r32, hi);
    finishSM(pB0, pB1, alB, l_reg, pa0, pa1, pa2, pa3); SBAR();
    if (j + 3 < NT) SLOAD(SE, (j + 1 + SDEPTH) * KVBLK); SBAR();
    pv_d0(o, vb0 + (int)SHM_V, pa0, pa1, pa2, pa3); partialSM(pA0, pA1, m_reg, mnA, alA);
    __syncthreads(); SWAIT(); SWRITE(1, SO);
    RESC(alA); __syncthreads();
  }
  SBAR(); qkt(pB0, pB1, (bf16_t*)((char*)K_lds + SHM_K), qr, r32, hi);
  finishSM(pA0, pA1, alA, l_reg, pa0, pa1, pa2, pa3); SBAR();
  pv_d0(o, vb0, pa0, pa1, pa2, pa3); partialSM(pB0, pB1, m_reg, mnB, alB);
  __syncthreads(); RESC(alB);
  finishSM(pB0, pB1, alB, l_reg, pa0, pa1, pa2, pa3); SBAR();
  pv_d0(o, vb0 + (int)SHM_V, pa0, pa1, pa2, pa3);
  if (hi == 0) li_l[r32] = l_reg; asm volatile("s_waitcnt lgkmcnt(0)" ::: "memory");
  float rli[16];
#pragma unroll
  for (int r = 0; r < 16; ++r) rli[r] = __builtin_amdgcn_rcpf(li_l[crow(r, hi)]);
  bf16_t* Ow = Ob + (long)(wid * QBLK) * LDO;
#pragma unroll
  for (int r = 0; r < 16; ++r) { int orow = crow(r, hi);
    for (int d0 = 0; d0 < 4; ++d0) Ow[(long)orow * LDO + d0 * 32 + r32] = (bf16_t)f2bf(o[d0][r] * rli[r]); }
#undef SLOAD
#undef SWRITE
#undef SWAIT
#undef RESC
}
#undef KSWZ
#undef SBAR
}

__device__ __forceinline__ void phase_attention(const Params& p, LAS unsigned char* lds, int G, int c) {
    const bf16_t* Q = (const bf16_t*)(p.ws + WS_Q); const bf16_t* KA = (const bf16_t*)(p.ws + WS_KA); const bf16_t* VA = (const bf16_t*)(p.ws + WS_VA); bf16_t* AO = (bf16_t*)(p.ws + WS_AO);
    for (int u = c; u < 576; u += G) {
        size_t qrow, kvoff; int h, seq;
        if (u < 512) { const int qb = u & 7, g = (u >> 3) & 3, kvh = (u >> 5) & 1, b = u >> 6; h = kvh * 4 + g; qrow = (size_t)b * SEQ + qb * 256; kvoff = (size_t)b * KVL * 256 + kvh * 128; seq = KVL; }
        else { const int uc = u - 512, b = uc >> 3; h = uc & 7; qrow = (size_t)ML + b * CTXL; kvoff = (size_t)b * KVL * 256 + (h >> 2) * 128; seq = CTXL; }
        attn::attn_dense_body<DM, 256, 2048>(Q + qrow * DM + h * 128, KA + kvoff, VA + kvoff, AO + qrow * 2048 + h * 128, seq, (char*)lds);
        __syncthreads();
    }
}
__device__ __forceinline__ void phase_moe_prenorm(const Params& p, LAS unsigned char* lds, int layer, const bf16_t* X, int nrows, bf16_t* H2, int gw, int NGW, int lane) {
    LAS float* RT = (LAS float*)lds;
    const float* router = p.in[I_ROUTER] + (size_t)layer * 1024 * 16;
    for (int i = TID_; i < 16384; i += 512) { const int k = i >> 4, e = i & 15; RT[e * 1024 + k] = router[i]; }
    __syncthreads();
    const float* mod = (const float*)(p.ws + WS_MOD) + (size_t)layer * 9 * 6144;
    float* aff = (float*)(p.ws + WS_AFF);
    const float* g = p.in[I_NORMG] + (size_t)(layer * 2 + 1) * 1024;
    constexpr int R = 4;
    for (int row0 = gw * R; row0 < nrows; row0 += NGW * R) {
        const int mr = row0 < ML ? (row0 >> 11) : 8;
        const float* m = mod + (size_t)mr * 6144;
        f32x4 v[R][4];
#pragma unroll
        for (int r = 0; r < R; ++r) ld_row_bf16(X + (size_t)(row0 + r) * DM, lane, v[r]);
        const float* const sh[R] = {m + 3072, m + 3072, m + 3072, m + 3072}; const float* const sc[R] = {m + 4096, m + 4096, m + 4096, m + 4096};
        ada_rows<R>(v, g, sh, sc, lane);
#pragma unroll
        for (int r = 0; r < R; ++r) st_row_bf16(H2 + (size_t)(row0 + r) * DM, lane, v[r]);
        float lg[R][16];
#pragma unroll
        for (int e = 0; e < 16; ++e) {
#pragma unroll
            for (int r = 0; r < R; ++r) lg[r][e] = 0.f;
#pragma unroll
            for (int j = 0; j < 4; ++j) { const f32x4 rt = *(const LAS f32x4*)(RT + e * 1024 + 256 * j + 4 * lane);
#pragma unroll
                for (int r = 0; r < R; ++r) lg[r][e] += (v[r][j].x * rt.x + v[r][j].y * rt.y) + (v[r][j].z * rt.z + v[r][j].w * rt.w); }
            asm volatile("" ::: "memory"); }
        float lgt[R];
#pragma unroll
        for (int r = 0; r < R; ++r) {
            float p8[8], p4[4], p2[2];
#pragma unroll
            for (int i = 0; i < 8; ++i) { const bool up = (lane & 32) != 0; const float keep = up ? lg[r][i + 8] : lg[r][i], send = up ? lg[r][i] : lg[r][i + 8]; p8[i] = keep + __shfl_xor(send, 32); }
#pragma unroll
            for (int i = 0; i < 4; ++i) { const bool up = (lane & 16) != 0; const float keep = up ? p8[i + 4] : p8[i], send = up ? p8[i] : p8[i + 4]; p4[i] = keep + __shfl_xor(send, 16); }
#pragma unroll
            for (int i = 0; i < 2; ++i) { const bool up = (lane & 8) != 0; const float keep = up ? p4[i + 2] : p4[i], send = up ? p4[i] : p4[i + 2]; p2[i] = keep + __shfl_xor(send, 8); }
            { const bool up = (lane & 4) != 0; const float keep = up ? p2[1] : p2[0], send = up ? p2[0] : p2[1]; lgt[r] = keep + __shfl_xor(send, 4); }
            lgt[r] += __shfl_xor(lgt[r], 2); lgt[r] += __shfl_xor(lgt[r], 1);
        }
        const int myexp = ((lane >> 5) & 1) * 8 + ((lane >> 4) & 1) * 4 + ((lane >> 3) & 1) * 2 + ((lane >> 2) & 1);
#pragma unroll
        for (int r = 0; r < R; ++r) {
            float mx = lgt[r];
#pragma unroll
            for (int o = 4; o < 64; o <<= 1) mx = fmaxf(mx, __shfl_xor(mx, o));
            const float ex = __expf(lgt[r] - mx); float sum = ex;
#pragma unroll
            for (int o = 4; o < 64; o <<= 1) sum += __shfl_xor(sum, o);
            if ((lane & 3) == 0) aff[(size_t)(row0 + r) * 16 + myexp] = ex * rcpf_(sum);
        }
    }
}

__device__ __forceinline__ int block_exscan(int flag, volatile LAS int* sm, int wave, int lane, int& tot) {
    const unsigned long long bal = __ballot(flag != 0);
    const int pre = __popcll(bal & ((1ull << lane) - 1ull)), wtot = __popcll(bal);
    __syncthreads();
    if (lane == 0) sm[wave] = wtot;
    __syncthreads();
    int base = 0, t = 0;
#pragma unroll
    for (int w = 0; w < 8; ++w) { const int x = sm[w]; base += (w < wave) ? x : 0; t += x; }
    tot = t; return base + pre;
}
__device__ __forceinline__ int block_sum(int v, volatile LAS int* sm, int wave, int lane) {
    v = wave_sum_i(v);
    __syncthreads();
    if (lane == 0) sm[wave] = v;
    __syncthreads();
    int t = 0;
#pragma unroll
    for (int w = 0; w < 8; ++w) t += sm[w];
    return t;
}
__device__ __forceinline__ void phase_select(const Params& p, LAS unsigned char* lds, int ntasks, int SL, int G, int c, int wave, int lane) {
    volatile LAS int* sm = (volatile LAS int*)lds;
    const float* aff = (const float*)(p.ws + WS_AFF);
    int* tokslot = (int*)(p.ws + WS_TOKSLOT); float* selaff = (float*)(p.ws + WS_SELAFF); int* selrow = (int*)(p.ws + WS_SELROW);
    const int tid = TID_;
    for (int tk = c; tk < ntasks; tk += G) {
        const bool lat = tk < 128; const int tt = lat ? tk : tk - 128, b = tt >> 4, e = tt & 15;
        const int n = lat ? SEQ : CTXL, cap = lat ? CAPL : CAPC, rowbase = lat ? b * SEQ : ML + b * CTXL, slotbase = lat ? b * CAPL : NB * CAPL + b * CAPC;
        unsigned key[4]; bool valid[4];
#pragma unroll
        for (int i = 0; i < 4; ++i) { const int idx = tid + 512 * i; valid[i] = idx < n; key[i] = valid[i] ? __float_as_uint(aff[(size_t)(rowbase + idx) * 16 + e]) : 0u; }
        unsigned prefix = 0u;
        for (int bit = 30; bit >= 0; --bit) {
            const unsigned cand = prefix | (1u << bit); int cnt = 0;
#pragma unroll
            for (int i = 0; i < 4; ++i) cnt += (valid[i] && key[i] >= cand) ? 1 : 0;
            if (block_sum(cnt, sm, wave, lane) >= cap) prefix = cand;
        }
        int cg = 0;
#pragma unroll
        for (int i = 0; i < 4; ++i) cg += (valid[i] && key[i] > prefix) ? 1 : 0;
        const int need_eq = cap - block_sum(cg, sm, wave, lane);
        int eqbase = 0, selbase = 0;
#pragma unroll
        for (int i = 0; i < 4; ++i) {
            const bool gt = valid[i] && key[i] > prefix, eq = valid[i] && key[i] == prefix;
            int tot; const int er = eqbase + block_exscan(eq ? 1 : 0, sm, wave, lane, tot); eqbase += tot;
            const bool sel = gt || (eq && er < need_eq);
            int tot2; const int slot = selbase + block_exscan(sel ? 1 : 0, sm, wave, lane, tot2); selbase += tot2;
            if (valid[i]) { const int row = rowbase + tid + 512 * i;
                tokslot[(size_t)row * 16 + e] = sel ? slotbase + slot : -1;
                if (sel) { selaff[(size_t)e * SL + slotbase + slot] = __uint_as_float(key[i]); selrow[(size_t)e * SL + slotbase + slot] = row; } }
        }
        __syncthreads();
    }
}

template <int R>
__device__ __forceinline__ void moe_gather_rows(const int* tokslot, const bf16_t* Ys, int SL, int row0, int lane, f32x4 (&acc)[R][4]) {
    int mys[R]; unsigned m[R]; unsigned any = 0u;
#pragma unroll
    for (int r = 0; r < R; ++r) { mys[r] = tokslot[(size_t)(row0 + r) * 16 + (lane & 15)];
#pragma unroll
        for (int j = 0; j < 4; ++j) acc[r][j] = (f32x4){0.f, 0.f, 0.f, 0.f}; }
#pragma unroll
    for (int r = 0; r < R; ++r) { m[r] = (unsigned)(__ballot(mys[r] >= 0) & 0xffffull); any |= m[r]; }
    while (any) {
        any = 0u;
#pragma unroll
        for (int r = 0; r < R; ++r) if (m[r]) { const int e = __builtin_ctz(m[r]); m[r] &= m[r] - 1u; any |= m[r]; const int s = __shfl(mys[r], e);
            const bf16_t* y = Ys + ((size_t)e * SL + s) * DM;
#pragma unroll
            for (int j = 0; j < 4; ++j) acc[r][j] += unpk4(*(const u32x2*)(y + 256 * j + 4 * lane)); }
    }
}

__device__ __forceinline__ void phase_combine_mix(const Params& p, LAS unsigned char* lds, int G, int c, int wave, int lane) {
    const float* mod0 = (const float*)(p.ws + WS_MOD); const float* mod1 = mod0 + 9 * 6144;
    const bf16_t* X1 = (const bf16_t*)(p.ws + WS_X1); bf16_t* X2 = (bf16_t*)(p.ws + WS_X2);
    const int* tokslot = (const int*)(p.ws + WS_TOKSLOT); const bf16_t* Ys = (const bf16_t*)(p.ws + WS_YS0);
    bf16_t* XR = (bf16_t*)(p.ws + WS_XR); bf16_t* XK = (bf16_t*)(p.ws + WS_XK); bf16_t* XV = (bf16_t*)(p.ws + WS_XV);
    bf16_t* XW = (bf16_t*)(p.ws + WS_XW); bf16_t* XA = (bf16_t*)(p.ws + WS_XA); bf16_t* XG = (bf16_t*)(p.ws + WS_XG);
    const float* mu = p.in[I_MU];
    constexpr int R = 4, BR = 24;
    for (int blk = c; blk < MT / BR; blk += G) {
        const int base = blk * BR, r0 = base + 3 * wave;
        int xr = wave == 0 ? base - 1 : wave == 7 ? base + BR : -1;
        if (xr >= MT) xr = -1;
        const bool has_x = xr >= 0;
        int rows[R] = {r0, r0 + 1, r0 + 2, has_x ? xr : r0};
        f32x4 v[R][4]; f32x4 acc[R][4];
        int mys[R]; unsigned m[R]; unsigned any = 0u;
#pragma unroll
        for (int r = 0; r < R; ++r) { ld_row_bf16(X1 + (size_t)rows[r] * DM, lane, v[r]); mys[r] = tokslot[(size_t)rows[r] * 16 + (lane & 15)];
#pragma unroll
            for (int j = 0; j < 4; ++j) acc[r][j] = (f32x4){0.f, 0.f, 0.f, 0.f}; }
#pragma unroll
        for (int r = 0; r < R; ++r) { m[r] = (unsigned)(__ballot(mys[r] >= 0) & 0xffffull); any |= m[r]; }
        while (any) {
            any = 0u;
#pragma unroll
            for (int r = 0; r < R; ++r) if (m[r]) { const int e = __builtin_ctz(m[r]); m[r] &= m[r] - 1u; any |= m[r]; const int s = __shfl(mys[r], e);
                const bf16_t* y = Ys + ((size_t)e * SL0 + s) * DM;
#pragma unroll
                for (int j = 0; j < 4; ++j) acc[r][j] += unpk4(*(const u32x2*)(y + 256 * j + 4 * lane)); }
        }
        const float* shp[R]; const float* scp[R];
#pragma unroll
        for (int r = 0; r < R; ++r) { const int mr = rows[r] < ML ? (rows[r] >> 11) : 8; const float* gt2 = mod0 + (size_t)mr * 6144 + 5120;
#pragma unroll
            for (int j = 0; j < 4; ++j) v[r][j] = v[r][j] + *(const f32x4*)(gt2 + 256 * j + 4 * lane) * acc[r][j];
            shp[r] = mod1 + (size_t)mr * 6144; scp[r] = shp[r] + 1024; }
#pragma unroll
        for (int r = 0; r < 3; ++r) st_row_bf16(X2 + (size_t)rows[r] * DM, lane, v[r]);
        {   const float* const sh[R] = {shp[0], shp[1], shp[2], shp[3]}; const float* const sc[R] = {scp[0], scp[1], scp[2], scp[3]};
            ada_rows<R>(v, p.in[I_NORMG] + 2 * 1024, sh, sc, lane); }
#pragma unroll
        for (int r = 0; r < R; ++r) { const int slot = rows[r] - (base - 1);
            if (r < 3 || has_x) {
#pragma unroll
                for (int j = 0; j < 4; ++j) *(LAS u32x2*)(lds + slot * 2048 + (256 * j + 4 * lane) * 2) = pk4(v[r][j]); } }
        __syncthreads();
#pragma unroll
        for (int r = 0; r < 3; ++r) {
            const int row = rows[r]; const bool lat = row < ML; const int t = lat ? (row & 2047) : ((row - ML) & 255), T = lat ? SEQ : CTXL;
            const int slot = row - (base - 1); const bool vp = t > 0, vn = t < T - 1;
#pragma unroll
            for (int j = 0; j < 4; ++j) {
                const int cc = 256 * j + 4 * lane;
                const f32x4 z0 = (f32x4){0.f, 0.f, 0.f, 0.f}; const f32x4 hp = vp ? unpk4(*(const LAS u32x2*)(lds + (slot - 1) * 2048 + cc * 2)) : z0, hn = vn ? unpk4(*(const LAS u32x2*)(lds + (slot + 1) * 2048 + cc * 2)) : z0;
                const f32x4 h = v[r][j], xx = (hp + hn) * 0.5f - h; const size_t o = (size_t)row * DM + cc;
                *(u32x2*)(XW + o) = pk4(h + xx * *(const f32x4*)(mu + 1 * 1024 + cc)); *(u32x2*)(XK + o) = pk4(h + xx * *(const f32x4*)(mu + 2 * 1024 + cc));
                *(u32x2*)(XV + o) = pk4(h + xx * *(const f32x4*)(mu + 3 * 1024 + cc)); *(u32x2*)(XA + o) = pk4(h + xx * *(const f32x4*)(mu + 4 * 1024 + cc));
                if (lat) { *(u32x2*)(XR + o) = pk4(h + xx * *(const f32x4*)(mu + 0 * 1024 + cc)); *(u32x2*)(XG + o) = pk4(h + xx * *(const f32x4*)(mu + 5 * 1024 + cc)); }
            }
        }
        __syncthreads();
    }
}

__device__ __forceinline__ bf16x8 tanh8(bf16x8 x) {
    bf16x8 o;
#pragma unroll
    for (int j = 0; j < 8; ++j) { const float v = bf2f((unsigned short)x[j]); o[j] = (short)f2bf(1.0f - 2.0f * rcpf_(1.0f + __expf(2.0f * v))); }
    return o;
}
namespace cs {
constexpr int O_V = 0, O_KQ = 2048, O_RQ = 4096, O_KKP = 6144, O_NBKP = 8192, O_KK = 10240, O_BK = 12288, O_GC = 14336, O_AT = 14592, O_ANA4 = 15104, O_AA1 = 15616, O_AA3 = 16128, SLOT = 16640;
constexpr int NSLOT = 8, WOFF = NSLOT * SLOT  , CNT_OFF = WOFF + 16384  ,
              CST_OFF = CNT_OFF + 64  ;
constexpr int NCHUNK = (CTXL + SEQ) / 16, NROUND = NCHUNK / 4;
static_assert(CST_OFF + 1280 <= RING_BYTES, "LDS");
__device__ __forceinline__ s16x4 pkbf(f32x4 v) { u32x2 w; w.x = pg8::cvt_pk_bf16(v.x, v.y); w.y = pg8::cvt_pk_bf16(v.z, v.w); return __builtin_bit_cast(s16x4, w); }
__device__ __forceinline__ f32x4 mfma16(s16x4 a, s16x4 b, f32x4 c) { return __builtin_amdgcn_mfma_f32_16x16x16bf16_1k(a, b, c, 0, 0, 0); }
__device__ __forceinline__ bf16x8 cat8(s16x4 a, s16x4 b) { return (bf16x8){a[0], a[1], a[2], a[3], b[0], b[1], b[2], b[3]}; }
__device__ __forceinline__ int step_row(int c, int s, int b, int d) { const int g = c * 16 + s; if (g < CTXL) return ML + b * CTXL + (d ? (CTXL - 1 - g) : g); const int gl = g - CTXL; return b * SEQ + (d ? (SEQ - 1 - gl) : gl); }
struct Raw { bf16x8 xw[2], xa[2]; u32x4 kb[2], vb[2], rb[2]; };
__device__ __forceinline__ void unpack16(const u32x4 (&w)[2], float (&o)[16]) {
#pragma unroll
    for (int m = 0; m < 8; ++m) { const unsigned x = w[m >> 2][m & 3]; o[2 * m] = bf2f(x & 0xffffu); o[2 * m + 1] = bf2f(x >> 16); }
}
__device__ __forceinline__ void pack16(const float (&v)[16], u32x4& lo, u32x4& hi) {
#pragma unroll
    for (int m = 0; m < 4; ++m) { lo[m] = pg8::cvt_pk_bf16(v[2 * m], v[2 * m + 1]); hi[m] = pg8::cvt_pk_bf16(v[8 + 2 * m], v[8 + 2 * m + 1]); }
}
}
__device__ __forceinline__ void phase_scan(const Params& p, LAS unsigned char* lds, int G, int c, int wave, int lane, int variant = 0) {
    using namespace cs;
    const bf16_t* RB = (const bf16_t*)(p.ws + WS_RB); const bf16_t* KB = (const bf16_t*)(p.ws + WS_KB); const bf16_t* VB = (const bf16_t*)(p.ws + WS_VB);
    const int fr = lane & 15, fq = lane >> 4;
    for (int sid = c; sid < 256; sid += G) {
        const int d = sid & 1, h = (sid >> 1) & 15, b = sid >> 5;
        const bf16_t* T1w = (const bf16_t*)(p.ws + WS_T1); const bf16_t* T1a = T1w + (size_t)MT * 128;
        const bf16_t* W2h = (const bf16_t*)(p.ws + WS_W2T) + ((size_t)d * 1024 + h * 64) * 64; const bf16_t* A2h = (const bf16_t*)(p.ws + WS_A2T) + ((size_t)d * 1024 + h * 64) * 64;
        const float* w0h = p.in[I_W0] + d * 1024 + h * 64; const float* a0h = p.in[I_A0] + d * 1024 + h * 64;
        bf16_t* Y = (bf16_t*)(p.ws + (variant ? WS_KK : (d ? WS_Y1 : WS_Y0)));
        __syncthreads();
        {   const int t_ = TID_;
            if (t_ == 0) *(volatile LAS unsigned*)(lds + cs::CNT_OFF) = 0u;
#pragma unroll
            for (int i = 0; i < 2; ++i) { const int q_ = t_ + 512 * i, m_ = q_ >> 9, ch_ = (q_ >> 3) & 63, c8_ = q_ & 7;
                *(LAS u32x4*)(lds + WOFF + m_ * 8192 + ch_ * 128 + ((c8_ ^ (ch_ & 7)) << 4)) = *(const u32x4*)((m_ ? A2h : W2h) + (size_t)ch_ * 64 + 8 * c8_); }
            if (t_ < 320) { const int a_ = t_ >> 6, c_ = t_ & 63; const float* src_ = a_ == 0 ? p.in[I_KK] + h * 64 : a_ == 1 ? p.in[I_KA] + h * 64 : a_ == 2 ? p.in[I_RK] + h * 64 : a_ == 3 ? w0h : a0h;
                *(LAS float*)(lds + CST_OFF + t_ * 4) = src_[c_]; }
        }
        __syncthreads();
        if (wave >= 4) {
            const int pw = wave - 4, step = lane >> 2, qt = lane & 3;
            float* BON = (float*)(p.ws + (variant ? WS_KK + 33 * MiB : WS_BON)) + (size_t)d * ML * 16;
            const LAS float* cst = (const LAS float*)(lds + CST_OFF);
            Raw raw, nxt;
#define CS_LOAD(raw, ch) do { const int row_ = step_row((ch), step, b, d); const size_t o_ = (size_t)row_ * DM + h * 64 + 16 * qt; \
            raw.kb[0] = *(const u32x4*)(KB + o_); raw.kb[1] = *(const u32x4*)(KB + o_ + 8); \
            raw.vb[0] = *(const u32x4*)(VB + o_); raw.vb[1] = *(const u32x4*)(VB + o_ + 8); \
            if (row_ < ML) { raw.rb[0] = *(const u32x4*)(RB + o_); raw.rb[1] = *(const u32x4*)(RB + o_ + 8); } else { raw.rb[0] = (u32x4){0u, 0u, 0u, 0u}; raw.rb[1] = (u32x4){0u, 0u, 0u, 0u}; } \
            const size_t x_ = (size_t)step_row((ch), fr, b, d) * 128 + d * 64 + 8 * fq; \
            raw.xw[0] = *(const bf16x8*)(T1w + x_); raw.xw[1] = *(const bf16x8*)(T1w + x_ + 32); raw.xa[0] = *(const bf16x8*)(T1a + x_); raw.xa[1] = *(const bf16x8*)(T1a + x_ + 32); } while (0)
            CS_LOAD(nxt, pw);
            for (int g = -1; g + 1 < NROUND; ++g) {
                const int ch = 4 * (g + 1) + pw;
                LAS unsigned char* slot = lds + (((g + 1) & 1) * 4 + pw) * SLOT;
                raw = nxt;
                if (ch + 4 < NCHUNK) CS_LOAD(nxt, ch + 4);
                if (!(variant & 1)) {
                {
                    const bf16x8 xw0 = tanh8(raw.xw[0]), xw1 = tanh8(raw.xw[1]);
#pragma unroll
                    for (int ct = 0; ct < 4; ++ct) {
                        const int chl = 16 * ct + fr; const LAS unsigned char* wrow = lds + WOFF + chl * 128;
                        const int o0 = (fq ^ (chl & 7)) << 4, o1 = ((4 + fq) ^ (chl & 7)) << 4;
                        f32x4 aw = (f32x4){0.f, 0.f, 0.f, 0.f}, aa_ = aw;
                        aw = __builtin_amdgcn_mfma_f32_16x16x32_bf16(*(const LAS bf16x8*)(wrow + o0), xw0, aw, 0, 0, 0); aw = __builtin_amdgcn_mfma_f32_16x16x32_bf16(*(const LAS bf16x8*)(wrow + o1), xw1, aw, 0, 0, 0);
                        aa_ = __builtin_amdgcn_mfma_f32_16x16x32_bf16(*(const LAS bf16x8*)(wrow + 8192 + o0), raw.xa[0], aa_, 0, 0, 0); aa_ = __builtin_amdgcn_mfma_f32_16x16x32_bf16(*(const LAS bf16x8*)(wrow + 8192 + o1), raw.xa[1], aa_, 0, 0, 0);
                        const f32x4 wb = *(const LAS f32x4*)(cst + 192 + 16 * ct + 4 * fq), ab = *(const LAS f32x4*)(cst + 256 + 16 * ct + 4 * fq);
                        f32x4 ldv, aav;
#pragma unroll
                        for (int r = 0; r < 4; ++r) { ldv[r] = -0.6065306597126334f * sigmoidf_(aw[r] + wb[r]); aav[r] = sigmoidf_(aa_[r] + ab[r]); }
                        *(LAS u32x2*)(slot + O_KK + fr * 128 + (16 * ct + 4 * fq) * 2) = pk4(ldv); *(LAS u32x2*)(slot + O_BK + fr * 128 + (16 * ct + 4 * fq) * 2) = pk4(aav);
                    }
                }
                {
                    float lgv = 0.f;
#pragma unroll
                    for (int t = 0; t < 16; ++t) { lgv += bf2f(*(const LAS unsigned short*)(slot + O_KK + t * 128 + lane * 2)); *(LAS float*)(slot + O_KKP + (t * 64 + lane) * 4) = lgv; }
                    *(LAS float*)(slot + O_GC + lane * 4) = __expf(lgv); }
                float rn;
                {
                    float ss = 0.f;
#pragma unroll
                    for (int hh = 0; hh < 2; ++hh) { float kbv[8]; unpk8(raw.kb[hh], kbv);
#pragma unroll
                        for (int i = 0; i < 8; ++i) { const float t = kbv[i] * cst[16 * qt + 8 * hh + i]; ss += t * t; } }
                    ss += dpp_mov<0xB1>(ss); ss += dpp_mov<0x4E>(ss);
                    rn = rsqf_(fmaxf(ss, 1e-24f));
                }
                u32x4 ldw[2], aaw[2]; f32x4 lgq[4];
#pragma unroll
                for (int hh = 0; hh < 2; ++hh) { ldw[hh] = *(const LAS u32x4*)(slot + O_KK + step * 128 + qt * 32 + 16 * hh); aaw[hh] = *(const LAS u32x4*)(slot + O_BK + step * 128 + qt * 32 + 16 * hh); }
#pragma unroll
                for (int qq = 0; qq < 4; ++qq) lgq[qq] = *(const LAS f32x4*)(slot + O_KKP + (step * 64 + 16 * qt + 4 * qq) * 4);
                asm volatile("s_waitcnt lgkmcnt(0)" ::: "memory");
                float bsum = 0.f;
                const int sw = (qt ^ ((step >> 1) & 3)) << 5, rowo = step * 128 + sw, hbit = (step >> 3) & 1;
#pragma unroll
                for (int qq = 0; qq < 4; ++qq) {
                    const int hh = qq >> 1, sub = qq & 1;
                    const f32x4 lg4 = lgq[qq], gc4 = *(const LAS f32x4*)(slot + O_GC + (16 * qt + 4 * qq) * 4);
                    const u32x2 ldp = sub ? (u32x2){ldw[hh].z, ldw[hh].w} : (u32x2){ldw[hh].x, ldw[hh].y}, aap = sub ? (u32x2){aaw[hh].z, aaw[hh].w} : (u32x2){aaw[hh].x, aaw[hh].y};
                    const u32x2 kbp = sub ? (u32x2){raw.kb[hh].z, raw.kb[hh].w} : (u32x2){raw.kb[hh].x, raw.kb[hh].y}, rbp = sub ? (u32x2){raw.rb[hh].z, raw.rb[hh].w} : (u32x2){raw.rb[hh].x, raw.rb[hh].y};
                    const f32x4 ld4 = unpk4(ldp), aa4 = unpk4(aap), kb4 = unpk4(kbp), rr4 = unpk4(rbp);
                    const int c0 = 16 * qt + 4 * qq;
                    const f32x4 kkw = *(const LAS f32x4*)(cst + c0), kaw = *(const LAS f32x4*)(cst + 64 + c0), rkw = *(const LAS f32x4*)(cst + 128 + c0);
                    f32x4 oKq, oRq, oKk, oBk, oKkp, oNBkp;
#pragma unroll
                    for (int i = 0; i < 4; ++i) {
                        const float e0 = __expf(lg4[i]), em = rcpf_(e0), e1 = __expf(lg4[i] - ld4[i]);
                        const float kk = kb4[i] * kkw[i] * rn;
                        const float beta = kk * aa4[i], kt_ = kb4[i] * ((aa4[i] - 1.0f) * kaw[i] + 1.0f);
                        oKq[i] = kk * e1; oRq[i] = rr4[i] * e0; oKk[i] = kt_ * em; oBk[i] = beta * em; oKkp[i] = oKk[i] * gc4[i]; oNBkp[i] = -(oBk[i] * gc4[i]);
                        bsum += rr4[i] * kt_ * rkw[i]; }
                    const int ho = (hh ^ hbit) * 16 + sub * 8;
                    *(LAS u32x2*)(slot + O_KQ + rowo + ho) = pk4(oKq); *(LAS u32x2*)(slot + O_RQ + rowo + ho) = pk4(oRq);
                    *(LAS u32x2*)(slot + O_KK + rowo + ho) = pk4(oKk); *(LAS u32x2*)(slot + O_BK + rowo + ho) = pk4(oBk);
                    *(LAS u32x2*)(slot + O_KKP + rowo + qq * 8) = pk4(oKkp); *(LAS u32x2*)(slot + O_NBKP + rowo + qq * 8) = pk4(oNBkp);
                }
                *(LAS u32x4*)(slot + O_V + rowo) = raw.vb[0]; *(LAS u32x4*)(slot + O_V + rowo + 16) = raw.vb[1];
                bsum += dpp_mov<0xB1>(bsum); bsum += dpp_mov<0x4E>(bsum);
                { const int brow = step_row(ch, step, b, d); if (qt == 0 && brow < ML) BON[(size_t)brow * 16 + h] = bsum; }
                }
                __syncthreads();
            }
            __syncthreads();
#undef CS_LOAD
        } else {
            const int j = wave;
            f32x4 z[4];
#pragma unroll
            for (int kt = 0; kt < 4; ++kt) z[kt] = (f32x4){0.f, 0.f, 0.f, 0.f};
            const int trr = 4 * fq + (fr >> 2);
            const int trbase = trr * 128 + 8 * (fr & 3), trsw = (trr >> 1) & 3;
            const int rdsw = (fr >> 1) & 3, rdq = (fq ^ (((fr >> 3) & 1) << 1)) << 3;
            __syncthreads();
            volatile LAS unsigned* ccnt = (volatile LAS unsigned*)(lds + CNT_OFF);
            for (int g = 0; g < NROUND; ++g) {
                if (!(variant & 2)) {   LAS unsigned char* dslot = lds + ((g & 1) * 4 + j) * SLOT;
                s16x4 rKq[4], rRq[4], rKk[4], rBk[4];
#pragma unroll
                for (int kt = 0; kt < 4; ++kt) { const int off = fr * 128 + ((kt ^ ((fr >> 1) & 3)) << 5) + ((fq ^ (((fr >> 3) & 1) << 1)) << 3);
                    rKq[kt] = *(const LAS s16x4*)(dslot + O_KQ + off); rRq[kt] = *(const LAS s16x4*)(dslot + O_RQ + off); rKk[kt] = *(const LAS s16x4*)(dslot + O_KK + off); rBk[kt] = *(const LAS s16x4*)(dslot + O_BK + off); }
                f32x4 dL = (f32x4){0.f, 0.f, 0.f, 0.f}, dLt = dL, dA1t = dL, dA3t = dL, dA4t = dL;
#pragma unroll
                for (int kt = 0; kt < 4; ++kt) { dL = mfma16(rKq[kt], rBk[kt], dL); dLt = mfma16(rBk[kt], rKq[kt], dLt); dA1t = mfma16(rKk[kt], rKq[kt], dA1t); dA3t = mfma16(rKk[kt], rRq[kt], dA3t); dA4t = mfma16(rBk[kt], rRq[kt], dA4t); }
                f32x4 dN, dNt, a1, a3, na4, eye;
#pragma unroll
                for (int r = 0; r < 4; ++r) { const int ROW = 4 * fq + r, COL = fr;
                    dN[r] = ROW > COL ? -dL[r] : 0.f; dNt[r] = COL > ROW ? -dLt[r] : 0.f; a1[r] = COL > ROW ? dA1t[r] : 0.f; a3[r] = COL >= ROW ? dA3t[r] : 0.f; na4[r] = COL >= ROW ? -dA4t[r] : 0.f; eye[r] = ROW == COL ? 1.f : 0.f; }
                const f32x4 z4 = (f32x4){0.f, 0.f, 0.f, 0.f};
                const s16x4 bN = pkbf(dN), bNt = pkbf(dNt);
                const f32x4 dN2 = mfma16(bNt, bN, z4), dN2t = mfma16(bN, bNt, z4);
                const s16x4 bN2 = pkbf(dN2), bN2t = pkbf(dN2t);
                const f32x4 dN4 = mfma16(bN2t, bN2, z4), dN4t = mfma16(bN2, bN2t, z4);
                const f32x4 dN8 = mfma16(pkbf(dN4t), pkbf(dN4), z4);
                const f32x4 q1 = mfma16(pkbf(eye + dN2), pkbf(eye + dNt), z4);
                const f32x4 q2 = mfma16(pkbf(eye + dN4), pkbf(q1), z4);
                const f32x4 tT = mfma16(pkbf(eye + dN8), pkbf(q2), z4);
                *(LAS s16x4*)(dslot + O_AT + lane * 8) = pkbf(tT); *(LAS s16x4*)(dslot + O_ANA4 + lane * 8) = pkbf(na4);
                *(LAS s16x4*)(dslot + O_AA1 + lane * 8) = pkbf(a1); *(LAS s16x4*)(dslot + O_AA3 + lane * 8) = pkbf(a3);
                }
                asm volatile("s_waitcnt lgkmcnt(0)" ::: "memory");
                if (lane == 0) __hip_atomic_fetch_add((LAS unsigned*)(lds + CNT_OFF), 1u, __ATOMIC_RELAXED, __HIP_MEMORY_SCOPE_WORKGROUP);
                while (*ccnt < 4u * (unsigned)(g + 1)) __builtin_amdgcn_s_sleep(0);
                asm volatile("" ::: "memory");
                if (!(variant & 4))
#pragma unroll
                for (int cc = 0; cc < 4; ++cc) {
                    const int ch = 4 * g + cc; const bool emit = ch >= CTXL / 16;
                    const LAS unsigned char* slot = lds + ((g & 1) * 4 + cc) * SLOT;
                    const s16x4 aT = *(const LAS s16x4*)(slot + O_AT + lane * 8), anA4 = *(const LAS s16x4*)(slot + O_ANA4 + lane * 8);
                    const s16x4 aA1 = *(const LAS s16x4*)(slot + O_AA1 + lane * 8), aA3 = *(const LAS s16x4*)(slot + O_AA3 + lane * 8);
                    const s16x4 vcol = __builtin_amdgcn_ds_read_tr16_b64_v4i16((LAS s16x4*)(slot + O_V + trbase + ((j ^ trsw) << 5)));
                    const f32x4 z4 = (f32x4){0.f, 0.f, 0.f, 0.f};
                    f32x4 acc = mfma16(aA1, vcol, z4), accY = z4;
                    if (emit) accY = mfma16(aA3, vcol, z4);
#pragma unroll
                    for (int pr = 0; pr < 2; ++pr) {
                        const int o0 = fr * 128 + (((2 * pr) ^ rdsw) << 5) + rdq, o1 = fr * 128 + (((2 * pr + 1) ^ rdsw) << 5) + rdq;
                        const bf16x8 bz = cat8(pkbf(z[2 * pr]), pkbf(z[2 * pr + 1]));
                        const bf16x8 aq = cat8(*(const LAS s16x4*)(slot + O_KQ + o0), *(const LAS s16x4*)(slot + O_KQ + o1));
                        acc = __builtin_amdgcn_mfma_f32_16x16x32_bf16(aq, bz, acc, 0, 0, 0);
                        if (emit) { const bf16x8 ar = cat8(*(const LAS s16x4*)(slot + O_RQ + o0), *(const LAS s16x4*)(slot + O_RQ + o1));
                            accY = __builtin_amdgcn_mfma_f32_16x16x32_bf16(ar, bz, accY, 0, 0, 0); }
                    }
                    const f32x4 U = mfma16(aT, pkbf(acc), z4);
                    const s16x4 ub = pkbf(U);
                    if (emit) { accY = mfma16(anA4, ub, accY);
#pragma unroll
                        for (int r = 0; r < 4; ++r) Y[(size_t)step_row(ch, 4 * fq + r, b, d) * DM + h * 64 + 16 * j + fr] = (bf16_t)f2bf(accY[r]); }
                    const bf16x8 bvu = cat8(vcol, ub);
#pragma unroll
                    for (int kt = 0; kt < 4; ++kt) {
                        const int to = trbase + ((kt ^ trsw) << 5);
                        const bf16x8 ak = cat8(__builtin_amdgcn_ds_read_tr16_b64_v4i16((LAS s16x4*)(slot + O_KKP + to)), __builtin_amdgcn_ds_read_tr16_b64_v4i16((LAS s16x4*)(slot + O_NBKP + to)));
                        const f32x4 gcv = *(const LAS f32x4*)(slot + O_GC + (16 * kt + 4 * fq) * 4);
                        z[kt] = __builtin_amdgcn_mfma_f32_16x16x32_bf16(ak, bvu, z[kt] * gcv, 0, 0, 0);
                    }
                }
                __syncthreads();
            }
        }
    }
}

constexpr int RO_STRIDE = 2064;
__device__ __forceinline__ bf16x8 sigm8(bf16x8 x) {
    bf16x8 o;
#pragma unroll
    for (int j = 0; j < 8; ++j) o[j] = (short)f2bf(sigmoidf_(bf2f((unsigned short)x[j])));
    return o;
}
__device__ __forceinline__ void phase_readout(const Params& p, LAS unsigned char* lds, int G, int c, int wave, int lane) {
    const bf16_t* T1g = (const bf16_t*)(p.ws + WS_T1) + (size_t)2 * MT * 128; const bf16_t* G2T = (const bf16_t*)(p.ws + WS_G2T);
    const bf16_t* RB = (const bf16_t*)(p.ws + WS_RB); const bf16_t* KB = (const bf16_t*)(p.ws + WS_KB); const bf16_t* VB = (const bf16_t*)(p.ws + WS_VB);
    const float* BON0 = (const float*)(p.ws + WS_BON); const float* BON1 = BON0 + (size_t)ML * 16;
    const bf16_t* Y0 = (const bf16_t*)(p.ws + WS_Y0); const bf16_t* Y1 = (const bf16_t*)(p.ws + WS_Y1);
    bf16_t* Z = (bf16_t*)(p.ws + WS_Z);
    const int fr = lane & 15, fq = lane >> 4;
    for (int tile = c; tile < ML / 32; tile += G) {
        const int tok0 = tile * 32;
        bf16x8 xb[2][4];
#pragma unroll
        for (int tt = 0; tt < 2; ++tt)
#pragma unroll
            for (int ks = 0; ks < 4; ++ks) xb[tt][ks] = sigm8(*(const bf16x8*)(T1g + (size_t)(tok0 + tt * 16 + fr) * 128 + 32 * ks + 8 * fq));
#pragma unroll
        for (int ct = 0; ct < 8; ++ct) {
            const int ch0 = wave * 128 + ct * 16;
            const bf16_t* wr_ = G2T + (size_t)(ch0 + fr) * 128 + 8 * fq;
            f32x4 acc0 = (f32x4){0.f, 0.f, 0.f, 0.f}, acc1 = (f32x4){0.f, 0.f, 0.f, 0.f};
#pragma unroll
            for (int ks = 0; ks < 4; ++ks) { const bf16x8 wa = *(const bf16x8*)(wr_ + 32 * ks);
                acc0 = __builtin_amdgcn_mfma_f32_16x16x32_bf16(wa, xb[0][ks], acc0, 0, 0, 0);
                acc1 = __builtin_amdgcn_mfma_f32_16x16x32_bf16(wa, xb[1][ks], acc1, 0, 0, 0); }
            *(LAS u32x2*)(lds + (fr) * RO_STRIDE + (ch0 + 4 * fq) * 2) = pk4(acc0);
            *(LAS u32x2*)(lds + (16 + fr) * RO_STRIDE + (ch0 + 4 * fq) * 2) = pk4(acc1);
        }
        __syncthreads();
        for (int i = 0; i < 4; ++i) {
            const int tl = wave * 4 + i, row = tok0 + tl; const size_t o = (size_t)row * DM + 16 * lane;
            f32x4 y[4]; float s = 0.f;
#pragma unroll
            for (int q = 0; q < 4; ++q) { y[q] = unpk4(*(const u32x2*)(Y0 + o + 4 * q)) + unpk4(*(const u32x2*)(Y1 + o + 4 * q)); s += (y[q].x + y[q].y) + (y[q].z + y[q].w); }
            s += __shfl_xor(s, 1); s += __shfl_xor(s, 2);
            const float mean = s * (1.0f / 64.0f); float vs = 0.f;
#pragma unroll
            for (int q = 0; q < 4; ++q) { y[q] = y[q] - mean; vs += (y[q].x * y[q].x + y[q].y * y[q].y) + (y[q].z * y[q].z + y[q].w * y[q].w); }
            vs += __shfl_xor(vs, 1); vs += __shfl_xor(vs, 2);
            const float rstd = rsqf_(vs * (1.0f / 64.0f) + 64e-5f);
            f32x4 v4[4];
#pragma unroll
            for (int q = 0; q < 4; ++q) v4[q] = unpk4(*(const u32x2*)(VB + o + 4 * q));
            const float bs = BON0[(size_t)row * 16 + (lane >> 2)] + BON1[(size_t)row * 16 + (lane >> 2)];
#pragma unroll
            for (int q = 0; q < 4; ++q) {
                const int cc = 16 * lane + 4 * q;
                const f32x4 lw = *(const f32x4*)(p.in[I_LNW] + cc), lb = *(const f32x4*)(p.in[I_LNB] + cc);
                const f32x4 g4 = unpk4(*(const LAS u32x2*)(lds + tl * RO_STRIDE + cc * 2));
                const f32x4 z = ((y[q] * rstd) * lw + lb + v4[q] * bs) * g4;
                *(u32x2*)(Z + o + 4 * q) = pk4(z);
            }
        }
        __syncthreads();
    }
}

__device__ __forceinline__ void phase_final(const Params& p, int gw, int NGW, int lane) {
    const float* mod1 = (const float*)(p.ws + WS_MOD) + 9 * 6144;
    const bf16_t* X3 = (const bf16_t*)(p.ws + WS_X3); const int* tokslot = (const int*)(p.ws + WS_TOKSLOT); const bf16_t* Ys = (const bf16_t*)(p.ws + WS_YS1);
    const float* fg = p.in[I_FINALG];
    constexpr int R = 4;
    for (int row0 = gw * R; row0 < ML; row0 += NGW * R) {
        const int mr = row0 >> 11;
        f32x4 v[R][4];
#pragma unroll
        for (int r = 0; r < R; ++r) ld_row_bf16(X3 + (size_t)(row0 + r) * DM, lane, v[r]);
        f32x4 acc[R][4]; moe_gather_rows<R>(tokslot, Ys, SL1, row0, lane, acc);
        const float* gt2 = mod1 + (size_t)mr * 6144 + 5120;
        float ss[R];
#pragma unroll
        for (int r = 0; r < R; ++r) ss[r] = 0.f;
#pragma unroll
        for (int j = 0; j < 4; ++j) { const f32x4 g4 = *(const f32x4*)(gt2 + 256 * j + 4 * lane);
#pragma unroll
            for (int r = 0; r < R; ++r) { v[r][j] = v[r][j] + g4 * acc[r][j]; ss[r] += (v[r][j].x * v[r][j].x + v[r][j].y * v[r][j].y) + (v[r][j].z * v[r][j].z + v[r][j].w * v[r][j].w); } }
#pragma unroll
        for (int o = 1; o < 64; o <<= 1) {
#pragma unroll
            for (int r = 0; r < R; ++r) ss[r] += __shfl_xor(ss[r], o); }
#pragma unroll
        for (int j = 0; j < 4; ++j) { const f32x4 f4 = *(const f32x4*)(fg + 256 * j + 4 * lane);
#pragma unroll
            for (int r = 0; r < R; ++r) v[r][j] = (v[r][j] * rsqf_(ss[r] * (1.0f / DM) + 1e-6f)) * f4; }
#pragma unroll
        for (int r = 0; r < R; ++r) st_row_f32(p.out + (size_t)(row0 + r) * DM, lane, v[r]);
    }
}

constexpr int NPH = 22;
__global__ void __launch_bounds__(512, 2) mega_fwd(Params p) {
    extern __shared__ __attribute__((aligned(16))) unsigned char lds_raw[];
    LAS unsigned char* lds = (LAS unsigned char*)lds_raw;
    const int tid = threadIdx.x, wave = __builtin_amdgcn_readfirstlane(tid >> 6);
    const int G = gridDim.x, bx = blockIdx.x, vcu = (G % 8 == 0) ? (bx % 8) * (G / 8) + bx / 8 : bx;
    const int gw = vcu * 8 + wave, NGW = G * 8;
    for (int u = tid; u < (LDS_BYTES - LDSCTL_OFF) / 4; u += 512) ((LAS unsigned*)(lds + LDSCTL_OFF))[u] = 0u;
    __syncthreads();
    const int lo = p.ph_lo, hi = p.ph_hi;
    XcdBarrier bar; bar.bar = (unsigned*)(p.ws + WS_CTL) + CTL_BAR_WORD; bar.x = 0; bar.st = (volatile LAS unsigned*)(lds + MISC_OFF + 32);
    if (hi - lo > 1) bar = xcd_barrier_post((unsigned*)(p.ws + WS_CTL) + CTL_BAR_WORD, (volatile LAS unsigned*)(lds + MISC_OFF + 32));
#ifndef PHMASK
#define PHMASK 0x3fffff
#endif
#define IN(k) (((PHMASK >> (k)) & 1) && lo <= (k) && (k) < hi)
#define SEAM(k) do { if (IN(k) && IN((k) + 1)) xcd_barrier(bar); } while (0)
#ifndef SCANVAR
#define SCANVAR 0
#endif
#ifndef FILLMASK
#define FILLMASK 0
#endif
#ifndef DUPMASK
#define DUPMASK 0
#endif
#define DUP(k) (((DUPMASK >> (k)) & 1) != 0)
    unsigned char* ws = p.ws;
#define ctlw ((unsigned*)(p.ws + WS_CTL))
#define gate1_l0 ((const float*)(ws + WS_MOD) + 2048)
#define gate1_l1 ((const float*)(ws + WS_MOD) + 9 * 6144 + 2048)

#define LANE_ (TID_ & 63)
    if (IN(0)) for (int rep_ = 0; rep_ < (DUP(0) ? 2 : 1); ++rep_) { if (rep_) xcd_barrier(bar); phase_prep(p, lds, gw, NGW, wave, LANE_, rep_ != 0); }
    SEAM(0);
    if (IN(1)) for (int rep_ = 0; rep_ < (DUP(1) ? 2 : 1); ++rep_) { if (rep_) xcd_barrier(bar); phase_prenorm0(p, gw, NGW, LANE_); }
    SEAM(1);
    if (IN(2)) { const int rep_ = DUP(2) ? 2 : 1;
        const bool split = (G > P2_GEMM_WGS) && P2_CONV_ITEMS > 0;
        if (!split || bx < P2_GEMM_WGS) { OrderSingle S; S.init(ws + WS_H, ws + WS_WIN_T, MT, PROJ, 1024, split ? P2_GEMM_WGS : G, bx, rep_); EpiStore E{(bf16_t*)(ws + WS_P), PROJ}; pg8::gemm_phase(lds, 1024, S, E); }
        else { LAS float* scr = (LAS float*)(lds + wave * 16640); const int ncw = (G - P2_GEMM_WGS) * 8, cw = (bx - P2_GEMM_WGS) * 8 + wave;
            for (int rr = 0; rr < rep_; ++rr) for (int it = cw; it < P2_CONV_ITEMS; it += ncw) moe_convert_item(p, 0, it, scr, LANE_); } if (!split) { __syncthreads(); LAS float* scr = (LAS float*)(lds + wave * 16640); for (int it = 0 + gw; it < P2_CONV_ITEMS; it += NGW) moe_convert_item(p, 0, it, scr, LANE_); } if (FILLMASK & 1) moe_fill(p, lds, 0, ctlw + CTL_Q0, ctlw + CTL_DONE, G, wave, LANE_); }
    SEAM(2);
    if (IN(3)) for (int rep_ = 0; rep_ < (DUP(3) ? 2 : 1); ++rep_) { if (rep_) xcd_barrier(bar); phase_qkconv(p, gw, NGW, LANE_); }
    SEAM(3);
    if (IN(4)) for (int rep_ = 0; rep_ < (DUP(4) ? 2 : 1); ++rep_) { if (rep_) xcd_barrier(bar); phase_attention(p, lds, G, vcu); if (FILLMASK & 2) moe_fill(p, lds, 0, ctlw + CTL_Q0, ctlw + CTL_DONE + 64, G, wave, LANE_); }
    SEAM(4);
    if (IN(5)) { const int rep_ = DUP(5) ? 2 : 1;
        const bool split = (G > P5_GEMM_WGS) && P5_CONV_ITEMS > 0;
        if (!split || bx < P5_GEMM_WGS) { OrderSingle S; S.init(ws + WS_AO, ws + WS_WOUT_T, MT, 1024, 2048, split ? P5_GEMM_WGS : G, bx, rep_); EpiResid<false> E{p.in[I_X], p.in[I_CTX], (bf16_t*)(ws + WS_X1), gate1_l0}; pg8::gemm_phase(lds, 2048, S, E); }
        else { LAS float* scr = (LAS float*)(lds + wave * 16640); const int ncw = (G - P5_GEMM_WGS) * 8, cw = (bx - P5_GEMM_WGS) * 8 + wave;
            for (int rr = 0; rr < rep_; ++rr) for (int it = P2_CONV_ITEMS + cw; it < P5_CONV_ITEMS; it += ncw) moe_convert_item(p, 0, it, scr, LANE_); } if (!split) { __syncthreads(); LAS float* scr = (LAS float*)(lds + wave * 16640); for (int it = P2_CONV_ITEMS + gw; it < P5_CONV_ITEMS; it += NGW) moe_convert_item(p, 0, it, scr, LANE_); } if (FILLMASK & 4) moe_fill(p, lds, 0, ctlw + CTL_Q0, ctlw + CTL_DONE + 128, G, wave, LANE_); }
    SEAM(5);
    if (IN(6)) for (int rep_ = 0; rep_ < (DUP(6) ? 2 : 1); ++rep_) { if (rep_) xcd_barrier(bar); phase_moe_prenorm(p, lds, 0, (const bf16_t*)(ws + WS_X1), MT, (bf16_t*)(ws + WS_H), gw, NGW, LANE_); }
    SEAM(6);
    if (IN(7)) for (int rep_ = 0; rep_ < (DUP(7) ? 2 : 1); ++rep_) { if (rep_) xcd_barrier(bar); phase_select(p, lds, 256, SL0, G, bx, wave, LANE_); }
    SEAM(7);
    if (IN(8)) { const int rep_ = DUP(8) ? 2 : 1; const bool split = G > P8_GEMM_WGS; if (!split || vcu < P8_GEMM_WGS) { OrderMoe S; S.init(ws + WS_H, ws + WS_WGU_T, 9, 8, 1024, split ? P8_GEMM_WGS : G, vcu, rep_); S.rowidx = (const int*)(ws + WS_SELROW); EpiAct E{(bf16_t*)(ws + WS_ACT0)}; pg8::gemm_phase<EpiAct, OrderMoe, true>(lds, 1024, S, E); } else { LAS float* scr = (LAS float*)(lds + wave * 16640); const int ncw = (G - P8_GEMM_WGS) * 8, cw = (vcu - P8_GEMM_WGS) * 8 + wave; for (int rr = 0; rr < rep_; ++rr) for (int it = 0 + cw; it < L1_A; it += ncw) moe_convert_item(p, 1, it, scr, LANE_); } if (!split) { __syncthreads(); LAS float* scr = (LAS float*)(lds + wave * 16640); for (int it = 0 + gw; it < L1_A; it += NGW) moe_convert_item(p, 1, it, scr, LANE_); } }
    SEAM(8);
    if (IN(9)) { const int rep_ = DUP(9) ? 2 : 1; const bool split = G > P9_GEMM_WGS; if (!split || vcu < P9_GEMM_WGS) { OrderMoe S; S.init(ws + WS_ACT0, ws + WS_WD_T, 9, 4, 1024, split ? P9_GEMM_WGS : G, vcu, rep_); EpiYs E{(bf16_t*)(ws + WS_YS0), (const float*)(ws + WS_SELAFF)}; pg8::gemm_phase(lds, 1024, S, E); } else { LAS float* scr = (LAS float*)(lds + wave * 16640); const int ncw = (G - P9_GEMM_WGS) * 8, cw = (vcu - P9_GEMM_WGS) * 8 + wave; for (int rr = 0; rr < rep_; ++rr) for (int it = L1_A + cw; it < L1_B; it += ncw) moe_convert_item(p, 1, it, scr, LANE_); } if (!split) { __syncthreads(); LAS float* scr = (LAS float*)(lds + wave * 16640); for (int it = L1_A + gw; it < L1_B; it += NGW) moe_convert_item(p, 1, it, scr, LANE_); } }
    SEAM(9);
    if (IN(10)) for (int rep_ = 0; rep_ < (DUP(10) ? 2 : 1); ++rep_) { if (rep_) xcd_barrier(bar); phase_combine_mix(p, lds, G, vcu, wave, LANE_); }
    SEAM(10);
    if (IN(11) && IN(12) && !IN(10)) { }
    if (IN(12)) { const int rep_ = DUP(12) ? 2 : 1; const bool split = G > P12_GEMM_WGS; if (!split || vcu < P12_GEMM_WGS) { OrderRkv S; S.A0 = (const char*)(ws + WS_XR); S.A1 = (const char*)(ws + WS_XK); S.A2 = (const char*)(ws + WS_XV); S.A3 = (const char*)(ws + WS_XW); S.A4 = (const char*)(ws + WS_XA); S.A5 = (const char*)(ws + WS_XG);
        S.B0 = (const char*)(ws + WS_WR_T); S.B1 = (const char*)(ws + WS_WK_T); S.B2 = (const char*)(ws + WS_WV_T); S.B3 = (const char*)(ws + WS_WL1_T); S.G = split ? P12_GEMM_WGS : G; S.c = vcu; S.rep = rep_;
        EpiRkv E{(bf16_t*)(ws + WS_RB), (bf16_t*)(ws + WS_KB), (bf16_t*)(ws + WS_VB), (bf16_t*)(ws + WS_T1)}; pg8::gemm_phase(lds, 1024, S, E); } else { LAS float* scr = (LAS float*)(lds + wave * 16640); const int ncw = (G - P12_GEMM_WGS) * 8, cw = (vcu - P12_GEMM_WGS) * 8 + wave; for (int rr = 0; rr < rep_; ++rr) for (int it = L1_B + cw; it < L1_C; it += ncw) moe_convert_item(p, 1, it, scr, LANE_); } if (!split) { __syncthreads(); LAS float* scr = (LAS float*)(lds + wave * 16640); for (int it = L1_B + gw; it < L1_C; it += NGW) moe_convert_item(p, 1, it, scr, LANE_); } }
    SEAM(12);
    if (IN(13)) for (int rep_ = 0; rep_ < (DUP(13) ? 2 : 1); ++rep_) { if (rep_) xcd_barrier(bar);   }
    SEAM(13);
    if (IN(14)) for (int rep_ = 0; rep_ < (DUP(14) ? 2 : 1); ++rep_) { if (rep_) xcd_barrier(bar); phase_scan(p, lds, G, bx, wave, LANE_, rep_ ? SCANVAR : 0); }
    SEAM(14);
    if (IN(15)) for (int rep_ = 0; rep_ < (DUP(15) ? 2 : 1); ++rep_) { if (rep_) xcd_barrier(bar); phase_readout(p, lds, G, vcu, wave, LANE_); }
    SEAM(15);
    if (IN(16)) { const int rep_ = DUP(16) ? 2 : 1; OrderSingle S; S.init(ws + WS_Z, ws + WS_WO_T, ML, 1024, 1024, G, bx, rep_); EpiResid<true> E{ws + WS_X2, ws + WS_X2, (bf16_t*)(ws + WS_X3), gate1_l1}; pg8::gemm_phase(lds, 1024, S, E); }
    SEAM(16);
    if (IN(17)) for (int rep_ = 0; rep_ < (DUP(17) ? 2 : 1); ++rep_) { if (rep_) xcd_barrier(bar); phase_moe_prenorm(p, lds, 1, (const bf16_t*)(ws + WS_X3), ML, (bf16_t*)(ws + WS_H2), gw, NGW, LANE_);
        __syncthreads();
        LAS float* scr = (LAS float*)(lds + wave * 16640);
        for (int it = L1_C + gw; it < P0_NMOE; it += NGW) moe_convert_item(p, 1, it, scr, LANE_); }
    SEAM(17);
    if (IN(18)) for (int rep_ = 0; rep_ < (DUP(18) ? 2 : 1); ++rep_) { if (rep_) xcd_barrier(bar); phase_select(p, lds, 128, SL1, G, bx, wave, LANE_); }
    SEAM(18);
    if (IN(19)) { const int rep_ = DUP(19) ? 2 : 1; OrderMoe S; S.init(ws + WS_H2, ws + WS_WGU1, 8, 8, 1024, G, vcu, rep_); S.rowidx = (const int*)(ws + WS_SELROW); EpiAct E{(bf16_t*)(ws + WS_ACT1)}; pg8::gemm_phase<EpiAct, OrderMoe, true>(lds, 1024, S, E); }
    SEAM(19);
    if (IN(20)) { const int rep_ = DUP(20) ? 2 : 1; OrderMoe S; S.init(ws + WS_ACT1, ws + WS_WD1, 8, 4, 1024, G, vcu, rep_); EpiYs E{(bf16_t*)(ws + WS_YS1), (const float*)(ws + WS_SELAFF)}; pg8::gemm_phase(lds, 1024, S, E); }
    SEAM(20);
    if (IN(21)) for (int rep_ = 0; rep_ < (DUP(21) ? 2 : 1); ++rep_) { if (rep_) xcd_barrier(bar); phase_final(p, gw, NGW, LANE_); }
#undef IN
#undef SEAM
}

#ifndef MK_PER_PHASE
#define MK_PER_PHASE 0
#endif
extern "C" void kernel_launch(void* const* d_in, const int* in_sizes, int n_in, void* d_out, int out_size, void* d_ws, size_t ws_size, hipStream_t stream) {
    static int grid = 0;
    if (grid == 0) {
        if (n_in != 35 || out_size != ML * DM || ws_size < WS_END) { fprintf(stderr, "kernel_launch: unexpected shapes: n_in %d out %d ws %zu (need %zu)\n", n_in, out_size, ws_size, (size_t)WS_END); grid = -1; return; }
        int dev = 0, cus = 0;
        if (hipGetDevice(&dev) != hipSuccess || hipDeviceGetAttribute(&cus, hipDeviceAttributeMultiprocessorCount, dev) != hipSuccess) { grid = -1; return; }
        if (hipFuncSetAttribute((const void*)mega_fwd, hipFuncAttributeMaxDynamicSharedMemorySize, LDS_BYTES) != hipSuccess) { fprintf(stderr, "kernel_launch: hipFuncSetAttribute failed\n"); grid = -1; return; }
        int per_cu = 0; (void)hipOccupancyMaxActiveBlocksPerMultiprocessor(&per_cu, (const void*)mega_fwd, 512, LDS_BYTES); (void)hipGetLastError();
        if (per_cu < 1) fprintf(stderr, "kernel_launch: occupancy query reports %d blocks per CU\n", per_cu);
        grid = cus;
    }
    if (grid < 0) return;
    (void)in_sizes;
    (void)hipMemsetAsync((char*)d_ws + WS_CTL, 0, 1 * MiB, stream);
    Params a{};
    for (int i = 0; i < 35; ++i) a.in[i] = (const float*)d_in[i];
    a.out = (float*)d_out; a.ws = (unsigned char*)d_ws;
#if MK_PER_PHASE
    for (int ph = 0; ph < NPH; ++ph) { a.ph_lo = ph; a.ph_hi = ph + 1; hipLaunchKernelGGL(mega_fwd, dim3(grid), dim3(512), LDS_BYTES, stream, a); }
#else
    a.ph_lo = 0; a.ph_hi = NPH; hipLaunchKernelGGL(mega_fwd, dim3(grid), dim3(512), LDS_BYTES, stream, a);
#endif
    const hipError_t le = hipPeekAtLastError();
    if (le != hipSuccess) fprintf(stderr, "kernel_launch: launch failed: %s\n", hipGetErrorName(le));
}
```

```cpp
#include <hip/hip_runtime.h>
#include <cstdio>
#include <cstdint>

#define GAS __attribute__((address_space(1)))
#define LAS __attribute__((address_space(3)))
typedef unsigned short bf16_t;
typedef short bf16x8 __attribute__((ext_vector_type(8)));
typedef short s16x4 __attribute__((ext_vector_type(4)));
typedef float f32x4 __attribute__((ext_vector_type(4)));
typedef float f32x2 __attribute__((ext_vector_type(2)));
typedef float f32x8 __attribute__((ext_vector_type(8)));
typedef float f32x16 __attribute__((ext_vector_type(16)));
typedef unsigned u32x4 __attribute__((ext_vector_type(4)));
typedef unsigned u32x2 __attribute__((ext_vector_type(2)));

constexpr int NB = 8, SEQ = 2048, CTXL = 256, DM = 1024;
constexpr int ML = NB * SEQ, MC = NB * CTXL, MT = ML + MC;
constexpr int PROJ = 4608, NE = 16;
constexpr int KVL = CTXL + SEQ;
constexpr int CAPL = 256, CAPC = 32, SL0 = NB * CAPL + NB * CAPC  , SL1 = NB * CAPL  ;

constexpr size_t MiB = 1u << 20;
constexpr size_t WS_CTL = 0;
constexpr size_t CTL_BAR_WORD = 4096;
constexpr size_t WS_MOD = 512 * 1024;
constexpr size_t WS_ROPE = 1 * MiB;
constexpr size_t WS_AFF = 2 * MiB;
constexpr size_t WS_TOKSLOT = 4 * MiB;
constexpr size_t WS_SELAFF = 6 * MiB;
constexpr size_t WS_SELROW = 7 * MiB;
constexpr size_t WS_WIN_T = 8 * MiB;
constexpr size_t WS_WOUT_T = 17 * MiB;
constexpr size_t WS_WR_T = 21 * MiB, WS_WK_T = 23 * MiB, WS_WV_T = 25 * MiB, WS_WO_T = 27 * MiB;
constexpr size_t WS_WL1_T = 29 * MiB;
constexpr size_t WS_W2T = 31 * MiB;
constexpr size_t WS_A2T = WS_W2T + 256 * 1024, WS_G2T = WS_W2T + 512 * 1024;
constexpr size_t WS_WMOE = 32 * MiB;
constexpr size_t WS_WGU_T = WS_WMOE, WS_WD_T = WS_WMOE + 64 * MiB;
constexpr size_t AB = 128 * MiB;
constexpr size_t WS_P = AB + 0 * MiB;
constexpr size_t WS_H = AB + 162 * MiB;
constexpr size_t WS_AO = AB + 198 * MiB;
constexpr size_t WS_Q = AB + 270 * MiB;
constexpr size_t WS_KA = AB + 306 * MiB, WS_VA = AB + 315 * MiB;
constexpr size_t WS_X1 = AB + 0 * MiB;
constexpr size_t WS_XS0 = AB + 72 * MiB, WS_YS0 = AB + 72 * MiB;
constexpr size_t WS_ACT0 = AB + 198 * MiB;
constexpr size_t WS_X2 = AB + 36 * MiB;
constexpr size_t WS_WGU1 = AB + 324 * MiB, WS_WD1 = AB + 388 * MiB;
constexpr size_t WS_XR = WS_WMOE, WS_XW = AB + 144 * MiB, WS_XA = AB + 180 * MiB, WS_XG = AB + 216 * MiB, WS_XV = AB + 248 * MiB, WS_XK = AB + 284 * MiB;
constexpr size_t WS_KB = AB + 0 * MiB, WS_RB = AB + 72 * MiB, WS_VB = AB + 104 * MiB, WS_T1 = WS_WMOE + 32 * MiB;
constexpr size_t WS_KK = AB + 284 * MiB;
constexpr size_t WS_Y0 = AB + 144 * MiB, WS_Y1 = AB + 176 * MiB;
constexpr size_t WS_BON = AB + 320 * MiB;
constexpr size_t WS_Z = AB + 208 * MiB;
constexpr size_t WS_X3 = AB + 240 * MiB;
constexpr size_t WS_H2 = AB + 272 * MiB;
constexpr size_t WS_ACT1 = AB + 72 * MiB, WS_YS1 = AB + 144 * MiB;
constexpr size_t WS_END = AB + 420 * MiB;

constexpr int RING_BYTES = 151552, LDSCTL_OFF = RING_BYTES, MISC_OFF = LDSCTL_OFF + 320, LDS_BYTES = 163840;

__device__ __forceinline__ int tid_opaque() { int t = (int)threadIdx.x; asm volatile("" : "+v"(t)); return t; }
#define TID_ tid_opaque()
#define LDS_WAIT() asm volatile("s_waitcnt lgkmcnt(0)" ::: "memory")
#define VM_WAIT() asm volatile("s_waitcnt vmcnt(0)" ::: "memory")
__device__ __forceinline__ float bf2f(unsigned b) { return __uint_as_float(b << 16); }
__device__ __forceinline__ unsigned f2bf(float f) { unsigned u = __float_as_uint(f); return (u + 0x7fffu + ((u >> 16) & 1u)) >> 16; }
typedef __bf16 bf16n2 __attribute__((ext_vector_type(2)));
__device__ __forceinline__ unsigned pk2(float lo, float hi) { const f32x2 v = {lo, hi}; return __builtin_bit_cast(unsigned, __builtin_convertvector(v, bf16n2)); }
__device__ __forceinline__ float wave_sum(float v) {
#pragma unroll
    for (int o = 1; o < 64; o <<= 1) v += __shfl_xor(v, o);
    return v;
}
__device__ __forceinline__ int wave_sum_i(int v) {
#pragma unroll
    for (int o = 1; o < 64; o <<= 1) v += __shfl_xor(v, o);
    return v;
}
__device__ __forceinline__ float rcpf_(float x) { return __builtin_amdgcn_rcpf(x); }
__device__ __forceinline__ float rsqf_(float x) { return __builtin_amdgcn_rsqf(x); }
__device__ __forceinline__ float sigmoidf_(float x) { return rcpf_(1.0f + __expf(-x)); }
template <int CTRL> __device__ __forceinline__ float dpp_mov(float v) { return __int_as_float(__builtin_amdgcn_update_dpp(__float_as_int(v), __float_as_int(v), CTRL, 0xf, 0xf, true)); }
__device__ __forceinline__ float allsum16(float v) { v += dpp_mov<0xB1>(v); v += dpp_mov<0x4E>(v); v += dpp_mov<0x141>(v); v += dpp_mov<0x140>(v); return v; }
__device__ __forceinline__ f32x4 unpk4(u32x2 w) { return (f32x4){bf2f(w.x & 0xffffu), bf2f(w.x >> 16), bf2f(w.y & 0xffffu), bf2f(w.y >> 16)}; }
__device__ __forceinline__ void unpk8(u32x4 w, float (&o)[8]) {
#pragma unroll
    for (int m = 0; m < 4; ++m) { o[2 * m] = bf2f(w[m] & 0xffffu); o[2 * m + 1] = bf2f(w[m] >> 16); }
}
__device__ __forceinline__ u32x4 pk8(const float (&v)[8]) { u32x4 w; w.x = pk2(v[0], v[1]); w.y = pk2(v[2], v[3]); w.z = pk2(v[4], v[5]); w.w = pk2(v[6], v[7]); return w; }
__device__ __forceinline__ u32x2 pk4(f32x4 v) { u32x2 w; w.x = pk2(v.x, v.y); w.y = pk2(v.z, v.w); return w; }

#define XB_TMO      128
#define XB_XCNT(j)  (256  + 64 * (j))
#define XB_XSUB(j)  (1280 + 64 * (j))
#define XB_XGEN(j)  (2304 + 64 * (j))
#define XB_TOP      3328
#define XB_TOPGEN   3392
#define XCD_BAR_WORDS 3456
#define XB_SPIN_CAP (1u << 18)
__device__ __forceinline__ unsigned xb_ld(unsigned* p)              { return __hip_atomic_load(p, __ATOMIC_RELAXED, __HIP_MEMORY_SCOPE_AGENT); }
__device__ __forceinline__ unsigned xb_add(unsigned* p, unsigned v) { return __hip_atomic_fetch_add(p, v, __ATOMIC_RELAXED, __HIP_MEMORY_SCOPE_AGENT); }
__device__ __forceinline__ unsigned xb_xcc_id() { return (unsigned)__builtin_amdgcn_s_getreg((3 << 11) | 20) & 0xFu; }
#define XB_SPIN(cond, bar) do { unsigned _sp = 0; while (cond) { __builtin_amdgcn_s_sleep(1); \
    if ((++_sp & 255u) == 0u) { if (xb_ld(&(bar)[XB_TMO])) break; if (_sp > XB_SPIN_CAP) { atomicAdd(&(bar)[XB_TMO], 1u); break; } } } } while (0)
struct XcdBarrier { unsigned* bar; unsigned x; volatile LAS unsigned* st; };
__device__ __forceinline__ XcdBarrier xcd_barrier_post(unsigned* bar, volatile LAS unsigned* st) {
    XcdBarrier b; b.bar = bar; b.x = xb_xcc_id(); b.st = st;
    if (threadIdx.x == 0) (void)xb_add(&bar[XB_XCNT(b.x)], 1u);
    return b;
}
__device__ __forceinline__ void xcd_barrier_complete(unsigned* bar, unsigned x, unsigned& nloc, unsigned& nx) {
    const unsigned G = gridDim.x * gridDim.y * gridDim.z;
    unsigned sum, cnt, mine, sp = 0u;
    for (;;) {
        sum = 0u; cnt = 0u; mine = 0u;
#pragma unroll
        for (unsigned j = 0; j < 16; ++j) { const unsigned c = xb_ld(&bar[XB_XCNT(j)]); sum += c; cnt += (c > 0u) ? 1u : 0u; mine = (j == x) ? c : mine; }
        if (sum == G) break;
        __builtin_amdgcn_s_sleep(1);
        if ((++sp & 255u) == 0u) { if (xb_ld(&bar[XB_TMO])) break; if (sp > XB_SPIN_CAP) { atomicAdd(&bar[XB_TMO], 1u); break; } }
    }
    nloc = mine > 0u ? mine : 1u; nx = cnt > 0u ? cnt : 1u;
}
__device__ __forceinline__ void xcd_barrier(const XcdBarrier& b) {
    asm volatile("s_waitcnt vmcnt(0)" ::: "memory");
    __syncthreads();
    if (threadIdx.x == 0) {
        unsigned* bar = b.bar;
        __builtin_amdgcn_s_waitcnt(0);
        unsigned nloc = b.st[0], nx = b.st[1];
        if (nloc == 0u) { xcd_barrier_complete(bar, b.x, nloc, nx); b.st[0] = nloc; b.st[1] = nx; }
        const unsigned old = xb_add(&bar[XB_XSUB(b.x)], 1u);
        const unsigned gen = old / nloc;
        if (old + 1u == (gen + 1u) * nloc) {
            __builtin_amdgcn_fence(__ATOMIC_RELEASE, "agent");
            asm volatile("s_waitcnt vmcnt(0)" ::: "memory");
            const unsigned og = xb_add(&bar[XB_TOP], 1u);
            const unsigned tg = og / nx;
            if (og + 1u == (tg + 1u) * nx) xb_add(&bar[XB_TOPGEN], 1u);
            else XB_SPIN(xb_ld(&bar[XB_TOPGEN]) == tg, bar);
            __builtin_amdgcn_fence(__ATOMIC_ACQUIRE, "agent");
            xb_add(&bar[XB_XGEN(b.x)], 1u);
            asm volatile("s_waitcnt vmcnt(0)" ::: "memory");
        } else {
            XB_SPIN(xb_ld(&bar[XB_XGEN(b.x)]) == gen, bar);
            __builtin_amdgcn_fence(__ATOMIC_ACQUIRE, "agent");
            asm volatile("s_waitcnt vmcnt(0)" ::: "memory");
        }
    }
    __syncthreads();
}

namespace pg8 {
constexpr int BM = 256, BK = 64, HALF = 128, HTB = HALF * BK * 2, STAGE_BYTES = 8 * HTB;
__host__ __device__ __forceinline__ int lds_byte(int r, int c) { const int st = (r >> 4) * 2 + (c >> 5), rr = r & 15, cc = c & 31, ob = rr * 64 + cc * 2; return st * 1024 + (ob ^ (((ob >> 9) & 1) << 5)); }
__host__ __device__ __forceinline__ void stage_rc(int b, int& R, int& C) { const int st = b / 1024, sb = b % 1024, swz = sb ^ (((sb >> 9) & 1) << 5); R = (st >> 1) * 16 + swz / 64; C = (st & 1) * 32 + (swz % 64) / 2; }
__host__ __device__ __forceinline__ int perm32(int rho) { const int n = rho >> 4, i = rho & 15; return 8 * (i >> 2) + 4 * n + (i & 3); }
struct Unit { int pm, pn, gi; };
__device__ __forceinline__ unsigned cvt_pk_bf16(float lo, float hi) { return ::pk2(lo, hi); }

template <class Epi, class Sched, bool GATHER = false>
__device__ __forceinline__ void gemm_phase(LAS unsigned char* lds, const int K, const Sched& S, const Epi& E) {
    const int tid = TID_, wid = __builtin_amdgcn_readfirstlane(tid >> 6), lane = tid & 63, wr = wid >> 2, wc = wid & 3, fr = lane & 15, fq = lane >> 4;
    const int nt = K / BK;
    unsigned voffA[2], voffB[2];
#pragma unroll
    for (int i = 0; i < 2; ++i) { int R, C; stage_rc(tid * 16 + i * 8192, R, C); const int Rb = Epi::PERM ? ((R & ~31) + perm32(R & 31)) : R;
        voffA[i] = (unsigned)(R * K + C) * 2u; voffB[i] = (unsigned)(Rb * K + C) * 2u; }
    const size_t kstep = (size_t)(BK * 2);
    const size_t hstep = (size_t)HALF * K * 2;
    const unsigned ldsw = (unsigned)wid * 1024u;
    const int aoff = lds_byte(wr * 64 + fr, fq * 8), boff = lds_byte(wc * 32 + fr, fq * 8);
#define PG8_SA(b, h) (((b) * 2 + (h)) * HTB)
#define PG8_SB(b, h) ((4 + (b) * 2 + (h)) * HTB)
#define PG8_STAGE(bufoff, gbase, voff) do { _Pragma("unroll") for (int _i = 0; _i < 2; ++_i) \
        __builtin_amdgcn_global_load_lds((const unsigned*)((const char*)(gbase) + (voff)[_i]), (LAS unsigned*)(lds + (bufoff) + ldsw + _i * 8192), 16, 0, 0); } while (0)
#define PG8_LDA(dst, b, h) do { _Pragma("unroll") for (int m = 0; m < 4; ++m) _Pragma("unroll") for (int k = 0; k < 2; ++k) dst[m][k] = *(const LAS bf16x8*)(lds + PG8_SA(b, h) + aoff + m * 2048 + k * 1024); } while (0)
#define PG8_LDB(dst, b, h) do { _Pragma("unroll") for (int n = 0; n < 2; ++n) _Pragma("unroll") for (int k = 0; k < 2; ++k) dst[n][k] = *(const LAS bf16x8*)(lds + PG8_SB(b, h) + boff + n * 2048 + k * 1024); } while (0)
#define PG8_MMA(ai, bj, At, Bt) do { __builtin_amdgcn_s_setprio(1); _Pragma("unroll") for (int m = 0; m < 4; ++m) _Pragma("unroll") for (int n = 0; n < 2; ++n) _Pragma("unroll") for (int k = 0; k < 2; ++k) \
        acc[ai][bj][m][n] = __builtin_amdgcn_mfma_f32_16x16x32_bf16(Bt[n][k], At[m][k], acc[ai][bj][m][n], 0, 0, 0); __builtin_amdgcn_s_setprio(0); } while (0)
#define PG8_WAIT_V(n) asm volatile("s_waitcnt vmcnt(" #n ")" ::: "memory")
#define PG8_WAIT_L(n) asm volatile("s_waitcnt lgkmcnt(" #n ")" ::: "memory")
#define PG8_BAR __builtin_amdgcn_s_barrier()
#define PG8_SCHED __builtin_amdgcn_sched_barrier(0)
    Unit cur, nxt; int ui = 0;
    int gR[2], gC[2];
#pragma unroll
    for (int i = 0; i < 2; ++i) stage_rc(tid * 16 + i * 8192, gR[i], gC[i]);
    unsigned vA[2][2] = {{0u, 0u}, {0u, 0u}}, vN[2][2] = {{0u, 0u}, {0u, 0u}};
    if constexpr (GATHER) {
        LAS int* gidx = (LAS int*)(lds + STAGE_BYTES);
        Unit gu; for (int i = 0; S.next(i, gu); ++i) if (tid < 256) gidx[i * 256 + tid] = S.rowidx[gu.pm * 256 + tid];
        __syncthreads();
    }
#define PG8_GIDX(dst, unit_i) do { if constexpr (GATHER) { const LAS int* gi_ = (const LAS int*)(lds + STAGE_BYTES) + (unit_i) * 256; _Pragma("unroll") for (int h_ = 0; h_ < 2; ++h_) _Pragma("unroll") for (int i_ = 0; i_ < 2; ++i_) \
        dst[h_][i_] = (unsigned)gi_[h_ * 128 + gR[i_]] * (unsigned)(K * 2) + (unsigned)(gC[i_] * 2); } } while (0)
    if (!S.next(0, cur)) return;
    PG8_GIDX(vA, 0);
    f32x4 acc[2][2][4][2];
#pragma unroll
    for (int a = 0; a < 2; ++a)
#pragma unroll
        for (int b = 0; b < 2; ++b)
#pragma unroll
            for (int m = 0; m < 4; ++m)
#pragma unroll
                for (int n = 0; n < 2; ++n) acc[a][b][m][n] = (f32x4){0.f, 0.f, 0.f, 0.f};
    bf16x8 At[4][2], B0[2][2], B1[2][2];
    const char* cA; if constexpr (GATHER) cA = S.gbase; else cA = S.a_base(cur);
    const char* cB = S.b_base(cur);
#define PG8_STAGE_A(bufoff, ap, h, v) do { if constexpr (GATHER) { PG8_STAGE(bufoff, ap, (v)[h]); } else { PG8_STAGE(bufoff, (ap) + (h) * hstep, voffA); } } while (0)
    PG8_STAGE(PG8_SB(0, 0), cB, voffB); PG8_STAGE_A(PG8_SA(0, 0), cA, 0, vA); PG8_STAGE(PG8_SB(0, 1), cB + hstep, voffB); PG8_STAGE_A(PG8_SA(0, 1), cA, 1, vA);
    if (wr == 1) PG8_BAR;
    PG8_WAIT_V(4); PG8_BAR;
    PG8_STAGE(PG8_SB(1, 0), cB + kstep, voffB); PG8_STAGE_A(PG8_SA(1, 0), cA + kstep, 0, vA); PG8_STAGE(PG8_SB(1, 1), cB + hstep + kstep, voffB);
    PG8_WAIT_V(6); PG8_BAR;
    for (;;) {
        const bool has_next = S.next(ui + 1, nxt);
        const char* nA = cA; if constexpr (!GATHER) { if (has_next) nA = S.a_base(nxt); }
        const char* nB = has_next ? S.b_base(nxt) : cB;
        if constexpr (GATHER) { if (has_next) PG8_GIDX(vN, ui + 1); else {
#pragma unroll
            for (int h_ = 0; h_ < 2; ++h_)
#pragma unroll
                for (int i_ = 0; i_ < 2; ++i_) vN[h_][i_] = vA[h_][i_]; } }
        for (int t = 0; t < nt; t += 2) {
            const bool last = (t == nt - 2);
            const char* a1 = cA + (size_t)(t + 1) * kstep;
            const char* a2 = last ? nA : cA + (size_t)(t + 2) * kstep; const char* b2 = last ? nB : cB + (size_t)(t + 2) * kstep;
            const char* a3 = a2 + kstep; const char* b3 = b2 + kstep;
            unsigned v2[2][2];
#pragma unroll
            for (int h_ = 0; h_ < 2; ++h_)
#pragma unroll
                for (int i_ = 0; i_ < 2; ++i_) v2[h_][i_] = last ? vN[h_][i_] : vA[h_][i_];
            PG8_LDB(B0, 0, 0); PG8_SCHED; PG8_LDA(At, 0, 0); PG8_STAGE_A(PG8_SA(1, 1), a1, 1, vA);
            PG8_WAIT_L(8); PG8_BAR; PG8_WAIT_L(0); PG8_MMA(0, 0, At, B0); PG8_BAR; PG8_SCHED;
            PG8_LDB(B1, 0, 1); PG8_STAGE(PG8_SB(0, 0), b2, voffB);
            PG8_BAR; PG8_WAIT_L(0); PG8_MMA(0, 1, At, B1); PG8_BAR;
            PG8_LDA(At, 0, 1); PG8_STAGE_A(PG8_SA(0, 0), a2, 0, v2);
            PG8_BAR; PG8_WAIT_L(0); PG8_MMA(1, 0, At, B0); PG8_BAR; PG8_SCHED;
            PG8_STAGE(PG8_SB(0, 1), b2 + hstep, voffB);
            PG8_WAIT_V(6); PG8_BAR; PG8_MMA(1, 1, At, B1); PG8_BAR;
            PG8_LDB(B0, 1, 0); PG8_SCHED; PG8_LDA(At, 1, 0); PG8_STAGE_A(PG8_SA(0, 1), a2, 1, v2);
            PG8_WAIT_L(8); PG8_BAR; PG8_WAIT_L(0); PG8_MMA(0, 0, At, B0); PG8_BAR; PG8_SCHED;
            PG8_LDB(B1, 1, 1); PG8_STAGE(PG8_SB(1, 0), b3, voffB);
            PG8_BAR; PG8_WAIT_L(0); PG8_MMA(0, 1, At, B1); PG8_BAR;
            PG8_LDA(At, 1, 1); PG8_STAGE_A(PG8_SA(1, 0), a3, 0, v2);
            PG8_BAR; PG8_WAIT_L(0); PG8_MMA(1, 0, At, B0); PG8_BAR; PG8_SCHED;
            PG8_STAGE(PG8_SB(1, 1), b3 + hstep, voffB);
            PG8_WAIT_V(6); PG8_BAR; PG8_MMA(1, 1, At, B1); PG8_BAR;
        }
        E(acc, cur, wr, wc, fr, fq);
        if (!has_next) break;
#pragma unroll
        for (int a = 0; a < 2; ++a)
#pragma unroll
            for (int b = 0; b < 2; ++b)
#pragma unroll
                for (int m = 0; m < 4; ++m)
#pragma unroll
                    for (int n = 0; n < 2; ++n) acc[a][b][m][n] = (f32x4){0.f, 0.f, 0.f, 0.f};
        cur = nxt; cA = nA; cB = nB; ++ui;
#pragma unroll
        for (int h_ = 0; h_ < 2; ++h_)
#pragma unroll
            for (int i_ = 0; i_ < 2; ++i_) vA[h_][i_] = vN[h_][i_];
    }
    PG8_WAIT_V(0);
    if (wr == 0) PG8_BAR;
    PG8_BAR;
#undef PG8_SA
#undef PG8_STAGE_A
#undef PG8_GIDX
#undef PG8_SB
#undef PG8_STAGE
#undef PG8_LDA
#undef PG8_LDB
#undef PG8_MMA
#undef PG8_WAIT_V
#undef PG8_WAIT_L
#undef PG8_BAR
#undef PG8_SCHED
}
}
struct Params { const float* in[35]; float* out; unsigned char* ws; int ph_lo, ph_hi; };
enum { I_X = 0, I_C, I_CTX, I_CCTX, I_ADAW, I_ADAB, I_NORMG, I_FINALG, I_WIN, I_WOUT, I_QG, I_KG, I_CONVW, I_MU, I_WR, I_WK, I_WV, I_WO, I_W0, I_W1, I_W2,
       I_A0, I_A1, I_A2, I_G1, I_G2, I_KK, I_KA, I_RK, I_LNW, I_LNB, I_ROUTER, I_WGATE, I_WUP, I_WDOWN };

struct OrderSingle {
    const char* A; const char* Bt; int nM, nN, nwg, G, c, rep; size_t tstep;
    __device__ __forceinline__ void init(const void* A_, const void* Bt_, int M, int N, int K, int G_, int c_, int rep_ = 1) { rep = rep_; A = (const char*)A_; Bt = (const char*)Bt_; nM = M / 256; nN = N / 256; nwg = nM * nN; G = G_; c = c_; tstep = (size_t)256 * K * 2; }
    __device__ __forceinline__ bool next(int i, pg8::Unit& u) const {
        long L = (long)i * G + c; if (L >= (long)nwg * rep) return false; L %= nwg;
        int wgid = (int)L; { const int q = nwg / 8, r = nwg % 8, xcd = wgid % 8, off = wgid / 8; wgid = (xcd < r ? xcd * (q + 1) : r * (q + 1) + (xcd - r) * q) + off; }
        const int nig = 8 * nN, gid = wgid / nig, fm = gid * 8, gsz = (nM - fm) < 8 ? (nM - fm) : 8;
        u.pm = fm + ((wgid % nig) % gsz); u.pn = (wgid % nig) / gsz; u.gi = 0; return true;
    }
    __device__ __forceinline__ const char* a_base(const pg8::Unit& u) const { return A + (size_t)u.pm * tstep; }
    __device__ __forceinline__ const char* b_base(const pg8::Unit& u) const { return Bt + (size_t)u.pn * tstep; }
};
struct OrderMoe {
    const char* A; const char* Bt; int PM, PN, nwg, G, c, rep; size_t tstep; const char* gbase; const int* rowidx;
    __device__ __forceinline__ void init(const void* A_, const void* Bt_, int PM_, int PN_, int K, int G_, int c_, int rep_ = 1) { rep = rep_; gbase = (const char*)A_; rowidx = nullptr; A = (const char*)A_; Bt = (const char*)Bt_; PM = PM_; PN = PN_; nwg = NE * PM * PN; G = G_; c = c_; tstep = (size_t)256 * K * 2; }
    __device__ __forceinline__ bool next(int i, pg8::Unit& u) const {
        int L = i * G + c; if (L >= nwg * rep) return false; L %= nwg;
        const int per = PM * PN, e = L / per, r = L % per; u.pm = e * PM + (r % PM); u.pn = e * PN + (r / PM); u.gi = e; return true;
    }
    __device__ __forceinline__ const char* a_base(const pg8::Unit& u) const { return A + (size_t)u.pm * tstep; }
    __device__ __forceinline__ const char* b_base(const pg8::Unit& u) const { return Bt + (size_t)u.pn * tstep; }
};
struct OrderRkv {
    const char *A0, *A1, *A2, *A3, *A4, *A5, *B0, *B1, *B2, *B3; int G, c, rep;
    __device__ __forceinline__ bool next(int i, pg8::Unit& u) const {
        int L = i * G + c; if (L >= 1040 * rep) return false; L %= 1040;
        int gi, nM;
        if (L < 256) { gi = 0; nM = 64; } else if (L < 544) { gi = 1; nM = 72; L -= 256; } else if (L < 832) { gi = 2; nM = 72; L -= 544; }
        else if (L < 904) { gi = 3; nM = 72; L -= 832; } else if (L < 976) { gi = 4; nM = 72; L -= 904; } else { gi = 5; nM = 64; L -= 976; }
        u.gi = gi; u.pm = L % nM; u.pn = L / nM; return true;
    }
    __device__ __forceinline__ const char* a_base(const pg8::Unit& u) const {
        const char* a = u.gi == 0 ? A0 : u.gi == 1 ? A1 : u.gi == 2 ? A2 : u.gi == 3 ? A3 : u.gi == 4 ? A4 : A5; return a + (size_t)u.pm * (256 * 1024 * 2); }
    __device__ __forceinline__ const char* b_base(const pg8::Unit& u) const {
        const char* b = u.gi == 0 ? B0 : u.gi == 1 ? B1 : u.gi == 2 ? B2 : B3 + (size_t)(u.gi - 3) * (256 * 1024 * 2); return b + (size_t)u.pn * (256 * 1024 * 2); }
};

typedef f32x4 Acc[2][2][4][2];
__device__ __forceinline__ u32x4 pack8(f32x4 v0, f32x4 v1) { u32x4 w; w.x = pg8::cvt_pk_bf16(v0[0], v0[1]); w.y = pg8::cvt_pk_bf16(v0[2], v0[3]); w.z = pg8::cvt_pk_bf16(v1[0], v1[1]); w.w = pg8::cvt_pk_bf16(v1[2], v1[3]); return w; }
struct EpiStore {
    static constexpr bool PERM = true;
    bf16_t* O; int ldc;
    __device__ __forceinline__ void operator()(const Acc& acc, const pg8::Unit& u, int wr, int wc, int fr, int fq) const {
        const int row0 = u.pm * 256 + wr * 64 + fr, col0 = u.pn * 256 + wc * 32 + 8 * fq;
#pragma unroll
        for (int ai = 0; ai < 2; ++ai)
#pragma unroll
            for (int m = 0; m < 4; ++m) { bf16_t* rowp = O + (size_t)(row0 + ai * 128 + m * 16) * ldc + col0;
#pragma unroll
                for (int bj = 0; bj < 2; ++bj) *(u32x4*)(rowp + bj * 128) = pack8(acc[ai][bj][m][0], acc[ai][bj][m][1]); }
    }
};
template <bool BASE_BF16>
struct EpiResid {
    static constexpr bool PERM = true;
    const void* baseL; const void* baseC; bf16_t* O; const float* gate;
    __device__ __forceinline__ void operator()(const Acc& acc, const pg8::Unit& u, int wr, int wc, int fr, int fq) const {
        const int row0 = u.pm * 256 + wr * 64 + fr, col0 = u.pn * 256 + wc * 32 + 8 * fq;
        const int mr = u.pm < 64 ? (u.pm >> 3) : 8;
        const float* gt = gate + (size_t)mr * 6144;
        f32x4 g4[2][2];
#pragma unroll
        for (int bj = 0; bj < 2; ++bj)
#pragma unroll
            for (int n = 0; n < 2; ++n) g4[bj][n] = *(const f32x4*)(gt + col0 + bj * 128 + n * 4);
#pragma unroll
        for (int ai = 0; ai < 2; ++ai)
#pragma unroll
            for (int m = 0; m < 4; ++m) { const int row = row0 + ai * 128 + m * 16; bf16_t* op = O + (size_t)row * DM + col0;
#pragma unroll
                for (int bj = 0; bj < 2; ++bj) { f32x4 b0, b1;
                    if (BASE_BF16) { const bf16_t* bp = (row < ML ? (const bf16_t*)baseL + (size_t)row * DM : (const bf16_t*)baseC + (size_t)(row - ML) * DM) + col0 + bj * 128;
                        const u32x4 w = *(const u32x4*)bp; b0 = unpk4((u32x2){w.x, w.y}); b1 = unpk4((u32x2){w.z, w.w}); }
                    else { const float* bp = (row < ML ? (const float*)baseL + (size_t)row * DM : (const float*)baseC + (size_t)(row - ML) * DM) + col0 + bj * 128;
                        b0 = *(const f32x4*)bp; b1 = *(const f32x4*)(bp + 4); }
                    *(u32x4*)(op + bj * 128) = pack8(b0 + g4[bj][0] * acc[ai][bj][m][0], b1 + g4[bj][1] * acc[ai][bj][m][1]); }
                asm volatile("" ::: "memory"); }
    }
};
struct EpiAct {
    static constexpr bool PERM = true;
    bf16_t* O;
    __device__ __forceinline__ void operator()(const Acc& acc, const pg8::Unit& u, int wr, int wc, int fr, int fq) const {
        const int row0 = u.pm * 256 + wr * 64 + fr, f0 = (u.pn & 7) * 128 + wc * 32 + 8 * fq;
#pragma unroll
        for (int ai = 0; ai < 2; ++ai)
#pragma unroll
            for (int m = 0; m < 4; ++m) { bf16_t* rowp = O + (size_t)(row0 + ai * 128 + m * 16) * DM + f0;
                f32x4 o[2];
#pragma unroll
                for (int n = 0; n < 2; ++n) { const f32x4 g = acc[ai][0][m][n], up = acc[ai][1][m][n];
#pragma unroll
                    for (int j = 0; j < 4; ++j) o[n][j] = g[j] * sigmoidf_(g[j]) * up[j]; }
                *(u32x4*)rowp = pack8(o[0], o[1]); }
    }
};
struct EpiYs {
    static constexpr bool PERM = true;
    bf16_t* O; const float* selaff;
    __device__ __forceinline__ void operator()(const Acc& acc, const pg8::Unit& u, int wr, int wc, int fr, int fq) const {
        const int row0 = u.pm * 256 + wr * 64 + fr, col0 = (u.pn & 3) * 256 + wc * 32 + 8 * fq;
#pragma unroll
        for (int ai = 0; ai < 2; ++ai)
#pragma unroll
            for (int m = 0; m < 4; ++m) { const int row = row0 + ai * 128 + m * 16; const float s = selaff[row]; bf16_t* rowp = O + (size_t)row * DM + col0;
#pragma unroll
                for (int bj = 0; bj < 2; ++bj) *(u32x4*)(rowp + bj * 128) = pack8(acc[ai][bj][m][0] * s, acc[ai][bj][m][1] * s); }
    }
};
struct EpiRkv {
    static constexpr bool PERM = true;
    bf16_t *R, *K, *V, *T1;
    __device__ __forceinline__ void operator()(const Acc& acc, const pg8::Unit& u, int wr, int wc, int fr, int fq) const {
        const int row0 = u.pm * 256 + wr * 64 + fr;
        if (u.gi < 3) {
            bf16_t* O = u.gi == 0 ? R : u.gi == 1 ? K : V; const int col0 = u.pn * 256 + wc * 32 + 8 * fq;
#pragma unroll
            for (int ai = 0; ai < 2; ++ai)
#pragma unroll
                for (int m = 0; m < 4; ++m) { bf16_t* rowp = O + (size_t)(row0 + ai * 128 + m * 16) * DM + col0;
#pragma unroll
                    for (int bj = 0; bj < 2; ++bj) *(u32x4*)(rowp + bj * 128) = pack8(acc[ai][bj][m][0], acc[ai][bj][m][1]); }
        } else {
            bf16_t* O = T1 + (size_t)(u.gi - 3) * MT * 128; const int col0 = wc * 32 + 8 * fq;
#pragma unroll
            for (int ai = 0; ai < 2; ++ai)
#pragma unroll
                for (int m = 0; m < 4; ++m) *(u32x4*)(O + (size_t)(row0 + ai * 128 + m * 16) * 128 + col0) = pack8(acc[ai][0][m][0], acc[ai][0][m][1]);
        }
    }
};
__device__ __forceinline__ void ld_row_f32(const float* p, int lane, f32x4 (&v)[4]) {
#pragma unroll
    for (int j = 0; j < 4; ++j) v[j] = *(const f32x4*)(p + 256 * j + 4 * lane);
}
__device__ __forceinline__ void ld_row_bf16(const bf16_t* p, int lane, f32x4 (&v)[4]) {
#pragma unroll
    for (int j = 0; j < 4; ++j) v[j] = unpk4(*(const u32x2*)(p + 256 * j + 4 * lane));
}
__device__ __forceinline__ void st_row_f32(float* p, int lane, const f32x4 (&v)[4]) {
#pragma unroll
    for (int j = 0; j < 4; ++j) *(f32x4*)(p + 256 * j + 4 * lane) = v[j];
}
__device__ __forceinline__ void st_row_bf16(bf16_t* p, int lane, const f32x4 (&v)[4]) {
#pragma unroll
    for (int j = 0; j < 4; ++j) *(u32x2*)(p + 256 * j + 4 * lane) = pk4(v[j]);
}
template <int R>
__device__ __forceinline__ void ada_rows(f32x4 (&v)[R][4], const float* g, const float* const (&sh)[R], const float* const (&sc)[R], int lane) {
    float ss[R];
#pragma unroll
    for (int r = 0; r < R; ++r) { ss[r] = 0.f;
#pragma unroll
        for (int j = 0; j < 4; ++j) ss[r] += (v[r][j].x * v[r][j].x + v[r][j].y * v[r][j].y) + (v[r][j].z * v[r][j].z + v[r][j].w * v[r][j].w); }
#pragma unroll
    for (int o = 1; o < 64; o <<= 1) {
#pragma unroll
        for (int r = 0; r < R; ++r) ss[r] += __shfl_xor(ss[r], o); }
#pragma unroll
    for (int j = 0; j < 4; ++j) { const f32x4 gg = *(const f32x4*)(g + 256 * j + 4 * lane);
#pragma unroll
        for (int r = 0; r < R; ++r) { const float rinv = rsqf_(ss[r] * (1.0f / DM) + 1e-6f);
            const f32x4 s = *(const f32x4*)(sc[r] + 256 * j + 4 * lane), h = *(const f32x4*)(sh[r] + 256 * j + 4 * lane);
            v[r][j] = (v[r][j] * rinv) * gg * (s + 1.0f) + h; } }
}

__device__ __forceinline__ void transpose_item64(const float* W, int N, bf16_t* WT, int ldk, LAS float* scr, int k0, int n0, int drow0, int lane) {
    float tv[64];
#pragma unroll
    for (int i = 0; i < 64; ++i) tv[i] = W[(size_t)(k0 + i) * N + n0 + lane];
#pragma unroll
    for (int i = 0; i < 64; ++i) scr[i * 65 + lane] = tv[i];
    LDS_WAIT(); asm volatile("" ::: "memory");
    const int c = lane & 7;
#pragma unroll
    for (int j = 0; j < 8; ++j) { const int n = (lane >> 3) + 8 * j; const LAS float* s = scr + (8 * c) * 65 + n;
        u32x4 o; o.x = pk2(s[0 * 65], s[1 * 65]); o.y = pk2(s[2 * 65], s[3 * 65]); o.z = pk2(s[4 * 65], s[5 * 65]); o.w = pk2(s[6 * 65], s[7 * 65]);
        *(u32x4*)(WT + (size_t)(drow0 + n) * ldk + k0 + 8 * c) = o; }
    LDS_WAIT(); asm volatile("" ::: "memory");
}
__device__ __forceinline__ void transpose_item(const float* W, int N, bf16_t* WT, int ldk, LAS float* scr, int k0, int n0, int drow0, int lane) {
#pragma unroll 8
    for (int i = 0; i < 32; ++i) { const int kk = 2 * i + (lane >> 5); scr[kk * 33 + (lane & 31)] = W[(size_t)(k0 + kk) * N + n0 + (lane & 31)]; }
    LDS_WAIT(); asm volatile("" ::: "memory");
    const int c = lane & 7;
#pragma unroll
    for (int j = 0; j < 4; ++j) { const int n = (lane >> 3) + 8 * j; const LAS float* s = scr + (8 * c) * 33 + n;
        u32x4 o; o.x = pk2(s[0 * 33], s[1 * 33]); o.y = pk2(s[2 * 33], s[3 * 33]); o.z = pk2(s[4 * 33], s[5 * 33]); o.w = pk2(s[6 * 33], s[7 * 33]);
        *(u32x4*)(WT + (size_t)(drow0 + n) * ldk + k0 + 8 * c) = o; }
    LDS_WAIT(); asm volatile("" ::: "memory");
}
__device__ __forceinline__ void transpose_item_64x128(const float* W, int N, bf16_t* WT, int ldk, LAS unsigned* scr, int k0, int n0, int drow0, int lane) {
    const int up = lane >> 5, lq = lane & 31;
    const float* src = W + (size_t)(k0 + up) * N + n0 + 4 * lq;
    LAS unsigned* wp = scr + (4 * lq + 2 * up) * 33;
    f32x4 tv[32];
#pragma unroll
    for (int i = 0; i < 32; ++i) tv[i] = *(const f32x4*)(src + (size_t)(2 * i) * N);
#pragma unroll
    for (int i = 0; i < 32; ++i) {
        const auto s0 = __builtin_amdgcn_permlane32_swap(__float_as_uint(tv[i][0]), __float_as_uint(tv[i][2]), false, false);
        const auto s1 = __builtin_amdgcn_permlane32_swap(__float_as_uint(tv[i][1]), __float_as_uint(tv[i][3]), false, false);
        wp[i] = pk2(__uint_as_float(s0[0]), __uint_as_float(s0[1]));
        wp[33 + i] = pk2(__uint_as_float(s1[0]), __uint_as_float(s1[1]));
    }
    LDS_WAIT(); asm volatile("" ::: "memory");
    const int c = lane & 7;
#pragma unroll
    for (int j = 0; j < 16; ++j) { const int n = (lane >> 3) + 8 * j; const LAS unsigned* s = scr + n * 33 + 4 * c;
        u32x4 o; o.x = s[0]; o.y = s[1]; o.z = s[2]; o.w = s[3];
        *(u32x4*)(WT + (size_t)(drow0 + n) * ldk + k0 + 8 * c) = o; }
    LDS_WAIT(); asm volatile("" ::: "memory");
}
__device__ __forceinline__ void moe_convert_item(const Params& p, int layer, int it, LAS float* scrf, int lane) {
    LAS unsigned* scr = (LAS unsigned*)scrf;
    const int e = it / 384, r = it % 384, which = r / 128, li = r % 128, k0 = 64 * (li / 8), n0 = 128 * (li % 8);
    const size_t woff = (size_t)(layer * NE + e) * 1024 * 1024;
    if (which == 0)      transpose_item_64x128(p.in[I_WGATE] + woff, 1024, (bf16_t*)(p.ws + (layer ? WS_WGU1 : WS_WGU_T)) + (size_t)e * 2048 * 1024, 1024, scr, k0, n0, (n0 >> 7) * 256, lane);
    else if (which == 1) transpose_item_64x128(p.in[I_WUP] + woff, 1024, (bf16_t*)(p.ws + (layer ? WS_WGU1 : WS_WGU_T)) + (size_t)e * 2048 * 1024, 1024, scr, k0, n0, (n0 >> 7) * 256 + 128, lane);
    else                 transpose_item_64x128(p.in[I_WDOWN] + woff, 1024, (bf16_t*)(p.ws + (layer ? WS_WD1 : WS_WD_T)) + (size_t)e * 1024 * 1024, 1024, scr, k0, n0, n0, lane);
}
constexpr int P0_NMOD = 768, P0_NSMALL = 5760, P0_NZERO = 384, P0_NMOE = 16 * 384;
#ifndef P2_CONV_ITEMS
#define P2_CONV_ITEMS 1792
#endif
#ifndef P5_CONV_ITEMS
#define P5_CONV_ITEMS 6144
#endif
#ifndef L1_A
#define L1_A 1500
#endif
#ifndef L1_B
#define L1_B 3800
#endif
#ifndef L1_C
#define L1_C 6144
#endif
constexpr int P8_GEMM_WGS = 231, P9_GEMM_WGS = 192, P12_GEMM_WGS = 208;
constexpr int P2_GEMM_WGS = 216;
constexpr int P5_GEMM_WGS = 144;
constexpr int CTL_Q0 = 8192, CTL_DONE = 8256;
__device__ __forceinline__ void moe_fill(const Params& p, LAS unsigned char* lds, int layer, unsigned* qword, unsigned* done, int G, int wave, int lane) {
    volatile LAS int* jw = (volatile LAS int*)(lds + 133120);
    LAS float* scr = (LAS float*)(lds + wave * 16640);
    constexpr int NJOBS = P0_NMOE / 8;
    __syncthreads();
    if (done && TID_ == 0) __hip_atomic_fetch_add(done, 1u, __ATOMIC_RELAXED, __HIP_MEMORY_SCOPE_AGENT);
    for (;;) {
        if (TID_ == 0) {
            bool go = true;
            if (done) go = __hip_atomic_load(done, __ATOMIC_RELAXED, __HIP_MEMORY_SCOPE_AGENT) < (unsigned)G;
            int j = NJOBS;
            if (go && __hip_atomic_load(qword, __ATOMIC_RELAXED, __HIP_MEMORY_SCOPE_AGENT) < (unsigned)NJOBS) j = (int)__hip_atomic_fetch_add(qword, 1u, __ATOMIC_RELAXED, __HIP_MEMORY_SCOPE_AGENT);
            *jw = j;
        }
        __syncthreads();
        const int j = *jw;
        __syncthreads();
        if (j >= NJOBS) break;
        moe_convert_item(p, layer, j * 8 + wave, scr, lane);
    }
}
__device__ __forceinline__ void small_convert_item(const Params& p, int it, LAS float* scr, int lane) {
    const float* W; int K, N, ldk; bf16_t* WT; int base;
    unsigned char* ws = p.ws;
    if (it < 2304)      { base = 0;    W = p.in[I_WIN];  K = 1024; N = 4608; WT = (bf16_t*)(ws + WS_WIN_T);  ldk = 1024; }
    else if (it < 3328) { base = 2304; W = p.in[I_WOUT]; K = 2048; N = 1024; WT = (bf16_t*)(ws + WS_WOUT_T); ldk = 2048; }
    else if (it < 3840) { base = 3328; W = p.in[I_WR];   K = 1024; N = 1024; WT = (bf16_t*)(ws + WS_WR_T);   ldk = 1024; }
    else if (it < 4352) { base = 3840; W = p.in[I_WK];   K = 1024; N = 1024; WT = (bf16_t*)(ws + WS_WK_T);   ldk = 1024; }
    else if (it < 4864) { base = 4352; W = p.in[I_WV];   K = 1024; N = 1024; WT = (bf16_t*)(ws + WS_WV_T);   ldk = 1024; }
    else if (it < 5376) { base = 4864; W = p.in[I_WO];   K = 1024; N = 1024; WT = (bf16_t*)(ws + WS_WO_T);   ldk = 1024; }
    else if (it < 5408) { base = 5376; W = p.in[I_W1];             K = 1024; N = 64;  WT = (bf16_t*)(ws + WS_WL1_T);                      ldk = 1024; }
    else if (it < 5440) { base = 5408; W = p.in[I_W1] + 1024 * 64; K = 1024; N = 64;  WT = (bf16_t*)(ws + WS_WL1_T) + 64 * 1024;          ldk = 1024; }
    else if (it < 5472) { base = 5440; W = p.in[I_A1];             K = 1024; N = 64;  WT = (bf16_t*)(ws + WS_WL1_T) + 256 * 1024;         ldk = 1024; }
    else if (it < 5504) { base = 5472; W = p.in[I_A1] + 1024 * 64; K = 1024; N = 64;  WT = (bf16_t*)(ws + WS_WL1_T) + (256 + 64) * 1024;  ldk = 1024; }
    else if (it < 5568) { base = 5504; W = p.in[I_G1];             K = 1024; N = 128; WT = (bf16_t*)(ws + WS_WL1_T) + 512 * 1024;         ldk = 1024; }
    else if (it < 5600) { base = 5568; W = p.in[I_W2];             K = 64;   N = 1024; WT = (bf16_t*)(ws + WS_W2T);                       ldk = 64; }
    else if (it < 5632) { base = 5600; W = p.in[I_W2] + 64 * 1024; K = 64;   N = 1024; WT = (bf16_t*)(ws + WS_W2T) + 1024 * 64;           ldk = 64; }
    else if (it < 5664) { base = 5632; W = p.in[I_A2];             K = 64;   N = 1024; WT = (bf16_t*)(ws + WS_A2T);                       ldk = 64; }
    else if (it < 5696) { base = 5664; W = p.in[I_A2] + 64 * 1024; K = 64;   N = 1024; WT = (bf16_t*)(ws + WS_A2T) + 1024 * 64;           ldk = 64; }
    else                { base = 5696; W = p.in[I_G2];             K = 128;  N = 1024; WT = (bf16_t*)(ws + WS_G2T);                       ldk = 128; }
    const int li = it - base, nblk = N / 32, k0 = 64 * (li / nblk), n0 = 32 * (li % nblk);
    (void)K;
    transpose_item(W, N, WT, ldk, scr, k0, n0, n0, lane);
}
__device__ __forceinline__ void phase_prep(const Params& p, LAS unsigned char* lds, int gw, int NGW, int wave, int lane, bool skip_mod) {
    LAS float* S = (LAS float*)lds;
    for (int i = TID_; i < 9 * 1024; i += 512) { const float c = i < 8192 ? p.in[I_C][i] : p.in[I_CCTX][i - 8192]; S[i] = c * sigmoidf_(c); }
    __syncthreads();
    float* mod = (float*)(p.ws + WS_MOD);
    if (!skip_mod) {
        LAS float* part = (LAS float*)(lds + 36864);
        for (int it = blockIdx.x; it < 192; it += gridDim.x) {
            const int l = it / 96, nch = it % 96, n = nch * 64 + lane, kb = wave * 128;
            const float* w = p.in[I_ADAW] + ((size_t)l * 1024 + kb) * 6144 + n;
            float acc[9];
#pragma unroll
            for (int r9 = 0; r9 < 9; ++r9) acc[r9] = 0.f;
            for (int k = 0; k < 128; k += 32) {
                float wv[32];
#pragma unroll
                for (int u = 0; u < 32; ++u) wv[u] = w[(size_t)(k + u) * 6144];
#pragma unroll
                for (int u = 0; u < 32; ++u)
#pragma unroll
                    for (int r9 = 0; r9 < 9; ++r9) acc[r9] += S[r9 * 1024 + kb + k + u] * wv[u];
            }
#pragma unroll
            for (int r9 = 0; r9 < 9; ++r9) part[(wave * 9 + r9) * 64 + lane] = acc[r9];
            __syncthreads();
            for (int o = TID_; o < 576; o += 512) { const int r9 = o >> 6, col = o & 63; float s = p.in[I_ADAB][l * 6144 + nch * 64 + col];
#pragma unroll
                for (int w8 = 0; w8 < 8; ++w8) s += part[(w8 * 9 + r9) * 64 + col];
                mod[(size_t)(l * 9 + r9) * 6144 + nch * 64 + col] = s; }
            __syncthreads();
        }
    }
    __syncthreads();
    LAS float* scr = (LAS float*)(lds + wave * 16640);
    const int NIT = P0_NSMALL + P0_NZERO + P0_NMOE - P5_CONV_ITEMS;
    for (int it = gw; it < NIT; it += NGW) {
        if (it < P0_NSMALL) {
            small_convert_item(p, it, scr, lane);
        } else if (it < P0_NSMALL + P0_NZERO) {
            const int r = it - P0_NSMALL, g = r >> 7, row = 128 + (r & 127);
            bf16_t* dst = (bf16_t*)(p.ws + WS_WL1_T) + (size_t)(g * 256 + row) * 1024;
            *(u32x4*)(dst + lane * 8) = (u32x4){0u, 0u, 0u, 0u}; *(u32x4*)(dst + 512 + lane * 8) = (u32x4){0u, 0u, 0u, 0u};
        } else {
            moe_convert_item(p, 0, P5_CONV_ITEMS + it - P0_NSMALL - P0_NZERO, scr, lane);
        }
    }
    float* rope = (float*)(p.ws + WS_ROPE);
    for (int idx = gw * 64 + lane; idx < SEQ * 64; idx += NGW * 64) { const int t = idx >> 6, j = idx & 63;
        const float ang = (float)(j < 32 ? (t >> 6) : (t & 63)) * powf(10000.0f, -(float)(j & 31) / 32.0f);
        rope[idx] = cosf(ang); rope[SEQ * 64 + idx] = sinf(ang); }
}

__device__ __forceinline__ void phase_prenorm0(const Params& p, int gw, int NGW, int lane) {
    const float* mod = (const float*)(p.ws + WS_MOD);
    bf16_t* H = (bf16_t*)(p.ws + WS_H);
    constexpr int R = 4;
    for (int row0 = gw * R; row0 < MT; row0 += NGW * R) {
        const float* xr = row0 < ML ? p.in[I_X] + (size_t)row0 * DM : p.in[I_CTX] + (size_t)(row0 - ML) * DM;
        const int mr = row0 < ML ? (row0 >> 11) : 8;
        const float* m = mod + (size_t)mr * 6144;
        f32x4 v[R][4];
#pragma unroll
        for (int r = 0; r < R; ++r) ld_row_f32(xr + (size_t)r * DM, lane, v[r]);
        const float* const sh[R] = {m, m, m, m}; const float* const sc[R] = {m + 1024, m + 1024, m + 1024, m + 1024};
        ada_rows<R>(v, p.in[I_NORMG], sh, sc, lane);
#pragma unroll
        for (int r = 0; r < R; ++r) st_row_bf16(H + (size_t)(row0 + r) * DM, lane, v[r]);
    }
}

__device__ __forceinline__ void phase_qkconv(const Params& p, int gw, int NGW, int lane) {
    const bf16_t* P = (const bf16_t*)(p.ws + WS_P);
    bf16_t* Q = (bf16_t*)(p.ws + WS_Q); bf16_t* KA = (bf16_t*)(p.ws + WS_KA); bf16_t* VA = (bf16_t*)(p.ws + WS_VA); bf16_t* AO = (bf16_t*)(p.ws + WS_AO);
    const float* rope = (const float*)(p.ws + WS_ROPE);
    const int i16 = lane & 15, dlo = 8 * (i16 & 7);
    const float sgn = i16 < 8 ? -1.f : 1.f;
    float qg[8], kg[8];
#pragma unroll
    for (int j = 0; j < 8; ++j) { qg[j] = p.in[I_QG][8 * i16 + j]; kg[j] = p.in[I_KG][8 * i16 + j]; }
    for (int row0 = gw * 2; row0 < MT; row0 += NGW * 2) {
        u32x4 ra[2], rb[2], rk[2]; f32x4 cs[2][2], sn[2][2];
#pragma unroll
        for (int r = 0; r < 2; ++r) { const int row = row0 + r; const bf16_t* pr = P + (size_t)row * PROJ;
            ra[r] = *(const u32x4*)(pr + 8 * lane); rb[r] = *(const u32x4*)(pr + 512 + 8 * lane); rk[r] = *(const u32x4*)(pr + 1024 + 8 * lane);
            if (row < ML) { const float* cp = rope + (size_t)(row & 2047) * 64 + dlo; cs[r][0] = *(const f32x4*)cp; cs[r][1] = *(const f32x4*)(cp + 4); sn[r][0] = *(const f32x4*)(cp + SEQ * 64); sn[r][1] = *(const f32x4*)(cp + SEQ * 64 + 4); }
            else { cs[r][0] = (f32x4){1.f, 1.f, 1.f, 1.f}; cs[r][1] = cs[r][0]; sn[r][0] = (f32x4){0.f, 0.f, 0.f, 0.f}; sn[r][1] = sn[r][0]; } }
#pragma unroll
        for (int r = 0; r < 2; ++r) {
            const int row = row0 + r; const bool lat = row < ML;
            const int b = lat ? (row >> 11) : ((row - ML) >> 8), t = lat ? (row & 2047) : ((row - ML) & 255);
            const size_t kvrow = ((size_t)b * KVL + (lat ? CTXL + t : t)) * 256;
#pragma unroll
            for (int part = 0; part < 3; ++part) {
                float x[8], o[8]; unpk8(part == 0 ? ra[r] : part == 1 ? rb[r] : rk[r], x);
                float ss = 0.f;
#pragma unroll
                for (int j = 0; j < 8; ++j) ss += x[j] * x[j];
                const float rinv = rsqf_(allsum16(ss) * (1.0f / 128.0f) + 1e-6f);
#pragma unroll
                for (int j = 0; j < 8; ++j) { const float y = x[j] * rinv * (part == 2 ? kg[j] : qg[j]); const float other = dpp_mov<0x128>(y);
                    o[j] = y * cs[r][j >> 2][j & 3] + sgn * other * sn[r][j >> 2][j & 3]; }
                if (part == 0) *(u32x4*)(Q + (size_t)row * DM + 8 * lane) = pk8(o);
                else if (part == 1) *(u32x4*)(Q + (size_t)row * DM + 512 + 8 * lane) = pk8(o);
                else { if (lane < 32) *(u32x4*)(KA + kvrow + 8 * lane) = pk8(o); else *(u32x4*)(VA + kvrow + 8 * (lane - 32)) = rk[r]; }
            }
        }
    }
    f32x4 w0[4], w1[4], w2[4];
#pragma unroll
    for (int q4 = 0; q4 < 4; ++q4) { const int c = 16 * lane + 4 * q4; w0[q4] = *(const f32x4*)(p.in[I_CONVW] + c); w1[q4] = *(const f32x4*)(p.in[I_CONVW] + 1024 + c); w2[q4] = *(const f32x4*)(p.in[I_CONVW] + 2048 + c); }
    for (int row0 = gw * 2; row0 < MT; row0 += NGW * 2) {
        const bool lat = row0 < ML; const int t0 = lat ? (row0 & 2047) : ((row0 - ML) & 255), T = lat ? SEQ : CTXL;
        const bf16_t* pr = P + (size_t)row0 * PROJ + 16 * lane;
        u32x4 gc[4][2], xc[4][2], gb[2][2];
#pragma unroll
        for (int r = 0; r < 4; ++r) { const bool ok = (r != 0 || t0 > 0) && (r != 3 || t0 + 2 < T); const bf16_t* q = pr + (ptrdiff_t)(r - 1) * PROJ;
#pragma unroll
            for (int hh = 0; hh < 2; ++hh) { gc[r][hh] = ok ? *(const u32x4*)(q + 2560 + 8 * hh) : (u32x4){0u, 0u, 0u, 0u}; xc[r][hh] = ok ? *(const u32x4*)(q + 3584 + 8 * hh) : (u32x4){0u, 0u, 0u, 0u}; } }
#pragma unroll
        for (int r = 0; r < 2; ++r)
#pragma unroll
            for (int hh = 0; hh < 2; ++hh) gb[r][hh] = *(const u32x4*)(pr + (size_t)r * PROJ + 1536 + 8 * hh);
#pragma unroll
        for (int hh = 0; hh < 2; ++hh) {
            float u[4][8];
#pragma unroll
            for (int r = 0; r < 4; ++r) { float a[8], b[8]; unpk8(gc[r][hh], a); unpk8(xc[r][hh], b);
#pragma unroll
                for (int j = 0; j < 8; ++j) u[r][j] = a[j] * b[j]; }
#pragma unroll
            for (int r = 0; r < 2; ++r) { float g[8], o[8]; unpk8(gb[r][hh], g);
#pragma unroll
                for (int j = 0; j < 8; ++j) { const int q4 = 2 * hh + (j >> 2), e = j & 3; o[j] = g[j] * (u[r][j] * w0[q4][e] + u[r + 1][j] * w1[q4][e] + u[r + 2][j] * w2[q4][e]); }
                *(u32x4*)(AO + (size_t)(row0 + r) * 2048 + 1024 + 16 * lane + 8 * hh) = pk8(o); }
        }
    }
}

namespace attn {
constexpr int D = 128, NW = 8, QBLK = 32, KVBLK = 64;
constexpr float SCALE = 0.088388347648318440f;
constexpr float THR = 8.f;
constexpr size_t SHM_V = KVBLK * D * 2, SHM_K = KVBLK * D * 2, SHM_ATTN = 2 * SHM_V + 2 * SHM_K + NW * 64 * 4;
#define KSWZ(row, colB) ((row) * 256 + ((colB) ^ (((row) & 7) << 4)))
#define SBAR() __builtin_amdgcn_sched_barrier(0)
__device__ __forceinline__ int crow(int r, int hi) { return (r & 3) + 8 * (r >> 2) + 4 * hi; }
__device__ __forceinline__ unsigned cvtpk(float lo, float hi) { unsigned r; asm volatile("v_cvt_pk_bf16_f32 %0, %1, %2" : "=v"(r) : "v"(lo), "v"(hi)); return r; }
__device__ __forceinline__ void partialSM(f32x16& p0, f32x16& p1, float& m_reg, float& mn, float& alpha) {
  constexpr float C = SCALE * 1.4426950408889634f;
  float pmax = p0[0]; for (int r = 1; r < 16; ++r) pmax = fmaxf(pmax, p0[r]); for (int r = 0; r < 16; ++r) pmax = fmaxf(pmax, p1[r]);
  { auto rr = __builtin_amdgcn_permlane32_swap(__float_as_uint(pmax), __float_as_uint(pmax), false, false);
    pmax = fmaxf(__uint_as_float(rr[0]), __uint_as_float(rr[1])); }
  if (__builtin_expect(__all(pmax - m_reg <= THR / SCALE), 1)) { mn = m_reg; alpha = 1.f; }
  else { mn = fmaxf(m_reg, pmax); alpha = __builtin_amdgcn_exp2f((m_reg - mn) * C); m_reg = mn; }
  float mnC = -mn * C;
  for (int r = 0; r < 16; ++r) p0[r] = fmaf(p0[r], C, mnC); for (int r = 0; r < 16; ++r) p1[r] = fmaf(p1[r], C, mnC);
  for (int r = 0; r < 16; ++r) p0[r] = __builtin_amdgcn_exp2f(p0[r]);
}
__device__ __forceinline__ void finishSM(f32x16& p0, f32x16& p1, float alpha, float& l_reg, bf16x8& pa0, bf16x8& pa1, bf16x8& pa2, bf16x8& pa3) {
  for (int r = 0; r < 16; ++r) p1[r] = __builtin_amdgcn_exp2f(p1[r]);
  float ps = 0; for (int r = 0; r < 16; ++r) ps += p0[r]; for (int r = 0; r < 16; ++r) ps += p1[r];
  { auto rr = __builtin_amdgcn_permlane32_swap(__float_as_uint(ps), __float_as_uint(ps), false, false);
    ps = __uint_as_float(rr[0]) + __uint_as_float(rr[1]); }
  l_reg = l_reg * alpha + ps;
#define PK4(P, BASE, OUT) do { unsigned a0 = cvtpk(P[BASE + 0], P[BASE + 1]), a1 = cvtpk(P[BASE + 2], P[BASE + 3]);   \
    unsigned b0 = cvtpk(P[BASE + 4], P[BASE + 5]), b1 = cvtpk(P[BASE + 6], P[BASE + 7]);                              \
    auto r0 = __builtin_amdgcn_permlane32_swap(a0, b0, false, false); auto r1 = __builtin_amdgcn_permlane32_swap(a1, b1, false, false); \
    u32x4 w = {r0[0], r1[0], r0[1], r1[1]}; OUT = *reinterpret_cast<bf16x8*>(&w); } while (0)
  PK4(p0, 0, pa0); PK4(p0, 8, pa1); PK4(p1, 0, pa2); PK4(p1, 8, pa3);
#undef PK4
}
__device__ __forceinline__ void qkt(f32x16& p0, f32x16& p1, const bf16_t* Ks, const bf16x8* qr, int r32, int hi) {
  p0 = f32x16{}; p1 = f32x16{};
  for (int d0 = 0; d0 < 8; ++d0) { int cb = (d0 * 16 + hi * 8) * 2;
    bf16x8 b0 = *reinterpret_cast<const bf16x8*>((const char*)Ks + KSWZ(r32, cb));
    bf16x8 b1 = *reinterpret_cast<const bf16x8*>((const char*)Ks + KSWZ(32 + r32, cb));
    p0 = __builtin_amdgcn_mfma_f32_32x32x16_bf16(b0, qr[d0], p0, 0, 0, 0);
    p1 = __builtin_amdgcn_mfma_f32_32x32x16_bf16(b1, qr[d0], p1, 0, 0, 0); }
}
__device__ __forceinline__ int v_st(int k, int c) { const int kk = (k & ~0xC) | ((k & 4) << 1) | ((k & 8) >> 1); return ((kk >> 3) * 4 + (c >> 5)) * 512 + ((kk & 7) * 32 + (c & 31)) * 2; }
__device__ __forceinline__ int v_rd_base(int lane) { return ((lane & 3) << 3) | (((lane >> 2) & 3) << 6) | (((lane >> 4) & 1) << 5) | (((lane >> 5) & 1) << 8); }
constexpr int v_rd_off(int d0, int ks, int half) { return d0 * 512 + ks * 4096 + half * 2048; }
template <int OFF> __device__ __forceinline__ s16x4 tr_read(int vb) {
  s16x4 r; asm volatile("ds_read_b64_tr_b16 %0, %1 offset:%2" : "=&v"(r) : "v"(vb), "i"(OFF) : "memory"); return r;
}
template <int D0> __device__ __forceinline__ void pv_one(f32x16& od, int vb, bf16x8 pa0, bf16x8 pa1, bf16x8 pa2, bf16x8 pa3) {
  const s16x4 l0 = tr_read<v_rd_off(D0, 0, 0)>(vb), h0 = tr_read<v_rd_off(D0, 0, 1)>(vb), l1 = tr_read<v_rd_off(D0, 1, 0)>(vb), h1 = tr_read<v_rd_off(D0, 1, 1)>(vb);
  const s16x4 l2 = tr_read<v_rd_off(D0, 2, 0)>(vb), h2 = tr_read<v_rd_off(D0, 2, 1)>(vb), l3 = tr_read<v_rd_off(D0, 3, 0)>(vb), h3 = tr_read<v_rd_off(D0, 3, 1)>(vb);
  asm volatile("s_waitcnt lgkmcnt(0)" ::: "memory"); SBAR();
#define PK(L, H) (bf16x8){L[0], L[1], L[2], L[3], H[0], H[1], H[2], H[3]}
  od = __builtin_amdgcn_mfma_f32_32x32x16_bf16(pa0, PK(l0, h0), od, 0, 0, 0);
  od = __builtin_amdgcn_mfma_f32_32x32x16_bf16(pa1, PK(l1, h1), od, 0, 0, 0);
  od = __builtin_amdgcn_mfma_f32_32x32x16_bf16(pa2, PK(l2, h2), od, 0, 0, 0);
  od = __builtin_amdgcn_mfma_f32_32x32x16_bf16(pa3, PK(l3, h3), od, 0, 0, 0);
#undef PK
}
__device__ __forceinline__ void pv_d0(f32x16* o, int vb, bf16x8 pa0, bf16x8 pa1, bf16x8 pa2, bf16x8 pa3) {
  pv_one<0>(o[0], vb, pa0, pa1, pa2, pa3); pv_one<1>(o[1], vb, pa0, pa1, pa2, pa3); pv_one<2>(o[2], vb, pa0, pa1, pa2, pa3); pv_one<3>(o[3], vb, pa0, pa1, pa2, pa3);
}
template <int LDQ, int LDK, int LDO>
__device__ __forceinline__ void attn_dense_body(const bf16_t* __restrict__ Qb, const bf16_t* __restrict__ Kh, const bf16_t* __restrict__ Vh,
                                                bf16_t* __restrict__ Ob, int seq, char* lds) {
  constexpr int SDEPTH = 2;
  const int tid = TID_, wid = tid >> 6, lane = tid & 63, r32 = lane & 31, hi = lane >> 5;
  bf16_t* V_lds = (bf16_t*)lds; bf16_t* K_lds = (bf16_t*)(lds + 2 * SHM_V);
  float* ws = (float*)(lds + 2 * SHM_V + 2 * SHM_K) + wid * 64; float* li_l = ws; float* al_l = ws + 32;
  float m_reg = -1e30f, l_reg = 0; f32x16 o[4] = {}; bf16x8 qr[8];
  const bf16_t* Qw = Qb + (long)(wid * QBLK + r32) * LDQ + hi * 8;
#pragma unroll
  for (int d0 = 0; d0 < 8; ++d0) qr[d0] = *reinterpret_cast<const bf16x8*>(Qw + d0 * 16);
  const int sr = tid >> 4, sc = (tid & 15) * 8, vst0 = v_st(sr, sc), vst1 = v_st(32 + sr, sc);
  const int vb0 = (int)(uintptr_t)V_lds + v_rd_base(lane);
  struct { bf16x8 vs0, vs1, ks0, ks1; } sr_[SDEPTH];
#define SLOAD(i, k0) do { sr_[i].vs0 = *reinterpret_cast<const bf16x8*>(&Vh[(long)((k0) + sr) * LDK + sc]); sr_[i].vs1 = *reinterpret_cast<const bf16x8*>(&Vh[(long)((k0) + 32 + sr) * LDK + sc]); \
    sr_[i].ks0 = *reinterpret_cast<const bf16x8*>(&Kh[(long)((k0) + sr) * LDK + sc]); sr_[i].ks1 = *reinterpret_cast<const bf16x8*>(&Kh[(long)((k0) + 32 + sr) * LDK + sc]); } while (0)
#define SWRITE(b, i) do { *(bf16x8*)((char*)V_lds + (b) * SHM_V + vst0) = sr_[i].vs0;          \
    *(bf16x8*)((char*)V_lds + (b) * SHM_V + vst1) = sr_[i].vs1; int kc = sc * 2;               \
    *(bf16x8*)((char*)K_lds + (b) * SHM_K + KSWZ(sr, kc)) = sr_[i].ks0;                       \
    *(bf16x8*)((char*)K_lds + (b) * SHM_K + KSWZ(32 + sr, kc)) = sr_[i].ks1; } while (0)
#define SWAIT() do { asm volatile("s_waitcnt vmcnt(4)" ::: "memory"); } while (0)
#define RESC(a) do { if (__any((a) < 1.f)) { if (hi == 0) al_l[r32] = (a); asm volatile("s_waitcnt lgkmcnt(0)" ::: "memory"); \
    for (int d = 0; d < 4; ++d) for (int r = 0; r < 16; ++r) o[d][r] *= al_l[crow(r, hi)]; } } while (0)
  f32x16 pA0, pA1, pB0, pB1; float mnA, mnB, alA, alB; bf16x8 pa0, pa1, pa2, pa3; const int NT = seq / KVBLK;
  constexpr int SE = 0, SO = SDEPTH - 1;
  SLOAD(SE, 0); asm volatile("s_waitcnt vmcnt(0)" ::: "memory"); SWRITE(0, SE); __syncthreads();
  qkt(pA0, pA1, K_lds, qr, r32, hi); partialSM(pA0, pA1, m_reg, mnA, alA);
  SLOAD(SO, KVBLK); if (2 < NT) SLOAD(SE, 2 * KVBLK);
  SWAIT(); SWRITE(1, SO); __syncthreads();
  for (int j = 1; j + 1 < NT; j += 2) {
    SBAR(); qkt(pB0, pB1, (bf16_t*)((char*)K_lds + SHM_K), qr, r32, hi);
    finishSM(pA0, pA1, alA, l_reg, pa0, pa1, pa2, pa3); SBAR();
    SLOAD(SO, (j + SDEPTH) * KVBLK); SBAR();
    pv_d0(o, vb0, pa0, pa1, pa2, pa3); partialSM(pB0, pB1, m_reg, mnB, alB);
    __syncthreads(); SWAIT(); SWRITE(0, SE);
    RESC(alB); __syncthreads();
    SBAR(); qkt(pA0, pA1, K_lds, qr, r32, hi);
    finishSM(pB0, pB1, alB, l_reg, pa0, pa1, pa2, pa3); SBAR();
    if (j + 3 < NT) SLOAD(SE, (j + 1 + SDEPTH) * KVBLK); SBAR();
    pv_d0(o, vb0 + (int)SHM_V, pa0, pa1, pa2, pa3); partialSM(pA0, pA1, m_reg, mnA, alA);
    __syncthreads(); SWAIT(); SWRITE(1, SO);
    RESC(alA); __syncthreads();
  }
  SBAR(); qkt(pB0, pB1, (bf16_t*)((char*)K_lds + SHM_K), qr, r32, hi);
  finishSM(pA0, pA1, alA, l_reg, pa0, pa1, pa2, pa3); SBAR();
  pv_d0(o, vb0, pa0, pa1, pa2, pa3); partialSM(pB0, pB1, m_reg, mnB, alB);
  __syncthreads(); RESC(alB);
  finishSM(pB0, pB1, alB, l_reg, pa0, pa1, pa2, pa3); SBAR();
  pv_d0(o, vb0 + (int)SHM_V, pa0, pa1, pa2, pa3);
  if (hi == 0) li_l[r32] = l_reg; asm volatile("s_waitcnt lgkmcnt(0)" ::: "memory");
  float rli[16];
#pragma unroll
  for (int r = 0; r < 16; ++r) rli[r] = __builtin_amdgcn_rcpf(li_l[crow(r, hi)]);
  bf16_t* Ow = Ob + (long)(wid * QBLK) * LDO;
#pragma unroll
  for (int r = 0; r < 16; ++r) { int orow = crow(r, hi);
    for (int d0 = 0; d0 < 4; ++d0) Ow[(long)orow * LDO + d0 * 32 + r32] = (bf16_t)f2bf(o[d0][r] * rli[r]); }
#undef SLOAD
#undef SWRITE
#undef SWAIT
#undef RESC
}
#undef KSWZ
#undef SBAR
}

__device__ __forceinline__ void phase_attention(const Params& p, LAS unsigned char* lds, int G, int c) {
    const bf16_t* Q = (const bf16_t*)(p.ws + WS_Q); const bf16_t* KA = (const bf16_t*)(p.ws + WS_KA); const bf16_t* VA = (const bf16_t*)(p.ws + WS_VA); bf16_t* AO = (bf16_t*)(p.ws + WS_AO);
    for (int u = c; u < 576; u += G) {
        size_t qrow, kvoff; int h, seq;
        if (u < 512) { const int qb = u & 7, g = (u >> 3) & 3, kvh = (u >> 5) & 1, b = u >> 6; h = kvh * 4 + g; qrow = (size_t)b * SEQ + qb * 256; kvoff = (size_t)b * KVL * 256 + kvh * 128; seq = KVL; }
        else { const int uc = u - 512, b = uc >> 3; h = uc & 7; qrow = (size_t)ML + b * CTXL; kvoff = (size_t)b * KVL * 256 + (h >> 2) * 128; seq = CTXL; }
        attn::attn_dense_body<DM, 256, 2048>(Q + qrow * DM + h * 128, KA + kvoff, VA + kvoff, AO + qrow * 2048 + h * 128, seq, (char*)lds);
        __syncthreads();
    }
}
__device__ __forceinline__ void phase_moe_prenorm(const Params& p, LAS unsigned char* lds, int layer, const bf16_t* X, int nrows, bf16_t* H2, int gw, int NGW, int lane) {
    LAS float* RT = (LAS float*)lds;
    const float* router = p.in[I_ROUTER] + (size_t)layer * 1024 * 16;
    for (int i = TID_; i < 16384; i += 512) { const int k = i >> 4, e = i & 15; RT[e * 1024 + k] = router[i]; }
    __syncthreads();
    const float* mod = (const float*)(p.ws + WS_MOD) + (size_t)layer * 9 * 6144;
    float* aff = (float*)(p.ws + WS_AFF);
    const float* g = p.in[I_NORMG] + (size_t)(layer * 2 + 1) * 1024;
    constexpr int R = 4;
    for (int row0 = gw * R; row0 < nrows; row0 += NGW * R) {
        const int mr = row0 < ML ? (row0 >> 11) : 8;
        const float* m = mod + (size_t)mr * 6144;
        f32x4 v[R][4];
#pragma unroll
        for (int r = 0; r < R; ++r) ld_row_bf16(X + (size_t)(row0 + r) * DM, lane, v[r]);
        const float* const sh[R] = {m + 3072, m + 3072, m + 3072, m + 3072}; const float* const sc[R] = {m + 4096, m + 4096, m + 4096, m + 4096};
        ada_rows<R>(v, g, sh, sc, lane);
#pragma unroll
        for (int r = 0; r < R; ++r) st_row_bf16(H2 + (size_t)(row0 + r) * DM, lane, v[r]);
        float lg[R][16];
#pragma unroll
        for (int e = 0; e < 16; ++e) {
#pragma unroll
            for (int r = 0; r < R; ++r) lg[r][e] = 0.f;
#pragma unroll
            for (int j = 0; j < 4; ++j) { const f32x4 rt = *(const LAS f32x4*)(RT + e * 1024 + 256 * j + 4 * lane);
#pragma unroll
                for (int r = 0; r < R; ++r) lg[r][e] += (v[r][j].x * rt.x + v[r][j].y * rt.y) + (v[r][j].z * rt.z + v[r][j].w * rt.w); }
            asm volatile("" ::: "memory"); }
        float lgt[R];
#pragma unroll
        for (int r = 0; r < R; ++r) {
            float p8[8], p4[4], p2[2];
#pragma unroll
            for (int i = 0; i < 8; ++i) { const bool up = (lane & 32) != 0; const float keep = up ? lg[r][i + 8] : lg[r][i], send = up ? lg[r][i] : lg[r][i + 8]; p8[i] = keep + __shfl_xor(send, 32); }
#pragma unroll
            for (int i = 0; i < 4; ++i) { const bool up = (lane & 16) != 0; const float keep = up ? p8[i + 4] : p8[i], send = up ? p8[i] : p8[i + 4]; p4[i] = keep + __shfl_xor(send, 16); }
#pragma unroll
            for (int i = 0; i < 2; ++i) { const bool up = (lane & 8) != 0; const float keep = up ? p4[i + 2] : p4[i], send = up ? p4[i] : p4[i + 2]; p2[i] = keep + __shfl_xor(send, 8); }
            { const bool up = (lane & 4) != 0; const float keep = up ? p2[1] : p2[0], send = up ? p2[0] : p2[1]; lgt[r] = keep + __shfl_xor(send, 4); }
            lgt[r] += __shfl_xor(lgt[r], 2); lgt[r] += __shfl_xor(lgt[r], 1);
        }
        const int myexp = ((lane >> 5) & 1) * 8 + ((lane >> 4) & 1) * 4 + ((lane >> 3) & 1) * 2 + ((lane >> 2) & 1);
#pragma unroll
        for (int r = 0; r < R; ++r) {
            float mx = lgt[r];
#pragma unroll
            for (int o = 4; o < 64; o <<= 1) mx = fmaxf(mx, __shfl_xor(mx, o));
            const float ex = __expf(lgt[r] - mx); float sum = ex;
#pragma unroll
            for (int o = 4; o < 64; o <<= 1) sum += __shfl_xor(sum, o);
            if ((lane & 3) == 0) aff[(size_t)(row0 + r) * 16 + myexp] = ex * rcpf_(sum);
        }
    }
}

__device__ __forceinline__ int block_exscan(int flag, volatile LAS int* sm, int wave, int lane, int& tot) {
    const unsigned long long bal = __ballot(flag != 0);
    const int pre = __popcll(bal & ((1ull << lane) - 1ull)), wtot = __popcll(bal);
    __syncthreads();
    if (lane == 0) sm[wave] = wtot;
    __syncthreads();
    int base = 0, t = 0;
#pragma unroll
    for (int w = 0; w < 8; ++w) { const int x = sm[w]; base += (w < wave) ? x : 0; t += x; }
    tot = t; return base + pre;
}
__device__ __forceinline__ int block_sum(int v, volatile LAS int* sm, int wave, int lane) {
    v = wave_sum_i(v);
    __syncthreads();
    if (lane == 0) sm[wave] = v;
    __syncthreads();
    int t = 0;
#pragma unroll
    for (int w = 0; w < 8; ++w) t += sm[w];
    return t;
}
__device__ __forceinline__ void phase_select(const Params& p, LAS unsigned char* lds, int ntasks, int SL, int G, int c, int wave, int lane) {
    volatile LAS int* sm = (volatile LAS int*)lds;
    const float* aff = (const float*)(p.ws + WS_AFF);
    int* tokslot = (int*)(p.ws + WS_TOKSLOT); float* selaff = (float*)(p.ws + WS_SELAFF); int* selrow = (int*)(p.ws + WS_SELROW);
    const int tid = TID_;
    for (int tk = c; tk < ntasks; tk += G) {
        const bool lat = tk < 128; const int tt = lat ? tk : tk - 128, b = tt >> 4, e = tt & 15;
        const int n = lat ? SEQ : CTXL, cap = lat ? CAPL : CAPC, rowbase = lat ? b * SEQ : ML + b * CTXL, slotbase = lat ? b * CAPL : NB * CAPL + b * CAPC;
        unsigned key[4]; bool valid[4];
#pragma unroll
        for (int i = 0; i < 4; ++i) { const int idx = tid + 512 * i; valid[i] = idx < n; key[i] = valid[i] ? __float_as_uint(aff[(size_t)(rowbase + idx) * 16 + e]) : 0u; }
        unsigned prefix = 0u;
        for (int bit = 30; bit >= 0; --bit) {
            const unsigned cand = prefix | (1u << bit); int cnt = 0;
#pragma unroll
            for (int i = 0; i < 4; ++i) cnt += (valid[i] && key[i] >= cand) ? 1 : 0;
            if (block_sum(cnt, sm, wave, lane) >= cap) prefix = cand;
        }
        int cg = 0;
#pragma unroll
        for (int i = 0; i < 4; ++i) cg += (valid[i] && key[i] > prefix) ? 1 : 0;
        const int need_eq = cap - block_sum(cg, sm, wave, lane);
        int eqbase = 0, selbase = 0;
#pragma unroll
        for (int i = 0; i < 4; ++i) {
            const bool gt = valid[i] && key[i] > prefix, eq = valid[i] && key[i] == prefix;
            int tot; const int er = eqbase + block_exscan(eq ? 1 : 0, sm, wave, lane, tot); eqbase += tot;
            const bool sel = gt || (eq && er < need_eq);
            int tot2; const int slot = selbase + block_exscan(sel ? 1 : 0, sm, wave, lane, tot2); selbase += tot2;
            if (valid[i]) { const int row = rowbase + tid + 512 * i;
                tokslot[(size_t)row * 16 + e] = sel ? slotbase + slot : -1;
                if (sel) { selaff[(size_t)e * SL + slotbase + slot] = __uint_as_float(key[i]); selrow[(size_t)e * SL + slotbase + slot] = row; } }
        }
        __syncthreads();
    }
}

template <int R>
__device__ __forceinline__ void moe_gather_rows(const int* tokslot, const bf16_t* Ys, int SL, int row0, int lane, f32x4 (&acc)[R][4]) {
    int mys[R]; unsigned m[R]; unsigned any = 0u;
#pragma unroll
    for (int r = 0; r < R; ++r) { mys[r] = tokslot[(size_t)(row0 + r) * 16 + (lane & 15)];
#pragma unroll
        for (int j = 0; j < 4; ++j) acc[r][j] = (f32x4){0.f, 0.f, 0.f, 0.f}; }
#pragma unroll
    for (int r = 0; r < R; ++r) { m[r] = (unsigned)(__ballot(mys[r] >= 0) & 0xffffull); any |= m[r]; }
    while (any) {
        any = 0u;
#pragma unroll
        for (int r = 0; r < R; ++r) if (m[r]) { const int e = __builtin_ctz(m[r]); m[r] &= m[r] - 1u; any |= m[r]; const int s = __shfl(mys[r], e);
            const bf16_t* y = Ys + ((size_t)e * SL + s) * DM;
#pragma unroll
            for (int j = 0; j < 4; ++j) acc[r][j] += unpk4(*(const u32x2*)(y + 256 * j + 4 * lane)); }
    }
}

__device__ __forceinline__ void phase_combine_mix(const Params& p, LAS unsigned char* lds, int G, int c, int wave, int lane) {
    const float* mod0 = (const float*)(p.ws + WS_MOD); const float* mod1 = mod0 + 9 * 6144;
    const bf16_t* X1 = (const bf16_t*)(p.ws + WS_X1); bf16_t* X2 = (bf16_t*)(p.ws + WS_X2);
    const int* tokslot = (const int*)(p.ws + WS_TOKSLOT); const bf16_t* Ys = (const bf16_t*)(p.ws + WS_YS0);
    bf16_t* XR = (bf16_t*)(p.ws + WS_XR); bf16_t* XK = (bf16_t*)(p.ws + WS_XK); bf16_t* XV = (bf16_t*)(p.ws + WS_XV);
    bf16_t* XW = (bf16_t*)(p.ws + WS_XW); bf16_t* XA = (bf16_t*)(p.ws + WS_XA); bf16_t* XG = (bf16_t*)(p.ws + WS_XG);
    const float* mu = p.in[I_MU];
    constexpr int R = 4, BR = 24;
    for (int blk = c; blk < MT / BR; blk += G) {
        const int base = blk * BR, r0 = base + 3 * wave;
        int xr = wave == 0 ? base - 1 : wave == 7 ? base + BR : -1;
        if (xr >= MT) xr = -1;
        const bool has_x = xr >= 0;
        int rows[R] = {r0, r0 + 1, r0 + 2, has_x ? xr : r0};
        f32x4 v[R][4]; f32x4 acc[R][4];
        int mys[R]; unsigned m[R]; unsigned any = 0u;
#pragma unroll
        for (int r = 0; r < R; ++r) { ld_row_bf16(X1 + (size_t)rows[r] * DM, lane, v[r]); mys[r] = tokslot[(size_t)rows[r] * 16 + (lane & 15)];
#pragma unroll
            for (int j = 0; j < 4; ++j) acc[r][j] = (f32x4){0.f, 0.f, 0.f, 0.f}; }
#pragma unroll
        for (int r = 0; r < R; ++r) { m[r] = (unsigned)(__ballot(mys[r] >= 0) & 0xffffull); any |= m[r]; }
        while (any) {
            any = 0u;
#pragma unroll
            for (int r = 0; r < R; ++r) if (m[r]) { const int e = __builtin_ctz(m[r]); m[r] &= m[r] - 1u; any |= m[r]; const int s = __shfl(mys[r], e);
                const bf16_t* y = Ys + ((size_t)e * SL0 + s) * DM;
#pragma unroll
                for (int j = 0; j < 4; ++j) acc[r][j] += unpk4(*(const u32x2*)(y + 256 * j + 4 * lane)); }
        }
        const float* shp[R]; const float* scp[R];
#pragma unroll
        for (int r = 0; r < R; ++r) { const int mr = rows[r] < ML ? (rows[r] >> 11) : 8; const float* gt2 = mod0 + (size_t)mr * 6144 + 5120;
#pragma unroll
            for (int j = 0; j < 4; ++j) v[r][j] = v[r][j] + *(const f32x4*)(gt2 + 256 * j + 4 * lane) * acc[r][j];
            shp[r] = mod1 + (size_t)mr * 6144; scp[r] = shp[r] + 1024; }
#pragma unroll
        for (int r = 0; r < 3; ++r) st_row_bf16(X2 + (size_t)rows[r] * DM, lane, v[r]);
        {   const float* const sh[R] = {shp[0], shp[1], shp[2], shp[3]}; const float* const sc[R] = {scp[0], scp[1], scp[2], scp[3]};
            ada_rows<R>(v, p.in[I_NORMG] + 2 * 1024, sh, sc, lane); }
#pragma unroll
        for (int r = 0; r < R; ++r) { const int slot = rows[r] - (base - 1);
            if (r < 3 || has_x) {
#pragma unroll
                for (int j = 0; j < 4; ++j) *(LAS u32x2*)(lds + slot * 2048 + (256 * j + 4 * lane) * 2) = pk4(v[r][j]); } }
        __syncthreads();
#pragma unroll
        for (int r = 0; r < 3; ++r) {
            const int row = rows[r]; const bool lat = row < ML; const int t = lat ? (row & 2047) : ((row - ML) & 255), T = lat ? SEQ : CTXL;
            const int slot = row - (base - 1); const bool vp = t > 0, vn = t < T - 1;
#pragma unroll
            for (int j = 0; j < 4; ++j) {
                const int cc = 256 * j + 4 * lane;
                const f32x4 z0 = (f32x4){0.f, 0.f, 0.f, 0.f}; const f32x4 hp = vp ? unpk4(*(const LAS u32x2*)(lds + (slot - 1) * 2048 + cc * 2)) : z0, hn = vn ? unpk4(*(const LAS u32x2*)(lds + (slot + 1) * 2048 + cc * 2)) : z0;
                const f32x4 h = v[r][j], xx = (hp + hn) * 0.5f - h; const size_t o = (size_t)row * DM + cc;
                *(u32x2*)(XW + o) = pk4(h + xx * *(const f32x4*)(mu + 1 * 1024 + cc)); *(u32x2*)(XK + o) = pk4(h + xx * *(const f32x4*)(mu + 2 * 1024 + cc));
                *(u32x2*)(XV + o) = pk4(h + xx * *(const f32x4*)(mu + 3 * 1024 + cc)); *(u32x2*)(XA + o) = pk4(h + xx * *(const f32x4*)(mu + 4 * 1024 + cc));
                if (lat) { *(u32x2*)(XR + o) = pk4(h + xx * *(const f32x4*)(mu + 0 * 1024 + cc)); *(u32x2*)(XG + o) = pk4(h + xx * *(const f32x4*)(mu + 5 * 1024 + cc)); }
            }
        }
        __syncthreads();
    }
}

__device__ __forceinline__ bf16x8 tanh8(bf16x8 x) {
    bf16x8 o;
#pragma unroll
    for (int j = 0; j < 8; ++j) { const float v = bf2f((unsigned short)x[j]); o[j] = (short)f2bf(1.0f - 2.0f * rcpf_(1.0f + __expf(2.0f * v))); }
    return o;
}
namespace cs {
constexpr int O_V = 0, O_KQ = 2048, O_RQ = 4096, O_KKP = 6144, O_NBKP = 8192, O_KK = 10240, O_BK = 12288, O_GC = 14336, O_AT = 14592, O_ANA4 = 15104, O_AA1 = 15616, O_AA3 = 16128, SLOT = 16640;
constexpr int NSLOT = 8, WOFF = NSLOT * SLOT  , CNT_OFF = WOFF + 16384  ,
              CST_OFF = CNT_OFF + 64  ;
constexpr int NCHUNK = (CTXL + SEQ) / 16, NROUND = NCHUNK / 4;
static_assert(CST_OFF + 1280 <= RING_BYTES, "LDS");
__device__ __forceinline__ s16x4 pkbf(f32x4 v) { u32x2 w; w.x = pg8::cvt_pk_bf16(v.x, v.y); w.y = pg8::cvt_pk_bf16(v.z, v.w); return __builtin_bit_cast(s16x4, w); }
__device__ __forceinline__ f32x4 mfma16(s16x4 a, s16x4 b, f32x4 c) { return __builtin_amdgcn_mfma_f32_16x16x16bf16_1k(a, b, c, 0, 0, 0); }
__device__ __forceinline__ bf16x8 cat8(s16x4 a, s16x4 b) { return (bf16x8){a[0], a[1], a[2], a[3], b[0], b[1], b[2], b[3]}; }
__device__ __forceinline__ int step_row(int c, int s, int b, int d) { const int g = c * 16 + s; if (g < CTXL) return ML + b * CTXL + (d ? (CTXL - 1 - g) : g); const int gl = g - CTXL; return b * SEQ + (d ? (SEQ - 1 - gl) : gl); }
struct Raw { bf16x8 xw[2], xa[2]; u32x4 kb[2], vb[2], rb[2]; };
__device__ __forceinline__ void unpack16(const u32x4 (&w)[2], float (&o)[16]) {
#pragma unroll
    for (int m = 0; m < 8; ++m) { const unsigned x = w[m >> 2][m & 3]; o[2 * m] = bf2f(x & 0xffffu); o[2 * m + 1] = bf2f(x >> 16); }
}
__device__ __forceinline__ void pack16(const float (&v)[16], u32x4& lo, u32x4& hi) {
#pragma unroll
    for (int m = 0; m < 4; ++m) { lo[m] = pg8::cvt_pk_bf16(v[2 * m], v[2 * m + 1]); hi[m] = pg8::cvt_pk_bf16(v[8 + 2 * m], v[8 + 2 * m + 1]); }
}
}
__device__ __forceinline__ void phase_scan(const Params& p, LAS unsigned char* lds, int G, int c, int wave, int lane, int variant = 0) {
    using namespace cs;
    const bf16_t* RB = (const bf16_t*)(p.ws + WS_RB); const bf16_t* KB = (const bf16_t*)(p.ws + WS_KB); const bf16_t* VB = (const bf16_t*)(p.ws + WS_VB);
    const int fr = lane & 15, fq = lane >> 4;
    for (int sid = c; sid < 256; sid += G) {
        const int d = sid & 1, h = (sid >> 1) & 15, b = sid >> 5;
        const bf16_t* T1w = (const bf16_t*)(p.ws + WS_T1); const bf16_t* T1a = T1w + (size_t)MT * 128;
        const bf16_t* W2h = (const bf16_t*)(p.ws + WS_W2T) + ((size_t)d * 1024 + h * 64) * 64; const bf16_t* A2h = (const bf16_t*)(p.ws + WS_A2T) + ((size_t)d * 1024 + h * 64) * 64;
        const float* w0h = p.in[I_W0] + d * 1024 + h * 64; const float* a0h = p.in[I_A0] + d * 1024 + h * 64;
        bf16_t* Y = (bf16_t*)(p.ws + (variant ? WS_KK : (d ? WS_Y1 : WS_Y0)));
        __syncthreads();
        {   const int t_ = TID_;
            if (t_ == 0) *(volatile LAS unsigned*)(lds + cs::CNT_OFF) = 0u;
#pragma unroll
            for (int i = 0; i < 2; ++i) { const int q_ = t_ + 512 * i, m_ = q_ >> 9, ch_ = (q_ >> 3) & 63, c8_ = q_ & 7;
                *(LAS u32x4*)(lds + WOFF + m_ * 8192 + ch_ * 128 + ((c8_ ^ (ch_ & 7)) << 4)) = *(const u32x4*)((m_ ? A2h : W2h) + (size_t)ch_ * 64 + 8 * c8_); }
            if (t_ < 320) { const int a_ = t_ >> 6, c_ = t_ & 63; const float* src_ = a_ == 0 ? p.in[I_KK] + h * 64 : a_ == 1 ? p.in[I_KA] + h * 64 : a_ == 2 ? p.in[I_RK] + h * 64 : a_ == 3 ? w0h : a0h;
                *(LAS float*)(lds + CST_OFF + t_ * 4) = src_[c_]; }
        }
        __syncthreads();
        if (wave >= 4) {
            const int pw = wave - 4, step = lane >> 2, qt = lane & 3;
            float* BON = (float*)(p.ws + (variant ? WS_KK + 33 * MiB : WS_BON)) + (size_t)d * ML * 16;
            const LAS float* cst = (const LAS float*)(lds + CST_OFF);
            Raw raw, nxt;
#define CS_LOAD(raw, ch) do { const int row_ = step_row((ch), step, b, d); const size_t o_ = (size_t)row_ * DM + h * 64 + 16 * qt; \
            raw.kb[0] = *(const u32x4*)(KB + o_); raw.kb[1] = *(const u32x4*)(KB + o_ + 8); \
            raw.vb[0] = *(const u32x4*)(VB + o_); raw.vb[1] = *(const u32x4*)(VB + o_ + 8); \
            if (row_ < ML) { raw.rb[0] = *(const u32x4*)(RB + o_); raw.rb[1] = *(const u32x4*)(RB + o_ + 8); } else { raw.rb[0] = (u32x4){0u, 0u, 0u, 0u}; raw.rb[1] = (u32x4){0u, 0u, 0u, 0u}; } \
            const size_t x_ = (size_t)step_row((ch), fr, b, d) * 128 + d * 64 + 8 * fq; \
            raw.xw[0] = *(const bf16x8*)(T1w + x_); raw.xw[1] = *(const bf16x8*)(T1w + x_ + 32); raw.xa[0] = *(const bf16x8*)(T1a + x_); raw.xa[1] = *(const bf16x8*)(T1a + x_ + 32); } while (0)
            CS_LOAD(nxt, pw);
            for (int g = -1; g + 1 < NROUND; ++g) {
                const int ch = 4 * (g + 1) + pw;
                LAS unsigned char* slot = lds + (((g + 1) & 1) * 4 + pw) * SLOT;
                raw = nxt;
                if (ch + 4 < NCHUNK) CS_LOAD(nxt, ch + 4);
                if (!(variant & 1)) {
                {
                    const bf16x8 xw0 = tanh8(raw.xw[0]), xw1 = tanh8(raw.xw[1]);
#pragma unroll
                    for (int ct = 0; ct < 4; ++ct) {
                        const int chl = 16 * ct + fr; const LAS unsigned char* wrow = lds + WOFF + chl * 128;
                        const int o0 = (fq ^ (chl & 7)) << 4, o1 = ((4 + fq) ^ (chl & 7)) << 4;
                        f32x4 aw = (f32x4){0.f, 0.f, 0.f, 0.f}, aa_ = aw;
                        aw = __builtin_amdgcn_mfma_f32_16x16x32_bf16(*(const LAS bf16x8*)(wrow + o0), xw0, aw, 0, 0, 0); aw = __builtin_amdgcn_mfma_f32_16x16x32_bf16(*(const LAS bf16x8*)(wrow + o1), xw1, aw, 0, 0, 0);
                        aa_ = __builtin_amdgcn_mfma_f32_16x16x32_bf16(*(const LAS bf16x8*)(wrow + 8192 + o0), raw.xa[0], aa_, 0, 0, 0); aa_ = __builtin_amdgcn_mfma_f32_16x16x32_bf16(*(const LAS bf16x8*)(wrow + 8192 + o1), raw.xa[1], aa_, 0, 0, 0);
                        const f32x4 wb = *(const LAS f32x4*)(cst + 192 + 16 * ct + 4 * fq), ab = *(const LAS f32x4*)(cst + 256 + 16 * ct + 4 * fq);
                        f32x4 ldv, aav;
#pragma unroll
                        for (int r = 0; r < 4; ++r) { ldv[r] = -0.6065306597126334f * sigmoidf_(aw[r] + wb[r]); aav[r] = sigmoidf_(aa_[r] + ab[r]); }
                        *(LAS u32x2*)(slot + O_KK + fr * 128 + (16 * ct + 4 * fq) * 2) = pk4(ldv); *(LAS u32x2*)(slot + O_BK + fr * 128 + (16 * ct + 4 * fq) * 2) = pk4(aav);
                    }
                }
                {
                    float lgv = 0.f;
#pragma unroll
                    for (int t = 0; t < 16; ++t) { lgv += bf2f(*(const LAS unsigned short*)(slot + O_KK + t * 128 + lane * 2)); *(LAS float*)(slot + O_KKP + (t * 64 + lane) * 4) = lgv; }
                    *(LAS float*)(slot + O_GC + lane * 4) = __expf(lgv); }
                float rn;
                {
                    float ss = 0.f;
#pragma unroll
                    for (int hh = 0; hh < 2; ++hh) { float kbv[8]; unpk8(raw.kb[hh], kbv);
#pragma unroll
                        for (int i = 0; i < 8; ++i) { const float t = kbv[i] * cst[16 * qt + 8 * hh + i]; ss += t * t; } }
                    ss += dpp_mov<0xB1>(ss); ss += dpp_mov<0x4E>(ss);
                    rn = rsqf_(fmaxf(ss, 1e-24f));
                }
                u32x4 ldw[2], aaw[2]; f32x4 lgq[4];
#pragma unroll
                for (int hh = 0; hh < 2; ++hh) { ldw[hh] = *(const LAS u32x4*)(slot + O_KK + step * 128 + qt * 32 + 16 * hh); aaw[hh] = *(const LAS u32x4*)(slot + O_BK + step * 128 + qt * 32 + 16 * hh); }
#pragma unroll
                for (int qq = 0; qq < 4; ++qq) lgq[qq] = *(const LAS f32x4*)(slot + O_KKP + (step * 64 + 16 * qt + 4 * qq) * 4);
                asm volatile("s_waitcnt lgkmcnt(0)" ::: "memory");
                float bsum = 0.f;
                const int sw = (qt ^ ((step >> 1) & 3)) << 5, rowo = step * 128 + sw, hbit = (step >> 3) & 1;
#pragma unroll
                for (int qq = 0; qq < 4; ++qq) {
                    const int hh = qq >> 1, sub = qq & 1;
                    const f32x4 lg4 = lgq[qq], gc4 = *(const LAS f32x4*)(slot + O_GC + (16 * qt + 4 * qq) * 4);
                    const u32x2 ldp = sub ? (u32x2){ldw[hh].z, ldw[hh].w} : (u32x2){ldw[hh].x, ldw[hh].y}, aap = sub ? (u32x2){aaw[hh].z, aaw[hh].w} : (u32x2){aaw[hh].x, aaw[hh].y};
                    const u32x2 kbp = sub ? (u32x2){raw.kb[hh].z, raw.kb[hh].w} : (u32x2){raw.kb[hh].x, raw.kb[hh].y}, rbp = sub ? (u32x2){raw.rb[hh].z, raw.rb[hh].w} : (u32x2){raw.rb[hh].x, raw.rb[hh].y};
                    const f32x4 ld4 = unpk4(ldp), aa4 = unpk4(aap), kb4 = unpk4(kbp), rr4 = unpk4(rbp);
                    const int c0 = 16 * qt + 4 * qq;
                    const f32x4 kkw = *(const LAS f32x4*)(cst + c0), kaw = *(const LAS f32x4*)(cst + 64 + c0), rkw = *(const LAS f32x4*)(cst + 128 + c0);
                    f32x4 oKq, oRq, oKk, oBk, oKkp, oNBkp;
#pragma unroll
                    for (int i = 0; i < 4; ++i) {
                        const float e0 = __expf(lg4[i]), em = rcpf_(e0), e1 = __expf(lg4[i] - ld4[i]);
                        const float kk = kb4[i] * kkw[i] * rn;
                        const float beta = kk * aa4[i], kt_ = kb4[i] * ((aa4[i] - 1.0f) * kaw[i] + 1.0f);
                        oKq[i] = kk * e1; oRq[i] = rr4[i] * e0; oKk[i] = kt_ * em; oBk[i] = beta * em; oKkp[i] = oKk[i] * gc4[i]; oNBkp[i] = -(oBk[i] * gc4[i]);
                        bsum += rr4[i] * kt_ * rkw[i]; }
                    const int ho = (hh ^ hbit) * 16 + sub * 8;
                    *(LAS u32x2*)(slot + O_KQ + rowo + ho) = pk4(oKq); *(LAS u32x2*)(slot + O_RQ + rowo + ho) = pk4(oRq);
                    *(LAS u32x2*)(slot + O_KK + rowo + ho) = pk4(oKk); *(LAS u32x2*)(slot + O_BK + rowo + ho) = pk4(oBk);
                    *(LAS u32x2*)(slot + O_KKP + rowo + qq * 8) = pk4(oKkp); *(LAS u32x2*)(slot + O_NBKP + rowo + qq * 8) = pk4(oNBkp);
                }
                *(LAS u32x4*)(slot + O_V + rowo) = raw.vb[0]; *(LAS u32x4*)(slot + O_V + rowo + 16) = raw.vb[1];
                bsum += dpp_mov<0xB1>(bsum); bsum += dpp_mov<0x4E>(bsum);
                { const int brow = step_row(ch, step, b, d); if (qt == 0 && brow < ML) BON[(size_t)brow * 16 + h] = bsum; }
                }
                __syncthreads();
            }
            __syncthreads();
#undef CS_LOAD
        } else {
            const int j = wave;
            f32x4 z[4];
#pragma unroll
            for (int kt = 0; kt < 4; ++kt) z[kt] = (f32x4){0.f, 0.f, 0.f, 0.f};
            const int trr = 4 * fq + (fr >> 2);
            const int trbase = trr * 128 + 8 * (fr & 3), trsw = (trr >> 1) & 3;
            const int rdsw = (fr >> 1) & 3, rdq = (fq ^ (((fr >> 3) & 1) << 1)) << 3;
            __syncthreads();
            volatile LAS unsigned* ccnt = (volatile LAS unsigned*)(lds + CNT_OFF);
            for (int g = 0; g < NROUND; ++g) {
                if (!(variant & 2)) {   LAS unsigned char* dslot = lds + ((g & 1) * 4 + j) * SLOT;
                s16x4 rKq[4], rRq[4], rKk[4], rBk[4];
#pragma unroll
                for (int kt = 0; kt < 4; ++kt) { const int off = fr * 128 + ((kt ^ ((fr >> 1) & 3)) << 5) + ((fq ^ (((fr >> 3) & 1) << 1)) << 3);
                    rKq[kt] = *(const LAS s16x4*)(dslot + O_KQ + off); rRq[kt] = *(const LAS s16x4*)(dslot + O_RQ + off); rKk[kt] = *(const LAS s16x4*)(dslot + O_KK + off); rBk[kt] = *(const LAS s16x4*)(dslot + O_BK + off); }
                f32x4 dL = (f32x4){0.f, 0.f, 0.f, 0.f}, dLt = dL, dA1t = dL, dA3t = dL, dA4t = dL;
#pragma unroll
                for (int kt = 0; kt < 4; ++kt) { dL = mfma16(rKq[kt], rBk[kt], dL); dLt = mfma16(rBk[kt], rKq[kt], dLt); dA1t = mfma16(rKk[kt], rKq[kt], dA1t); dA3t = mfma16(rKk[kt], rRq[kt], dA3t); dA4t = mfma16(rBk[kt], rRq[kt], dA4t); }
                f32x4 dN, dNt, a1, a3, na4, eye;
#pragma unroll
                for (int r = 0; r < 4; ++r) { const int ROW = 4 * fq + r, COL = fr;
                    dN[r] = ROW > COL ? -dL[r] : 0.f; dNt[r] = COL > ROW ? -dLt[r] : 0.f; a1[r] = COL > ROW ? dA1t[r] : 0.f; a3[r] = COL >= ROW ? dA3t[r] : 0.f; na4[r] = COL >= ROW ? -dA4t[r] : 0.f; eye[r] = ROW == COL ? 1.f : 0.f; }
                const f32x4 z4 = (f32x4){0.f, 0.f, 0.f, 0.f};
                const s16x4 bN = pkbf(dN), bNt = pkbf(dNt);
                const f32x4 dN2 = mfma16(bNt, bN, z4), dN2t = mfma16(bN, bNt, z4);
                const s16x4 bN2 = pkbf(dN2), bN2t = pkbf(dN2t);
                const f32x4 dN4 = mfma16(bN2t, bN2, z4), dN4t = mfma16(bN2, bN2t, z4);
                const f32x4 dN8 = mfma16(pkbf(dN4t), pkbf(dN4), z4);
                const f32x4 q1 = mfma16(pkbf(eye + dN2), pkbf(eye + dNt), z4);
                const f32x4 q2 = mfma16(pkbf(eye + dN4), pkbf(q1), z4);
                const f32x4 tT = mfma16(pkbf(eye + dN8), pkbf(q2), z4);
                *(LAS s16x4*)(dslot + O_AT + lane * 8) = pkbf(tT); *(LAS s16x4*)(dslot + O_ANA4 + lane * 8) = pkbf(na4);
                *(LAS s16x4*)(dslot + O_AA1 + lane * 8) = pkbf(a1); *(LAS s16x4*)(dslot + O_AA3 + lane * 8) = pkbf(a3);
                }
                asm volatile("s_waitcnt lgkmcnt(0)" ::: "memory");
                if (lane == 0) __hip_atomic_fetch_add((LAS unsigned*)(lds + CNT_OFF), 1u, __ATOMIC_RELAXED, __HIP_MEMORY_SCOPE_WORKGROUP);
                while (*ccnt < 4u * (unsigned)(g + 1)) __builtin_amdgcn_s_sleep(0);
                asm volatile("" ::: "memory");
                if (!(variant & 4))
#pragma unroll
                for (int cc = 0; cc < 4; ++cc) {
                    const int ch = 4 * g + cc; const bool emit = ch >= CTXL / 16;
                    const LAS unsigned char* slot = lds + ((g & 1) * 4 + cc) * SLOT;
                    const s16x4 aT = *(const LAS s16x4*)(slot + O_AT + lane * 8), anA4 = *(const LAS s16x4*)(slot + O_ANA4 + lane * 8);
                    const s16x4 aA1 = *(const LAS s16x4*)(slot + O_AA1 + lane * 8), aA3 = *(const LAS s16x4*)(slot + O_AA3 + lane * 8);
                    const s16x4 vcol = __builtin_amdgcn_ds_read_tr16_b64_v4i16((LAS s16x4*)(slot + O_V + trbase + ((j ^ trsw) << 5)));
                    const f32x4 z4 = (f32x4){0.f, 0.f, 0.f, 0.f};
                    f32x4 acc = mfma16(aA1, vcol, z4), accY = z4;
                    if (emit) accY = mfma16(aA3, vcol, z4);
#pragma unroll
                    for (int pr = 0; pr < 2; ++pr) {
                        const int o0 = fr * 128 + (((2 * pr) ^ rdsw) << 5) + rdq, o1 = fr * 128 + (((2 * pr + 1) ^ rdsw) << 5) + rdq;
                        const bf16x8 bz = cat8(pkbf(z[2 * pr]), pkbf(z[2 * pr + 1]));
                        const bf16x8 aq = cat8(*(const LAS s16x4*)(slot + O_KQ + o0), *(const LAS s16x4*)(slot + O_KQ + o1));
                        acc = __builtin_amdgcn_mfma_f32_16x16x32_bf16(aq, bz, acc, 0, 0, 0);
                        if (emit) { const bf16x8 ar = cat8(*(const LAS s16x4*)(slot + O_RQ + o0), *(const LAS s16x4*)(slot + O_RQ + o1));
                            accY = __builtin_amdgcn_mfma_f32_16x16x32_bf16(ar, bz, accY, 0, 0, 0); }
                    }
                    const f32x4 U = mfma16(aT, pkbf(acc), z4);
                    const s16x4 ub = pkbf(U);
                    if (emit) { accY = mfma16(anA4, ub, accY);
#pragma unroll
                        for (int r = 0; r < 4; ++r) Y[(size_t)step_row(ch, 4 * fq + r, b, d) * DM + h * 64 + 16 * j + fr] = (bf16_t)f2bf(accY[r]); }
                    const bf16x8 bvu = cat8(vcol, ub);
#pragma unroll
                    for (int kt = 0; kt < 4; ++kt) {
                        const int to = trbase + ((kt ^ trsw) << 5);
                        const bf16x8 ak = cat8(__builtin_amdgcn_ds_read_tr16_b64_v4i16((LAS s16x4*)(slot + O_KKP + to)), __builtin_amdgcn_ds_read_tr16_b64_v4i16((LAS s16x4*)(slot + O_NBKP + to)));
                        const f32x4 gcv = *(const LAS f32x4*)(slot + O_GC + (16 * kt + 4 * fq) * 4);
                        z[kt] = __builtin_amdgcn_mfma_f32_16x16x32_bf16(ak, bvu, z[kt] * gcv, 0, 0, 0);
                    }
                }
                __syncthreads();
            }
        }
    }
}

constexpr int RO_STRIDE = 2064;
__device__ __forceinline__ bf16x8 sigm8(bf16x8 x) {
    bf16x8 o;
#pragma unroll
    for (int j = 0; j < 8; ++j) o[j] = (short)f2bf(sigmoidf_(bf2f((unsigned short)x[j])));
    return o;
}
__device__ __forceinline__ void phase_readout(const Params& p, LAS unsigned char* lds, int G, int c, int wave, int lane) {
    const bf16_t* T1g = (const bf16_t*)(p.ws + WS_T1) + (size_t)2 * MT * 128; const bf16_t* G2T = (const bf16_t*)(p.ws + WS_G2T);
    const bf16_t* RB = (const bf16_t*)(p.ws + WS_RB); const bf16_t* KB = (const bf16_t*)(p.ws + WS_KB); const bf16_t* VB = (const bf16_t*)(p.ws + WS_VB);
    const float* BON0 = (const float*)(p.ws + WS_BON); const float* BON1 = BON0 + (size_t)ML * 16;
    const bf16_t* Y0 = (const bf16_t*)(p.ws + WS_Y0); const bf16_t* Y1 = (const bf16_t*)(p.ws + WS_Y1);
    bf16_t* Z = (bf16_t*)(p.ws + WS_Z);
    const int fr = lane & 15, fq = lane >> 4;
    for (int tile = c; tile < ML / 32; tile += G) {
        const int tok0 = tile * 32;
        bf16x8 xb[2][4];
#pragma unroll
        for (int tt = 0; tt < 2; ++tt)
#pragma unroll
            for (int ks = 0; ks < 4; ++ks) xb[tt][ks] = sigm8(*(const bf16x8*)(T1g + (size_t)(tok0 + tt * 16 + fr) * 128 + 32 * ks + 8 * fq));
#pragma unroll
        for (int ct = 0; ct < 8; ++ct) {
            const int ch0 = wave * 128 + ct * 16;
            const bf16_t* wr_ = G2T + (size_t)(ch0 + fr) * 128 + 8 * fq;
            f32x4 acc0 = (f32x4){0.f, 0.f, 0.f, 0.f}, acc1 = (f32x4){0.f, 0.f, 0.f, 0.f};
#pragma unroll
            for (int ks = 0; ks < 4; ++ks) { const bf16x8 wa = *(const bf16x8*)(wr_ + 32 * ks);
                acc0 = __builtin_amdgcn_mfma_f32_16x16x32_bf16(wa, xb[0][ks], acc0, 0, 0, 0);
                acc1 = __builtin_amdgcn_mfma_f32_16x16x32_bf16(wa, xb[1][ks], acc1, 0, 0, 0); }
            *(LAS u32x2*)(lds + (fr) * RO_STRIDE + (ch0 + 4 * fq) * 2) = pk4(acc0);
            *(LAS u32x2*)(lds + (16 + fr) * RO_STRIDE + (ch0 + 4 * fq) * 2) = pk4(acc1);
        }
        __syncthreads();
        for (int i = 0; i < 4; ++i) {
            const int tl = wave * 4 + i, row = tok0 + tl; const size_t o = (size_t)row * DM + 16 * lane;
            f32x4 y[4]; float s = 0.f;
#pragma unroll
            for (int q = 0; q < 4; ++q) { y[q] = unpk4(*(const u32x2*)(Y0 + o + 4 * q)) + unpk4(*(const u32x2*)(Y1 + o + 4 * q)); s += (y[q].x + y[q].y) + (y[q].z + y[q].w); }
            s += __shfl_xor(s, 1); s += __shfl_xor(s, 2);
            const float mean = s * (1.0f / 64.0f); float vs = 0.f;
#pragma unroll
            for (int q = 0; q < 4; ++q) { y[q] = y[q] - mean; vs += (y[q].x * y[q].x + y[q].y * y[q].y) + (y[q].z * y[q].z + y[q].w * y[q].w); }
            vs += __shfl_xor(vs, 1); vs += __shfl_xor(vs, 2);
            const float rstd = rsqf_(vs * (1.0f / 64.0f) + 64e-5f);
            f32x4 v4[4];
#pragma unroll
            for (int q = 0; q < 4; ++q) v4[q] = unpk4(*(const u32x2*)(VB + o + 4 * q));
            const float bs = BON0[(size_t)row * 16 + (lane >> 2)] + BON1[(size_t)row * 16 + (lane >> 2)];
#pragma unroll
            for (int q = 0; q < 4; ++q) {
                const int cc = 16 * lane + 4 * q;
                const f32x4 lw = *(const f32x4*)(p.in[I_LNW] + cc), lb = *(const f32x4*)(p.in[I_LNB] + cc);
                const f32x4 g4 = unpk4(*(const LAS u32x2*)(lds + tl * RO_STRIDE + cc * 2));
                const f32x4 z = ((y[q] * rstd) * lw + lb + v4[q] * bs) * g4;
                *(u32x2*)(Z + o + 4 * q) = pk4(z);
            }
        }
        __syncthreads();
    }
}

__device__ __forceinline__ void phase_final(const Params& p, int gw, int NGW, int lane) {
    const float* mod1 = (const float*)(p.ws + WS_MOD) + 9 * 6144;
    const bf16_t* X3 = (const bf16_t*)(p.ws + WS_X3); const int* tokslot = (const int*)(p.ws + WS_TOKSLOT); const bf16_t* Ys = (const bf16_t*)(p.ws + WS_YS1);
    const float* fg = p.in[I_FINALG];
    constexpr int R = 4;
    for (int row0 = gw * R; row0 < ML; row0 += NGW * R) {
        const int mr = row0 >> 11;
        f32x4 v[R][4];
#pragma unroll
        for (int r = 0; r < R; ++r) ld_row_bf16(X3 + (size_t)(row0 + r) * DM, lane, v[r]);
        f32x4 acc[R][4]; moe_gather_rows<R>(tokslot, Ys, SL1, row0, lane, acc);
        const float* gt2 = mod1 + (size_t)mr * 6144 + 5120;
        float ss[R];
#pragma unroll
        for (int r = 0; r < R; ++r) ss[r] = 0.f;
#pragma unroll
        for (int j = 0; j < 4; ++j) { const f32x4 g4 = *(const f32x4*)(gt2 + 256 * j + 4 * lane);
#pragma unroll
            for (int r = 0; r < R; ++r) { v[r][j] = v[r][j] + g4 * acc[r][j]; ss[r] += (v[r][j].x * v[r][j].x + v[r][j].y * v[r][j].y) + (v[r][j].z * v[r][j].z + v[r][j].w * v[r][j].w); } }
#pragma unroll
        for (int o = 1; o < 64; o <<= 1) {
#pragma unroll
            for (int r = 0; r < R; ++r) ss[r] += __shfl_xor(ss[r], o); }
#pragma unroll
        for (int j = 0; j < 4; ++j) { const f32x4 f4 = *(const f32x4*)(fg + 256 * j + 4 * lane);
#pragma unroll
            for (int r = 0; r < R; ++r) v[r][j] = (v[r][j] * rsqf_(ss[r] * (1.0f / DM) + 1e-6f)) * f4; }
#pragma unroll
        for (int r = 0; r < R; ++r) st_row_f32(p.out + (size_t)(row0 + r) * DM, lane, v[r]);
    }
}

constexpr int NPH = 22;
__global__ void __launch_bounds__(512, 2) mega_fwd(Params p) {
    extern __shared__ __attribute__((aligned(16))) unsigned char lds_raw[];
    LAS unsigned char* lds = (LAS unsigned char*)lds_raw;
    const int tid = threadIdx.x, wave = __builtin_amdgcn_readfirstlane(tid >> 6);
    const int G = gridDim.x, bx = blockIdx.x, vcu = (G % 8 == 0) ? (bx % 8) * (G / 8) + bx / 8 : bx;
    const int gw = vcu * 8 + wave, NGW = G * 8;
    for (int u = tid; u < (LDS_BYTES - LDSCTL_OFF) / 4; u += 512) ((LAS unsigned*)(lds + LDSCTL_OFF))[u] = 0u;
    __syncthreads();
    const int lo = p.ph_lo, hi = p.ph_hi;
    XcdBarrier bar; bar.bar = (unsigned*)(p.ws + WS_CTL) + CTL_BAR_WORD; bar.x = 0; bar.st = (volatile LAS unsigned*)(lds + MISC_OFF + 32);
    if (hi - lo > 1) bar = xcd_barrier_post((unsigned*)(p.ws + WS_CTL) + CTL_BAR_WORD, (volatile LAS unsigned*)(lds + MISC_OFF + 32));
#ifndef PHMASK
#define PHMASK 0x3fffff
#endif
#define IN(k) (((PHMASK >> (k)) & 1) && lo <= (k) && (k) < hi)
#define SEAM(k) do { if (IN(k) && IN((k) + 1)) xcd_barrier(bar); } while (0)
#ifndef SCANVAR
#define SCANVAR 0
#endif
#ifndef FILLMASK
#define FILLMASK 0
#endif
#ifndef DUPMASK
#ifndef CONVDUP
#define CONVDUP 0
#endif
#ifndef GEMMDUP
#define GEMMDUP 0
#endif
#define CDUP(n) ((CONVDUP >> (n)) & 1)
#define GDUP(n) ((GEMMDUP >> (n)) & 1)
#define DUPMASK 0
#endif
#define DUP(k) (((DUPMASK >> (k)) & 1) != 0)
    unsigned char* ws = p.ws;
#define ctlw ((unsigned*)(p.ws + WS_CTL))
#define gate1_l0 ((const float*)(ws + WS_MOD) + 2048)
#define gate1_l1 ((const float*)(ws + WS_MOD) + 9 * 6144 + 2048)

#define LANE_ (TID_ & 63)
    if (IN(0)) for (int rep_ = 0; rep_ < (DUP(0) ? 2 : 1); ++rep_) { if (rep_) xcd_barrier(bar); phase_prep(p, lds, gw, NGW, wave, LANE_, rep_ != 0); }
    SEAM(0);
    if (IN(1)) for (int rep_ = 0; rep_ < (DUP(1) ? 2 : 1); ++rep_) { if (rep_) xcd_barrier(bar); phase_prenorm0(p, gw, NGW, LANE_); }
    SEAM(1);
    if (IN(2)) { const int rep_ = (DUP(2) || GDUP(2)) ? 2 : 1;
        const bool split = (G > P2_GEMM_WGS) && P2_CONV_ITEMS > 0;
        if (!split || bx < P2_GEMM_WGS) { OrderSingle S; S.init(ws + WS_H, ws + WS_WIN_T, MT, PROJ, 1024, split ? P2_GEMM_WGS : G, bx, rep_); EpiStore E{(bf16_t*)(ws + WS_P), PROJ}; pg8::gemm_phase(lds, 1024, S, E); }
        else { LAS float* scr = (LAS float*)(lds + wave * 16896); const int ncw = (G - P2_GEMM_WGS) * 8, cw = (bx - P2_GEMM_WGS) * 8 + wave;
            for (int rr = 0; rr < ((DUP(2) || CDUP(2)) ? 2 : 1); ++rr) for (int it = cw; it < P2_CONV_ITEMS; it += ncw) moe_convert_item(p, 0, it, scr, LANE_); } if (!split) { __syncthreads(); LAS float* scr = (LAS float*)(lds + wave * 16896); for (int it = 0 + gw; it < P2_CONV_ITEMS; it += NGW) moe_convert_item(p, 0, it, scr, LANE_); } if (FILLMASK & 1) moe_fill(p, lds, 0, ctlw + CTL_Q0, ctlw + CTL_DONE, G, wave, LANE_); }
    SEAM(2);
    if (IN(3)) for (int rep_ = 0; rep_ < (DUP(3) ? 2 : 1); ++rep_) { if (rep_) xcd_barrier(bar); phase_qkconv(p, gw, NGW, LANE_); }
    SEAM(3);
    if (IN(4)) for (int rep_ = 0; rep_ < (DUP(4) ? 2 : 1); ++rep_) { if (rep_) xcd_barrier(bar); phase_attention(p, lds, G, vcu); if (FILLMASK & 2) moe_fill(p, lds, 0, ctlw + CTL_Q0, ctlw + CTL_DONE + 64, G, wave, LANE_); }
    SEAM(4);
    if (IN(5)) { const int rep_ = (DUP(5) || GDUP(5)) ? 2 : 1;
        const bool split = (G > P5_GEMM_WGS) && P5_CONV_ITEMS > 0;
        if (!split || bx < P5_GEMM_WGS) { OrderSingle S; S.init(ws + WS_AO, ws + WS_WOUT_T, MT, 1024, 2048, split ? P5_GEMM_WGS : G, bx, rep_); EpiResid<false> E{p.in[I_X], p.in[I_CTX], (bf16_t*)(ws + WS_X1), gate1_l0}; pg8::gemm_phase(lds, 2048, S, E); }
        else { LAS float* scr = (LAS float*)(lds + wave * 16896); const int ncw = (G - P5_GEMM_WGS) * 8, cw = (bx - P5_GEMM_WGS) * 8 + wave;
            for (int rr = 0; rr < ((DUP(5) || CDUP(5)) ? 2 : 1); ++rr) for (int it = P2_CONV_ITEMS + cw; it < P5_CONV_ITEMS; it += ncw) moe_convert_item(p, 0, it, scr, LANE_); } if (!split) { __syncthreads(); LAS float* scr = (LAS float*)(lds + wave * 16896); for (int it = P2_CONV_ITEMS + gw; it < P5_CONV_ITEMS; it += NGW) moe_convert_item(p, 0, it, scr, LANE_); } if (FILLMASK & 4) moe_fill(p, lds, 0, ctlw + CTL_Q0, ctlw + CTL_DONE + 128, G, wave, LANE_); }
    SEAM(5);
    if (IN(6)) for (int rep_ = 0; rep_ < (DUP(6) ? 2 : 1); ++rep_) { if (rep_) xcd_barrier(bar); phase_moe_prenorm(p, lds, 0, (const bf16_t*)(ws + WS_X1), MT, (bf16_t*)(ws + WS_H), gw, NGW, LANE_); }
    SEAM(6);
    if (IN(7)) for (int rep_ = 0; rep_ < (DUP(7) ? 2 : 1); ++rep_) { if (rep_) xcd_barrier(bar); phase_select(p, lds, 256, SL0, G, bx, wave, LANE_); }
    SEAM(7);
    if (IN(8)) { const int rep_ = (DUP(8) || GDUP(8)) ? 2 : 1; const bool split = G > P8_GEMM_WGS; if (!split || vcu < P8_GEMM_WGS) { OrderMoe S; S.init(ws + WS_H, ws + WS_WGU_T, 9, 8, 1024, split ? P8_GEMM_WGS : G, vcu, rep_); S.rowidx = (const int*)(ws + WS_SELROW); EpiAct E{(bf16_t*)(ws + WS_ACT0)}; pg8::gemm_phase<EpiAct, OrderMoe, true>(lds, 1024, S, E); } else { LAS float* scr = (LAS float*)(lds + wave * 16896); const int ncw = (G - P8_GEMM_WGS) * 8, cw = (vcu - P8_GEMM_WGS) * 8 + wave; for (int rr = 0; rr < ((DUP(8) || CDUP(8)) ? 2 : 1); ++rr) for (int it = 0 + cw; it < L1_A; it += ncw) moe_convert_item(p, 1, it, scr, LANE_); } if (!split) { __syncthreads(); LAS float* scr = (LAS float*)(lds + wave * 16896); for (int it = 0 + gw; it < L1_A; it += NGW) moe_convert_item(p, 1, it, scr, LANE_); } }
    SEAM(8);
    if (IN(9)) { const int rep_ = (DUP(9) || GDUP(9)) ? 2 : 1; const bool split = G > P9_GEMM_WGS; if (!split || vcu < P9_GEMM_WGS) { OrderMoe S; S.init(ws + WS_ACT0, ws + WS_WD_T, 9, 4, 1024, split ? P9_GEMM_WGS : G, vcu, rep_); EpiYs E{(bf16_t*)(ws + WS_YS0), (const float*)(ws + WS_SELAFF)}; pg8::gemm_phase(lds, 1024, S, E); } else { LAS float* scr = (LAS float*)(lds + wave * 16896); const int ncw = (G - P9_GEMM_WGS) * 8, cw = (vcu - P9_GEMM_WGS) * 8 + wave; for (int rr = 0; rr < ((DUP(9) || CDUP(9)) ? 2 : 1); ++rr) for (int it = L1_A + cw; it < L1_B; it += ncw) moe_convert_item(p, 1, it, scr, LANE_); } if (!split) { __syncthreads(); LAS float* scr = (LAS float*)(lds + wave * 16896); for (int it = L1_A + gw; it < L1_B; it += NGW) moe_convert_item(p, 1, it, scr, LANE_); } }
    SEAM(9);
    if (IN(10)) for (int rep_ = 0; rep_ < (DUP(10) ? 2 : 1); ++rep_) { if (rep_) xcd_barrier(bar); phase_combine_mix(p, lds, G, vcu, wave, LANE_); }
    SEAM(10);
    if (IN(11) && IN(12) && !IN(10)) { }
    if (IN(12)) { const int rep_ = (DUP(12) || GDUP(12)) ? 2 : 1; const bool split = G > P12_GEMM_WGS; if (!split || vcu < P12_GEMM_WGS) { OrderRkv S; S.A0 = (const char*)(ws + WS_XR); S.A1 = (const char*)(ws + WS_XK); S.A2 = (const char*)(ws + WS_XV); S.A3 = (const char*)(ws + WS_XW); S.A4 = (const char*)(ws + WS_XA); S.A5 = (const char*)(ws + WS_XG);
        S.B0 = (const char*)(ws + WS_WR_T); S.B1 = (const char*)(ws + WS_WK_T); S.B2 = (const char*)(ws + WS_WV_T); S.B3 = (const char*)(ws + WS_WL1_T); S.G = split ? P12_GEMM_WGS : G; S.c = vcu; S.rep = rep_;
        EpiRkv E{(bf16_t*)(ws + WS_RB), (bf16_t*)(ws + WS_KB), (bf16_t*)(ws + WS_VB), (bf16_t*)(ws + WS_T1)}; pg8::gemm_phase(lds, 1024, S, E); } else { LAS float* scr = (LAS float*)(lds + wave * 16896); const int ncw = (G - P12_GEMM_WGS) * 8, cw = (vcu - P12_GEMM_WGS) * 8 + wave; for (int rr = 0; rr < ((DUP(12) || CDUP(12)) ? 2 : 1); ++rr) for (int it = L1_B + cw; it < L1_C; it += ncw) moe_convert_item(p, 1, it, scr, LANE_); } if (!split) { __syncthreads(); LAS float* scr = (LAS float*)(lds + wave * 16896); for (int it = L1_B + gw; it < L1_C; it += NGW) moe_convert_item(p, 1, it, scr, LANE_); } }
    SEAM(12);
    if (IN(13)) for (int rep_ = 0; rep_ < (DUP(13) ? 2 : 1); ++rep_) { if (rep_) xcd_barrier(bar);   }
    SEAM(13);
    if (IN(14)) for (int rep_ = 0; rep_ < (DUP(14) ? 2 : 1); ++rep_) { if (rep_) xcd_barrier(bar); phase_scan(p, lds, G, bx, wave, LANE_, rep_ ? SCANVAR : 0); }
    SEAM(14);
    if (IN(15)) for (int rep_ = 0; rep_ < (DUP(15) ? 2 : 1); ++rep_) { if (rep_) xcd_barrier(bar); phase_readout(p, lds, G, vcu, wave, LANE_); }
    SEAM(15);
    if (IN(16)) { const int rep_ = (DUP(16) || GDUP(16)) ? 2 : 1; OrderSingle S; S.init(ws + WS_Z, ws + WS_WO_T, ML, 1024, 1024, G, bx, rep_); EpiResid<true> E{ws + WS_X2, ws + WS_X2, (bf16_t*)(ws + WS_X3), gate1_l1}; pg8::gemm_phase(lds, 1024, S, E); }
    SEAM(16);
    if (IN(17)) for (int rep_ = 0; rep_ < (DUP(17) ? 2 : 1); ++rep_) { if (rep_) xcd_barrier(bar); phase_moe_prenorm(p, lds, 1, (const bf16_t*)(ws + WS_X3), ML, (bf16_t*)(ws + WS_H2), gw, NGW, LANE_);
        __syncthreads();
        LAS float* scr = (LAS float*)(lds + wave * 16896);
        for (int it = L1_C + gw; it < P0_NMOE; it += NGW) moe_convert_item(p, 1, it, scr, LANE_); }
    SEAM(17);
    if (IN(18)) for (int rep_ = 0; rep_ < (DUP(18) ? 2 : 1); ++rep_) { if (rep_) xcd_barrier(bar); phase_select(p, lds, 128, SL1, G, bx, wave, LANE_); }
    SEAM(18);
    if (IN(19)) { const int rep_ = (DUP(19) || GDUP(19)) ? 2 : 1; OrderMoe S; S.init(ws + WS_H2, ws + WS_WGU1, 8, 8, 1024, G, vcu, rep_); S.rowidx = (const int*)(ws + WS_SELROW); EpiAct E{(bf16_t*)(ws + WS_ACT1)}; pg8::gemm_phase<EpiAct, OrderMoe, true>(lds, 1024, S, E); }
    SEAM(19);
    if (IN(20)) { const int rep_ = (DUP(20) || GDUP(20)) ? 2 : 1; OrderMoe S; S.init(ws + WS_ACT1, ws + WS_WD1, 8, 4, 1024, G, vcu, rep_); EpiYs E{(bf16_t*)(ws + WS_YS1), (const float*)(ws + WS_SELAFF)}; pg8::gemm_phase(lds, 1024, S, E); }
    SEAM(20);
    if (IN(21)) for (int rep_ = 0; rep_ < (DUP(21) ? 2 : 1); ++rep_) { if (rep_) xcd_barrier(bar); phase_final(p, gw, NGW, LANE_); }
#undef IN
#undef SEAM
}

#ifndef MK_PER_PHASE
#define MK_PER_PHASE 0
#endif
extern "C" void kernel_launch(void* const* d_in, const int* in_sizes, int n_in, void* d_out, int out_size, void* d_ws, size_t ws_size, hipStream_t stream) {
    static int grid = 0;
    if (grid == 0) {
        if (n_in != 35 || out_size != ML * DM || ws_size < WS_END) { fprintf(stderr, "kernel_launch: unexpected shapes: n_in %d out %d ws %zu (need %zu)\n", n_in, out_size, ws_size, (size_t)WS_END); grid = -1; return; }
        int dev = 0, cus = 0;
        if (hipGetDevice(&dev) != hipSuccess || hipDeviceGetAttribute(&cus, hipDeviceAttributeMultiprocessorCount, dev) != hipSuccess) { grid = -1; return; }
        if (hipFuncSetAttribute((const void*)mega_fwd, hipFuncAttributeMaxDynamicSharedMemorySize, LDS_BYTES) != hipSuccess) { fprintf(stderr, "kernel_launch: hipFuncSetAttribute failed\n"); grid = -1; return; }
        int per_cu = 0; (void)hipOccupancyMaxActiveBlocksPerMultiprocessor(&per_cu, (const void*)mega_fwd, 512, LDS_BYTES); (void)hipGetLastError();
        if (per_cu < 1) fprintf(stderr, "kernel_launch: occupancy query reports %d blocks per CU\n", per_cu);
        grid = cus;
    }
    if (grid < 0) return;
    (void)in_sizes;
    (void)hipMemsetAsync((char*)d_ws + WS_CTL, 0, 1 * MiB, stream);
    Params a{};
    for (int i = 0; i < 35; ++i) a.in[i] = (const float*)d_in[i];
    a.out = (float*)d_out; a.ws = (unsigned char*)d_ws;
#if MK_PER_PHASE
    for (int ph = 0; ph < NPH; ++ph) { a.ph_lo = ph; a.ph_hi = ph + 1; hipLaunchKernelGGL(mega_fwd, dim3(grid), dim3(512), LDS_BYTES, stream, a); }
#else
    a.ph_lo = 0; a.ph_hi = NPH; hipLaunchKernelGGL(mega_fwd, dim3(grid), dim3(512), LDS_BYTES, stream, a);
#endif
    const hipError_t le = hipPeekAtLastError();
    if (le != hipSuccess) fprintf(stderr, "kernel_launch: launch failed: %s\n", hipGetErrorName(le));
}
```

```cpp
#include <hip/hip_runtime.h>
#include <cstdio>
#include <cstdint>

#define GAS __attribute__((address_space(1)))
#define LAS __attribute__((address_space(3)))
typedef unsigned short bf16_t;
typedef short bf16x8 __attribute__((ext_vector_type(8)));
typedef short s16x4 __attribute__((ext_vector_type(4)));
typedef float f32x4 __attribute__((ext_vector_type(4)));
typedef float f32x2 __attribute__((ext_vector_type(2)));
typedef float f32x8 __attribute__((ext_vector_type(8)));
typedef float f32x16 __attribute__((ext_vector_type(16)));
typedef unsigned u32x4 __attribute__((ext_vector_type(4)));
typedef unsigned u32x2 __attribute__((ext_vector_type(2)));

constexpr int NB = 8, SEQ = 2048, CTXL = 256, DM = 1024;
constexpr int ML = NB * SEQ, MC = NB * CTXL, MT = ML + MC;
constexpr int PROJ = 4608, NE = 16;
constexpr int KVL = CTXL + SEQ;
constexpr int CAPL = 256, CAPC = 32, SL0 = NB * CAPL + NB * CAPC  , SL1 = NB * CAPL  ;

constexpr size_t MiB = 1u << 20;
constexpr size_t WS_CTL = 0;
constexpr size_t CTL_BAR_WORD = 4096;
constexpr size_t WS_MOD = 512 * 1024;
constexpr size_t WS_ROPE = 1 * MiB;
constexpr size_t WS_AFF = 2 * MiB;
constexpr size_t WS_TOKSLOT = 4 * MiB;
constexpr size_t WS_SELAFF = 6 * MiB;
constexpr size_t WS_SELROW = 7 * MiB;
constexpr size_t WS_WIN_T = 8 * MiB;
constexpr size_t WS_WOUT_T = 17 * MiB;
constexpr size_t WS_WR_T = 21 * MiB, WS_WK_T = 23 * MiB, WS_WV_T = 25 * MiB, WS_WO_T = 27 * MiB;
constexpr size_t WS_WL1_T = 29 * MiB;
constexpr size_t WS_W2T = 31 * MiB;
constexpr size_t WS_A2T = WS_W2T + 256 * 1024, WS_G2T = WS_W2T + 512 * 1024;
constexpr size_t WS_WMOE = 32 * MiB;
constexpr size_t WS_WGU_T = WS_WMOE, WS_WD_T = WS_WMOE + 64 * MiB;
constexpr size_t AB = 128 * MiB;
constexpr size_t WS_P = AB + 0 * MiB;
constexpr size_t WS_H = AB + 162 * MiB;
constexpr size_t WS_AO = AB + 198 * MiB;
constexpr size_t WS_Q = AB + 270 * MiB;
constexpr size_t WS_KA = AB + 306 * MiB, WS_VA = AB + 315 * MiB;
constexpr size_t WS_X1 = AB + 0 * MiB;
constexpr size_t WS_XS0 = AB + 72 * MiB, WS_YS0 = AB + 72 * MiB;
constexpr size_t WS_ACT0 = AB + 198 * MiB;
constexpr size_t WS_X2 = AB + 36 * MiB;
constexpr size_t WS_WGU1 = AB + 324 * MiB, WS_WD1 = AB + 388 * MiB;
constexpr size_t WS_XR = WS_WMOE, WS_XW = AB + 144 * MiB, WS_XA = AB + 180 * MiB, WS_XG = AB + 216 * MiB, WS_XV = AB + 248 * MiB, WS_XK = AB + 284 * MiB;
constexpr size_t WS_KB = AB + 0 * MiB, WS_RB = AB + 72 * MiB, WS_VB = AB + 104 * MiB, WS_T1 = WS_WMOE + 32 * MiB;
constexpr size_t WS_KK = AB + 284 * MiB;
constexpr size_t WS_Y0 = AB + 144 * MiB, WS_Y1 = AB + 176 * MiB;
constexpr size_t WS_BON = AB + 320 * MiB;
constexpr size_t WS_Z = AB + 208 * MiB;
constexpr size_t WS_X3 = AB + 240 * MiB;
constexpr size_t WS_H2 = AB + 272 * MiB;
constexpr size_t WS_ACT1 = AB + 72 * MiB, WS_YS1 = AB + 144 * MiB;
constexpr size_t WS_END = AB + 420 * MiB;

constexpr int RING_BYTES = 151552, LDSCTL_OFF = RING_BYTES, MISC_OFF = LDSCTL_OFF + 320, LDS_BYTES = 163840;

__device__ __forceinline__ int tid_opaque() { int t = (int)threadIdx.x; asm volatile("" : "+v"(t)); return t; }
#define TID_ tid_opaque()
#define LDS_WAIT() asm volatile("s_waitcnt lgkmcnt(0)" ::: "memory")
#define VM_WAIT() asm volatile("s_waitcnt vmcnt(0)" ::: "memory")
__device__ __forceinline__ float bf2f(unsigned b) { return __uint_as_float(b << 16); }
__device__ __forceinline__ unsigned f2bf(float f) { unsigned u = __float_as_uint(f); return (u + 0x7fffu + ((u >> 16) & 1u)) >> 16; }
typedef __bf16 bf16n2 __attribute__((ext_vector_type(2)));
__device__ __forceinline__ unsigned pk2(float lo, float hi) { const f32x2 v = {lo, hi}; return __builtin_bit_cast(unsigned, __builtin_convertvector(v, bf16n2)); }
__device__ __forceinline__ float wave_sum(float v) {
#pragma unroll
    for (int o = 1; o < 64; o <<= 1) v += __shfl_xor(v, o);
    return v;
}
__device__ __forceinline__ int wave_sum_i(int v) {
#pragma unroll
    for (int o = 1; o < 64; o <<= 1) v += __shfl_xor(v, o);
    return v;
}
__device__ __forceinline__ float rcpf_(float x) { return __builtin_amdgcn_rcpf(x); }
__device__ __forceinline__ float rsqf_(float x) { return __builtin_amdgcn_rsqf(x); }
__device__ __forceinline__ float sigmoidf_(float x) { return rcpf_(1.0f + __expf(-x)); }
template <int CTRL> __device__ __forceinline__ float dpp_mov(float v) { return __int_as_float(__builtin_amdgcn_update_dpp(__float_as_int(v), __float_as_int(v), CTRL, 0xf, 0xf, true)); }
__device__ __forceinline__ float allsum16(float v) { v += dpp_mov<0xB1>(v); v += dpp_mov<0x4E>(v); v += dpp_mov<0x141>(v); v += dpp_mov<0x140>(v); return v; }
__device__ __forceinline__ f32x4 unpk4(u32x2 w) { return (f32x4){bf2f(w.x & 0xffffu), bf2f(w.x >> 16), bf2f(w.y & 0xffffu), bf2f(w.y >> 16)}; }
__device__ __forceinline__ void unpk8(u32x4 w, float (&o)[8]) {
#pragma unroll
    for (int m = 0; m < 4; ++m) { o[2 * m] = bf2f(w[m] & 0xffffu); o[2 * m + 1] = bf2f(w[m] >> 16); }
}
__device__ __forceinline__ u32x4 pk8(const float (&v)[8]) { u32x4 w; w.x = pk2(v[0], v[1]); w.y = pk2(v[2], v[3]); w.z = pk2(v[4], v[5]); w.w = pk2(v[6], v[7]); return w; }
__device__ __forceinline__ u32x2 pk4(f32x4 v) { u32x2 w; w.x = pk2(v.x, v.y); w.y = pk2(v.z, v.w); return w; }

#define XB_TMO      128
#define XB_XCNT(j)  (256  + 64 * (j))
#define XB_XSUB(j)  (1280 + 64 * (j))
#define XB_XGEN(j)  (2304 + 64 * (j))
#define XB_TOP      3328
#define XB_TOPGEN   3392
#define XCD_BAR_WORDS 3456
#define XB_SPIN_CAP (1u << 18)
__device__ __forceinline__ unsigned xb_ld(unsigned* p)              { return __hip_atomic_load(p, __ATOMIC_RELAXED, __HIP_MEMORY_SCOPE_AGENT); }
__device__ __forceinline__ unsigned xb_add(unsigned* p, unsigned v) { return __hip_atomic_fetch_add(p, v, __ATOMIC_RELAXED, __HIP_MEMORY_SCOPE_AGENT); }
__device__ __forceinline__ unsigned xb_xcc_id() { return (unsigned)__builtin_amdgcn_s_getreg((3 << 11) | 20) & 0xFu; }
#define XB_SPIN(cond, bar) do { unsigned _sp = 0; while (cond) { __builtin_amdgcn_s_sleep(1); \
    if ((++_sp & 255u) == 0u) { if (xb_ld(&(bar)[XB_TMO])) break; if (_sp > XB_SPIN_CAP) { atomicAdd(&(bar)[XB_TMO], 1u); break; } } } } while (0)
struct XcdBarrier { unsigned* bar; unsigned x; volatile LAS unsigned* st; };
__device__ __forceinline__ XcdBarrier xcd_barrier_post(unsigned* bar, volatile LAS unsigned* st) {
    XcdBarrier b; b.bar = bar; b.x = xb_xcc_id(); b.st = st;
    if (threadIdx.x == 0) (void)xb_add(&bar[XB_XCNT(b.x)], 1u);
    return b;
}
__device__ __forceinline__ void xcd_barrier_complete(unsigned* bar, unsigned x, unsigned& nloc, unsigned& nx) {
    const unsigned G = gridDim.x * gridDim.y * gridDim.z;
    unsigned sum, cnt, mine, sp = 0u;
    for (;;) {
        sum = 0u; cnt = 0u; mine = 0u;
#pragma unroll
        for (unsigned j = 0; j < 16; ++j) { const unsigned c = xb_ld(&bar[XB_XCNT(j)]); sum += c; cnt += (c > 0u) ? 1u : 0u; mine = (j == x) ? c : mine; }
        if (sum == G) break;
        __builtin_amdgcn_s_sleep(1);
        if ((++sp & 255u) == 0u) { if (xb_ld(&bar[XB_TMO])) break; if (sp > XB_SPIN_CAP) { atomicAdd(&bar[XB_TMO], 1u); break; } }
    }
    nloc = mine > 0u ? mine : 1u; nx = cnt > 0u ? cnt : 1u;
}
__device__ __forceinline__ void xcd_barrier(const XcdBarrier& b) {
    asm volatile("s_waitcnt vmcnt(0)" ::: "memory");
    __syncthreads();
    if (threadIdx.x == 0) {
        unsigned* bar = b.bar;
        __builtin_amdgcn_s_waitcnt(0);
        unsigned nloc = b.st[0], nx = b.st[1];
        if (nloc == 0u) { xcd_barrier_complete(bar, b.x, nloc, nx); b.st[0] = nloc; b.st[1] = nx; }
        const unsigned old = xb_add(&bar[XB_XSUB(b.x)], 1u);
        const unsigned gen = old / nloc;
        if (old + 1u == (gen + 1u) * nloc) {
            __builtin_amdgcn_fence(__ATOMIC_RELEASE, "agent");
            asm volatile("s_waitcnt vmcnt(0)" ::: "memory");
            const unsigned og = xb_add(&bar[XB_TOP], 1u);
            const unsigned tg = og / nx;
            if (og + 1u == (tg + 1u) * nx) xb_add(&bar[XB_TOPGEN], 1u);
            else XB_SPIN(xb_ld(&bar[XB_TOPGEN]) == tg, bar);
            __builtin_amdgcn_fence(__ATOMIC_ACQUIRE, "agent");
            xb_add(&bar[XB_XGEN(b.x)], 1u);
            asm volatile("s_waitcnt vmcnt(0)" ::: "memory");
        } else {
            XB_SPIN(xb_ld(&bar[XB_XGEN(b.x)]) == gen, bar);
            __builtin_amdgcn_fence(__ATOMIC_ACQUIRE, "agent");
            asm volatile("s_waitcnt vmcnt(0)" ::: "memory");
        }
    }
    __syncthreads();
}

namespace pg8 {
constexpr int BM = 256, BK = 64, HALF = 128, HTB = HALF * BK * 2, STAGE_BYTES = 8 * HTB;
__host__ __device__ __forceinline__ int lds_byte(int r, int c) { const int st = (r >> 4) * 2 + (c >> 5), rr = r & 15, cc = c & 31, ob = rr * 64 + cc * 2; return st * 1024 + (ob ^ (((ob >> 9) & 1) << 5)); }
__host__ __device__ __forceinline__ void stage_rc(int b, int& R, int& C) { const int st = b / 1024, sb = b % 1024, swz = sb ^ (((sb >> 9) & 1) << 5); R = (st >> 1) * 16 + swz / 64; C = (st & 1) * 32 + (swz % 64) / 2; }
__host__ __device__ __forceinline__ int perm32(int rho) { const int n = rho >> 4, i = rho & 15; return 8 * (i >> 2) + 4 * n + (i & 3); }
struct Unit { int pm, pn, gi; };
__device__ __forceinline__ unsigned cvt_pk_bf16(float lo, float hi) { return ::pk2(lo, hi); }

template <class Epi, class Sched, bool GATHER = false>
__device__ __forceinline__ void gemm_phase(LAS unsigned char* lds, const int K, const Sched& S, const Epi& E) {
    const int tid = TID_, wid = __builtin_amdgcn_readfirstlane(tid >> 6), lane = tid & 63, wr = wid >> 2, wc = wid & 3, fr = lane & 15, fq = lane >> 4;
    const int nt = K / BK;
    unsigned voffA[2], voffB[2];
#pragma unroll
    for (int i = 0; i < 2; ++i) { int R, C; stage_rc(tid * 16 + i * 8192, R, C); const int Rb = Epi::PERM ? ((R & ~31) + perm32(R & 31)) : R;
        voffA[i] = (unsigned)(R * K + C) * 2u; voffB[i] = (unsigned)(Rb * K + C) * 2u; }
    const size_t kstep = (size_t)(BK * 2);
    const size_t hstep = (size_t)HALF * K * 2;
    const unsigned ldsw = (unsigned)wid * 1024u;
    const int aoff = lds_byte(wr * 64 + fr, fq * 8), boff = lds_byte(wc * 32 + fr, fq * 8);
#define PG8_SA(b, h) (((b) * 2 + (h)) * HTB)
#define PG8_SB(b, h) ((4 + (b) * 2 + (h)) * HTB)
#define PG8_STAGE(bufoff, gbase, voff) do { _Pragma("unroll") for (int _i = 0; _i < 2; ++_i) \
        __builtin_amdgcn_global_load_lds((const unsigned*)((const char*)(gbase) + (voff)[_i]), (LAS unsigned*)(lds + (bufoff) + ldsw + _i * 8192), 16, 0, 0); } while (0)
#define PG8_LDA(dst, b, h) do { _Pragma("unroll") for (int m = 0; m < 4; ++m) _Pragma("unroll") for (int k = 0; k < 2; ++k) dst[m][k] = *(const LAS bf16x8*)(lds + PG8_SA(b, h) + aoff + m * 2048 + k * 1024); } while (0)
#define PG8_LDB(dst, b, h) do { _Pragma("unroll") for (int n = 0; n < 2; ++n) _Pragma("unroll") for (int k = 0; k < 2; ++k) dst[n][k] = *(const LAS bf16x8*)(lds + PG8_SB(b, h) + boff + n * 2048 + k * 1024); } while (0)
#define PG8_MMA(ai, bj, At, Bt) do { __builtin_amdgcn_s_setprio(1); _Pragma("unroll") for (int m = 0; m < 4; ++m) _Pragma("unroll") for (int n = 0; n < 2; ++n) _Pragma("unroll") for (int k = 0; k < 2; ++k) \
        acc[ai][bj][m][n] = __builtin_amdgcn_mfma_f32_16x16x32_bf16(Bt[n][k], At[m][k], acc[ai][bj][m][n], 0, 0, 0); __builtin_amdgcn_s_setprio(0); } while (0)
#define PG8_WAIT_V(n) asm volatile("s_waitcnt vmcnt(" #n ")" ::: "memory")
#define PG8_WAIT_L(n) asm volatile("s_waitcnt lgkmcnt(" #n ")" ::: "memory")
#define PG8_BAR __builtin_amdgcn_s_barrier()
#define PG8_SCHED __builtin_amdgcn_sched_barrier(0)
    Unit cur, nxt; int ui = 0;
    int gR[2], gC[2];
#pragma unroll
    for (int i = 0; i < 2; ++i) stage_rc(tid * 16 + i * 8192, gR[i], gC[i]);
    unsigned vA[2][2] = {{0u, 0u}, {0u, 0u}}, vN[2][2] = {{0u, 0u}, {0u, 0u}};
    if constexpr (GATHER) {
        LAS int* gidx = (LAS int*)(lds + STAGE_BYTES);
        Unit gu; for (int i = 0; S.next(i, gu); ++i) if (tid < 256) gidx[i * 256 + tid] = S.rowidx[gu.pm * 256 + tid];
        __syncthreads();
    }
#define PG8_GIDX(dst, unit_i) do { if constexpr (GATHER) { const LAS int* gi_ = (const LAS int*)(lds + STAGE_BYTES) + (unit_i) * 256; _Pragma("unroll") for (int h_ = 0; h_ < 2; ++h_) _Pragma("unroll") for (int i_ = 0; i_ < 2; ++i_) \
        dst[h_][i_] = (unsigned)gi_[h_ * 128 + gR[i_]] * (unsigned)(K * 2) + (unsigned)(gC[i_] * 2); } } while (0)
    if (!S.next(0, cur)) return;
    PG8_GIDX(vA, 0);
    f32x4 acc[2][2][4][2];
#pragma unroll
    for (int a = 0; a < 2; ++a)
#pragma unroll
        for (int b = 0; b < 2; ++b)
#pragma unroll
            for (int m = 0; m < 4; ++m)
#pragma unroll
                for (int n = 0; n < 2; ++n) acc[a][b][m][n] = (f32x4){0.f, 0.f, 0.f, 0.f};
    bf16x8 At[4][2], B0[2][2], B1[2][2];
    const char* cA; if constexpr (GATHER) cA = S.gbase; else cA = S.a_base(cur);
    const char* cB = S.b_base(cur);
#define PG8_STAGE_A(bufoff, ap, h, v) do { if constexpr (GATHER) { PG8_STAGE(bufoff, ap, (v)[h]); } else { PG8_STAGE(bufoff, (ap) + (h) * hstep, voffA); } } while (0)
    PG8_STAGE(PG8_SB(0, 0), cB, voffB); PG8_STAGE_A(PG8_SA(0, 0), cA, 0, vA); PG8_STAGE(PG8_SB(0, 1), cB + hstep, voffB); PG8_STAGE_A(PG8_SA(0, 1), cA, 1, vA);
    if (wr == 1) PG8_BAR;
    PG8_WAIT_V(4); PG8_BAR;
    PG8_STAGE(PG8_SB(1, 0), cB + kstep, voffB); PG8_STAGE_A(PG8_SA(1, 0), cA + kstep, 0, vA); PG8_STAGE(PG8_SB(1, 1), cB + hstep + kstep, voffB);
    PG8_WAIT_V(6); PG8_BAR;
    for (;;) {
        const bool has_next = S.next(ui + 1, nxt);
        const char* nA = cA; if constexpr (!GATHER) { if (has_next) nA = S.a_base(nxt); }
        const char* nB = has_next ? S.b_base(nxt) : cB;
        if constexpr (GATHER) { if (has_next) PG8_GIDX(vN, ui + 1); else {
#pragma unroll
            for (int h_ = 0; h_ < 2; ++h_)
#pragma unroll
                for (int i_ = 0; i_ < 2; ++i_) vN[h_][i_] = vA[h_][i_]; } }
        for (int t = 0; t < nt; t += 2) {
            const bool last = (t == nt - 2);
            const char* a1 = cA + (size_t)(t + 1) * kstep;
            const char* a2 = last ? nA : cA + (size_t)(t + 2) * kstep; const char* b2 = last ? nB : cB + (size_t)(t + 2) * kstep;
            const char* a3 = a2 + kstep; const char* b3 = b2 + kstep;
            unsigned v2[2][2];
#pragma unroll
            for (int h_ = 0; h_ < 2; ++h_)
#pragma unroll
                for (int i_ = 0; i_ < 2; ++i_) v2[h_][i_] = last ? vN[h_][i_] : vA[h_][i_];
            PG8_LDB(B0, 0, 0); PG8_SCHED; PG8_LDA(At, 0, 0); PG8_STAGE_A(PG8_SA(1, 1), a1, 1, vA);
            PG8_WAIT_L(8); PG8_BAR; PG8_WAIT_L(0); PG8_MMA(0, 0, At, B0); PG8_BAR; PG8_SCHED;
            PG8_LDB(B1, 0, 1); PG8_STAGE(PG8_SB(0, 0), b2, voffB);
            PG8_BAR; PG8_WAIT_L(0); PG8_MMA(0, 1, At, B1); PG8_BAR;
            PG8_LDA(At, 0, 1); PG8_STAGE_A(PG8_SA(0, 0), a2, 0, v2);
            PG8_BAR; PG8_WAIT_L(0); PG8_MMA(1, 0, At, B0); PG8_BAR; PG8_SCHED;
            PG8_STAGE(PG8_SB(0, 1), b2 + hstep, voffB);
            PG8_WAIT_V(6); PG8_BAR; PG8_MMA(1, 1, At, B1); PG8_BAR;
            PG8_LDB(B0, 1, 0); PG8_SCHED; PG8_LDA(At, 1, 0); PG8_STAGE_A(PG8_SA(0, 1), a2, 1, v2);
            PG8_WAIT_L(8); PG8_BAR; PG8_WAIT_L(0); PG8_MMA(0, 0, At, B0); PG8_BAR; PG8_SCHED;
            PG8_LDB(B1, 1, 1); PG8_STAGE(PG8_SB(1, 0), b3, voffB);
            PG8_BAR; PG8_WAIT_L(0); PG8_MMA(0, 1, At, B1); PG8_BAR;
            PG8_LDA(At, 1, 1); PG8_STAGE_A(PG8_SA(1, 0), a3, 0, v2);
            PG8_BAR; PG8_WAIT_L(0); PG8_MMA(1, 0, At, B0); PG8_BAR; PG8_SCHED;
            PG8_STAGE(PG8_SB(1, 1), b3 + hstep, voffB);
            PG8_WAIT_V(6); PG8_BAR; PG8_MMA(1, 1, At, B1); PG8_BAR;
        }
        E(acc, cur, wr, wc, fr, fq);
        if (!has_next) break;
#pragma unroll
        for (int a = 0; a < 2; ++a)
#pragma unroll
            for (int b = 0; b < 2; ++b)
#pragma unroll
                for (int m = 0; m < 4; ++m)
#pragma unroll
                    for (int n = 0; n < 2; ++n) acc[a][b][m][n] = (f32x4){0.f, 0.f, 0.f, 0.f};
        cur = nxt; cA = nA; cB = nB; ++ui;
#pragma unroll
        for (int h_ = 0; h_ < 2; ++h_)
#pragma unroll
            for (int i_ = 0; i_ < 2; ++i_) vA[h_][i_] = vN[h_][i_];
    }
    PG8_WAIT_V(0);
    if (wr == 0) PG8_BAR;
    PG8_BAR;
#undef PG8_SA
#undef PG8_STAGE_A
#undef PG8_GIDX
#undef PG8_SB
#undef PG8_STAGE
#undef PG8_LDA
#undef PG8_LDB
#undef PG8_MMA
#undef PG8_WAIT_V
#undef PG8_WAIT_L
#undef PG8_BAR
#undef PG8_SCHED
}
}
struct Params { const float* in[35]; float* out; unsigned char* ws; int ph_lo, ph_hi; };
enum { I_X = 0, I_C, I_CTX, I_CCTX, I_ADAW, I_ADAB, I_NORMG, I_FINALG, I_WIN, I_WOUT, I_QG, I_KG, I_CONVW, I_MU, I_WR, I_WK, I_WV, I_WO, I_W0, I_W1, I_W2,
       I_A0, I_A1, I_A2, I_G1, I_G2, I_KK, I_KA, I_RK, I_LNW, I_LNB, I_ROUTER, I_WGATE, I_WUP, I_WDOWN };

struct OrderSingle {
    const char* A; const char* Bt; int nM, nN, nwg, G, c, rep; size_t tstep;
    __device__ __forceinline__ void init(const void* A_, const void* Bt_, int M, int N, int K, int G_, int c_, int rep_ = 1) { rep = rep_; A = (const char*)A_; Bt = (const char*)Bt_; nM = M / 256; nN = N / 256; nwg = nM * nN; G = G_; c = c_; tstep = (size_t)256 * K * 2; }
    __device__ __forceinline__ bool next(int i, pg8::Unit& u) const {
        long L = (long)i * G + c; if (L >= (long)nwg * rep) return false; L %= nwg;
        int wgid = (int)L; { const int q = nwg / 8, r = nwg % 8, xcd = wgid % 8, off = wgid / 8; wgid = (xcd < r ? xcd * (q + 1) : r * (q + 1) + (xcd - r) * q) + off; }
        const int nig = 8 * nN, gid = wgid / nig, fm = gid * 8, gsz = (nM - fm) < 8 ? (nM - fm) : 8;
        u.pm = fm + ((wgid % nig) % gsz); u.pn = (wgid % nig) / gsz; u.gi = 0; return true;
    }
    __device__ __forceinline__ const char* a_base(const pg8::Unit& u) const { return A + (size_t)u.pm * tstep; }
    __device__ __forceinline__ const char* b_base(const pg8::Unit& u) const { return Bt + (size_t)u.pn * tstep; }
};
struct OrderMoe {
    const char* A; const char* Bt; int PM, PN, nwg, G, c, rep; size_t tstep; const char* gbase; const int* rowidx;
    __device__ __forceinline__ void init(const void* A_, const void* Bt_, int PM_, int PN_, int K, int G_, int c_, int rep_ = 1) { rep = rep_; gbase = (const char*)A_; rowidx = nullptr; A = (const char*)A_; Bt = (const char*)Bt_; PM = PM_; PN = PN_; nwg = NE * PM * PN; G = G_; c = c_; tstep = (size_t)256 * K * 2; }
    __device__ __forceinline__ bool next(int i, pg8::Unit& u) const {
        int L = i * G + c; if (L >= nwg * rep) return false; L %= nwg;
        const int per = PM * PN, e = L / per, r = L % per; u.pm = e * PM + (r % PM); u.pn = e * PN + (r / PM); u.gi = e; return true;
    }
    __device__ __forceinline__ const char* a_base(const pg8::Unit& u) const { return A + (size_t)u.pm * tstep; }
    __device__ __forceinline__ const char* b_base(const pg8::Unit& u) const { return Bt + (size_t)u.pn * tstep; }
};
struct OrderRkv {
    const char *A0, *A1, *A2, *A3, *A4, *A5, *B0, *B1, *B2, *B3; int G, c, rep;
    __device__ __forceinline__ bool next(int i, pg8::Unit& u) const {
        int L = i * G + c; if (L >= 1040 * rep) return false; L %= 1040;
        int gi, nM;
        if (L < 256) { gi = 0; nM = 64; } else if (L < 544) { gi = 1; nM = 72; L -= 256; } else if (L < 832) { gi = 2; nM = 72; L -= 544; }
        else if (L < 904) { gi = 3; nM = 72; L -= 832; } else if (L < 976) { gi = 4; nM = 72; L -= 904; } else { gi = 5; nM = 64; L -= 976; }
        u.gi = gi; u.pm = L % nM; u.pn = L / nM; return true;
    }
    __device__ __forceinline__ const char* a_base(const pg8::Unit& u) const {
        const char* a = u.gi == 0 ? A0 : u.gi == 1 ? A1 : u.gi == 2 ? A2 : u.gi == 3 ? A3 : u.gi == 4 ? A4 : A5; return a + (size_t)u.pm * (256 * 1024 * 2); }
    __device__ __forceinline__ const char* b_base(const pg8::Unit& u) const {
        const char* b = u.gi == 0 ? B0 : u.gi == 1 ? B1 : u.gi == 2 ? B2 : B3 + (size_t)(u.gi - 3) * (256 * 1024 * 2); return b + (size_t)u.pn * (256 * 1024 * 2); }
};

typedef f32x4 Acc[2][2][4][2];
__device__ __forceinline__ u32x4 pack8(f32x4 v0, f32x4 v1) { u32x4 w; w.x = pg8::cvt_pk_bf16(v0[0], v0[1]); w.y = pg8::cvt_pk_bf16(v0[2], v0[3]); w.z = pg8::cvt_pk_bf16(v1[0], v1[1]); w.w = pg8::cvt_pk_bf16(v1[2], v1[3]); return w; }
struct EpiStore {
    static constexpr bool PERM = true;
    bf16_t* O; int ldc;
    __device__ __forceinline__ void operator()(const Acc& acc, const pg8::Unit& u, int wr, int wc, int fr, int fq) const {
        const int row0 = u.pm * 256 + wr * 64 + fr, col0 = u.pn * 256 + wc * 32 + 8 * fq;
#pragma unroll
        for (int ai = 0; ai < 2; ++ai)
#pragma unroll
            for (int m = 0; m < 4; ++m) { bf16_t* rowp = O + (size_t)(row0 + ai * 128 + m * 16) * ldc + col0;
#pragma unroll
                for (int bj = 0; bj < 2; ++bj) *(u32x4*)(rowp + bj * 128) = pack8(acc[ai][bj][m][0], acc[ai][bj][m][1]); }
    }
};
template <bool BASE_BF16>
struct EpiResid {
    static constexpr bool PERM = true;
    const void* baseL; const void* baseC; bf16_t* O; const float* gate;
    __device__ __forceinline__ void operator()(const Acc& acc, const pg8::Unit& u, int wr, int wc, int fr, int fq) const {
        const int row0 = u.pm * 256 + wr * 64 + fr, col0 = u.pn * 256 + wc * 32 + 8 * fq;
        const int mr = u.pm < 64 ? (u.pm >> 3) : 8;
        const float* gt = gate + (size_t)mr * 6144;
        f32x4 g4[2][2];
#pragma unroll
        for (int bj = 0; bj < 2; ++bj)
#pragma unroll
            for (int n = 0; n < 2; ++n) g4[bj][n] = *(const f32x4*)(gt + col0 + bj * 128 + n * 4);
#pragma unroll
        for (int ai = 0; ai < 2; ++ai)
#pragma unroll
            for (int m = 0; m < 4; ++m) { const int row = row0 + ai * 128 + m * 16; bf16_t* op = O + (size_t)row * DM + col0;
#pragma unroll
                for (int bj = 0; bj < 2; ++bj) { f32x4 b0, b1;
                    if (BASE_BF16) { const bf16_t* bp = (row < ML ? (const bf16_t*)baseL + (size_t)row * DM : (const bf16_t*)baseC + (size_t)(row - ML) * DM) + col0 + bj * 128;
                        const u32x4 w = *(const u32x4*)bp; b0 = unpk4((u32x2){w.x, w.y}); b1 = unpk4((u32x2){w.z, w.w}); }
                    else { const float* bp = (row < ML ? (const float*)baseL + (size_t)row * DM : (const float*)baseC + (size_t)(row - ML) * DM) + col0 + bj * 128;
                        b0 = *(const f32x4*)bp; b1 = *(const f32x4*)(bp + 4); }
                    *(u32x4*)(op + bj * 128) = pack8(b0 + g4[bj][0] * acc[ai][bj][m][0], b1 + g4[bj][1] * acc[ai][bj][m][1]); }
                asm volatile("" ::: "memory"); }
    }
};
struct EpiAct {
    static constexpr bool PERM = true;
    bf16_t* O;
    __device__ __forceinline__ void operator()(const Acc& acc, const pg8::Unit& u, int wr, int wc, int fr, int fq) const {
        const int row0 = u.pm * 256 + wr * 64 + fr, f0 = (u.pn & 7) * 128 + wc * 32 + 8 * fq;
#pragma unroll
        for (int ai = 0; ai < 2; ++ai)
#pragma unroll
            for (int m = 0; m < 4; ++m) { bf16_t* rowp = O + (size_t)(row0 + ai * 128 + m * 16) * DM + f0;
                f32x4 o[2];
#pragma unroll
                for (int n = 0; n < 2; ++n) { const f32x4 g = acc[ai][0][m][n], up = acc[ai][1][m][n];
#pragma unroll
                    for (int j = 0; j < 4; ++j) o[n][j] = g[j] * sigmoidf_(g[j]) * up[j]; }
                *(u32x4*)rowp = pack8(o[0], o[1]); }
    }
};
struct EpiYs {
    static constexpr bool PERM = true;
    bf16_t* O; const float* selaff;
    __device__ __forceinline__ void operator()(const Acc& acc, const pg8::Unit& u, int wr, int wc, int fr, int fq) const {
        const int row0 = u.pm * 256 + wr * 64 + fr, col0 = (u.pn & 3) * 256 + wc * 32 + 8 * fq;
#pragma unroll
        for (int ai = 0; ai < 2; ++ai)
#pragma unroll
            for (int m = 0; m < 4; ++m) { const int row = row0 + ai * 128 + m * 16; const float s = selaff[row]; bf16_t* rowp = O + (size_t)row * DM + col0;
#pragma unroll
                for (int bj = 0; bj < 2; ++bj) *(u32x4*)(rowp + bj * 128) = pack8(acc[ai][bj][m][0] * s, acc[ai][bj][m][1] * s); }
    }
};
struct EpiRkv {
    static constexpr bool PERM = true;
    bf16_t *R, *K, *V, *T1;
    __device__ __forceinline__ void operator()(const Acc& acc, const pg8::Unit& u, int wr, int wc, int fr, int fq) const {
        const int row0 = u.pm * 256 + wr * 64 + fr;
        if (u.gi < 3) {
            bf16_t* O = u.gi == 0 ? R : u.gi == 1 ? K : V; const int col0 = u.pn * 256 + wc * 32 + 8 * fq;
#pragma unroll
            for (int ai = 0; ai < 2; ++ai)
#pragma unroll
                for (int m = 0; m < 4; ++m) { bf16_t* rowp = O + (size_t)(row0 + ai * 128 + m * 16) * DM + col0;
#pragma unroll
                    for (int bj = 0; bj < 2; ++bj) *(u32x4*)(rowp + bj * 128) = pack8(acc[ai][bj][m][0], acc[ai][bj][m][1]); }
        } else {
            bf16_t* O = T1 + (size_t)(u.gi - 3) * MT * 128; const int col0 = wc * 32 + 8 * fq;
#pragma unroll
            for (int ai = 0; ai < 2; ++ai)
#pragma unroll
                for (int m = 0; m < 4; ++m) *(u32x4*)(O + (size_t)(row0 + ai * 128 + m * 16) * 128 + col0) = pack8(acc[ai][0][m][0], acc[ai][0][m][1]);
        }
    }
};
__device__ __forceinline__ void ld_row_f32(const float* p, int lane, f32x4 (&v)[4]) {
#pragma unroll
    for (int j = 0; j < 4; ++j) v[j] = *(const f32x4*)(p + 256 * j + 4 * lane);
}
__device__ __forceinline__ void ld_row_bf16(const bf16_t* p, int lane, f32x4 (&v)[4]) {
#pragma unroll
    for (int j = 0; j < 4; ++j) v[j] = unpk4(*(const u32x2*)(p + 256 * j + 4 * lane));
}
__device__ __forceinline__ void st_row_f32(float* p, int lane, const f32x4 (&v)[4]) {
#pragma unroll
    for (int j = 0; j < 4; ++j) *(f32x4*)(p + 256 * j + 4 * lane) = v[j];
}
__device__ __forceinline__ void st_row_bf16(bf16_t* p, int lane, const f32x4 (&v)[4]) {
#pragma unroll
    for (int j = 0; j < 4; ++j) *(u32x2*)(p + 256 * j + 4 * lane) = pk4(v[j]);
}
template <int R>
__device__ __forceinline__ void ada_rows(f32x4 (&v)[R][4], const float* g, const float* const (&sh)[R], const float* const (&sc)[R], int lane) {
    float ss[R];
#pragma unroll
    for (int r = 0; r < R; ++r) { ss[r] = 0.f;
#pragma unroll
        for (int j = 0; j < 4; ++j) ss[r] += (v[r][j].x * v[r][j].x + v[r][j].y * v[r][j].y) + (v[r][j].z * v[r][j].z + v[r][j].w * v[r][j].w); }
#pragma unroll
    for (int o = 1; o < 64; o <<= 1) {
#pragma unroll
        for (int r = 0; r < R; ++r) ss[r] += __shfl_xor(ss[r], o); }
#pragma unroll
    for (int j = 0; j < 4; ++j) { const f32x4 gg = *(const f32x4*)(g + 256 * j + 4 * lane);
#pragma unroll
        for (int r = 0; r < R; ++r) { const float rinv = rsqf_(ss[r] * (1.0f / DM) + 1e-6f);
            const f32x4 s = *(const f32x4*)(sc[r] + 256 * j + 4 * lane), h = *(const f32x4*)(sh[r] + 256 * j + 4 * lane);
            v[r][j] = (v[r][j] * rinv) * gg * (s + 1.0f) + h; } }
}

__device__ __forceinline__ void transpose_item64(const float* W, int N, bf16_t* WT, int ldk, LAS float* scr, int k0, int n0, int drow0, int lane) {
    float tv[64];
#pragma unroll
    for (int i = 0; i < 64; ++i) tv[i] = W[(size_t)(k0 + i) * N + n0 + lane];
#pragma unroll
    for (int i = 0; i < 64; ++i) scr[i * 65 + lane] = tv[i];
    LDS_WAIT(); asm volatile("" ::: "memory");
    const int c = lane & 7;
#pragma unroll
    for (int j = 0; j < 8; ++j) { const int n = (lane >> 3) + 8 * j; const LAS float* s = scr + (8 * c) * 65 + n;
        u32x4 o; o.x = pk2(s[0 * 65], s[1 * 65]); o.y = pk2(s[2 * 65], s[3 * 65]); o.z = pk2(s[4 * 65], s[5 * 65]); o.w = pk2(s[6 * 65], s[7 * 65]);
        *(u32x4*)(WT + (size_t)(drow0 + n) * ldk + k0 + 8 * c) = o; }
    LDS_WAIT(); asm volatile("" ::: "memory");
}
__device__ __forceinline__ void transpose_item(const float* W, int N, bf16_t* WT, int ldk, LAS float* scr, int k0, int n0, int drow0, int lane) {
#pragma unroll 8
    for (int i = 0; i < 32; ++i) { const int kk = 2 * i + (lane >> 5); scr[kk * 33 + (lane & 31)] = W[(size_t)(k0 + kk) * N + n0 + (lane & 31)]; }
    LDS_WAIT(); asm volatile("" ::: "memory");
    const int c = lane & 7;
#pragma unroll
    for (int j = 0; j < 4; ++j) { const int n = (lane >> 3) + 8 * j; const LAS float* s = scr + (8 * c) * 33 + n;
        u32x4 o; o.x = pk2(s[0 * 33], s[1 * 33]); o.y = pk2(s[2 * 33], s[3 * 33]); o.z = pk2(s[4 * 33], s[5 * 33]); o.w = pk2(s[6 * 33], s[7 * 33]);
        *(u32x4*)(WT + (size_t)(drow0 + n) * ldk + k0 + 8 * c) = o; }
    LDS_WAIT(); asm volatile("" ::: "memory");
}
__device__ __forceinline__ void transpose_item_64x128(const float* W, int N, bf16_t* WT, int ldk, LAS unsigned* scr, int k0, int n0, int drow0, int lane) {
    const int up = lane >> 5, lq = lane & 31;
    const float* src = W + (size_t)(k0 + up) * N + n0 + 4 * lq;
    LAS unsigned* wp = scr + (4 * lq + 2 * up) * 33;
    f32x4 tv[32];
#pragma unroll
    for (int i = 0; i < 32; ++i) tv[i] = *(const f32x4*)(src + (size_t)(2 * i) * N);
#pragma unroll
    for (int i = 0; i < 32; ++i) {
        const auto s0 = __builtin_amdgcn_permlane32_swap(__float_as_uint(tv[i][0]), __float_as_uint(tv[i][2]), false, false);
        const auto s1 = __builtin_amdgcn_permlane32_swap(__float_as_uint(tv[i][1]), __float_as_uint(tv[i][3]), false, false);
        wp[i] = pk2(__uint_as_float(s0[0]), __uint_as_float(s0[1]));
        wp[33 + i] = pk2(__uint_as_float(s1[0]), __uint_as_float(s1[1]));
    }
    LDS_WAIT(); asm volatile("" ::: "memory");
    const int c = lane & 7;
#pragma unroll
    for (int j = 0; j < 16; ++j) { const int n = (lane >> 3) + 8 * j; const LAS unsigned* s = scr + n * 33 + 4 * c;
        u32x4 o; o.x = s[0]; o.y = s[1]; o.z = s[2]; o.w = s[3];
        *(u32x4*)(WT + (size_t)(drow0 + n) * ldk + k0 + 8 * c) = o; }
    LDS_WAIT(); asm volatile("" ::: "memory");
}
__device__ __forceinline__ void moe_convert_item(const Params& p, int layer, int it, LAS float* scrf, int lane) {
    LAS unsigned* scr = (LAS unsigned*)scrf;
    const int e = it / 384, r = it % 384, which = r / 128, li = r % 128, k0 = 64 * (li / 8), n0 = 128 * (li % 8);
    const size_t woff = (size_t)(layer * NE + e) * 1024 * 1024;
    if (which == 0)      transpose_item_64x128(p.in[I_WGATE] + woff, 1024, (bf16_t*)(p.ws + (layer ? WS_WGU1 : WS_WGU_T)) + (size_t)e * 2048 * 1024, 1024, scr, k0, n0, (n0 >> 7) * 256, lane);
    else if (which == 1) transpose_item_64x128(p.in[I_WUP] + woff, 1024, (bf16_t*)(p.ws + (layer ? WS_WGU1 : WS_WGU_T)) + (size_t)e * 2048 * 1024, 1024, scr, k0, n0, (n0 >> 7) * 256 + 128, lane);
    else                 transpose_item_64x128(p.in[I_WDOWN] + woff, 1024, (bf16_t*)(p.ws + (layer ? WS_WD1 : WS_WD_T)) + (size_t)e * 1024 * 1024, 1024, scr, k0, n0, n0, lane);
}
constexpr int BIG_WIN = 0, BIG_SMALL_END = 768;
constexpr size_t WS_PTRS = 128 * 1024;
__device__ __forceinline__ void big_convert_item(const Params& p, int idx, LAS float* scrf, int lane) {
    LAS unsigned* scr = (LAS unsigned*)scrf;
    const float* const* tab = (const float* const*)(p.ws + WS_PTRS);
    const float* W; bf16_t* WT; int ldk = 1024, k0, n0, drow0;
    if (idx >= BIG_SMALL_END) {
        const int it = idx - BIG_SMALL_END, e = it / 384, r = it % 384, which = r / 128, li = r % 128; k0 = 64 * (li / 8); n0 = 128 * (li % 8);
        W = tab[5 + which] + (size_t)e * 1024 * 1024;
        if (which < 2) { WT = (bf16_t*)(p.ws + WS_WGU_T) + (size_t)e * 2048 * 1024; drow0 = (n0 >> 7) * 256 + which * 128; }
        else           { WT = (bf16_t*)(p.ws + WS_WD_T) + (size_t)e * 1024 * 1024;  drow0 = n0; }
    } else {
        const int m = idx < 256 ? 0 : 1 + ((idx - 256) >> 7), li = idx < 256 ? idx : ((idx - 256) & 127);
        W = tab[m]; ldk = idx < 256 ? 2048 : 1024;
        WT = (bf16_t*)(p.ws + (idx < 256 ? WS_WOUT_T : WS_WR_T + (size_t)(m - 1) * 2 * MiB));
        k0 = 64 * (li >> 3); n0 = 128 * (li & 7); drow0 = n0;
    }
    transpose_item_64x128(W, 1024, WT, ldk, scr, k0, n0, drow0, lane);
}
constexpr int P0_NMOD = 768, P0_NSMALL = 5760, P0_NZERO = 384, P0_NMOE = 16 * 384;
#ifndef P2_CONV_ITEMS
#define P2_CONV_ITEMS 1792
#endif
#ifndef P5_CONV_ITEMS
#define P5_CONV_ITEMS 6144
#endif
#ifndef L1_A
#define L1_A 1500
#endif
#ifndef L1_B
#define L1_B 3800
#endif
#ifndef L1_C
#define L1_C 6144
#endif
constexpr int P8_GEMM_WGS = 231, P9_GEMM_WGS = 192, P12_GEMM_WGS = 208;
constexpr int P2_GEMM_WGS = 216;
constexpr int P5_GEMM_WGS = 144;
constexpr int CTL_Q0 = 8192, CTL_DONE = 8256;
__device__ __forceinline__ void moe_fill(const Params& p, LAS unsigned char* lds, int layer, unsigned* qword, unsigned* done, int G, int wave, int lane) {
    volatile LAS int* jw = (volatile LAS int*)(lds + 133120);
    LAS float* scr = (LAS float*)(lds + wave * 16640);
    constexpr int NJOBS = P0_NMOE / 8;
    __syncthreads();
    if (done && TID_ == 0) __hip_atomic_fetch_add(done, 1u, __ATOMIC_RELAXED, __HIP_MEMORY_SCOPE_AGENT);
    for (;;) {
        if (TID_ == 0) {
            bool go = true;
            if (done) go = __hip_atomic_load(done, __ATOMIC_RELAXED, __HIP_MEMORY_SCOPE_AGENT) < (unsigned)G;
            int j = NJOBS;
            if (go && __hip_atomic_load(qword, __ATOMIC_RELAXED, __HIP_MEMORY_SCOPE_AGENT) < (unsigned)NJOBS) j = (int)__hip_atomic_fetch_add(qword, 1u, __ATOMIC_RELAXED, __HIP_MEMORY_SCOPE_AGENT);
            *jw = j;
        }
        __syncthreads();
        const int j = *jw;
        __syncthreads();
        if (j >= NJOBS) break;
        moe_convert_item(p, layer, j * 8 + wave, scr, lane);
    }
}
__device__ __forceinline__ void small_convert_item(const Params& p, int it, LAS float* scr, int lane) {
    const float* W; int K, N, ldk; bf16_t* WT; int base;
    unsigned char* ws = p.ws;
    if (it < 2304)      { base = 0;    W = p.in[I_WIN];  K = 1024; N = 4608; WT = (bf16_t*)(ws + WS_WIN_T);  ldk = 1024; }
    else if (it < 3328) { base = 2304; W = p.in[I_WOUT]; K = 2048; N = 1024; WT = (bf16_t*)(ws + WS_WOUT_T); ldk = 2048; }
    else if (it < 3840) { base = 3328; W = p.in[I_WR];   K = 1024; N = 1024; WT = (bf16_t*)(ws + WS_WR_T);   ldk = 1024; }
    else if (it < 4352) { base = 3840; W = p.in[I_WK];   K = 1024; N = 1024; WT = (bf16_t*)(ws + WS_WK_T);   ldk = 1024; }
    else if (it < 4864) { base = 4352; W = p.in[I_WV];   K = 1024; N = 1024; WT = (bf16_t*)(ws + WS_WV_T);   ldk = 1024; }
    else if (it < 5376) { base = 4864; W = p.in[I_WO];   K = 1024; N = 1024; WT = (bf16_t*)(ws + WS_WO_T);   ldk = 1024; }
    else if (it < 5408) { base = 5376; W = p.in[I_W1];             K = 1024; N = 64;  WT = (bf16_t*)(ws + WS_WL1_T);                      ldk = 1024; }
    else if (it < 5440) { base = 5408; W = p.in[I_W1] + 1024 * 64; K = 1024; N = 64;  WT = (bf16_t*)(ws + WS_WL1_T) + 64 * 1024;          ldk = 1024; }
    else if (it < 5472) { base = 5440; W = p.in[I_A1];             K = 1024; N = 64;  WT = (bf16_t*)(ws + WS_WL1_T) + 256 * 1024;         ldk = 1024; }
    else if (it < 5504) { base = 5472; W = p.in[I_A1] + 1024 * 64; K = 1024; N = 64;  WT = (bf16_t*)(ws + WS_WL1_T) + (256 + 64) * 1024;  ldk = 1024; }
    else if (it < 5568) { base = 5504; W = p.in[I_G1];             K = 1024; N = 128; WT = (bf16_t*)(ws + WS_WL1_T) + 512 * 1024;         ldk = 1024; }
    else if (it < 5600) { base = 5568; W = p.in[I_W2];             K = 64;   N = 1024; WT = (bf16_t*)(ws + WS_W2T);                       ldk = 64; }
    else if (it < 5632) { base = 5600; W = p.in[I_W2] + 64 * 1024; K = 64;   N = 1024; WT = (bf16_t*)(ws + WS_W2T) + 1024 * 64;           ldk = 64; }
    else if (it < 5664) { base = 5632; W = p.in[I_A2];             K = 64;   N = 1024; WT = (bf16_t*)(ws + WS_A2T);                       ldk = 64; }
    else if (it < 5696) { base = 5664; W = p.in[I_A2] + 64 * 1024; K = 64;   N = 1024; WT = (bf16_t*)(ws + WS_A2T) + 1024 * 64;           ldk = 64; }
    else                { base = 5696; W = p.in[I_G2];             K = 128;  N = 1024; WT = (bf16_t*)(ws + WS_G2T);                       ldk = 128; }
    const int li = it - base, nblk = N / 32, k0 = 64 * (li / nblk), n0 = 32 * (li % nblk);
    (void)K;
    transpose_item(W, N, WT, ldk, scr, k0, n0, n0, lane);
}
constexpr int P0_SMALL_KEEP = 2304;
__device__ __forceinline__ void phase_prep(const Params& p, LAS unsigned char* lds, int gw, int NGW, int wave, int lane, bool skip_mod) {
    LAS float* S = (LAS float*)lds;
    for (int i = TID_; i < 9 * 1024; i += 512) { const float c = i < 8192 ? p.in[I_C][i] : p.in[I_CCTX][i - 8192]; S[i] = c * sigmoidf_(c); }
    __syncthreads();
    float* mod = (float*)(p.ws + WS_MOD);
    if (!skip_mod) {
        LAS float* part = (LAS float*)(lds + 36864);
        for (int it = blockIdx.x; it < 192; it += gridDim.x) {
            const int l = it / 96, nch = it % 96, n = nch * 64 + lane, kb = wave * 128;
            const float* w = p.in[I_ADAW] + ((size_t)l * 1024 + kb) * 6144 + n;
            float acc[9];
#pragma unroll
            for (int r9 = 0; r9 < 9; ++r9) acc[r9] = 0.f;
            for (int k = 0; k < 128; k += 32) {
                float wv[32];
#pragma unroll
                for (int u = 0; u < 32; ++u) wv[u] = w[(size_t)(k + u) * 6144];
#pragma unroll
                for (int u = 0; u < 32; ++u)
#pragma unroll
                    for (int r9 = 0; r9 < 9; ++r9) acc[r9] += S[r9 * 1024 + kb + k + u] * wv[u];
            }
#pragma unroll
            for (int r9 = 0; r9 < 9; ++r9) part[(wave * 9 + r9) * 64 + lane] = acc[r9];
            __syncthreads();
            for (int o = TID_; o < 576; o += 512) { const int r9 = o >> 6, col = o & 63; float s = p.in[I_ADAB][l * 6144 + nch * 64 + col];
#pragma unroll
                for (int w8 = 0; w8 < 8; ++w8) s += part[(w8 * 9 + r9) * 64 + col];
                mod[(size_t)(l * 9 + r9) * 6144 + nch * 64 + col] = s; }
            __syncthreads();
        }
    }
    __syncthreads();
    LAS float* scr = (LAS float*)(lds + wave * 16896);
    if (gw == 0 && lane == 0) { const float** tab = (const float**)(p.ws + WS_PTRS);
        tab[0] = p.in[I_WOUT]; tab[1] = p.in[I_WR]; tab[2] = p.in[I_WK]; tab[3] = p.in[I_WV]; tab[4] = p.in[I_WO]; tab[5] = p.in[I_WGATE]; tab[6] = p.in[I_WUP]; tab[7] = p.in[I_WDOWN]; }
    constexpr int P0_LORA0 = 5376, NLORA = P0_NSMALL - P0_LORA0;
    constexpr int nwin = P0_SMALL_KEEP;
    const int NIT = nwin + NLORA + P0_NZERO;
    for (int it = gw; it < NIT; it += NGW) {
        if (it < nwin + NLORA) {
            small_convert_item(p, it < nwin ? it : P0_LORA0 + it - nwin, scr, lane);
        } else {
            const int r = it - nwin - NLORA, g = r >> 7, row = 128 + (r & 127);
            bf16_t* dst = (bf16_t*)(p.ws + WS_WL1_T) + (size_t)(g * 256 + row) * 1024;
            *(u32x4*)(dst + lane * 8) = (u32x4){0u, 0u, 0u, 0u}; *(u32x4*)(dst + 512 + lane * 8) = (u32x4){0u, 0u, 0u, 0u};
        }
    }
    float* rope = (float*)(p.ws + WS_ROPE);
    for (int idx = gw * 64 + lane; idx < SEQ * 64; idx += NGW * 64) { const int t = idx >> 6, j = idx & 63;
        const float ang = (float)(j < 32 ? (t >> 6) : (t & 63)) * powf(10000.0f, -(float)(j & 31) / 32.0f);
        rope[idx] = cosf(ang); rope[SEQ * 64 + idx] = sinf(ang); }
}

__device__ __forceinline__ void phase_prenorm0(const Params& p, int gw, int NGW, int lane) {
    const float* mod = (const float*)(p.ws + WS_MOD);
    bf16_t* H = (bf16_t*)(p.ws + WS_H);
    constexpr int R = 4;
    for (int row0 = gw * R; row0 < MT; row0 += NGW * R) {
        const float* xr = row0 < ML ? p.in[I_X] + (size_t)row0 * DM : p.in[I_CTX] + (size_t)(row0 - ML) * DM;
        const int mr = row0 < ML ? (row0 >> 11) : 8;
        const float* m = mod + (size_t)mr * 6144;
        f32x4 v[R][4];
#pragma unroll
        for (int r = 0; r < R; ++r) ld_row_f32(xr + (size_t)r * DM, lane, v[r]);
        const float* const sh[R] = {m, m, m, m}; const float* const sc[R] = {m + 1024, m + 1024, m + 1024, m + 1024};
        ada_rows<R>(v, p.in[I_NORMG], sh, sc, lane);
#pragma unroll
        for (int r = 0; r < R; ++r) st_row_bf16(H + (size_t)(row0 + r) * DM, lane, v[r]);
    }
}

__device__ __forceinline__ void phase_qkconv(const Params& p, int gw, int NGW, int lane) {
    const bf16_t* P = (const bf16_t*)(p.ws + WS_P);
    bf16_t* Q = (bf16_t*)(p.ws + WS_Q); bf16_t* KA = (bf16_t*)(p.ws + WS_KA); bf16_t* VA = (bf16_t*)(p.ws + WS_VA); bf16_t* AO = (bf16_t*)(p.ws + WS_AO);
    const float* rope = (const float*)(p.ws + WS_ROPE);
    const int i16 = lane & 15, dlo = 8 * (i16 & 7);
    const float sgn = i16 < 8 ? -1.f : 1.f;
    float qg[8], kg[8];
#pragma unroll
    for (int j = 0; j < 8; ++j) { qg[j] = p.in[I_QG][8 * i16 + j]; kg[j] = p.in[I_KG][8 * i16 + j]; }
    for (int row0 = gw * 2; row0 < MT; row0 += NGW * 2) {
        u32x4 ra[2], rb[2], rk[2]; f32x4 cs[2][2], sn[2][2];
#pragma unroll
        for (int r = 0; r < 2; ++r) { const int row = row0 + r; const bf16_t* pr = P + (size_t)row * PROJ;
            ra[r] = *(const u32x4*)(pr + 8 * lane); rb[r] = *(const u32x4*)(pr + 512 + 8 * lane); rk[r] = *(const u32x4*)(pr + 1024 + 8 * lane);
            if (row < ML) { const float* cp = rope + (size_t)(row & 2047) * 64 + dlo; cs[r][0] = *(const f32x4*)cp; cs[r][1] = *(const f32x4*)(cp + 4); sn[r][0] = *(const f32x4*)(cp + SEQ * 64); sn[r][1] = *(const f32x4*)(cp + SEQ * 64 + 4); }
            else { cs[r][0] = (f32x4){1.f, 1.f, 1.f, 1.f}; cs[r][1] = cs[r][0]; sn[r][0] = (f32x4){0.f, 0.f, 0.f, 0.f}; sn[r][1] = sn[r][0]; } }
#pragma unroll
        for (int r = 0; r < 2; ++r) {
            const int row = row0 + r; const bool lat = row < ML;
            const int b = lat ? (row >> 11) : ((row - ML) >> 8), t = lat ? (row & 2047) : ((row - ML) & 255);
            const size_t kvrow = ((size_t)b * KVL + (lat ? CTXL + t : t)) * 256;
#pragma unroll
            for (int part = 0; part < 3; ++part) {
                float x[8], o[8]; unpk8(part == 0 ? ra[r] : part == 1 ? rb[r] : rk[r], x);
                float ss = 0.f;
#pragma unroll
                for (int j = 0; j < 8; ++j) ss += x[j] * x[j];
                const float rinv = rsqf_(allsum16(ss) * (1.0f / 128.0f) + 1e-6f);
#pragma unroll
                for (int j = 0; j < 8; ++j) { const float y = x[j] * rinv * (part == 2 ? kg[j] : qg[j]); const float other = dpp_mov<0x128>(y);
                    o[j] = y * cs[r][j >> 2][j & 3] + sgn * other * sn[r][j >> 2][j & 3]; }
                if (part == 0) *(u32x4*)(Q + (size_t)row * DM + 8 * lane) = pk8(o);
                else if (part == 1) *(u32x4*)(Q + (size_t)row * DM + 512 + 8 * lane) = pk8(o);
                else { if (lane < 32) *(u32x4*)(KA + kvrow + 8 * lane) = pk8(o); else *(u32x4*)(VA + kvrow + 8 * (lane - 32)) = rk[r]; }
            }
        }
    }
    f32x4 w0[4], w1[4], w2[4];
#pragma unroll
    for (int q4 = 0; q4 < 4; ++q4) { const int c = 16 * lane + 4 * q4; w0[q4] = *(const f32x4*)(p.in[I_CONVW] + c); w1[q4] = *(const f32x4*)(p.in[I_CONVW] + 1024 + c); w2[q4] = *(const f32x4*)(p.in[I_CONVW] + 2048 + c); }
    for (int row0 = gw * 2; row0 < MT; row0 += NGW * 2) {
        const bool lat = row0 < ML; const int t0 = lat ? (row0 & 2047) : ((row0 - ML) & 255), T = lat ? SEQ : CTXL;
        const bf16_t* pr = P + (size_t)row0 * PROJ + 16 * lane;
        u32x4 gc[4][2], xc[4][2], gb[2][2];
#pragma unroll
        for (int r = 0; r < 4; ++r) { const bool ok = (r != 0 || t0 > 0) && (r != 3 || t0 + 2 < T); const bf16_t* q = pr + (ptrdiff_t)(r - 1) * PROJ;
#pragma unroll
            for (int hh = 0; hh < 2; ++hh) { gc[r][hh] = ok ? *(const u32x4*)(q + 2560 + 8 * hh) : (u32x4){0u, 0u, 0u, 0u}; xc[r][hh] = ok ? *(const u32x4*)(q + 3584 + 8 * hh) : (u32x4){0u, 0u, 0u, 0u}; } }
#pragma unroll
        for (int r = 0; r < 2; ++r)
#pragma unroll
            for (int hh = 0; hh < 2; ++hh) gb[r][hh] = *(const u32x4*)(pr + (size_t)r * PROJ + 1536 + 8 * hh);
#pragma unroll
        for (int hh = 0; hh < 2; ++hh) {
            float u[4][8];
#pragma unroll
            for (int r = 0; r < 4; ++r) { float a[8], b[8]; unpk8(gc[r][hh], a); unpk8(xc[r][hh], b);
#pragma unroll
                for (int j = 0; j < 8; ++j) u[r][j] = a[j] * b[j]; }
#pragma unroll
            for (int r = 0; r < 2; ++r) { float g[8], o[8]; unpk8(gb[r][hh], g);
#pragma unroll
                for (int j = 0; j < 8; ++j) { const int q4 = 2 * hh + (j >> 2), e = j & 3; o[j] = g[j] * (u[r][j] * w0[q4][e] + u[r + 1][j] * w1[q4][e] + u[r + 2][j] * w2[q4][e]); }
                *(u32x4*)(AO + (size_t)(row0 + r) * 2048 + 1024 + 16 * lane + 8 * hh) = pk8(o); }
        }
    }
}

namespace attn {
constexpr int D = 128, NW = 8, QBLK = 32, KVBLK = 64;
constexpr float SCALE = 0.088388347648318440f;
constexpr float THR = 8.f;
constexpr size_t SHM_V = KVBLK * D * 2, SHM_K = KVBLK * D * 2, SHM_ATTN = 2 * SHM_V + 2 * SHM_K + NW * 64 * 4;
#define KSWZ(row, colB) ((row) * 256 + ((colB) ^ (((row) & 7) << 4)))
#define SBAR() __builtin_amdgcn_sched_barrier(0)
__device__ __forceinline__ int crow(int r, int hi) { return (r & 3) + 8 * (r >> 2) + 4 * hi; }
__device__ __forceinline__ unsigned cvtpk(float lo, float hi) { unsigned r; asm volatile("v_cvt_pk_bf16_f32 %0, %1, %2" : "=v"(r) : "v"(lo), "v"(hi)); return r; }
__device__ __forceinline__ void partialSM(f32x16& p0, f32x16& p1, float& m_reg, float& mn, float& alpha) {
  constexpr float C = SCALE * 1.4426950408889634f;
  float pmax = p0[0]; for (int r = 1; r < 16; ++r) pmax = fmaxf(pmax, p0[r]); for (int r = 0; r < 16; ++r) pmax = fmaxf(pmax, p1[r]);
  { auto rr = __builtin_amdgcn_permlane32_swap(__float_as_uint(pmax), __float_as_uint(pmax), false, false);
    pmax = fmaxf(__uint_as_float(rr[0]), __uint_as_float(rr[1])); }
  if (__builtin_expect(__all(pmax - m_reg <= THR / SCALE), 1)) { mn = m_reg; alpha = 1.f; }
  else { mn = fmaxf(m_reg, pmax); alpha = __builtin_amdgcn_exp2f((m_reg - mn) * C); m_reg = mn; }
  float mnC = -mn * C;
  for (int r = 0; r < 16; ++r) p0[r] = fmaf(p0[r], C, mnC); for (int r = 0; r < 16; ++r) p1[r] = fmaf(p1[r], C, mnC);
  for (int r = 0; r < 16; ++r) p0[r] = __builtin_amdgcn_exp2f(p0[r]);
}
__device__ __forceinline__ void finishSM(f32x16& p0, f32x16& p1, float alpha, float& l_reg, bf16x8& pa0, bf16x8& pa1, bf16x8& pa2, bf16x8& pa3) {
  for (int r = 0; r < 16; ++r) p1[r] = __builtin_amdgcn_exp2f(p1[r]);
  float ps = 0; for (int r = 0; r < 16; ++r) ps += p0[r]; for (int r = 0; r < 16; ++r) ps += p1[r];
  { auto rr = __builtin_amdgcn_permlane32_swap(__float_as_uint(ps), __float_as_uint(ps), false, false);
    ps = __uint_as_float(rr[0]) + __uint_as_float(rr[1]); }
  l_reg = l_reg * alpha + ps;
#define PK4(P, BASE, OUT) do { unsigned a0 = cvtpk(P[BASE + 0], P[BASE + 1]), a1 = cvtpk(P[BASE + 2], P[BASE + 3]);   \
    unsigned b0 = cvtpk(P[BASE + 4], P[BASE + 5]), b1 = cvtpk(P[BASE + 6], P[BASE + 7]);                              \
    auto r0 = __builtin_amdgcn_permlane32_swap(a0, b0, false, false); auto r1 = __builtin_amdgcn_permlane32_swap(a1, b1, false, false); \
    u32x4 w = {r0[0], r1[0], r0[1], r1[1]}; OUT = *reinterpret_cast<bf16x8*>(&w); } while (0)
  PK4(p0, 0, pa0); PK4(p0, 8, pa1); PK4(p1, 0, pa2); PK4(p1, 8, pa3);
#undef PK4
}
__device__ __forceinline__ void qkt(f32x16& p0, f32x16& p1, const bf16_t* Ks, const bf16x8* qr, int r32, int hi) {
  p0 = f32x16{}; p1 = f32x16{};
  for (int d0 = 0; d0 < 8; ++d0) { int cb = (d0 * 16 + hi * 8) * 2;
    bf16x8 b0 = *reinterpret_cast<const bf16x8*>((const char*)Ks + KSWZ(r32, cb));
    bf16x8 b1 = *reinterpret_cast<const bf16x8*>((const char*)Ks + KSWZ(32 + r32, cb));
    p0 = __builtin_amdgcn_mfma_f32_32x32x16_bf16(b0, qr[d0], p0, 0, 0, 0);
    p1 = __builtin_amdgcn_mfma_f32_32x32x16_bf16(b1, qr[d0], p1, 0, 0, 0); }
}
__device__ __forceinline__ int v_st(int k, int c) { const int kk = (k & ~0xC) | ((k & 4) << 1) | ((k & 8) >> 1); return ((kk >> 3) * 4 + (c >> 5)) * 512 + ((kk & 7) * 32 + (c & 31)) * 2; }
__device__ __forceinline__ int v_rd_base(int lane) { return ((lane & 3) << 3) | (((lane >> 2) & 3) << 6) | (((lane >> 4) & 1) << 5) | (((lane >> 5) & 1) << 8); }
constexpr int v_rd_off(int d0, int ks, int half) { return d0 * 512 + ks * 4096 + half * 2048; }
template <int OFF> __device__ __forceinline__ s16x4 tr_read(int vb) {
  s16x4 r; asm volatile("ds_read_b64_tr_b16 %0, %1 offset:%2" : "=&v"(r) : "v"(vb), "i"(OFF) : "memory"); return r;
}
template <int D0> __device__ __forceinline__ void pv_one(f32x16& od, int vb, bf16x8 pa0, bf16x8 pa1, bf16x8 pa2, bf16x8 pa3) {
  const s16x4 l0 = tr_read<v_rd_off(D0, 0, 0)>(vb), h0 = tr_read<v_rd_off(D0, 0, 1)>(vb), l1 = tr_read<v_rd_off(D0, 1, 0)>(vb), h1 = tr_read<v_rd_off(D0, 1, 1)>(vb);
  const s16x4 l2 = tr_read<v_rd_off(D0, 2, 0)>(vb), h2 = tr_read<v_rd_off(D0, 2, 1)>(vb), l3 = tr_read<v_rd_off(D0, 3, 0)>(vb), h3 = tr_read<v_rd_off(D0, 3, 1)>(vb);
  asm volatile("s_waitcnt lgkmcnt(0)" ::: "memory"); SBAR();
#define PK(L, H) (bf16x8){L[0], L[1], L[2], L[3], H[0], H[1], H[2], H[3]}
  od = __builtin_amdgcn_mfma_f32_32x32x16_bf16(pa0, PK(l0, h0), od, 0, 0, 0);
  od = __builtin_amdgcn_mfma_f32_32x32x16_bf16(pa1, PK(l1, h1), od, 0, 0, 0);
  od = __builtin_amdgcn_mfma_f32_32x32x16_bf16(pa2, PK(l2, h2), od, 0, 0, 0);
  od = __builtin_amdgcn_mfma_f32_32x32x16_bf16(pa3, PK(l3, h3), od, 0, 0, 0);
#undef PK
}
__device__ __forceinline__ void pv_d0(f32x16* o, int vb, bf16x8 pa0, bf16x8 pa1, bf16x8 pa2, bf16x8 pa3) {
  pv_one<0>(o[0], vb, pa0, pa1, pa2, pa3); pv_one<1>(o[1], vb, pa0, pa1, pa2, pa3); pv_one<2>(o[2], vb, pa0, pa1, pa2, pa3); pv_one<3>(o[3], vb, pa0, pa1, pa2, pa3);
}
template <int LDQ, int LDK, int LDO>
__device__ __forceinline__ void attn_dense_body(const bf16_t* __restrict__ Qb, const bf16_t* __restrict__ Kh, const bf16_t* __restrict__ Vh,
                                                bf16_t* __restrict__ Ob, int seq, char* lds) {
  constexpr int SDEPTH = 2;
  const int tid = TID_, wid = tid >> 6, lane = tid & 63, r32 = lane & 31, hi = lane >> 5;
  bf16_t* V_lds = (bf16_t*)lds; bf16_t* K_lds = (bf16_t*)(lds + 2 * SHM_V);
  float* ws = (float*)(lds + 2 * SHM_V + 2 * SHM_K) + wid * 64; float* li_l = ws; float* al_l = ws + 32;
  float m_reg = -1e30f, l_reg = 0; f32x16 o[4] = {}; bf16x8 qr[8];
  const bf16_t* Qw = Qb + (long)(wid * QBLK + r32) * LDQ + hi * 8;
#pragma unroll
  for (int d0 = 0; d0 < 8; ++d0) qr[d0] = *reinterpret_cast<const bf16x8*>(Qw + d0 * 16);
  const int sr = tid >> 4, sc = (tid & 15) * 8, vst0 = v_st(sr, sc), vst1 = v_st(32 + sr, sc);
  const int vb0 = (int)(uintptr_t)V_lds + v_rd_base(lane);
  struct { bf16x8 vs0, vs1, ks0, ks1; } sr_[SDEPTH];
#define SLOAD(i, k0) do { sr_[i].vs0 = *reinterpret_cast<const bf16x8*>(&Vh[(long)((k0) + sr) * LDK + sc]); sr_[i].vs1 = *reinterpret_cast<const bf16x8*>(&Vh[(long)((k0) + 32 + sr) * LDK + sc]); \
    sr_[i].ks0 = *reinterpret_cast<const bf16x8*>(&Kh[(long)((k0) + sr) * LDK + sc]); sr_[i].ks1 = *reinterpret_cast<const bf16x8*>(&Kh[(long)((k0) + 32 + sr) * LDK + sc]); } while (0)
#define SWRITE(b, i) do { *(bf16x8*)((char*)V_lds + (b) * SHM_V + vst0) = sr_[i].vs0;          \
    *(bf16x8*)((char*)V_lds + (b) * SHM_V + vst1) = sr_[i].vs1; int kc = sc * 2;               \
    *(bf16x8*)((char*)K_lds + (b) * SHM_K + KSWZ(sr, kc)) = sr_[i].ks0;                       \
    *(bf16x8*)((char*)K_lds + (b) * SHM_K + KSWZ(32 + sr, kc)) = sr_[i].ks1; } while (0)
#define SWAIT() do { asm volatile("s_waitcnt vmcnt(4)" ::: "memory"); } while (0)
#define RESC(a) do { if (__any((a) < 1.f)) { if (hi == 0) al_l[r32] = (a); asm volatile("s_waitcnt lgkmcnt(0)" ::: "memory"); \
    for (int d = 0; d < 4; ++d) for (int r = 0; r < 16; ++r) o[d][r] *= al_l[crow(r, hi)]; } } while (0)
  f32x16 pA0, pA1, pB0, pB1; float mnA, mnB, alA, alB; bf16x8 pa0, pa1, pa2, pa3; const int NT = seq / KVBLK;
  constexpr int SE = 0, SO = SDEPTH - 1;
  SLOAD(SE, 0); asm volatile("s_waitcnt vmcnt(0)" ::: "memory"); SWRITE(0, SE); __syncthreads();
  qkt(pA0, pA1, K_lds, qr, r32, hi); partialSM(pA0, pA1, m_reg, mnA, alA);
  SLOAD(SO, KVBLK); if (2 < NT) SLOAD(SE, 2 * KVBLK);
  SWAIT(); SWRITE(1, SO); __syncthreads();
  for (int j = 1; j + 1 < NT; j += 2) {
    SBAR(); qkt(pB0, pB1, (bf16_t*)((char*)K_lds + SHM_K), qr, r32, hi);
    finishSM(pA0, pA1, alA, l_reg, pa0, pa1, pa2, pa3); SBAR();
    SLOAD(SO, (j + SDEPTH) * KVBLK); SBAR();
    pv_d0(o, vb0, pa0, pa1, pa2, pa3); partialSM(pB0, pB1, m_reg, mnB, alB);
    __syncthreads(); SWAIT(); SWRITE(0, SE);
    RESC(alB); __syncthreads();
    SBAR(); qkt(pA0, pA1, K_lds, qr, r32, hi);
    finishSM(pB0, pB1, alB, l_reg, pa0, pa1, pa2, pa3); SBAR();
    if (j + 3 < NT) SLOAD(SE, (j + 1 + SDEPTH) * KVBLK); SBAR();
    pv_d0(o, vb0 + (int)SHM_V, pa0, pa1, pa2, pa3); partialSM(pA0, pA1, m_reg, mnA, alA);
    __syncthreads(); SWAIT(); SWRITE(1, SO);
    RESC(alA); __syncthreads();
  }
  SBAR(); qkt(pB0, pB1, (bf16_t*)((char*)K_lds + SHM_K), qr, r32, hi);
  finishSM(pA0, pA1, alA, l_reg, pa0, pa1, pa2, pa3); SBAR();
  pv_d0(o, vb0, pa0, pa1, pa2, pa3); partialSM(pB0, pB1, m_reg, mnB, alB);
  __syncthreads(); RESC(alB);
  finishSM(pB0, pB1, alB, l_reg, pa0, pa1, pa2, pa3); SBAR();
  pv_d0(o, vb0 + (int)SHM_V, pa0, pa1, pa2, pa3);
  if (hi == 0) li_l[r32] = l_reg; asm volatile("s_waitcnt lgkmcnt(0)" ::: "memory");
  float rli[16];
#pragma unroll
  for (int r = 0; r < 16; ++r) rli[r] = __builtin_amdgcn_rcpf(li_l[crow(r, hi)]);
  bf16_t* Ow = Ob + (long)(wid * QBLK) * LDO;
#pragma unroll
  for (int r = 0; r < 16; ++r) { int orow = crow(r, hi);
    for (int d0 = 0; d0 < 4; ++d0) Ow[(long)orow * LDO + d0 * 32 + r32] = (bf16_t)f2bf(o[d0][r] * rli[r]); }
#undef SLOAD
#undef SWRITE
#undef SWAIT
#undef RESC
}
#undef KSWZ
#undef SBAR
}

__device__ __forceinline__ void phase_attention(const Params& p, LAS unsigned char* lds, int G, int c) {
    const bf16_t* Q = (const bf16_t*)(p.ws + WS_Q); const bf16_t* KA = (const bf16_t*)(p.ws + WS_KA); const bf16_t* VA = (const bf16_t*)(p.ws + WS_VA); bf16_t* AO = (bf16_t*)(p.ws + WS_AO);
    for (int u = c; u < 576; u += G) {
        size_t qrow, kvoff; int h, seq;
        if (u < 512) { const int qb = u & 7, g = (u >> 3) & 3, kvh = (u >> 5) & 1, b = u >> 6; h = kvh * 4 + g; qrow = (size_t)b * SEQ + qb * 256; kvoff = (size_t)b * KVL * 256 + kvh * 128; seq = KVL; }
        else { const int uc = u - 512, b = uc >> 3; h = uc & 7; qrow = (size_t)ML + b * CTXL; kvoff = (size_t)b * KVL * 256 + (h >> 2) * 128; seq = CTXL; }
        attn::attn_dense_body<DM, 256, 2048>(Q + qrow * DM + h * 128, KA + kvoff, VA + kvoff, AO + qrow * 2048 + h * 128, seq, (char*)lds);
        __syncthreads();
    }
}
__device__ __forceinline__ void phase_moe_prenorm(const Params& p, LAS unsigned char* lds, int layer, const bf16_t* X, int nrows, bf16_t* H2, int gw, int NGW, int lane) {
    LAS float* RT = (LAS float*)lds;
    const float* router = p.in[I_ROUTER] + (size_t)layer * 1024 * 16;
    for (int i = TID_; i < 16384; i += 512) { const int k = i >> 4, e = i & 15; RT[e * 1024 + k] = router[i]; }
    __syncthreads();
    const float* mod = (const float*)(p.ws + WS_MOD) + (size_t)layer * 9 * 6144;
    float* aff = (float*)(p.ws + WS_AFF);
    const float* g = p.in[I_NORMG] + (size_t)(layer * 2 + 1) * 1024;
    constexpr int R = 4;
    for (int row0 = gw * R; row0 < nrows; row0 += NGW * R) {
        const int mr = row0 < ML ? (row0 >> 11) : 8;
        const float* m = mod + (size_t)mr * 6144;
        f32x4 v[R][4];
#pragma unroll
        for (int r = 0; r < R; ++r) ld_row_bf16(X + (size_t)(row0 + r) * DM, lane, v[r]);
        const float* const sh[R] = {m + 3072, m + 3072, m + 3072, m + 3072}; const float* const sc[R] = {m + 4096, m + 4096, m + 4096, m + 4096};
        ada_rows<R>(v, g, sh, sc, lane);
#pragma unroll
        for (int r = 0; r < R; ++r) st_row_bf16(H2 + (size_t)(row0 + r) * DM, lane, v[r]);
        float lg[R][16];
#pragma unroll
        for (int e = 0; e < 16; ++e) {
#pragma unroll
            for (int r = 0; r < R; ++r) lg[r][e] = 0.f;
#pragma unroll
            for (int j = 0; j < 4; ++j) { const f32x4 rt = *(const LAS f32x4*)(RT + e * 1024 + 256 * j + 4 * lane);
#pragma unroll
                for (int r = 0; r < R; ++r) lg[r][e] += (v[r][j].x * rt.x + v[r][j].y * rt.y) + (v[r][j].z * rt.z + v[r][j].w * rt.w); }
            asm volatile("" ::: "memory"); }
        float lgt[R];
#pragma unroll
        for (int r = 0; r < R; ++r) {
            float p8[8], p4[4], p2[2];
#pragma unroll
            for (int i = 0; i < 8; ++i) { const bool up = (lane & 32) != 0; const float keep = up ? lg[r][i + 8] : lg[r][i], send = up ? lg[r][i] : lg[r][i + 8]; p8[i] = keep + __shfl_xor(send, 32); }
#pragma unroll
            for (int i = 0; i < 4; ++i) { const bool up = (lane & 16) != 0; const float keep = up ? p8[i + 4] : p8[i], send = up ? p8[i] : p8[i + 4]; p4[i] = keep + __shfl_xor(send, 16); }
#pragma unroll
            for (int i = 0; i < 2; ++i) { const bool up = (lane & 8) != 0; const float keep = up ? p4[i + 2] : p4[i], send = up ? p4[i] : p4[i + 2]; p2[i] = keep + __shfl_xor(send, 8); }
            { const bool up = (lane & 4) != 0; const float keep = up ? p2[1] : p2[0], send = up ? p2[0] : p2[1]; lgt[r] = keep + __shfl_xor(send, 4); }
            lgt[r] += __shfl_xor(lgt[r], 2); lgt[r] += __shfl_xor(lgt[r], 1);
        }
        const int myexp = ((lane >> 5) & 1) * 8 + ((lane >> 4) & 1) * 4 + ((lane >> 3) & 1) * 2 + ((lane >> 2) & 1);
#pragma unroll
        for (int r = 0; r < R; ++r) {
            float mx = lgt[r];
#pragma unroll
            for (int o = 4; o < 64; o <<= 1) mx = fmaxf(mx, __shfl_xor(mx, o));
            const float ex = __expf(lgt[r] - mx); float sum = ex;
#pragma unroll
            for (int o = 4; o < 64; o <<= 1) sum += __shfl_xor(sum, o);
            if ((lane & 3) == 0) aff[(size_t)(row0 + r) * 16 + myexp] = ex * rcpf_(sum);
        }
    }
}

__device__ __forceinline__ int block_exscan(int flag, volatile LAS int* sm, int wave, int lane, int& tot) {
    const unsigned long long bal = __ballot(flag != 0);
    const int pre = __popcll(bal & ((1ull << lane) - 1ull)), wtot = __popcll(bal);
    __syncthreads();
    if (lane == 0) sm[wave] = wtot;
    __syncthreads();
    int base = 0, t = 0;
#pragma unroll
    for (int w = 0; w < 8; ++w) { const int x = sm[w]; base += (w < wave) ? x : 0; t += x; }
    tot = t; return base + pre;
}
__device__ __forceinline__ int block_sum(int v, volatile LAS int* sm, int wave, int lane) {
    v = wave_sum_i(v);
    __syncthreads();
    if (lane == 0) sm[wave] = v;
    __syncthreads();
    int t = 0;
#pragma unroll
    for (int w = 0; w < 8; ++w) t += sm[w];
    return t;
}
__device__ __forceinline__ void phase_select(const Params& p, LAS unsigned char* lds, int ntasks, int SL, int G, int c, int wave, int lane) {
    volatile LAS int* sm = (volatile LAS int*)lds;
    const float* aff = (const float*)(p.ws + WS_AFF);
    int* tokslot = (int*)(p.ws + WS_TOKSLOT); float* selaff = (float*)(p.ws + WS_SELAFF); int* selrow = (int*)(p.ws + WS_SELROW);
    const int tid = TID_;
    for (int tk = c; tk < ntasks; tk += G) {
        const bool lat = tk < 128; const int tt = lat ? tk : tk - 128, b = tt >> 4, e = tt & 15;
        const int n = lat ? SEQ : CTXL, cap = lat ? CAPL : CAPC, rowbase = lat ? b * SEQ : ML + b * CTXL, slotbase = lat ? b * CAPL : NB * CAPL + b * CAPC;
        unsigned key[4]; bool valid[4];
#pragma unroll
        for (int i = 0; i < 4; ++i) { const int idx = tid + 512 * i; valid[i] = idx < n; key[i] = valid[i] ? __float_as_uint(aff[(size_t)(rowbase + idx) * 16 + e]) : 0u; }
        unsigned prefix = 0u;
        for (int bit = 30; bit >= 0; --bit) {
            const unsigned cand = prefix | (1u << bit); int cnt = 0;
#pragma unroll
            for (int i = 0; i < 4; ++i) cnt += (valid[i] && key[i] >= cand) ? 1 : 0;
            if (block_sum(cnt, sm, wave, lane) >= cap) prefix = cand;
        }
        int cg = 0;
#pragma unroll
        for (int i = 0; i < 4; ++i) cg += (valid[i] && key[i] > prefix) ? 1 : 0;
        const int need_eq = cap - block_sum(cg, sm, wave, lane);
        int eqbase = 0, selbase = 0;
#pragma unroll
        for (int i = 0; i < 4; ++i) {
            const bool gt = valid[i] && key[i] > prefix, eq = valid[i] && key[i] == prefix;
            int tot; const int er = eqbase + block_exscan(eq ? 1 : 0, sm, wave, lane, tot); eqbase += tot;
            const bool sel = gt || (eq && er < need_eq);
            int tot2; const int slot = selbase + block_exscan(sel ? 1 : 0, sm, wave, lane, tot2); selbase += tot2;
            if (valid[i]) { const int row = rowbase + tid + 512 * i;
                tokslot[(size_t)row * 16 + e] = sel ? slotbase + slot : -1;
                if (sel) { selaff[(size_t)e * SL + slotbase + slot] = __uint_as_float(key[i]); selrow[(size_t)e * SL + slotbase + slot] = row; } }
        }
        __syncthreads();
    }
}

template <int R>
__device__ __forceinline__ void moe_gather_rows(const int* tokslot, const bf16_t* Ys, int SL, int row0, int lane, f32x4 (&acc)[R][4]) {
    int mys[R]; unsigned m[R]; unsigned any = 0u;
#pragma unroll
    for (int r = 0; r < R; ++r) { mys[r] = tokslot[(size_t)(row0 + r) * 16 + (lane & 15)];
#pragma unroll
        for (int j = 0; j < 4; ++j) acc[r][j] = (f32x4){0.f, 0.f, 0.f, 0.f}; }
#pragma unroll
    for (int r = 0; r < R; ++r) { m[r] = (unsigned)(__ballot(mys[r] >= 0) & 0xffffull); any |= m[r]; }
    while (any) {
        any = 0u;
#pragma unroll
        for (int r = 0; r < R; ++r) if (m[r]) { const int e = __builtin_ctz(m[r]); m[r] &= m[r] - 1u; any |= m[r]; const int s = __shfl(mys[r], e);
            const bf16_t* y = Ys + ((size_t)e * SL + s) * DM;
#pragma unroll
            for (int j = 0; j < 4; ++j) acc[r][j] += unpk4(*(const u32x2*)(y + 256 * j + 4 * lane)); }
    }
}

__device__ __forceinline__ void phase_combine_mix(const Params& p, LAS unsigned char* lds, int G, int c, int wave, int lane) {
    const float* mod0 = (const float*)(p.ws + WS_MOD); const float* mod1 = mod0 + 9 * 6144;
    const bf16_t* X1 = (const bf16_t*)(p.ws + WS_X1); bf16_t* X2 = (bf16_t*)(p.ws + WS_X2);
    const int* tokslot = (const int*)(p.ws + WS_TOKSLOT); const bf16_t* Ys = (const bf16_t*)(p.ws + WS_YS0);
    bf16_t* XR = (bf16_t*)(p.ws + WS_XR); bf16_t* XK = (bf16_t*)(p.ws + WS_XK); bf16_t* XV = (bf16_t*)(p.ws + WS_XV);
    bf16_t* XW = (bf16_t*)(p.ws + WS_XW); bf16_t* XA = (bf16_t*)(p.ws + WS_XA); bf16_t* XG = (bf16_t*)(p.ws + WS_XG);
    const float* mu = p.in[I_MU];
    constexpr int R = 4, BR = 24;
    for (int blk = c; blk < MT / BR; blk += G) {
        const int base = blk * BR, r0 = base + 3 * wave;
        int xr = wave == 0 ? base - 1 : wave == 7 ? base + BR : -1;
        if (xr >= MT) xr = -1;
        const bool has_x = xr >= 0;
        int rows[R] = {r0, r0 + 1, r0 + 2, has_x ? xr : r0};
        f32x4 v[R][4]; f32x4 acc[R][4];
        int mys[R]; unsigned m[R]; unsigned any = 0u;
#pragma unroll
        for (int r = 0; r < R; ++r) { ld_row_bf16(X1 + (size_t)rows[r] * DM, lane, v[r]); mys[r] = tokslot[(size_t)rows[r] * 16 + (lane & 15)];
#pragma unroll
            for (int j = 0; j < 4; ++j) acc[r][j] = (f32x4){0.f, 0.f, 0.f, 0.f}; }
#pragma unroll
        for (int r = 0; r < R; ++r) { m[r] = (unsigned)(__ballot(mys[r] >= 0) & 0xffffull); any |= m[r]; }
        while (any) {
            any = 0u;
#pragma unroll
            for (int r = 0; r < R; ++r) if (m[r]) { const int e = __builtin_ctz(m[r]); m[r] &= m[r] - 1u; any |= m[r]; const int s = __shfl(mys[r], e);
                const bf16_t* y = Ys + ((size_t)e * SL0 + s) * DM;
#pragma unroll
                for (int j = 0; j < 4; ++j) acc[r][j] += unpk4(*(const u32x2*)(y + 256 * j + 4 * lane)); }
        }
        const float* shp[R]; const float* scp[R];
#pragma unroll
        for (int r = 0; r < R; ++r) { const int mr = rows[r] < ML ? (rows[r] >> 11) : 8; const float* gt2 = mod0 + (size_t)mr * 6144 + 5120;
#pragma unroll
            for (int j = 0; j < 4; ++j) v[r][j] = v[r][j] + *(const f32x4*)(gt2 + 256 * j + 4 * lane) * acc[r][j];
            shp[r] = mod1 + (size_t)mr * 6144; scp[r] = shp[r] + 1024; }
#pragma unroll
        for (int r = 0; r < 3; ++r) st_row_bf16(X2 + (size_t)rows[r] * DM, lane, v[r]);
        {   const float* const sh[R] = {shp[0], shp[1], shp[2], shp[3]}; const float* const sc[R] = {scp[0], scp[1], scp[2], scp[3]};
            ada_rows<R>(v, p.in[I_NORMG] + 2 * 1024, sh, sc, lane); }
#pragma unroll
        for (int r = 0; r < R; ++r) { const int slot = rows[r] - (base - 1);
            if (r < 3 || has_x) {
#pragma unroll
                for (int j = 0; j < 4; ++j) *(LAS u32x2*)(lds + slot * 2048 + (256 * j + 4 * lane) * 2) = pk4(v[r][j]); } }
        __syncthreads();
#pragma unroll
        for (int r = 0; r < 3; ++r) {
            const int row = rows[r]; const bool lat = row < ML; const int t = lat ? (row & 2047) : ((row - ML) & 255), T = lat ? SEQ : CTXL;
            const int slot = row - (base - 1); const bool vp = t > 0, vn = t < T - 1;
#pragma unroll
            for (int j = 0; j < 4; ++j) {
                const int cc = 256 * j + 4 * lane;
                const f32x4 z0 = (f32x4){0.f, 0.f, 0.f, 0.f}; const f32x4 hp = vp ? unpk4(*(const LAS u32x2*)(lds + (slot - 1) * 2048 + cc * 2)) : z0, hn = vn ? unpk4(*(const LAS u32x2*)(lds + (slot + 1) * 2048 + cc * 2)) : z0;
                const f32x4 h = v[r][j], xx = (hp + hn) * 0.5f - h; const size_t o = (size_t)row * DM + cc;
                *(u32x2*)(XW + o) = pk4(h + xx * *(const f32x4*)(mu + 1 * 1024 + cc)); *(u32x2*)(XK + o) = pk4(h + xx * *(const f32x4*)(mu + 2 * 1024 + cc));
                *(u32x2*)(XV + o) = pk4(h + xx * *(const f32x4*)(mu + 3 * 1024 + cc)); *(u32x2*)(XA + o) = pk4(h + xx * *(const f32x4*)(mu + 4 * 1024 + cc));
                if (lat) { *(u32x2*)(XR + o) = pk4(h + xx * *(const f32x4*)(mu + 0 * 1024 + cc)); *(u32x2*)(XG + o) = pk4(h + xx * *(const f32x4*)(mu + 5 * 1024 + cc)); }
            }
        }
        __syncthreads();
    }
}

__device__ __forceinline__ bf16x8 tanh8(bf16x8 x) {
    bf16x8 o;
#pragma unroll
    for (int j = 0; j < 8; ++j) { const float v = bf2f((unsigned short)x[j]); o[j] = (short)f2bf(1.0f - 2.0f * rcpf_(1.0f + __expf(2.0f * v))); }
    return o;
}
namespace cs {
constexpr int O_V = 0, O_KQ = 2048, O_RQ = 4096, O_KKP = 6144, O_NBKP = 8192, O_KK = 10240, O_BK = 12288, O_GC = 14336, O_AT = 14592, O_ANA4 = 15104, O_AA1 = 15616, O_AA3 = 16128, SLOT = 16640;
constexpr int NSLOT = 8, WOFF = NSLOT * SLOT  , CNT_OFF = WOFF + 16384  ,
              CST_OFF = CNT_OFF + 64  ;
constexpr int NCHUNK = (CTXL + SEQ) / 16, NROUND = NCHUNK / 4;
static_assert(CST_OFF + 1280 <= RING_BYTES, "LDS");
__device__ __forceinline__ s16x4 pkbf(f32x4 v) { u32x2 w; w.x = pg8::cvt_pk_bf16(v.x, v.y); w.y = pg8::cvt_pk_bf16(v.z, v.w); return __builtin_bit_cast(s16x4, w); }
__device__ __forceinline__ f32x4 mfma16(s16x4 a, s16x4 b, f32x4 c) { return __builtin_amdgcn_mfma_f32_16x16x16bf16_1k(a, b, c, 0, 0, 0); }
__device__ __forceinline__ bf16x8 cat8(s16x4 a, s16x4 b) { return (bf16x8){a[0], a[1], a[2], a[3], b[0], b[1], b[2], b[3]}; }
__device__ __forceinline__ int step_row(int c, int s, int b, int d) { const int g = c * 16 + s; if (g < CTXL) return ML + b * CTXL + (d ? (CTXL - 1 - g) : g); const int gl = g - CTXL; return b * SEQ + (d ? (SEQ - 1 - gl) : gl); }
struct Raw { bf16x8 xw[2], xa[2]; u32x4 kb[2], vb[2], rb[2]; };
__device__ __forceinline__ void unpack16(const u32x4 (&w)[2], float (&o)[16]) {
#pragma unroll
    for (int m = 0; m < 8; ++m) { const unsigned x = w[m >> 2][m & 3]; o[2 * m] = bf2f(x & 0xffffu); o[2 * m + 1] = bf2f(x >> 16); }
}
__device__ __forceinline__ void pack16(const float (&v)[16], u32x4& lo, u32x4& hi) {
#pragma unroll
    for (int m = 0; m < 4; ++m) { lo[m] = pg8::cvt_pk_bf16(v[2 * m], v[2 * m + 1]); hi[m] = pg8::cvt_pk_bf16(v[8 + 2 * m], v[8 + 2 * m + 1]); }
}
}
__device__ __forceinline__ void phase_scan(const Params& p, LAS unsigned char* lds, int G, int c, int wave, int lane, int variant = 0) {
    using namespace cs;
    const bf16_t* RB = (const bf16_t*)(p.ws + WS_RB); const bf16_t* KB = (const bf16_t*)(p.ws + WS_KB); const bf16_t* VB = (const bf16_t*)(p.ws + WS_VB);
    const int fr = lane & 15, fq = lane >> 4;
    for (int sid = c; sid < 256; sid += G) {
        const int d = sid & 1, h = (sid >> 1) & 15, b = sid >> 5;
        const bf16_t* T1w = (const bf16_t*)(p.ws + WS_T1); const bf16_t* T1a = T1w + (size_t)MT * 128;
        const bf16_t* W2h = (const bf16_t*)(p.ws + WS_W2T) + ((size_t)d * 1024 + h * 64) * 64; const bf16_t* A2h = (const bf16_t*)(p.ws + WS_A2T) + ((size_t)d * 1024 + h * 64) * 64;
        const float* w0h = p.in[I_W0] + d * 1024 + h * 64; const float* a0h = p.in[I_A0] + d * 1024 + h * 64;
        bf16_t* Y = (bf16_t*)(p.ws + (variant ? WS_KK : (d ? WS_Y1 : WS_Y0)));
        __syncthreads();
        {   const int t_ = TID_;
            if (t_ == 0) *(volatile LAS unsigned*)(lds + cs::CNT_OFF) = 0u;
#pragma unroll
            for (int i = 0; i < 2; ++i) { const int q_ = t_ + 512 * i, m_ = q_ >> 9, ch_ = (q_ >> 3) & 63, c8_ = q_ & 7;
                *(LAS u32x4*)(lds + WOFF + m_ * 8192 + ch_ * 128 + ((c8_ ^ (ch_ & 7)) << 4)) = *(const u32x4*)((m_ ? A2h : W2h) + (size_t)ch_ * 64 + 8 * c8_); }
            if (t_ < 320) { const int a_ = t_ >> 6, c_ = t_ & 63; const float* src_ = a_ == 0 ? p.in[I_KK] + h * 64 : a_ == 1 ? p.in[I_KA] + h * 64 : a_ == 2 ? p.in[I_RK] + h * 64 : a_ == 3 ? w0h : a0h;
                *(LAS float*)(lds + CST_OFF + t_ * 4) = src_[c_]; }
        }
        __syncthreads();
        if (wave >= 4) {
            const int pw = wave - 4, step = lane >> 2, qt = lane & 3;
            float* BON = (float*)(p.ws + (variant ? WS_KK + 33 * MiB : WS_BON)) + (size_t)d * ML * 16;
            const LAS float* cst = (const LAS float*)(lds + CST_OFF);
            Raw raw, nxt;
#define CS_LOAD(raw, ch) do { const int row_ = step_row((ch), step, b, d); const size_t o_ = (size_t)row_ * DM + h * 64 + 16 * qt; \
            raw.kb[0] = *(const u32x4*)(KB + o_); raw.kb[1] = *(const u32x4*)(KB + o_ + 8); \
            raw.vb[0] = *(const u32x4*)(VB + o_); raw.vb[1] = *(const u32x4*)(VB + o_ + 8); \
            if (row_ < ML) { raw.rb[0] = *(const u32x4*)(RB + o_); raw.rb[1] = *(const u32x4*)(RB + o_ + 8); } else { raw.rb[0] = (u32x4){0u, 0u, 0u, 0u}; raw.rb[1] = (u32x4){0u, 0u, 0u, 0u}; } \
            const size_t x_ = (size_t)step_row((ch), fr, b, d) * 128 + d * 64 + 8 * fq; \
            raw.xw[0] = *(const bf16x8*)(T1w + x_); raw.xw[1] = *(const bf16x8*)(T1w + x_ + 32); raw.xa[0] = *(const bf16x8*)(T1a + x_); raw.xa[1] = *(const bf16x8*)(T1a + x_ + 32); } while (0)
            CS_LOAD(nxt, pw);
            for (int g = -1; g + 1 < NROUND; ++g) {
                const int ch = 4 * (g + 1) + pw;
                LAS unsigned char* slot = lds + (((g + 1) & 1) * 4 + pw) * SLOT;
                raw = nxt;
                if (ch + 4 < NCHUNK) CS_LOAD(nxt, ch + 4);
                if (!(variant & 1)) {
                {
                    const bf16x8 xw0 = tanh8(raw.xw[0]), xw1 = tanh8(raw.xw[1]);
#pragma unroll
                    for (int ct = 0; ct < 4; ++ct) {
                        const int chl = 16 * ct + fr; const LAS unsigned char* wrow = lds + WOFF + chl * 128;
                        const int o0 = (fq ^ (chl & 7)) << 4, o1 = ((4 + fq) ^ (chl & 7)) << 4;
                        f32x4 aw = (f32x4){0.f, 0.f, 0.f, 0.f}, aa_ = aw;
                        aw = __builtin_amdgcn_mfma_f32_16x16x32_bf16(*(const LAS bf16x8*)(wrow + o0), xw0, aw, 0, 0, 0); aw = __builtin_amdgcn_mfma_f32_16x16x32_bf16(*(const LAS bf16x8*)(wrow + o1), xw1, aw, 0, 0, 0);
                        aa_ = __builtin_amdgcn_mfma_f32_16x16x32_bf16(*(const LAS bf16x8*)(wrow + 8192 + o0), raw.xa[0], aa_, 0, 0, 0); aa_ = __builtin_amdgcn_mfma_f32_16x16x32_bf16(*(const LAS bf16x8*)(wrow + 8192 + o1), raw.xa[1], aa_, 0, 0, 0);
                        const f32x4 wb = *(const LAS f32x4*)(cst + 192 + 16 * ct + 4 * fq), ab = *(const LAS f32x4*)(cst + 256 + 16 * ct + 4 * fq);
                        f32x4 ldv, aav;
#pragma unroll
                        for (int r = 0; r < 4; ++r) { ldv[r] = -0.6065306597126334f * sigmoidf_(aw[r] + wb[r]); aav[r] = sigmoidf_(aa_[r] + ab[r]); }
                        *(LAS u32x2*)(slot + O_KK + fr * 128 + (16 * ct + 4 * fq) * 2) = pk4(ldv); *(LAS u32x2*)(slot + O_BK + fr * 128 + (16 * ct + 4 * fq) * 2) = pk4(aav);
                    }
                }
                {
                    float lgv = 0.f;
#pragma unroll
                    for (int t = 0; t < 16; ++t) { lgv += bf2f(*(const LAS unsigned short*)(slot + O_KK + t * 128 + lane * 2)); *(LAS float*)(slot + O_KKP + (t * 64 + lane) * 4) = lgv; }
                    *(LAS float*)(slot + O_GC + lane * 4) = __expf(lgv); }
                float rn;
                {
                    float ss = 0.f;
#pragma unroll
                    for (int hh = 0; hh < 2; ++hh) { float kbv[8]; unpk8(raw.kb[hh], kbv);
#pragma unroll
                        for (int i = 0; i < 8; ++i) { const float t = kbv[i] * cst[16 * qt + 8 * hh + i]; ss += t * t; } }
                    ss += dpp_mov<0xB1>(ss); ss += dpp_mov<0x4E>(ss);
                    rn = rsqf_(fmaxf(ss, 1e-24f));
                }
                u32x4 ldw[2], aaw[2]; f32x4 lgq[4];
#pragma unroll
                for (int hh = 0; hh < 2; ++hh) { ldw[hh] = *(const LAS u32x4*)(slot + O_KK + step * 128 + qt * 32 + 16 * hh); aaw[hh] = *(const LAS u32x4*)(slot + O_BK + step * 128 + qt * 32 + 16 * hh); }
#pragma unroll
                for (int qq = 0; qq < 4; ++qq) lgq[qq] = *(const LAS f32x4*)(slot + O_KKP + (step * 64 + 16 * qt + 4 * qq) * 4);
                asm volatile("s_waitcnt lgkmcnt(0)" ::: "memory");
                float bsum = 0.f;
                const int sw = (qt ^ ((step >> 1) & 3)) << 5, rowo = step * 128 + sw, hbit = (step >> 3) & 1;
#pragma unroll
                for (int qq = 0; qq < 4; ++qq) {
                    const int hh = qq >> 1, sub = qq & 1;
                    const f32x4 lg4 = lgq[qq], gc4 = *(const LAS f32x4*)(slot + O_GC + (16 * qt + 4 * qq) * 4);
                    const u32x2 ldp = sub ? (u32x2){ldw[hh].z, ldw[hh].w} : (u32x2){ldw[hh].x, ldw[hh].y}, aap = sub ? (u32x2){aaw[hh].z, aaw[hh].w} : (u32x2){aaw[hh].x, aaw[hh].y};
                    const u32x2 kbp = sub ? (u32x2){raw.kb[hh].z, raw.kb[hh].w} : (u32x2){raw.kb[hh].x, raw.kb[hh].y}, rbp = sub ? (u32x2){raw.rb[hh].z, raw.rb[hh].w} : (u32x2){raw.rb[hh].x, raw.rb[hh].y};
                    const f32x4 ld4 = unpk4(ldp), aa4 = unpk4(aap), kb4 = unpk4(kbp), rr4 = unpk4(rbp);
                    const int c0 = 16 * qt + 4 * qq;
                    const f32x4 kkw = *(const LAS f32x4*)(cst + c0), kaw = *(const LAS f32x4*)(cst + 64 + c0), rkw = *(const LAS f32x4*)(cst + 128 + c0);
                    f32x4 oKq, oRq, oKk, oBk, oKkp, oNBkp;
#pragma unroll
                    for (int i = 0; i < 4; ++i) {
                        const float e0 = __expf(lg4[i]), em = rcpf_(e0), e1 = __expf(lg4[i] - ld4[i]);
                        const float kk = kb4[i] * kkw[i] * rn;
                        const float beta = kk * aa4[i], kt_ = kb4[i] * ((aa4[i] - 1.0f) * kaw[i] + 1.0f);
                        oKq[i] = kk * e1; oRq[i] = rr4[i] * e0; oKk[i] = kt_ * em; oBk[i] = beta * em; oKkp[i] = oKk[i] * gc4[i]; oNBkp[i] = -(oBk[i] * gc4[i]);
                        bsum += rr4[i] * kt_ * rkw[i]; }
                    const int ho = (hh ^ hbit) * 16 + sub * 8;
                    *(LAS u32x2*)(slot + O_KQ + rowo + ho) = pk4(oKq); *(LAS u32x2*)(slot + O_RQ + rowo + ho) = pk4(oRq);
                    *(LAS u32x2*)(slot + O_KK + rowo + ho) = pk4(oKk); *(LAS u32x2*)(slot + O_BK + rowo + ho) = pk4(oBk);
                    *(LAS u32x2*)(slot + O_KKP + rowo + qq * 8) = pk4(oKkp); *(LAS u32x2*)(slot + O_NBKP + rowo + qq * 8) = pk4(oNBkp);
                }
                *(LAS u32x4*)(slot + O_V + rowo) = raw.vb[0]; *(LAS u32x4*)(slot + O_V + rowo + 16) = raw.vb[1];
                bsum += dpp_mov<0xB1>(bsum); bsum += dpp_mov<0x4E>(bsum);
                { const int brow = step_row(ch, step, b, d); if (qt == 0 && brow < ML) BON[(size_t)brow * 16 + h] = bsum; }
                }
                __syncthreads();
            }
            __syncthreads();
#undef CS_LOAD
        } else {
            const int j = wave;
            f32x4 z[4];
#pragma unroll
            for (int kt = 0; kt < 4; ++kt) z[kt] = (f32x4){0.f, 0.f, 0.f, 0.f};
            const int trr = 4 * fq + (fr >> 2);
            const int trbase = trr * 128 + 8 * (fr & 3), trsw = (trr >> 1) & 3;
            const int rdsw = (fr >> 1) & 3, rdq = (fq ^ (((fr >> 3) & 1) << 1)) << 3;
            __syncthreads();
            volatile LAS unsigned* ccnt = (volatile LAS unsigned*)(lds + CNT_OFF);
            for (int g = 0; g < NROUND; ++g) {
                if (!(variant & 2)) {   LAS unsigned char* dslot = lds + ((g & 1) * 4 + j) * SLOT;
                s16x4 rKq[4], rRq[4], rKk[4], rBk[4];
#pragma unroll
                for (int kt = 0; kt < 4; ++kt) { const int off = fr * 128 + ((kt ^ ((fr >> 1) & 3)) << 5) + ((fq ^ (((fr >> 3) & 1) << 1)) << 3);
                    rKq[kt] = *(const LAS s16x4*)(dslot + O_KQ + off); rRq[kt] = *(const LAS s16x4*)(dslot + O_RQ + off); rKk[kt] = *(const LAS s16x4*)(dslot + O_KK + off); rBk[kt] = *(const LAS s16x4*)(dslot + O_BK + off); }
                f32x4 dL = (f32x4){0.f, 0.f, 0.f, 0.f}, dLt = dL, dA1t = dL, dA3t = dL, dA4t = dL;
#pragma unroll
                for (int kt = 0; kt < 4; ++kt) { dL = mfma16(rKq[kt], rBk[kt], dL); dLt = mfma16(rBk[kt], rKq[kt], dLt); dA1t = mfma16(rKk[kt], rKq[kt], dA1t); dA3t = mfma16(rKk[kt], rRq[kt], dA3t); dA4t = mfma16(rBk[kt], rRq[kt], dA4t); }
                f32x4 dN, dNt, a1, a3, na4, eye;
#pragma unroll
                for (int r = 0; r < 4; ++r) { const int ROW = 4 * fq + r, COL = fr;
                    dN[r] = ROW > COL ? -dL[r] : 0.f; dNt[r] = COL > ROW ? -dLt[r] : 0.f; a1[r] = COL > ROW ? dA1t[r] : 0.f; a3[r] = COL >= ROW ? dA3t[r] : 0.f; na4[r] = COL >= ROW ? -dA4t[r] : 0.f; eye[r] = ROW == COL ? 1.f : 0.f; }
                const f32x4 z4 = (f32x4){0.f, 0.f, 0.f, 0.f};
                const s16x4 bN = pkbf(dN), bNt = pkbf(dNt);
                const f32x4 dN2 = mfma16(bNt, bN, z4), dN2t = mfma16(bN, bNt, z4);
                const s16x4 bN2 = pkbf(dN2), bN2t = pkbf(dN2t);
                const f32x4 dN4 = mfma16(bN2t, bN2, z4), dN4t = mfma16(bN2, bN2t, z4);
                const f32x4 dN8 = mfma16(pkbf(dN4t), pkbf(dN4), z4);
                const f32x4 q1 = mfma16(pkbf(eye + dN2), pkbf(eye + dNt), z4);
                const f32x4 q2 = mfma16(pkbf(eye + dN4), pkbf(q1), z4);
                const f32x4 tT = mfma16(pkbf(eye + dN8), pkbf(q2), z4);
                *(LAS s16x4*)(dslot + O_AT + lane * 8) = pkbf(tT); *(LAS s16x4*)(dslot + O_ANA4 + lane * 8) = pkbf(na4);
                *(LAS s16x4*)(dslot + O_AA1 + lane * 8) = pkbf(a1); *(LAS s16x4*)(dslot + O_AA3 + lane * 8) = pkbf(a3);
                }
                asm volatile("s_waitcnt lgkmcnt(0)" ::: "memory");
                if (lane == 0) __hip_atomic_fetch_add((LAS unsigned*)(lds + CNT_OFF), 1u, __ATOMIC_RELAXED, __HIP_MEMORY_SCOPE_WORKGROUP);
                while (*ccnt < 4u * (unsigned)(g + 1)) __builtin_amdgcn_s_sleep(0);
                asm volatile("" ::: "memory");
                if (!(variant & 4))
#pragma unroll
                for (int cc = 0; cc < 4; ++cc) {
                    const int ch = 4 * g + cc; const bool emit = ch >= CTXL / 16;
                    const LAS unsigned char* slot = lds + ((g & 1) * 4 + cc) * SLOT;
                    const s16x4 aT = *(const LAS s16x4*)(slot + O_AT + lane * 8), anA4 = *(const LAS s16x4*)(slot + O_ANA4 + lane * 8);
                    const s16x4 aA1 = *(const LAS s16x4*)(slot + O_AA1 + lane * 8), aA3 = *(const LAS s16x4*)(slot + O_AA3 + lane * 8);
                    const s16x4 vcol = __builtin_amdgcn_ds_read_tr16_b64_v4i16((LAS s16x4*)(slot + O_V + trbase + ((j ^ trsw) << 5)));
                    const f32x4 z4 = (f32x4){0.f, 0.f, 0.f, 0.f};
                    f32x4 acc = mfma16(aA1, vcol, z4), accY = z4;
                    if (emit) accY = mfma16(aA3, vcol, z4);
#pragma unroll
                    for (int pr = 0; pr < 2; ++pr) {
                        const int o0 = fr * 128 + (((2 * pr) ^ rdsw) << 5) + rdq, o1 = fr * 128 + (((2 * pr + 1) ^ rdsw) << 5) + rdq;
                        const bf16x8 bz = cat8(pkbf(z[2 * pr]), pkbf(z[2 * pr + 1]));
                        const bf16x8 aq = cat8(*(const LAS s16x4*)(slot + O_KQ + o0), *(const LAS s16x4*)(slot + O_KQ + o1));
                        acc = __builtin_amdgcn_mfma_f32_16x16x32_bf16(aq, bz, acc, 0, 0, 0);
                        if (emit) { const bf16x8 ar = cat8(*(const LAS s16x4*)(slot + O_RQ + o0), *(const LAS s16x4*)(slot + O_RQ + o1));
                            accY = __builtin_amdgcn_mfma_f32_16x16x32_bf16(ar, bz, accY, 0, 0, 0); }
                    }
                    const f32x4 U = mfma16(aT, pkbf(acc), z4);
                    const s16x4 ub = pkbf(U);
                    if (emit) { accY = mfma16(anA4, ub, accY);
#pragma unroll
                        for (int r = 0; r < 4; ++r) Y[(size_t)step_row(ch, 4 * fq + r, b, d) * DM + h * 64 + 16 * j + fr] = (bf16_t)f2bf(accY[r]); }
                    const bf16x8 bvu = cat8(vcol, ub);
#pragma unroll
                    for (int kt = 0; kt < 4; ++kt) {
                        const int to = trbase + ((kt ^ trsw) << 5);
                        const bf16x8 ak = cat8(__builtin_amdgcn_ds_read_tr16_b64_v4i16((LAS s16x4*)(slot + O_KKP + to)), __builtin_amdgcn_ds_read_tr16_b64_v4i16((LAS s16x4*)(slot + O_NBKP + to)));
                        const f32x4 gcv = *(const LAS f32x4*)(slot + O_GC + (16 * kt + 4 * fq) * 4);
                        z[kt] = __builtin_amdgcn_mfma_f32_16x16x32_bf16(ak, bvu, z[kt] * gcv, 0, 0, 0);
                    }
                }
                __syncthreads();
            }
        }
    }
}

constexpr int RO_STRIDE = 2064;
__device__ __forceinline__ bf16x8 sigm8(bf16x8 x) {
    bf16x8 o;
#pragma unroll
    for (int j = 0; j < 8; ++j) o[j] = (short)f2bf(sigmoidf_(bf2f((unsigned short)x[j])));
    return o;
}
__device__ __forceinline__ void phase_readout(const Params& p, LAS unsigned char* lds, int G, int c, int wave, int lane) {
    const bf16_t* T1g = (const bf16_t*)(p.ws + WS_T1) + (size_t)2 * MT * 128; const bf16_t* G2T = (const bf16_t*)(p.ws + WS_G2T);
    const bf16_t* RB = (const bf16_t*)(p.ws + WS_RB); const bf16_t* KB = (const bf16_t*)(p.ws + WS_KB); const bf16_t* VB = (const bf16_t*)(p.ws + WS_VB);
    const float* BON0 = (const float*)(p.ws + WS_BON); const float* BON1 = BON0 + (size_t)ML * 16;
    const bf16_t* Y0 = (const bf16_t*)(p.ws + WS_Y0); const bf16_t* Y1 = (const bf16_t*)(p.ws + WS_Y1);
    bf16_t* Z = (bf16_t*)(p.ws + WS_Z);
    const int fr = lane & 15, fq = lane >> 4;
    for (int tile = c; tile < ML / 32; tile += G) {
        const int tok0 = tile * 32;
        bf16x8 xb[2][4];
#pragma unroll
        for (int tt = 0; tt < 2; ++tt)
#pragma unroll
            for (int ks = 0; ks < 4; ++ks) xb[tt][ks] = sigm8(*(const bf16x8*)(T1g + (size_t)(tok0 + tt * 16 + fr) * 128 + 32 * ks + 8 * fq));
#pragma unroll
        for (int ct = 0; ct < 8; ++ct) {
            const int ch0 = wave * 128 + ct * 16;
            const bf16_t* wr_ = G2T + (size_t)(ch0 + fr) * 128 + 8 * fq;
            f32x4 acc0 = (f32x4){0.f, 0.f, 0.f, 0.f}, acc1 = (f32x4){0.f, 0.f, 0.f, 0.f};
#pragma unroll
            for (int ks = 0; ks < 4; ++ks) { const bf16x8 wa = *(const bf16x8*)(wr_ + 32 * ks);
                acc0 = __builtin_amdgcn_mfma_f32_16x16x32_bf16(wa, xb[0][ks], acc0, 0, 0, 0);
                acc1 = __builtin_amdgcn_mfma_f32_16x16x32_bf16(wa, xb[1][ks], acc1, 0, 0, 0); }
            *(LAS u32x2*)(lds + (fr) * RO_STRIDE + (ch0 + 4 * fq) * 2) = pk4(acc0);
            *(LAS u32x2*)(lds + (16 + fr) * RO_STRIDE + (ch0 + 4 * fq) * 2) = pk4(acc1);
        }
        __syncthreads();
        for (int i = 0; i < 4; ++i) {
            const int tl = wave * 4 + i, row = tok0 + tl; const size_t o = (size_t)row * DM + 16 * lane;
            f32x4 y[4]; float s = 0.f;
#pragma unroll
            for (int q = 0; q < 4; ++q) { y[q] = unpk4(*(const u32x2*)(Y0 + o + 4 * q)) + unpk4(*(const u32x2*)(Y1 + o + 4 * q)); s += (y[q].x + y[q].y) + (y[q].z + y[q].w); }
            s += __shfl_xor(s, 1); s += __shfl_xor(s, 2);
            const float mean = s * (1.0f / 64.0f); float vs = 0.f;
#pragma unroll
            for (int q = 0; q < 4; ++q) { y[q] = y[q] - mean; vs += (y[q].x * y[q].x + y[q].y * y[q].y) + (y[q].z * y[q].z + y[q].w * y[q].w); }
            vs += __shfl_xor(vs, 1); vs += __shfl_xor(vs, 2);
            const float rstd = rsqf_(vs * (1.0f / 64.0f) + 64e-5f);
            f32x4 v4[4];
#pragma unroll
            for (int q = 0; q < 4; ++q) v4[q] = unpk4(*(const u32x2*)(VB + o + 4 * q));
            const float bs = BON0[(size_t)row * 16 + (lane >> 2)] + BON1[(size_t)row * 16 + (lane >> 2)];
#pragma unroll
            for (int q = 0; q < 4; ++q) {
                const int cc = 16 * lane + 4 * q;
                const f32x4 lw = *(const f32x4*)(p.in[I_LNW] + cc), lb = *(const f32x4*)(p.in[I_LNB] + cc);
                const f32x4 g4 = unpk4(*(const LAS u32x2*)(lds + tl * RO_STRIDE + cc * 2));
                const f32x4 z = ((y[q] * rstd) * lw + lb + v4[q] * bs) * g4;
                *(u32x2*)(Z + o + 4 * q) = pk4(z);
            }
        }
        __syncthreads();
    }
}

__device__ __forceinline__ void phase_final(const Params& p, int gw, int NGW, int lane) {
    const float* mod1 = (const float*)(p.ws + WS_MOD) + 9 * 6144;
    const bf16_t* X3 = (const bf16_t*)(p.ws + WS_X3); const int* tokslot = (const int*)(p.ws + WS_TOKSLOT); const bf16_t* Ys = (const bf16_t*)(p.ws + WS_YS1);
    const float* fg = p.in[I_FINALG];
    constexpr int R = 4;
    for (int row0 = gw * R; row0 < ML; row0 += NGW * R) {
        const int mr = row0 >> 11;
        f32x4 v[R][4];
#pragma unroll
        for (int r = 0; r < R; ++r) ld_row_bf16(X3 + (size_t)(row0 + r) * DM, lane, v[r]);
        f32x4 acc[R][4]; moe_gather_rows<R>(tokslot, Ys, SL1, row0, lane, acc);
        const float* gt2 = mod1 + (size_t)mr * 6144 + 5120;
        float ss[R];
#pragma unroll
        for (int r = 0; r < R; ++r) ss[r] = 0.f;
#pragma unroll
        for (int j = 0; j < 4; ++j) { const f32x4 g4 = *(const f32x4*)(gt2 + 256 * j + 4 * lane);
#pragma unroll
            for (int r = 0; r < R; ++r) { v[r][j] = v[r][j] + g4 * acc[r][j]; ss[r] += (v[r][j].x * v[r][j].x + v[r][j].y * v[r][j].y) + (v[r][j].z * v[r][j].z + v[r][j].w * v[r][j].w); } }
#pragma unroll
        for (int o = 1; o < 64; o <<= 1) {
#pragma unroll
            for (int r = 0; r < R; ++r) ss[r] += __shfl_xor(ss[r], o); }
#pragma unroll
        for (int j = 0; j < 4; ++j) { const f32x4 f4 = *(const f32x4*)(fg + 256 * j + 4 * lane);
#pragma unroll
            for (int r = 0; r < R; ++r) v[r][j] = (v[r][j] * rsqf_(ss[r] * (1.0f / DM) + 1e-6f)) * f4; }
#pragma unroll
        for (int r = 0; r < R; ++r) st_row_f32(p.out + (size_t)(row0 + r) * DM, lane, v[r]);
    }
}

constexpr int NPH = 22;
__global__ void __launch_bounds__(512, 2) mega_fwd(Params p) {
    extern __shared__ __attribute__((aligned(16))) unsigned char lds_raw[];
    LAS unsigned char* lds = (LAS unsigned char*)lds_raw;
    const int tid = threadIdx.x, wave = __builtin_amdgcn_readfirstlane(tid >> 6);
    const int G = gridDim.x, bx = blockIdx.x, vcu = (G % 8 == 0) ? (bx % 8) * (G / 8) + bx / 8 : bx;
    const int gw = vcu * 8 + wave, NGW = G * 8;
    for (int u = tid; u < (LDS_BYTES - LDSCTL_OFF) / 4; u += 512) ((LAS unsigned*)(lds + LDSCTL_OFF))[u] = 0u;
    __syncthreads();
    const int lo = p.ph_lo, hi = p.ph_hi;
    XcdBarrier bar; bar.bar = (unsigned*)(p.ws + WS_CTL) + CTL_BAR_WORD; bar.x = 0; bar.st = (volatile LAS unsigned*)(lds + MISC_OFF + 32);
    if (hi - lo > 1) bar = xcd_barrier_post((unsigned*)(p.ws + WS_CTL) + CTL_BAR_WORD, (volatile LAS unsigned*)(lds + MISC_OFF + 32));
#ifndef PHMASK
#define PHMASK 0x3fffff
#endif
#define IN(k) (((PHMASK >> (k)) & 1) && lo <= (k) && (k) < hi)
#define SEAM(k) do { if (IN(k) && IN((k) + 1)) xcd_barrier(bar); } while (0)
#ifndef SCANVAR
#define SCANVAR 0
#endif
#ifndef FILLMASK
#define FILLMASK 0
#endif
#ifndef DUPMASK
#ifndef CONVDUP
#define CONVDUP 0
#endif
#ifndef GEMMDUP
#define GEMMDUP 0
#endif
#define CDUP(n) ((CONVDUP >> (n)) & 1)
#define GDUP(n) ((GEMMDUP >> (n)) & 1)
#define DUPMASK 0
#endif
#define DUP(k) (((DUPMASK >> (k)) & 1) != 0)
    unsigned char* ws = p.ws;
#define ctlw ((unsigned*)(p.ws + WS_CTL))
#define gate1_l0 ((const float*)(ws + WS_MOD) + 2048)
#define gate1_l1 ((const float*)(ws + WS_MOD) + 9 * 6144 + 2048)

#define LANE_ (TID_ & 63)
    if (IN(0)) for (int rep_ = 0; rep_ < (DUP(0) ? 2 : 1); ++rep_) { if (rep_) xcd_barrier(bar); phase_prep(p, lds, gw, NGW, wave, LANE_, rep_ != 0); }
    SEAM(0);
    if (IN(1)) for (int rep_ = 0; rep_ < (DUP(1) ? 2 : 1); ++rep_) { if (rep_) xcd_barrier(bar); phase_prenorm0(p, gw, NGW, LANE_); }
    SEAM(1);
    if (IN(2)) { const int rep_ = (DUP(2) || GDUP(2)) ? 2 : 1;
        const bool split = (G > P2_GEMM_WGS) && P2_CONV_ITEMS > 0;
        if (!split || bx < P2_GEMM_WGS) { OrderSingle S; S.init(ws + WS_H, ws + WS_WIN_T, MT, PROJ, 1024, split ? P2_GEMM_WGS : G, bx, rep_); EpiStore E{(bf16_t*)(ws + WS_P), PROJ}; pg8::gemm_phase(lds, 1024, S, E); }
        if (!split || bx >= P2_GEMM_WGS) { if (!split) __syncthreads(); LAS float* scr = (LAS float*)(lds + wave * 16896); const int ncw = split ? (G - P2_GEMM_WGS) * 8 : NGW, cw = split ? (bx - P2_GEMM_WGS) * 8 + wave : gw; for (int rr = 0; rr < ((DUP(2) || CDUP(2)) ? 2 : 1); ++rr) for (int it = BIG_WIN + cw; it < BIG_SMALL_END + P2_CONV_ITEMS; it += ncw) big_convert_item(p, it, scr, LANE_); } if (FILLMASK & 1) moe_fill(p, lds, 0, ctlw + CTL_Q0, ctlw + CTL_DONE, G, wave, LANE_); }
    SEAM(2);
    if (IN(3)) for (int rep_ = 0; rep_ < (DUP(3) ? 2 : 1); ++rep_) { if (rep_) xcd_barrier(bar); phase_qkconv(p, gw, NGW, LANE_); }
    SEAM(3);
    if (IN(4)) for (int rep_ = 0; rep_ < (DUP(4) ? 2 : 1); ++rep_) { if (rep_) xcd_barrier(bar); phase_attention(p, lds, G, vcu); if (FILLMASK & 2) moe_fill(p, lds, 0, ctlw + CTL_Q0, ctlw + CTL_DONE + 64, G, wave, LANE_); }
    SEAM(4);
    if (IN(5)) { const int rep_ = (DUP(5) || GDUP(5)) ? 2 : 1;
        const bool split = (G > P5_GEMM_WGS) && P5_CONV_ITEMS > 0;
        if (!split || bx < P5_GEMM_WGS) { OrderSingle S; S.init(ws + WS_AO, ws + WS_WOUT_T, MT, 1024, 2048, split ? P5_GEMM_WGS : G, bx, rep_); EpiResid<false> E{p.in[I_X], p.in[I_CTX], (bf16_t*)(ws + WS_X1), gate1_l0}; pg8::gemm_phase(lds, 2048, S, E); }
        if (!split || bx >= P5_GEMM_WGS) { if (!split) __syncthreads(); LAS float* scr = (LAS float*)(lds + wave * 16896); const int ncw = split ? (G - P5_GEMM_WGS) * 8 : NGW, cw = split ? (bx - P5_GEMM_WGS) * 8 + wave : gw; for (int rr = 0; rr < ((DUP(5) || CDUP(5)) ? 2 : 1); ++rr) for (int it = P2_CONV_ITEMS + cw; it < P5_CONV_ITEMS; it += ncw) moe_convert_item(p, 0, it, scr, LANE_); } if (FILLMASK & 4) moe_fill(p, lds, 0, ctlw + CTL_Q0, ctlw + CTL_DONE + 128, G, wave, LANE_); }
    SEAM(5);
    if (IN(6)) for (int rep_ = 0; rep_ < (DUP(6) ? 2 : 1); ++rep_) { if (rep_) xcd_barrier(bar); phase_moe_prenorm(p, lds, 0, (const bf16_t*)(ws + WS_X1), MT, (bf16_t*)(ws + WS_H), gw, NGW, LANE_); }
    SEAM(6);
    if (IN(7)) for (int rep_ = 0; rep_ < (DUP(7) ? 2 : 1); ++rep_) { if (rep_) xcd_barrier(bar); phase_select(p, lds, 256, SL0, G, bx, wave, LANE_); }
    SEAM(7);
    if (IN(8)) { const int rep_ = (DUP(8) || GDUP(8)) ? 2 : 1; const bool split = G > P8_GEMM_WGS; if (!split || vcu < P8_GEMM_WGS) { OrderMoe S; S.init(ws + WS_H, ws + WS_WGU_T, 9, 8, 1024, split ? P8_GEMM_WGS : G, vcu, rep_); S.rowidx = (const int*)(ws + WS_SELROW); EpiAct E{(bf16_t*)(ws + WS_ACT0)}; pg8::gemm_phase<EpiAct, OrderMoe, true>(lds, 1024, S, E); } if (!split || vcu >= P8_GEMM_WGS) { if (!split) __syncthreads(); LAS float* scr = (LAS float*)(lds + wave * 16896); const int ncw = split ? (G - P8_GEMM_WGS) * 8 : NGW, cw = split ? (vcu - P8_GEMM_WGS) * 8 + wave : gw; for (int rr = 0; rr < ((DUP(8) || CDUP(8)) ? 2 : 1); ++rr) for (int it = 0 + cw; it < L1_A; it += ncw) moe_convert_item(p, 1, it, scr, LANE_); } }
    SEAM(8);
    if (IN(9)) { const int rep_ = (DUP(9) || GDUP(9)) ? 2 : 1; const bool split = G > P9_GEMM_WGS; if (!split || vcu < P9_GEMM_WGS) { OrderMoe S; S.init(ws + WS_ACT0, ws + WS_WD_T, 9, 4, 1024, split ? P9_GEMM_WGS : G, vcu, rep_); EpiYs E{(bf16_t*)(ws + WS_YS0), (const float*)(ws + WS_SELAFF)}; pg8::gemm_phase(lds, 1024, S, E); } if (!split || vcu >= P9_GEMM_WGS) { if (!split) __syncthreads(); LAS float* scr = (LAS float*)(lds + wave * 16896); const int ncw = split ? (G - P9_GEMM_WGS) * 8 : NGW, cw = split ? (vcu - P9_GEMM_WGS) * 8 + wave : gw; for (int rr = 0; rr < ((DUP(9) || CDUP(9)) ? 2 : 1); ++rr) for (int it = L1_A + cw; it < L1_B; it += ncw) moe_convert_item(p, 1, it, scr, LANE_); } }
    SEAM(9);
    if (IN(10)) for (int rep_ = 0; rep_ < (DUP(10) ? 2 : 1); ++rep_) { if (rep_) xcd_barrier(bar); phase_combine_mix(p, lds, G, vcu, wave, LANE_); }
    SEAM(10);
    if (IN(11) && IN(12) && !IN(10)) { }
    if (IN(12)) { const int rep_ = (DUP(12) || GDUP(12)) ? 2 : 1; const bool split = G > P12_GEMM_WGS; if (!split || vcu < P12_GEMM_WGS) { OrderRkv S; S.A0 = (const char*)(ws + WS_XR); S.A1 = (const char*)(ws + WS_XK); S.A2 = (const char*)(ws + WS_XV); S.A3 = (const char*)(ws + WS_XW); S.A4 = (const char*)(ws + WS_XA); S.A5 = (const char*)(ws + WS_XG);
        S.B0 = (const char*)(ws + WS_WR_T); S.B1 = (const char*)(ws + WS_WK_T); S.B2 = (const char*)(ws + WS_WV_T); S.B3 = (const char*)(ws + WS_WL1_T); S.G = split ? P12_GEMM_WGS : G; S.c = vcu; S.rep = rep_;
        EpiRkv E{(bf16_t*)(ws + WS_RB), (bf16_t*)(ws + WS_KB), (bf16_t*)(ws + WS_VB), (bf16_t*)(ws + WS_T1)}; pg8::gemm_phase(lds, 1024, S, E); } if (!split || vcu >= P12_GEMM_WGS) { if (!split) __syncthreads(); LAS float* scr = (LAS float*)(lds + wave * 16896); const int ncw = split ? (G - P12_GEMM_WGS) * 8 : NGW, cw = split ? (vcu - P12_GEMM_WGS) * 8 + wave : gw; for (int rr = 0; rr < ((DUP(12) || CDUP(12)) ? 2 : 1); ++rr) for (int it = L1_B + cw; it < L1_C; it += ncw) moe_convert_item(p, 1, it, scr, LANE_); } }
    SEAM(12);
    if (IN(13)) for (int rep_ = 0; rep_ < (DUP(13) ? 2 : 1); ++rep_) { if (rep_) xcd_barrier(bar);   }
    SEAM(13);
    if (IN(14)) for (int rep_ = 0; rep_ < (DUP(14) ? 2 : 1); ++rep_) { if (rep_) xcd_barrier(bar); phase_scan(p, lds, G, bx, wave, LANE_, rep_ ? SCANVAR : 0); }
    SEAM(14);
    if (IN(15)) for (int rep_ = 0; rep_ < (DUP(15) ? 2 : 1); ++rep_) { if (rep_) xcd_barrier(bar); phase_readout(p, lds, G, vcu, wave, LANE_); }
    SEAM(15);
    if (IN(16)) { const int rep_ = (DUP(16) || GDUP(16)) ? 2 : 1; OrderSingle S; S.init(ws + WS_Z, ws + WS_WO_T, ML, 1024, 1024, G, bx, rep_); EpiResid<true> E{ws + WS_X2, ws + WS_X2, (bf16_t*)(ws + WS_X3), gate1_l1}; pg8::gemm_phase(lds, 1024, S, E); }
    SEAM(16);
    if (IN(17)) for (int rep_ = 0; rep_ < (DUP(17) ? 2 : 1); ++rep_) { if (rep_) xcd_barrier(bar); phase_moe_prenorm(p, lds, 1, (const bf16_t*)(ws + WS_X3), ML, (bf16_t*)(ws + WS_H2), gw, NGW, LANE_);
        __syncthreads();
        LAS float* scr = (LAS float*)(lds + wave * 16896);
        for (int it = L1_C + gw; it < P0_NMOE; it += NGW) moe_convert_item(p, 1, it, scr, LANE_); }
    SEAM(17);
    if (IN(18)) for (int rep_ = 0; rep_ < (DUP(18) ? 2 : 1); ++rep_) { if (rep_) xcd_barrier(bar); phase_select(p, lds, 128, SL1, G, bx, wave, LANE_); }
    SEAM(18);
    if (IN(19)) { const int rep_ = (DUP(19) || GDUP(19)) ? 2 : 1; OrderMoe S; S.init(ws + WS_H2, ws + WS_WGU1, 8, 8, 1024, G, vcu, rep_); S.rowidx = (const int*)(ws + WS_SELROW); EpiAct E{(bf16_t*)(ws + WS_ACT1)}; pg8::gemm_phase<EpiAct, OrderMoe, true>(lds, 1024, S, E); }
    SEAM(19);
    if (IN(20)) { const int rep_ = (DUP(20) || GDUP(20)) ? 2 : 1; OrderMoe S; S.init(ws + WS_ACT1, ws + WS_WD1, 8, 4, 1024, G, vcu, rep_); EpiYs E{(bf16_t*)(ws + WS_YS1), (const float*)(ws + WS_SELAFF)}; pg8::gemm_phase(lds, 1024, S, E); }
    SEAM(20);
    if (IN(21)) for (int rep_ = 0; rep_ < (DUP(21) ? 2 : 1); ++rep_) { if (rep_) xcd_barrier(bar); phase_final(p, gw, NGW, LANE_); }
#undef IN
#undef SEAM
}

#ifndef MK_PER_PHASE
#define MK_PER_PHASE 0
#endif
extern "C" void kernel_launch(void* const* d_in, const int* in_sizes, int n_in, void* d_out, int out_size, void* d_ws, size_t ws_size, hipStream_t stream) {
    static int grid = 0;
    if (grid == 0) {
        if (n_in != 35 || out_size != ML * DM || ws_size < WS_END) { fprintf(stderr, "kernel_launch: unexpected shapes: n_in %d out %d ws %zu (need %zu)\n", n_in, out_size, ws_size, (size_t)WS_END); grid = -1; return; }
        int dev = 0, cus = 0;
        if (hipGetDevice(&dev) != hipSuccess || hipDeviceGetAttribute(&cus, hipDeviceAttributeMultiprocessorCount, dev) != hipSuccess) { grid = -1; return; }
        if (hipFuncSetAttribute((const void*)mega_fwd, hipFuncAttributeMaxDynamicSharedMemorySize, LDS_BYTES) != hipSuccess) { fprintf(stderr, "kernel_launch: hipFuncSetAttribute failed\n"); grid = -1; return; }
        int per_cu = 0; (void)hipOccupancyMaxActiveBlocksPerMultiprocessor(&per_cu, (const void*)mega_fwd, 512, LDS_BYTES); (void)hipGetLastError();
        if (per_cu < 1) fprintf(stderr, "kernel_launch: occupancy query reports %d blocks per CU\n", per_cu);
        grid = cus;
    }
    if (grid < 0) return;
    (void)in_sizes;
    (void)hipMemsetAsync((char*)d_ws + WS_CTL, 0, 1 * MiB, stream);
    Params a{};
    for (int i = 0; i < 35; ++i) a.in[i] = (const float*)d_in[i];
    a.out = (float*)d_out; a.ws = (unsigned char*)d_ws;
#if MK_PER_PHASE
    for (int ph = 0; ph < NPH; ++ph) { a.ph_lo = ph; a.ph_hi = ph + 1; hipLaunchKernelGGL(mega_fwd, dim3(grid), dim3(512), LDS_BYTES, stream, a); }
#else
    a.ph_lo = 0; a.ph_hi = NPH; hipLaunchKernelGGL(mega_fwd, dim3(grid), dim3(512), LDS_BYTES, stream, a);
#endif
    const hipError_t le = hipPeekAtLastError();
    if (le != hipSuccess) fprintf(stderr, "kernel_launch: launch failed: %s\n", hipGetErrorName(le));
}
```
